# Optimizing an MI355X kernel written in HIP

```python
import math
import jax, jax.numpy as jnp
from jax import lax
import numpy as np

D_MODEL = 1024
BATCH = 8
SEQ = 4096
DEPTH = 1

CHUNK = 64
Q_BLOCK = 128
HEAD_DIM = 64
ROT_DIM = HEAD_DIM // 4
ROPE_THETA = 500000.0
RMS_EPS = 1e-6
A_HEADS = 4
A_QK_DIM = HEAD_DIM
A_V_DIM = 2 * HEAD_DIM
A_WIDTH = A_HEADS * A_V_DIM
B_HEADS = 8
B_QK_DIM = HEAD_DIM
B_LATENT = 128
B_OUT_DIM = HEAD_DIM
B_WIDTH = B_HEADS * B_OUT_DIM
IDX_HEADS = 8
IDX_DIM = 64
IDX_TOPK_MAX = 256
MIX_WIDTH = A_WIDTH + B_WIDTH
IN_SIZES = (A_HEADS * A_QK_DIM, A_HEADS * A_QK_DIM, A_HEADS * A_QK_DIM, A_HEADS * A_QK_DIM,
            A_HEADS * A_V_DIM,
            B_HEADS * B_QK_DIM, B_QK_DIM, B_LATENT, IDX_HEADS * IDX_DIM, IDX_DIM, IDX_HEADS)
N_IN = sum(IN_SIZES)
N_EXPERTS = 32
TOP_K = 4
D_FF = D_MODEL
SWIGLU_LIMIT = 7.0
SWIGLU_ALPHA = 1.702
EXPERT_BLOCK = 256

kernel_name = "hybrid_diffattn_dsa_moe_block"


def rms_norm(x, g):
    xf = x.astype(jnp.float32)
    y = xf * lax.rsqrt(jnp.mean(xf * xf, axis=-1, keepdims=True) + RMS_EPS)
    return (y * g.astype(jnp.float32)).astype(x.dtype)


def rope_tables(S):
    pos = jnp.arange(S, dtype=jnp.float32)
    inv = ROPE_THETA ** (-jnp.arange(0, ROT_DIM, 2, dtype=jnp.float32) / ROT_DIM)
    ang = pos[:, None] * inv[None, :]
    return jnp.cos(ang), jnp.sin(ang)


def apply_partial_rope(x, cos, sin):
    half = ROT_DIM // 2
    shape = (1, x.shape[1]) + (1,) * (x.ndim - 3) + (half,)
    cs, sn = cos.reshape(shape), sin.reshape(shape)
    xr = x[..., :ROT_DIM].astype(jnp.float32)
    x1, x2 = xr[..., :half], xr[..., half:]
    rot = jnp.concatenate([x1 * cs - x2 * sn, x2 * cs + x1 * sn], axis=-1)
    return jnp.concatenate([rot.astype(x.dtype), x[..., ROT_DIM:]], axis=-1)


def to_blocks(t):
    B, S = t.shape[:2]
    return jnp.moveaxis(t.reshape((B, S // Q_BLOCK, Q_BLOCK) + t.shape[2:]), 1, 0)


def from_blocks(t):
    nb, B, qb = t.shape[:3]
    return jnp.moveaxis(t, 0, 1).reshape((B, nb * qb) + t.shape[3:])


def diff_attention(q1, q2, k1, k2, v, lam_vecs, sub_g, lambda_init):
    B, S = q1.shape[:2]
    lv = lam_vecs.astype(jnp.float32)
    lam = jnp.exp(jnp.sum(lv[0] * lv[1])) - jnp.exp(jnp.sum(lv[2] * lv[3])) + lambda_init
    key_chunk = jnp.arange(S) // CHUNK
    scale = A_QK_DIM ** -0.5

    def block(args):
        q1b, q2b, i = args
        q_chunk = (i * Q_BLOCK + jnp.arange(Q_BLOCK)) // CHUNK
        allowed = key_chunk[None, :] <= q_chunk[:, None]

        def probs(qb, k):
            s = jnp.einsum('bqhd,bshd->bhqs', qb, k).astype(jnp.float32) * scale
            return jax.nn.softmax(jnp.where(allowed, s, -jnp.inf), axis=-1)

        a = probs(q1b, k1) - lam * probs(q2b, k2)
        return jnp.einsum('bhqs,bshe->bqhe', a.astype(v.dtype), v)

    nqb = S // Q_BLOCK
    o = from_blocks(lax.map(block, (to_blocks(q1), to_blocks(q2), jnp.arange(nqb))))
    o = rms_norm(o, sub_g) * (1.0 - lambda_init)
    return o.reshape(B, S, A_WIDTH)


def dsa_attention(q, k, lat, iq, ik, iw, w_uv):
    B, S = q.shape[:2]
    topk = min(IDX_TOPK_MAX, S // 4)
    key_chunk = jnp.arange(S) // CHUNK
    scale = B_QK_DIM ** -0.5
    iw = iw.astype(jnp.float32) * (IDX_HEADS ** -0.5) * (IDX_DIM ** -0.5)
    gather = jax.vmap(lambda arr, idx: arr[idx])

    def block(args):
        qb, iqb, iwb, i = args
        q_chunk = (i * Q_BLOCK + jnp.arange(Q_BLOCK)) // CHUNK
        allowed = key_chunk[None, :] <= q_chunk[:, None]
        rel = jax.nn.relu(jnp.einsum('bqhd,bsd->bqhs', iqb, ik).astype(jnp.float32))
        score = jnp.einsum('bqhs,bqh->bqs', rel, iwb)
        score = jnp.where(allowed[None], score, -jnp.inf)
        _, idx = lax.top_k(score, topk)
        valid = (idx // CHUNK) <= q_chunk[None, :, None]
        flat = idx.reshape(B, Q_BLOCK * topk)
        k_sel = gather(k, flat).reshape(B, Q_BLOCK, topk, B_QK_DIM)
        v_sel = gather(lat, flat).reshape(B, Q_BLOCK, topk, B_LATENT)
        s = jnp.einsum('bqhd,bqkd->bqhk', qb, k_sel).astype(jnp.float32) * scale
        p = jax.nn.softmax(jnp.where(valid[:, :, None, :], s, -jnp.inf), axis=-1)
        return jnp.einsum('bqhk,bqkc->bqhc', p.astype(v_sel.dtype), v_sel)

    nqb = S // Q_BLOCK
    o = from_blocks(lax.map(block, (to_blocks(q), to_blocks(iq), to_blocks(iw), jnp.arange(nqb))))
    o = jnp.einsum('bshc,hcd->bshd', o, w_uv)
    return o.reshape(B, S, B_WIDTH)


def moe(h, router_w, router_b, w_gate, b_gate, w_up, b_up, w_down, b_down):
    B, S, D = h.shape
    T = B * S
    P = T * TOP_K
    G = EXPERT_BLOCK
    hf = h.reshape(T, D)
    logits = (hf @ router_w + router_b).astype(jnp.float32)
    top_vals, top_idx = lax.top_k(logits, TOP_K)
    gates = jax.nn.softmax(top_vals, axis=-1)
    e_flat = top_idx.reshape(P)
    g_flat = gates.reshape(P)
    tok = jnp.arange(P) // TOP_K
    order = jnp.argsort(e_flat, stable=True)
    e_s, tok_s, g_s = e_flat[order], tok[order], g_flat[order]
    counts = jnp.bincount(e_flat, length=N_EXPERTS)
    padded = ((counts + G - 1) // G) * G
    off = jnp.cumsum(counts) - counts
    pcum = jnp.cumsum(padded)
    poff = pcum - padded
    dest = poff[e_s] + (jnp.arange(P) - off[e_s])
    nb = -(-P // G) + N_EXPERTS
    xbuf = jnp.zeros((nb * G, D), hf.dtype).at[dest].set(hf[tok_s])
    block_expert = jnp.minimum(jnp.searchsorted(pcum, jnp.arange(nb) * G, side='right'), N_EXPERTS - 1)

    def expert_block(args):
        xb, e = args
        g = xb @ w_gate[e] + b_gate[e]
        u = xb @ w_up[e] + b_up[e]
        g = jnp.minimum(g, SWIGLU_LIMIT)
        u = jnp.clip(u, -SWIGLU_LIMIT, SWIGLU_LIMIT)
        a = g * jax.nn.sigmoid(SWIGLU_ALPHA * g) * (u + 1.0)
        return a @ w_down[e] + b_down[e]

    ybuf = lax.map(expert_block, (xbuf.reshape(nb, G, D), block_expert)).reshape(nb * G, D)
    contrib = ybuf[dest].astype(jnp.float32) * g_s[:, None]
    y = jax.ops.segment_sum(contrib, tok_s, num_segments=T)
    return y.astype(h.dtype).reshape(B, S, D)


def setup_inputs(seed: int = 0) -> dict:
    key = jax.random.key(seed)
    ks = jax.random.split(key, 24)

    def nrm(k, shape, scale):
        return jax.random.normal(k, shape, jnp.float32) * scale

    D = D_MODEL
    return {
        "x": nrm(ks[0], (BATCH, SEQ, D), 1.0),
        "c": nrm(ks[1], (BATCH, D), 1.0),
        "norm1_g": 1.0 + nrm(ks[2], (DEPTH, D), 0.02),
        "norm2_g": 1.0 + nrm(ks[3], (DEPTH, D), 0.02),
        "w_ada": nrm(ks[4], (DEPTH, D, 6 * D), D ** -0.5),
        "b_ada": nrm(ks[5], (DEPTH, 6 * D), 0.02),
        "w_in": nrm(ks[6], (DEPTH, D, N_IN), D ** -0.5),
        "w_out": nrm(ks[7], (DEPTH, MIX_WIDTH, D), MIX_WIDTH ** -0.5),
        "a_q_norm_g": 1.0 + nrm(ks[8], (DEPTH, A_QK_DIM), 0.02),
        "a_k_norm_g": 1.0 + nrm(ks[9], (DEPTH, A_QK_DIM), 0.02),
        "a_lambda": nrm(ks[10], (DEPTH, 4, A_QK_DIM), 0.1),
        "a_sub_g": 1.0 + nrm(ks[11], (DEPTH, A_V_DIM), 0.02),
        "b_q_norm_g": 1.0 + nrm(ks[12], (DEPTH, B_QK_DIM), 0.02),
        "b_k_norm_g": 1.0 + nrm(ks[13], (DEPTH, B_QK_DIM), 0.02),
        "b_kv_norm_g": 1.0 + nrm(ks[14], (DEPTH, B_LATENT), 0.02),
        "b_w_uv": nrm(ks[15], (DEPTH, B_HEADS, B_LATENT, B_OUT_DIM), B_LATENT ** -0.5),
        "router_w": nrm(ks[16], (DEPTH, D, N_EXPERTS), D ** -0.5),
        "router_b": nrm(ks[17], (DEPTH, N_EXPERTS), 0.01),
        "w_gate": nrm(ks[18], (DEPTH, N_EXPERTS, D, D_FF), D ** -0.5),
        "b_gate": nrm(ks[19], (DEPTH, N_EXPERTS, D_FF), 0.01),
        "w_up": nrm(ks[20], (DEPTH, N_EXPERTS, D, D_FF), D ** -0.5),
        "b_up": nrm(ks[21], (DEPTH, N_EXPERTS, D_FF), 0.01),
        "w_down": nrm(ks[22], (DEPTH, N_EXPERTS, D_FF, D), D_FF ** -0.5),
        "b_down": nrm(ks[23], (DEPTH, N_EXPERTS, D), 0.01),
    }


def reference(x, c, norm1_g, norm2_g, w_ada, b_ada, w_in, w_out, a_q_norm_g, a_k_norm_g,
              a_lambda, a_sub_g, b_q_norm_g, b_k_norm_g, b_kv_norm_g, b_w_uv, router_w, router_b,
              w_gate, b_gate, w_up, b_up, w_down, b_down):
    B, S, D = x.shape
    cos, sin = rope_tables(S)
    split_pts = [int(v) for v in np.cumsum(IN_SIZES)[:-1]]
    for l in range(DEPTH):
        lambda_init = 0.8 - 0.6 * math.exp(-0.3 * l)
        mod = jax.nn.silu(c) @ w_ada[l] + b_ada[l]
        sh1, sc1, g1, sh2, sc2, g2 = jnp.split(mod[:, None, :], 6, axis=-1)

        h = rms_norm(x, norm1_g[l]) * (1.0 + sc1) + sh1
        proj = h @ w_in[l]
        aq1, aq2, ak1, ak2, av, bq, bk, blat, iq, ik, iw = jnp.split(proj, split_pts, axis=-1)

        def a_heads(t, g):
            t = rms_norm(t.reshape(B, S, A_HEADS, A_QK_DIM), g)
            return apply_partial_rope(t, cos, sin)

        a_out = diff_attention(a_heads(aq1, a_q_norm_g[l]), a_heads(aq2, a_q_norm_g[l]),
                               a_heads(ak1, a_k_norm_g[l]), a_heads(ak2, a_k_norm_g[l]),
                               av.reshape(B, S, A_HEADS, A_V_DIM), a_lambda[l], a_sub_g[l],
                               lambda_init)

        bq = apply_partial_rope(rms_norm(bq.reshape(B, S, B_HEADS, B_QK_DIM), b_q_norm_g[l]), cos, sin)
        bk = apply_partial_rope(rms_norm(bk, b_k_norm_g[l]), cos, sin)
        blat = rms_norm(blat, b_kv_norm_g[l])
        iq = apply_partial_rope(iq.reshape(B, S, IDX_HEADS, IDX_DIM), cos, sin)
        ik = apply_partial_rope(ik, cos, sin)
        b_out = dsa_attention(bq, bk, blat, iq, ik, iw, b_w_uv[l])

        mix = jnp.concatenate([a_out, b_out], axis=-1) @ w_out[l]
        x = x + g1 * mix

        h2 = rms_norm(x, norm2_g[l]) * (1.0 + sc2) + sh2
        x = x + g2 * moe(h2, router_w[l], router_b[l], w_gate[l], b_gate[l], w_up[l], b_up[l],
                         w_down[l], b_down[l])
    return x
```

```cpp
#include <hip/hip_runtime.h>
#include <stdint.h>
#include <cstdio>

typedef unsigned short bf16_t;
__device__ __forceinline__ float bf2f(bf16_t v) { return __uint_as_float(((unsigned)v) << 16); }
__device__ __forceinline__ bf16_t f2bf(float f) { unsigned u = __float_as_uint(f); return (bf16_t)((u + 0x7fffu + ((u >> 16) & 1u)) >> 16); }

constexpr int NB = 8, SEQ = 4096, DM = 1024, NTOK = NB * SEQ;
constexpr int NIN = 2824, NPJ = 2816;
constexpr int C_AQ1 = 0, C_AQ2 = 256, C_AK1 = 512, C_AK2 = 768, C_AV = 1024, C_BQ = 1536, C_BK = 2048, C_BLAT = 2112, C_IQ = 2240, C_IK = 2752, C_IW = 2816;
constexpr int NEXP = 32, TOPK = 4, NPAIR = NTOK * TOPK;
constexpr int MAXTILES = NPAIR / 256 + NEXP;
constexpr int PPAD = MAXTILES * 256;
constexpr int NCHUNK = 256, CHTOK = NTOK / NCHUNK;
constexpr float RMS_EPS = 1e-6f;
constexpr float LAMBDA_INIT = 0.2f;

constexpr size_t MiB = 1u << 20;
constexpr size_t WS_CTL = 0;
constexpr size_t WS_MOD = 1 * MiB;
constexpr size_t WS_ROPE = WS_MOD + 256 * 1024;
constexpr size_t WS_LAM = WS_ROPE + 256 * 1024;
constexpr size_t WS_CHCNT = WS_LAM + 4096;
constexpr size_t WS_TILEE = WS_CHCNT + 32768;
constexpr size_t WS_TOPI = 2 * MiB;
constexpr size_t WS_TOPG = WS_TOPI + 512 * 1024;
constexpr size_t WS_ROWTOK = 3 * MiB;
constexpr size_t WS_ROWSRC = 3 * MiB + 640 * 1024;
constexpr size_t WS_IW = 5 * MiB;
constexpr size_t WS_WINT = 8 * MiB;
constexpr size_t WS_WOUTT = 14 * MiB;
constexpr size_t WS_WUVT = 16 * MiB;
constexpr size_t WS_WDT = 17 * MiB;
constexpr size_t WS_WGUT = 81 * MiB;
constexpr size_t WS_H = 209 * MiB;
constexpr size_t WS_PROJ = 273 * MiB;
constexpr size_t WS_ACT = WS_PROJ;
constexpr size_t WS_Y = WS_WGUT;
constexpr size_t WS_END = WS_ACT + (size_t)PPAD * 1024 * 2;

__device__ __forceinline__ float block_sum_256(float v, float* red) {
#pragma unroll
    for (int o = 32; o > 0; o >>= 1) v += __shfl_xor(v, o);
    const int w = threadIdx.x >> 6;
    __syncthreads();
    if ((threadIdx.x & 63) == 0) red[w] = v;
    __syncthreads();
    return red[0] + red[1] + red[2] + red[3];
}
__device__ __forceinline__ float block_max_256(float v, float* red) {
#pragma unroll
    for (int o = 32; o > 0; o >>= 1) v = fmaxf(v, __shfl_xor(v, o));
    const int w = threadIdx.x >> 6;
    __syncthreads();
    if ((threadIdx.x & 63) == 0) red[w] = v;
    __syncthreads();
    return fmaxf(fmaxf(red[0], red[1]), fmaxf(red[2], red[3]));
}

__global__ __launch_bounds__(256) void nv_prep(float* rope, float* lam, const float* a_lambda) {
    const int i = blockIdx.x * 256 + threadIdx.x;
    if (i < SEQ * 8) {
        const int pos = i >> 3, f = i & 7;
        const float inv = (float)exp(-(double)f / 8.0 * log(500000.0));
        const float ang = (float)pos * inv;
        double a = (double)ang;
        const double TWO_PI = 6.283185307179586476925287;
        double k = rint(a / TWO_PI);
        double r = a - k * TWO_PI;
        double r2 = r * r, s = 0.0, c = 0.0;
        double ts = r, tc = 1.0;
        for (int n = 0; n < 14; ++n) {
            s += ts; c += tc;
            ts *= -r2 / (double)((2 * n + 2) * (2 * n + 3));
            tc *= -r2 / (double)((2 * n + 1) * (2 * n + 2));
        }
        rope[i * 2 + 0] = (float)c;
        rope[i * 2 + 1] = (float)s;
    }
    if (i == 0) {
        float d01 = 0.f, d23 = 0.f;
        for (int j = 0; j < 64; ++j) { d01 += a_lambda[j] * a_lambda[64 + j]; d23 += a_lambda[128 + j] * a_lambda[192 + j]; }
        lam[0] = expf(d01) - expf(d23) + LAMBDA_INIT;
    }
}

__global__ __launch_bounds__(256) void nv_mod(const float* c, const float* w_ada, const float* b_ada, float* mod) {
    __shared__ float sc[8 * 1024];
    for (int i = threadIdx.x; i < 8 * 1024; i += 256) { const float v = c[i]; sc[i] = v / (1.f + expf(-v)); }
    __syncthreads();
    const int j = blockIdx.x * 256 + threadIdx.x;
    float acc[8];
#pragma unroll
    for (int b = 0; b < 8; ++b) acc[b] = 0.f;
    for (int k = 0; k < 1024; ++k) {
        const float w = w_ada[(size_t)k * 6144 + j];
#pragma unroll
        for (int b = 0; b < 8; ++b) acc[b] += sc[b * 1024 + k] * w;
    }
#pragma unroll
    for (int b = 0; b < 8; ++b) mod[b * 6144 + j] = acc[b] + b_ada[j];
}

__global__ __launch_bounds__(256) void nv_norm1(const float* x, const float* g, const float* mod, const float* w_in, bf16_t* H, float* IW) {
    __shared__ float red[8];
    __shared__ float hrow[1024];
    const int t = blockIdx.x, b = t / SEQ, tid = threadIdx.x;
    const float4 v = ((const float4*)(x + (size_t)t * DM))[tid];
    const float ss = block_sum_256(v.x * v.x + v.y * v.y + v.z * v.z + v.w * v.w, red);
    const float r = 1.0f / sqrtf(ss * (1.f / DM) + RMS_EPS);
    const float* sh = mod + b * 6144, * sc = mod + b * 6144 + 1024;
    float hv[4]; const float xv[4] = {v.x, v.y, v.z, v.w};
#pragma unroll
    for (int i = 0; i < 4; ++i) { const int k = tid * 4 + i; hv[i] = (xv[i] * r * g[k]) * (1.f + sc[k]) + sh[k]; hrow[k] = hv[i]; H[(size_t)t * DM + k] = f2bf(hv[i]); }
    __syncthreads();
    const int col = tid & 7, part = tid >> 3;
    float p = 0.f;
    for (int k = part * 32; k < part * 32 + 32; ++k) p += hrow[k] * w_in[(size_t)k * NIN + C_IW + col];
    p += __shfl_xor(p, 8); p += __shfl_xor(p, 16); p += __shfl_xor(p, 32);
    __shared__ float pw[4][8];
    if ((tid & 63) < 8) pw[tid >> 6][tid & 7] = p;
    __syncthreads();
    if (tid < 8) IW[(size_t)t * 8 + tid] = (pw[0][tid] + pw[1][tid] + pw[2][tid] + pw[3][tid]) * 0.04419417382415922f;
}

struct NvGemm {
    const bf16_t* A; int lda;
    const float* B; const float* B2; int ldb;
    int K;
    bf16_t* Obf; int ldo;
    const float* x; float* out; const float* mod;
    const int* rowtok; const int* tile_e; const float* topg; const float* bias; const float* bias2; bf16_t* Y;
};
template <int MODE>
__global__ __launch_bounds__(256) void nv_gemm(NvGemm a) {
    __shared__ float As[16][68];
    __shared__ float Bs[16][64];
    __shared__ float Bs2[MODE == 2 ? 16 : 1][64];
    __shared__ int rows[64];
    const int tid = threadIdx.x, tx = tid & 15, ty = tid >> 4;
    const int n0 = blockIdx.x * 64, m0 = blockIdx.y * 64;
    int e = 0;
    if (MODE == 2 || MODE == 3) {
        const int ntiles = a.tile_e[MAXTILES];
        if ((int)(blockIdx.y >> 2) >= ntiles) return;
        e = a.tile_e[blockIdx.y >> 2];
    }
    if (tid < 64) {
        int r = m0 + tid;
        if (MODE == 2) { const int ent = a.rowtok[m0 + tid]; r = ent < 0 ? 0 : (ent >> 2); }
        rows[tid] = r;
    }
    __syncthreads();
    const float* Bp = a.B + ((MODE == 2 || MODE == 3) ? (size_t)e * 1024 * 1024 : 0);
    const float* Bp2 = MODE == 2 ? a.B2 + (size_t)e * 1024 * 1024 : nullptr;
    float acc[4][4], acc2[4][4];
#pragma unroll
    for (int i = 0; i < 4; ++i)
#pragma unroll
        for (int j = 0; j < 4; ++j) { acc[i][j] = 0.f; acc2[i][j] = 0.f; }
    const int ar = tid >> 2, ak = (tid & 3) * 4;
    const int bk = tid >> 4, bn = (tid & 15) * 4;
    for (int k0 = 0; k0 < a.K; k0 += 16) {
        const uint2 av = *(const uint2*)(a.A + (size_t)rows[ar] * a.lda + k0 + ak);
        As[ak + 0][ar] = __uint_as_float(av.x << 16); As[ak + 1][ar] = __uint_as_float(av.x & 0xffff0000u);
        As[ak + 2][ar] = __uint_as_float(av.y << 16); As[ak + 3][ar] = __uint_as_float(av.y & 0xffff0000u);
        const float4 bv = *(const float4*)(Bp + (size_t)(k0 + bk) * a.ldb + n0 + bn);
        Bs[bk][bn] = bv.x; Bs[bk][bn + 1] = bv.y; Bs[bk][bn + 2] = bv.z; Bs[bk][bn + 3] = bv.w;
        if (MODE == 2) { const float4 b2 = *(const float4*)(Bp2 + (size_t)(k0 + bk) * a.ldb + n0 + bn);
            Bs2[bk][bn] = b2.x; Bs2[bk][bn + 1] = b2.y; Bs2[bk][bn + 2] = b2.z; Bs2[bk][bn + 3] = b2.w; }
        __syncthreads();
#pragma unroll
        for (int k = 0; k < 16; ++k) {
            float av4[4], bv4[4], cv4[4];
#pragma unroll
            for (int i = 0; i < 4; ++i) av4[i] = As[k][ty * 4 + i];
#pragma unroll
            for (int j = 0; j < 4; ++j) { bv4[j] = Bs[k][tx * 4 + j]; if (MODE == 2) cv4[j] = Bs2[k][tx * 4 + j]; }
#pragma unroll
            for (int i = 0; i < 4; ++i)
#pragma unroll
                for (int j = 0; j < 4; ++j) { acc[i][j] += av4[i] * bv4[j]; if (MODE == 2) acc2[i][j] += av4[i] * cv4[j]; }
        }
        __syncthreads();
    }
#pragma unroll
    for (int i = 0; i < 4; ++i) {
        const int m = m0 + ty * 4 + i;
#pragma unroll
        for (int j = 0; j < 4; ++j) {
            const int n = n0 + tx * 4 + j;
            if (MODE == 0) a.Obf[(size_t)m * a.ldo + n] = f2bf(acc[i][j]);
            if (MODE == 1) { const int b = m / SEQ; a.out[(size_t)m * DM + n] = a.x[(size_t)m * DM + n] + a.mod[b * 6144 + 2 * 1024 + n] * acc[i][j]; }
            if (MODE == 2) {
                float g = acc[i][j] + a.bias[e * 1024 + n], u = acc2[i][j] + a.bias2[e * 1024 + n];
                g = fminf(g, 7.0f); u = fminf(fmaxf(u, -7.0f), 7.0f);
                const float act = g * (1.f / (1.f + expf(-1.702f * g))) * (u + 1.0f);
                a.Obf[(size_t)m * a.ldo + n] = f2bf(act);
            }
            if (MODE == 3) {
                const int ent = a.rowtok[m];
                if (ent >= 0) {
                    const int tok = ent >> 2, kk = ent & 3, b = tok / SEQ;
                    const float val = a.topg[ent] * (acc[i][j] + a.bias[e * 1024 + n]);
                    if (kk == 0) a.out[(size_t)tok * DM + n] += a.mod[b * 6144 + 5 * 1024 + n] * val;
                    else a.Y[((size_t)(kk - 1) * NTOK + tok) * DM + n] = f2bf(val);
                }
            }
        }
    }
}

__global__ __launch_bounds__(256) void nv_post(bf16_t* PROJ, const float* rope, const float* aq_g, const float* ak_g, const float* bq_g, const float* bk_g, const float* bkv_g) {
    const int t = blockIdx.x, pos = t % SEQ;
    bf16_t* row = PROJ + (size_t)t * NPJ;
    const int gidx = threadIdx.x;
    if (gidx >= 44) return;
    const int c0 = gidx * 64;
    float v[64];
    bool donorm = false, dorope = false; const float* gg = nullptr;
    if (c0 < 512) { donorm = true; dorope = true; gg = aq_g; }
    else if (c0 < 1024) { donorm = true; dorope = true; gg = ak_g; }
    else if (c0 < 1536) { return; }
    else if (c0 < 2048) { donorm = true; dorope = true; gg = bq_g; }
    else if (c0 < 2112) { donorm = true; dorope = true; gg = bk_g; }
    else if (c0 < 2240) {
        if (c0 != 2112) return;
        float ss = 0.f;
        for (int i = 0; i < 128; ++i) { const float f = bf2f(row[c0 + i]); ss += f * f; }
        const float r = 1.0f / sqrtf(ss * (1.f / 128.f) + RMS_EPS);
        for (int i = 0; i < 128; ++i) row[c0 + i] = f2bf(bf2f(row[c0 + i]) * r * bkv_g[i]);
        return;
    }
    else { dorope = true; }
    float ss = 0.f;
#pragma unroll
    for (int i = 0; i < 64; ++i) { v[i] = bf2f(row[c0 + i]); ss += v[i] * v[i]; }
    if (donorm) { const float r = 1.0f / sqrtf(ss * (1.f / 64.f) + RMS_EPS);
#pragma unroll
        for (int i = 0; i < 64; ++i) v[i] = v[i] * r * gg[i]; }
    if (dorope) {
#pragma unroll
        for (int i = 0; i < 8; ++i) { const float cs = rope[(pos * 8 + i) * 2], sn = rope[(pos * 8 + i) * 2 + 1];
            const float x1 = v[i], x2 = v[8 + i]; v[i] = x1 * cs - x2 * sn; v[8 + i] = x2 * cs + x1 * sn; }
    }
#pragma unroll
    for (int i = 0; i < 64; ++i) row[c0 + i] = f2bf(v[i]);
}

__global__ __launch_bounds__(256) void nv_diffattn(const bf16_t* PROJ, bf16_t* H, const float* lamp, const float* sub_g) {
    __shared__ float q1[64], q2[64], s1[4096], s2[4096], red[8], osum[2][128];
    const int t = blockIdx.x, h = blockIdx.y, b = t / SEQ, s = t % SEQ, N = (s / 64 + 1) * 64, tid = threadIdx.x;
    const bf16_t* qrow = PROJ + (size_t)t * NPJ;
    if (tid < 64) q1[tid] = bf2f(qrow[C_AQ1 + h * 64 + tid]);
    else if (tid < 128) q2[tid - 64] = bf2f(qrow[C_AQ2 + h * 64 + tid - 64]);
    __syncthreads();
    float m1 = -INFINITY, m2 = -INFINITY;
    for (int key = tid; key < N; key += 256) {
        const bf16_t* kr = PROJ + (size_t)(b * SEQ + key) * NPJ;
        float d1 = 0.f, d2 = 0.f;
        for (int d = 0; d < 64; ++d) { d1 += q1[d] * bf2f(kr[C_AK1 + h * 64 + d]); d2 += q2[d] * bf2f(kr[C_AK2 + h * 64 + d]); }
        d1 *= 0.125f; d2 *= 0.125f; s1[key] = d1; s2[key] = d2; m1 = fmaxf(m1, d1); m2 = fmaxf(m2, d2);
    }
    m1 = block_max_256(m1, red); m2 = block_max_256(m2, red);
    float l1 = 0.f, l2 = 0.f;
    for (int key = tid; key < N; key += 256) { const float e1 = expf(s1[key] - m1), e2 = expf(s2[key] - m2); s1[key] = e1; s2[key] = e2; l1 += e1; l2 += e2; }
    l1 = block_sum_256(l1, red); l2 = block_sum_256(l2, red);
    const float lam = lamp[0], i1 = 1.f / l1, i2 = lam / l2;
    for (int key = tid; key < N; key += 256) s1[key] = s1[key] * i1 - s2[key] * i2;
    __syncthreads();
    const int e = tid & 127, half = tid >> 7;
    float o = 0.f;
    for (int key = half; key < N; key += 2) o += s1[key] * bf2f(PROJ[(size_t)(b * SEQ + key) * NPJ + C_AV + h * 128 + e]);
    osum[half][e] = o;
    __syncthreads();
    float ov = 0.f, sq = 0.f;
    if (tid < 128) { ov = osum[0][tid] + osum[1][tid]; sq = ov * ov; }
    const float ss = block_sum_256(sq, red);
    if (tid < 128) H[(size_t)t * DM + h * 128 + tid] = f2bf(ov * (1.0f / sqrtf(ss * (1.f / 128.f) + RMS_EPS)) * sub_g[tid] * (1.0f - LAMBDA_INIT));
}

__global__ __launch_bounds__(256) void nv_dsa(const bf16_t* PROJ, const float* IW, const float* w_uv, bf16_t* H) {
    __shared__ float iq[8 * 64], bq[8 * 64], w[8], score[4096], p[8][256], o[8][128];
    __shared__ int sel[256];
    const int t = blockIdx.x, b = t / SEQ, s = t % SEQ, N = (s / 64 + 1) * 64, tid = threadIdx.x;
    const bf16_t* qrow = PROJ + (size_t)t * NPJ;
    for (int i = tid; i < 512; i += 256) { iq[i] = bf2f(qrow[C_IQ + i]); bq[i] = bf2f(qrow[C_BQ + i]); }
    if (tid < 8) w[tid] = IW[(size_t)t * 8 + tid];
    __syncthreads();
    for (int key = tid; key < N; key += 256) {
        const bf16_t* kr = PROJ + (size_t)(b * SEQ + key) * NPJ + C_IK;
        float kd[64];
#pragma unroll
        for (int d = 0; d < 64; ++d) kd[d] = bf2f(kr[d]);
        float sc = 0.f;
        for (int hh = 0; hh < 8; ++hh) { float d0 = 0.f;
#pragma unroll
            for (int d = 0; d < 64; ++d) d0 += iq[hh * 64 + d] * kd[d];
            sc += w[hh] * fmaxf(d0, 0.f); }
        score[key] = sc;
    }
    __syncthreads();
    const int nsel = N < 256 ? N : 256;
    for (int key = tid; key < N; key += 256) {
        const float my = score[key]; int r = 0;
        for (int j = 0; j < N; ++j) { const float ot = score[j]; r += (ot > my || (ot == my && j < key)) ? 1 : 0; }
        if (r < 256) sel[r] = key;
    }
    __syncthreads();
    if (tid < nsel) {
        const bf16_t* kr = PROJ + (size_t)(b * SEQ + sel[tid]) * NPJ + C_BK;
        float kd[64];
#pragma unroll
        for (int d = 0; d < 64; ++d) kd[d] = bf2f(kr[d]);
        for (int hh = 0; hh < 8; ++hh) { float d0 = 0.f;
#pragma unroll
            for (int d = 0; d < 64; ++d) d0 += bq[hh * 64 + d] * kd[d];
            p[hh][tid] = d0 * 0.125f; }
    }
    __syncthreads();
    {
        const int hh = tid >> 5, l = tid & 31;
        float m = -INFINITY;
        for (int j = l; j < nsel; j += 32) m = fmaxf(m, p[hh][j]);
#pragma unroll
        for (int of = 16; of > 0; of >>= 1) m = fmaxf(m, __shfl_xor(m, of));
        float sum = 0.f;
        for (int j = l; j < nsel; j += 32) { const float ev = expf(p[hh][j] - m); p[hh][j] = ev; sum += ev; }
#pragma unroll
        for (int of = 16; of > 0; of >>= 1) sum += __shfl_xor(sum, of);
        const float inv = 1.f / sum;
        for (int j = l; j < nsel; j += 32) p[hh][j] *= inv;
    }
    __syncthreads();
    {
        const int hh = tid >> 5, l = tid & 31;
        float a0 = 0.f, a1 = 0.f, a2 = 0.f, a3 = 0.f;
        for (int j = 0; j < nsel; ++j) {
            const bf16_t* lr = PROJ + (size_t)(b * SEQ + sel[j]) * NPJ + C_BLAT;
            const float pv = p[hh][j];
            a0 += pv * bf2f(lr[l]); a1 += pv * bf2f(lr[l + 32]); a2 += pv * bf2f(lr[l + 64]); a3 += pv * bf2f(lr[l + 96]);
        }
        o[hh][l] = a0; o[hh][l + 32] = a1; o[hh][l + 64] = a2; o[hh][l + 96] = a3;
    }
    __syncthreads();
    {
        const int hh = tid >> 5, l = tid & 31;
        float a0 = 0.f, a1 = 0.f;
        for (int c = 0; c < 128; ++c) { const float ov = o[hh][c]; a0 += ov * w_uv[(hh * 128 + c) * 64 + l]; a1 += ov * w_uv[(hh * 128 + c) * 64 + l + 32]; }
        H[(size_t)t * DM + 512 + hh * 64 + l] = f2bf(a0); H[(size_t)t * DM + 512 + hh * 64 + l + 32] = f2bf(a1);
    }
}

__global__ __launch_bounds__(256) void nv_norm2(const float* x1, const float* g, const float* mod, const float* rw, const float* rb, bf16_t* H, int* topi, float* topg) {
    __shared__ float red[8];
    __shared__ float hrow[1024];
    __shared__ float part[8][32];
    __shared__ float logit[32];
    const int t = blockIdx.x, b = t / SEQ, tid = threadIdx.x;
    const float4 v = ((const float4*)(x1 + (size_t)t * DM))[tid];
    const float ss = block_sum_256(v.x * v.x + v.y * v.y + v.z * v.z + v.w * v.w, red);
    const float r = 1.0f / sqrtf(ss * (1.f / DM) + RMS_EPS);
    const float* sh = mod + b * 6144 + 3 * 1024, * sc = mod + b * 6144 + 4 * 1024;
    const float xv[4] = {v.x, v.y, v.z, v.w};
#pragma unroll
    for (int i = 0; i < 4; ++i) { const int k = tid * 4 + i; const float hv = (xv[i] * r * g[k]) * (1.f + sc[k]) + sh[k]; hrow[k] = hv; H[(size_t)t * DM + k] = f2bf(hv); }
    __syncthreads();
    const int e = tid & 31, pt = tid >> 5;
    float pa = 0.f;
    for (int k = pt * 128; k < pt * 128 + 128; ++k) pa += hrow[k] * rw[k * 32 + e];
    part[pt][e] = pa;
    __syncthreads();
    if (tid < 32) { float l = rb[tid]; for (int q = 0; q < 8; ++q) l += part[q][tid]; logit[tid] = l; }
    __syncthreads();
    if (tid == 0) {
        int idx[4]; float val[4]; unsigned used = 0;
        for (int k = 0; k < 4; ++k) { int bi = -1; float bv = -INFINITY;
            for (int j = 0; j < 32; ++j) if (!((used >> j) & 1u) && (bi < 0 || logit[j] > bv)) { bi = j; bv = logit[j]; }
            used |= 1u << bi; idx[k] = bi; val[k] = bv; }
        float sum = 0.f, ex[4];
        for (int k = 0; k < 4; ++k) { ex[k] = expf(val[k] - val[0]); sum += ex[k]; }
        for (int k = 0; k < 4; ++k) { topi[t * 4 + k] = idx[k]; topg[t * 4 + k] = ex[k] / sum; }
    }
}

__global__ __launch_bounds__(256) void nv_count(const int* topi, int* chcnt) {
    __shared__ int cnt[32];
    const int ch = blockIdx.x, tid = threadIdx.x;
    if (tid < 32) cnt[tid] = 0;
    __syncthreads();
    for (int i = tid; i < CHTOK * 4; i += 256) atomicAdd(&cnt[topi[ch * CHTOK * 4 + i]], 1);
    __syncthreads();
    if (tid < 32) chcnt[ch * 32 + tid] = cnt[tid];
}
__global__ __launch_bounds__(256) void nv_scatter(const int* topi, const int* chcnt, int* rowtok, int* tile_e) {
    __shared__ int total[32], before[32], padded[32], poff[33];
    __shared__ int ent[CHTOK * 4];
    const int ch = blockIdx.x, tid = threadIdx.x;
    if (tid < 32) { int tt = 0, bb = 0; for (int c = 0; c < NCHUNK; ++c) { const int v = chcnt[c * 32 + tid]; tt += v; if (c < ch) bb += v; }
        total[tid] = tt; before[tid] = bb; padded[tid] = (tt + 255) / 256 * 256; }
    for (int i = tid; i < CHTOK * 4; i += 256) ent[i] = topi[ch * CHTOK * 4 + i];
    __syncthreads();
    if (tid == 0) { int acc = 0; for (int e = 0; e < 32; ++e) { poff[e] = acc; acc += padded[e]; } poff[32] = acc; }
    __syncthreads();
    if (tid < 32) { int pos = poff[tid] + before[tid];
        for (int i = 0; i < CHTOK * 4; ++i) if (ent[i] == tid) rowtok[pos++] = ch * CHTOK * 4 + i; }
    if (ch == 0) {
        for (int e = 0; e < 32; ++e) for (int r = poff[e] + total[e] + tid; r < poff[e] + padded[e]; r += 256) rowtok[r] = -1;
        for (int e = 0; e < 32; ++e) for (int ti = poff[e] / 256 + tid; ti < (poff[e] + padded[e]) / 256; ti += 256) tile_e[ti] = e;
        if (tid == 0) tile_e[MAXTILES] = poff[32] / 256;
    }
}
__global__ __launch_bounds__(256) void nv_combine(float* out, const bf16_t* Y, const float* mod) {
    const int t = blockIdx.x, b = t / SEQ, tid = threadIdx.x;
#pragma unroll
    for (int i = 0; i < 4; ++i) { const int n = tid + 256 * i; const size_t o = (size_t)t * DM + n;
        const float sum = bf2f(Y[o]) + bf2f(Y[(size_t)NTOK * DM + o]) + bf2f(Y[(size_t)2 * NTOK * DM + o]);
        out[o] += mod[b * 6144 + 5 * 1024 + n] * sum; }
}

namespace gp {
#define GP_LAS __attribute__((address_space(3)))
typedef short bf16x8 __attribute__((ext_vector_type(8)));
typedef float f32x4 __attribute__((ext_vector_type(4)));
typedef unsigned u32x4 __attribute__((ext_vector_type(4)));
constexpr int BM = 256, BK = 64, HALF = 128, HTB = HALF * BK * 2  , STAGE_BYTES = 8 * HTB;

__host__ __device__ __forceinline__ int lds_byte(int r, int c) { const int st = (r >> 4) * 2 + (c >> 5), rr = r & 15, cc = c & 31, ob = rr * 64 + cc * 2; return st * 1024 + (ob ^ (((ob >> 9) & 1) << 5)); }
__host__ __device__ __forceinline__ void stage_rc(int b, int& R, int& C) { const int st = b / 1024, sb = b % 1024, swz = sb ^ (((sb >> 9) & 1) << 5); R = (st >> 1) * 16 + swz / 64; C = (st & 1) * 32 + (swz % 64) / 2; }
__host__ __device__ __forceinline__ int perm32(int rho) { const int n = rho >> 4, i = rho & 15; return 8 * (i >> 2) + 4 * n + (i & 3); }

struct Unit { int pm, pn, e; };
struct Gemm { const bf16_t* A; const bf16_t* Bt; int N, K; const int* rowsrc; };

struct StaticOrder {
    int nM, nN, nwg, G, c;
    __device__ void init(int M, int N, int G_, int c_) { nM = M / BM; nN = N / BM; nwg = nM * nN; G = G_; c = c_; }
    __device__ bool next(int i, Unit& u) const {
        const long L = (long)i * G + c; if (L >= nwg) return false;
        int wgid = (int)L; { const int q = nwg / 8, r = nwg % 8, xcd = wgid % 8, off = wgid / 8; wgid = (xcd < r ? xcd * (q + 1) : r * (q + 1) + (xcd - r) * q) + off; }
        const int nig = 8 * nN, gid = wgid / nig, fm = gid * 8, gsz = (nM - fm) < 8 ? (nM - fm) : 8;
        u.pm = fm + ((wgid % nig) % gsz); u.pn = (wgid % nig) / gsz; u.e = 0; return true;
    }
};
struct MoeOrder {
    const int* tile_e; int ntiles, nN, c, G;
    __device__ bool next(int i, Unit& u) const {
        const int j = c >> 3, x = c & 7, tpx = (G >> 3) / nN;
        const int tile = i * (tpx * 8) + x * tpx + j / nN;
        if (tile >= ntiles) return false;
        u.pm = tile; u.pn = j % nN; u.e = tile_e[tile]; return true;
    }
};

__device__ __forceinline__ unsigned cvt_pk_bf16(float lo, float hi) { unsigned r; asm volatile("v_cvt_pk_bf16_f32 %0, %1, %2" : "=v"(r) : "v"(lo), "v"(hi)); return r; }

struct EpiBf16 {
    bf16_t* O; int ldc;
    __device__ __forceinline__ void operator()(const f32x4 (&acc)[2][2][4][2], const Unit& u, int wr, int wc, int fr, int fq) const {
        const int row0 = u.pm * BM + wr * 64 + fr, col0 = u.pn * BM + wc * 32 + 8 * fq;
#pragma unroll
        for (int ai = 0; ai < 2; ++ai)
#pragma unroll
            for (int m = 0; m < 4; ++m) { bf16_t* rowp = O + (size_t)(row0 + ai * HALF + m * 16) * ldc + col0;
#pragma unroll
                for (int bj = 0; bj < 2; ++bj) { const f32x4 v0 = acc[ai][bj][m][0], v1 = acc[ai][bj][m][1];
                    u32x4 w; w.x = cvt_pk_bf16(v0[0], v0[1]); w.y = cvt_pk_bf16(v0[2], v0[3]); w.z = cvt_pk_bf16(v1[0], v1[1]); w.w = cvt_pk_bf16(v1[2], v1[3]);
                    *(u32x4*)(rowp + bj * HALF) = w; } }
    }
};
struct EpiResid {
    const float* x; float* out; const float* mod;
    __device__ __forceinline__ void operator()(const f32x4 (&acc)[2][2][4][2], const Unit& u, int wr, int wc, int fr, int fq) const {
        const int row0 = u.pm * BM + wr * 64 + fr, col0 = u.pn * BM + wc * 32 + 8 * fq, b = (u.pm * BM) / SEQ;
        f32x4 gv[2][2];
#pragma unroll
        for (int bj = 0; bj < 2; ++bj)
#pragma unroll
            for (int n = 0; n < 2; ++n) gv[bj][n] = *(const f32x4*)(mod + b * 6144 + 2 * 1024 + col0 + bj * HALF + 4 * n);
#pragma unroll
        for (int ai = 0; ai < 2; ++ai)
#pragma unroll
            for (int m = 0; m < 4; ++m) { const size_t off = (size_t)(row0 + ai * HALF + m * 16) * DM + col0;
#pragma unroll
                for (int bj = 0; bj < 2; ++bj)
#pragma unroll
                    for (int n = 0; n < 2; ++n) { const f32x4 xv = *(const f32x4*)(x + off + bj * HALF + 4 * n);
                        *(f32x4*)(out + off + bj * HALF + 4 * n) = xv + gv[bj][n] * acc[ai][bj][m][n]; }
                asm volatile("" ::: "memory"); }
    }
};
struct EpiSwiglu {
    bf16_t* act; const float* bg; const float* bu;
    __device__ __forceinline__ void operator()(const f32x4 (&acc)[2][2][4][2], const Unit& u, int wr, int wc, int fr, int fq) const {
        const int row0 = u.pm * BM + wr * 64 + fr, ff0 = u.pn * HALF + wc * 32 + 8 * fq;
        f32x4 bgv[2], buv[2];
#pragma unroll
        for (int n = 0; n < 2; ++n) { bgv[n] = *(const f32x4*)(bg + u.e * 1024 + ff0 + 4 * n); buv[n] = *(const f32x4*)(bu + u.e * 1024 + ff0 + 4 * n); }
#pragma unroll
        for (int ai = 0; ai < 2; ++ai)
#pragma unroll
            for (int m = 0; m < 4; ++m) {
                float a[8];
#pragma unroll
                for (int n = 0; n < 2; ++n) { const f32x4 g4 = acc[ai][0][m][n] + bgv[n], u4 = acc[ai][1][m][n] + buv[n];
#pragma unroll
                    for (int j = 0; j < 4; ++j) { const float g = fminf(g4[j], 7.0f), uu = fminf(fmaxf(u4[j], -7.0f), 7.0f);
                        const float sg = __builtin_amdgcn_rcpf(1.0f + __builtin_amdgcn_exp2f(-1.702f * 1.4426950408889634f * g));
                        a[4 * n + j] = g * sg * (uu + 1.0f); } }
                u32x4 w; w.x = cvt_pk_bf16(a[0], a[1]); w.y = cvt_pk_bf16(a[2], a[3]); w.z = cvt_pk_bf16(a[4], a[5]); w.w = cvt_pk_bf16(a[6], a[7]);
                *(u32x4*)(act + (size_t)(row0 + ai * HALF + m * 16) * 1024 + ff0) = w; }
    }
};
struct EpiDown {
    float* out; bf16_t* Y; const float* bd; const float* mod; const int* rowtok; const float* topg;
    __device__ __forceinline__ void operator()(const f32x4 (&acc)[2][2][4][2], const Unit& u, int wr, int wc, int fr, int fq) const {
        const int row0 = u.pm * BM + wr * 64 + fr, col0 = u.pn * BM + wc * 32 + 8 * fq;
        f32x4 bv[2][2];
#pragma unroll
        for (int bj = 0; bj < 2; ++bj)
#pragma unroll
            for (int n = 0; n < 2; ++n) bv[bj][n] = *(const f32x4*)(bd + u.e * 1024 + col0 + bj * HALF + 4 * n);
#pragma unroll
        for (int ai = 0; ai < 2; ++ai)
#pragma unroll
            for (int m = 0; m < 4; ++m) {
                const int ent = rowtok[row0 + ai * HALF + m * 16];
                if (ent >= 0) {
                    const int tok = ent >> 2, kk = ent & 3; const float gt = topg[ent];
                    if (kk == 0) { const float* g2 = mod + (tok / SEQ) * 6144 + 5 * 1024 + col0; float* op = out + (size_t)tok * DM + col0;
#pragma unroll
                        for (int bj = 0; bj < 2; ++bj)
#pragma unroll
                            for (int n = 0; n < 2; ++n) { const f32x4 g4 = *(const f32x4*)(g2 + bj * HALF + 4 * n), o4 = *(const f32x4*)(op + bj * HALF + 4 * n);
                                *(f32x4*)(op + bj * HALF + 4 * n) = o4 + g4 * ((acc[ai][bj][m][n] + bv[bj][n]) * gt); }
                    } else { bf16_t* yp = Y + ((size_t)(kk - 1) * NTOK + tok) * DM + col0;
#pragma unroll
                        for (int bj = 0; bj < 2; ++bj) { const f32x4 v0 = (acc[ai][bj][m][0] + bv[bj][0]) * gt, v1 = (acc[ai][bj][m][1] + bv[bj][1]) * gt;
                            u32x4 w; w.x = cvt_pk_bf16(v0[0], v0[1]); w.y = cvt_pk_bf16(v0[2], v0[3]); w.z = cvt_pk_bf16(v1[0], v1[1]); w.w = cvt_pk_bf16(v1[2], v1[3]);
                            *(u32x4*)(yp + bj * HALF) = w; } }
                }
                asm volatile("" ::: "memory"); }
    }
};

template <class Epi, class Sched, bool GATHER>
__device__ __forceinline__ void gemm_phase(GP_LAS unsigned char* lds, const Gemm g, const Sched& S, const Epi& E) {
    const int tid = threadIdx.x, wid = __builtin_amdgcn_readfirstlane(tid >> 6), lane = tid & 63, wr = wid >> 2, wc = wid & 3, fr = lane & 15, fq = lane >> 4;
    const int K = g.K, nt = K / BK;
    int RA[2], CA[2]; unsigned voffB[2];
#pragma unroll
    for (int i = 0; i < 2; ++i) { int R, C; stage_rc(tid * 16 + i * 8192, R, C); RA[i] = R; CA[i] = C; const int Rb = (R & ~31) + perm32(R & 31); voffB[i] = (unsigned)(Rb * K + C) * 2u; }
    const size_t kstep = (size_t)(BK * 2);
    const size_t hstep = (size_t)HALF * K * 2;
    const size_t tstep = 2 * hstep;
    const unsigned ldsw = (unsigned)wid * 1024u;
    const int aoff = lds_byte(wr * 64 + fr, fq * 8), boff = lds_byte(wc * 32 + fr, fq * 8);
#define GP_SA(b, h) (((b) * 2 + (h)) * HTB)
#define GP_SB(b, h) ((4 + (b) * 2 + (h)) * HTB)
#define GP_STAGE(bufoff, gbase, voff) do { _Pragma("unroll") for (int _i = 0; _i < 2; ++_i) \
        __builtin_amdgcn_global_load_lds((const unsigned*)((const char*)(gbase) + (voff)[_i]), (GP_LAS unsigned*)(lds + (bufoff) + ldsw + _i * 8192), 16, 0, 0); } while (0)
#define GP_LDA(dst, b, h) do { _Pragma("unroll") for (int m = 0; m < 4; ++m) _Pragma("unroll") for (int k = 0; k < 2; ++k) dst[m][k] = *(const GP_LAS bf16x8*)(lds + GP_SA(b, h) + aoff + m * 2048 + k * 1024); } while (0)
#define GP_LDB(dst, b, h) do { _Pragma("unroll") for (int n = 0; n < 2; ++n) _Pragma("unroll") for (int k = 0; k < 2; ++k) dst[n][k] = *(const GP_LAS bf16x8*)(lds + GP_SB(b, h) + boff + n * 2048 + k * 1024); } while (0)
#define GP_MMA(ai, bj, At, Bt) do { __builtin_amdgcn_s_setprio(1); _Pragma("unroll") for (int m = 0; m < 4; ++m) _Pragma("unroll") for (int n = 0; n < 2; ++n) _Pragma("unroll") for (int k = 0; k < 2; ++k) \
        acc[ai][bj][m][n] = __builtin_amdgcn_mfma_f32_16x16x32_bf16(Bt[n][k], At[m][k], acc[ai][bj][m][n], 0, 0, 0); __builtin_amdgcn_s_setprio(0); } while (0)
#define GP_WAIT_V(n) asm volatile("s_waitcnt vmcnt(" #n ")" ::: "memory")
#define GP_WAIT_L(n) asm volatile("s_waitcnt lgkmcnt(" #n ")" ::: "memory")
#define GP_BAR __builtin_amdgcn_s_barrier()
#define GP_SCHED __builtin_amdgcn_sched_barrier(0)
#define GP_AOFFS(u_, v0_, v1_) do { _Pragma("unroll") for (int _i = 0; _i < 2; ++_i) { int r0_ = (u_).pm * BM + RA[_i], r1_ = r0_ + HALF; \
        if (GATHER) { r0_ = g.rowsrc[r0_]; r1_ = g.rowsrc[r1_]; } \
        v0_[_i] = (unsigned)(r0_ * K + CA[_i]) * 2u; v1_[_i] = (unsigned)(r1_ * K + CA[_i]) * 2u; } } while (0)
    Unit cur, nxt; int ui = 0;
    if (!S.next(0, cur)) return;
    f32x4 acc[2][2][4][2];
#pragma unroll
    for (int a = 0; a < 2; ++a)
#pragma unroll
        for (int b = 0; b < 2; ++b)
#pragma unroll
            for (int m = 0; m < 4; ++m)
#pragma unroll
                for (int n = 0; n < 2; ++n) acc[a][b][m][n] = (f32x4){0.f, 0.f, 0.f, 0.f};
    bf16x8 At[4][2], B0[2][2], B1[2][2];
    unsigned vA0[2], vA1[2], nA0[2], nA1[2];
    GP_AOFFS(cur, vA0, vA1);
    const char* Ab = (const char*)g.A;
    const char* cB = (const char*)g.Bt + ((size_t)cur.e * g.N + (size_t)cur.pn * BM) * K * 2;
    GP_STAGE(GP_SB(0, 0), cB, voffB); GP_STAGE(GP_SB(0, 1), cB + hstep, voffB); GP_STAGE(GP_SA(0, 0), Ab, vA0); GP_STAGE(GP_SA(0, 1), Ab, vA1);
    if (wr == 1) GP_BAR;
    GP_WAIT_V(2); GP_BAR;
    GP_STAGE(GP_SB(1, 0), cB + kstep, voffB); GP_STAGE(GP_SA(1, 0), Ab + kstep, vA0); GP_STAGE(GP_SB(1, 1), cB + hstep + kstep, voffB);
    GP_WAIT_V(6); GP_BAR;
    for (;;) {
        const bool has_next = S.next(ui + 1, nxt);
        const char* nB = cB;
        if (has_next) { nB = (const char*)g.Bt + ((size_t)nxt.e * g.N + (size_t)nxt.pn * BM) * K * 2; GP_AOFFS(nxt, nA0, nA1); }
        else { nA0[0] = vA0[0]; nA0[1] = vA0[1]; nA1[0] = vA1[0]; nA1[1] = vA1[1]; }
        for (int t = 0; t < nt; t += 2) {
            const bool last = (t == nt - 2);
            const char* a1 = Ab + (size_t)(t + 1) * kstep;
            const char* a2 = last ? Ab : Ab + (size_t)(t + 2) * kstep; const char* b2 = last ? nB : cB + (size_t)(t + 2) * kstep;
            const char* a3 = a2 + kstep; const char* b3 = b2 + kstep;
            GP_LDB(B0, 0, 0); GP_LDB(B1, 0, 1); GP_SCHED; GP_LDA(At, 0, 0); GP_STAGE(GP_SA(1, 1), a1, vA1);
            if (last) { vA0[0] = nA0[0]; vA0[1] = nA0[1]; vA1[0] = nA1[0]; vA1[1] = nA1[1]; }
            GP_WAIT_V(8); GP_WAIT_L(0); GP_BAR; GP_MMA(0, 0, At, B0); GP_MMA(0, 1, At, B1); GP_BAR; GP_SCHED;
            GP_LDA(At, 0, 1); GP_STAGE(GP_SB(0, 0), b2, voffB); GP_STAGE(GP_SB(0, 1), b2 + hstep, voffB); GP_STAGE(GP_SA(0, 0), a2, vA0);
            GP_WAIT_V(8); GP_WAIT_L(0); GP_BAR; GP_MMA(1, 0, At, B0); GP_MMA(1, 1, At, B1); GP_BAR; GP_SCHED;
            GP_LDB(B0, 1, 0); GP_LDB(B1, 1, 1); GP_SCHED; GP_LDA(At, 1, 0); GP_STAGE(GP_SA(0, 1), a2, vA1);
            GP_WAIT_V(8); GP_WAIT_L(0); GP_BAR; GP_MMA(0, 0, At, B0); GP_MMA(0, 1, At, B1); GP_BAR; GP_SCHED;
            GP_LDA(At, 1, 1); GP_STAGE(GP_SB(1, 0), b3, voffB); GP_STAGE(GP_SB(1, 1), b3 + hstep, voffB); GP_STAGE(GP_SA(1, 0), a3, vA0);
            GP_WAIT_V(8); GP_WAIT_L(0); GP_BAR; GP_MMA(1, 0, At, B0); GP_MMA(1, 1, At, B1); GP_BAR; GP_SCHED;
        }
        if (wr == 0) GP_BAR;
        E(acc, cur, wr, wc, fr, fq);
        if (!has_next) break;
#pragma unroll
        for (int a = 0; a < 2; ++a)
#pragma unroll
            for (int b = 0; b < 2; ++b)
#pragma unroll
                for (int m = 0; m < 4; ++m)
#pragma unroll
                    for (int n = 0; n < 2; ++n) acc[a][b][m][n] = (f32x4){0.f, 0.f, 0.f, 0.f};
        cur = nxt; cB = nB; ++ui;
        if (wr == 1) GP_BAR;
    }
    GP_WAIT_V(0);
    GP_BAR;
#undef GP_SA
#undef GP_SB
#undef GP_STAGE
#undef GP_LDA
#undef GP_LDB
#undef GP_MMA
#undef GP_WAIT_V
#undef GP_WAIT_L
#undef GP_BAR
#undef GP_SCHED
#undef GP_AOFFS
}
}
#include <hip/hip_cooperative_groups.h>
namespace cg = cooperative_groups;
#define LAS __attribute__((address_space(3)))
typedef float f32x4 __attribute__((ext_vector_type(4)));
typedef unsigned u32x4 __attribute__((ext_vector_type(4)));
typedef short bf16x8 __attribute__((ext_vector_type(8)));
constexpr int NWAVES = 8, NTHREADS = 512;
constexpr int LDS_RING = 131072;
constexpr int LDS_BYTES = 159744;

struct Params {
    const float* in[24];
    float* out; unsigned char* ws;
    int ph_lo, ph_hi;
};
__device__ __forceinline__ unsigned pk2(float lo, float hi) { return (unsigned)f2bf(lo) | ((unsigned)f2bf(hi) << 16); }
__device__ __forceinline__ float wave_sum(float v) {
#pragma unroll
    for (int o = 1; o < 64; o <<= 1) v += __shfl_xor(v, o);
    return v;
}

__device__ __forceinline__ void p0_transpose(const float* W, int ld, int k0, int n0, bf16_t* WT, int row0, int Kdst, LAS float* scr, int lane) {
#pragma unroll 8
    for (int i = 0; i < 32; ++i) { const int kk = 2 * i + (lane >> 5); scr[kk * 33 + (lane & 31)] = W[(size_t)(k0 + kk) * ld + n0 + (lane & 31)]; }
    asm volatile("s_waitcnt lgkmcnt(0)" ::: "memory");
    const int c = lane & 7;
#pragma unroll
    for (int j = 0; j < 4; ++j) { const int n = (lane >> 3) + 8 * j; const LAS float* s = scr + (8 * c) * 33 + n;
        u32x4 o; o.x = pk2(s[0 * 33], s[1 * 33]); o.y = pk2(s[2 * 33], s[3 * 33]); o.z = pk2(s[4 * 33], s[5 * 33]); o.w = pk2(s[6 * 33], s[7 * 33]);
        *(u32x4*)(WT + (size_t)(row0 + n) * Kdst + k0 + 8 * c) = o; }
    asm volatile("s_waitcnt lgkmcnt(0)" ::: "memory");
}
__device__ __forceinline__ void phase_prep(const Params& p, LAS unsigned char* lds, int tid, int lane, int wave) {
    unsigned char* ws = p.ws;
    {
        LAS float* sc = (LAS float*)lds;
        LAS float* part = (LAS float*)(lds + 32768);
        const float* c = p.in[1]; const float* w_ada = p.in[4]; const float* b_ada = p.in[5];
        for (int i = tid; i < 8192; i += NTHREADS) { const float v = c[i]; sc[i] = v / (1.f + __expf(-v)); }
        __syncthreads();
        for (int cb = blockIdx.x; cb < 256; cb += gridDim.x) {
            const int half = lane >> 5, cl = lane & 31;
            float acc[8];
#pragma unroll
            for (int b = 0; b < 8; ++b) acc[b] = 0.f;
            if (cl < 24) {
                for (int it = 0; it < 64; ++it) { const int k = 128 * wave + 2 * it + half; const float wv = w_ada[(size_t)k * 6144 + 24 * cb + cl];
#pragma unroll
                    for (int b = 0; b < 8; ++b) acc[b] += sc[b * 1024 + k] * wv; }
#pragma unroll
                for (int b = 0; b < 8; ++b) part[((wave * 2 + half) * 8 + b) * 24 + cl] = acc[b];
            }
            __syncthreads();
            if (tid < 192) { const int b = tid / 24, cc = tid % 24; float s = 0.f;
                for (int q = 0; q < 16; ++q) s += part[(q * 8 + b) * 24 + cc];
                ((float*)(ws + WS_MOD))[b * 6144 + 24 * cb + cc] = s + b_ada[24 * cb + cc]; }
            __syncthreads();
        }
    }
    {
        float* rope = (float*)(ws + WS_ROPE);
        for (int i = blockIdx.x * NTHREADS + tid; i < SEQ * 8; i += gridDim.x * NTHREADS) {
            const int pos = i >> 3, f = i & 7;
            const float inv = (float)exp(-(double)f / 8.0 * log(500000.0));
            const float ang = (float)pos * inv;
            const double TWO_PI = 6.283185307179586476925287;
            const double a = (double)ang, r = a - rint(a / TWO_PI) * TWO_PI, r2 = r * r;
            double s = 0.0, c = 0.0, ts = r, tc = 1.0;
            for (int n = 0; n < 14; ++n) { s += ts; c += tc; ts *= -r2 / (double)((2 * n + 2) * (2 * n + 3)); tc *= -r2 / (double)((2 * n + 1) * (2 * n + 2)); }
            rope[i * 2 + 0] = (float)c; rope[i * 2 + 1] = (float)s;
        }
        if (blockIdx.x == 0 && tid == 0) { const float* al = p.in[10]; float d01 = 0.f, d23 = 0.f;
            for (int j = 0; j < 64; ++j) { d01 += al[j] * al[64 + j]; d23 += al[128 + j] * al[192 + j]; }
            ((float*)(ws + WS_LAM))[0] = expf(d01) - expf(d23) + LAMBDA_INIT; }
    }
    __syncthreads();
    {
        LAS float* scr = (LAS float*)(lds + wave * 8704);
        const int gw = blockIdx.x * NWAVES + wave, NGW = gridDim.x * NWAVES;
        constexpr int I_IN = 16 * 88, I_OUT = 16 * 32, I_UV = 32, I_EXP = 32 * 3 * 512, NITEMS = I_IN + I_OUT + I_UV + I_EXP;
        for (int it = gw; it < NITEMS; it += NGW) {
            int r = it;
            if (r < I_IN) { p0_transpose(p.in[6], NIN, 64 * (r / 88), 32 * (r % 88), (bf16_t*)(ws + WS_WINT), 32 * (r % 88), 1024, scr, lane); continue; } r -= I_IN;
            if (r < I_OUT) { p0_transpose(p.in[7], 1024, 64 * (r / 32), 32 * (r % 32), (bf16_t*)(ws + WS_WOUTT), 32 * (r % 32), 1024, scr, lane); continue; } r -= I_OUT;
            if (r < I_UV) { const int h = r >> 2, rr = r & 3; p0_transpose(p.in[15] + h * 128 * 64, 64, 64 * (rr >> 1), 32 * (rr & 1), (bf16_t*)(ws + WS_WUVT) + h * 64 * 128, 32 * (rr & 1), 128, scr, lane); continue; } r -= I_UV;
            const int e = r / 1536, q = r % 1536, mat = q / 512, i2 = q % 512, kb = i2 / 32, nb = i2 % 32, n0 = 32 * nb;
            if (mat == 2) p0_transpose(p.in[22] + (size_t)e * 1048576, 1024, 64 * kb, n0, (bf16_t*)(ws + WS_WDT) + (size_t)e * 1048576, n0, 1024, scr, lane);
            else p0_transpose(p.in[mat == 0 ? 18 : 20] + (size_t)e * 1048576, 1024, 64 * kb, n0, (bf16_t*)(ws + WS_WGUT) + (size_t)e * 2097152, 256 * (n0 >> 7) + (n0 & 127) + (mat == 1 ? 128 : 0), 1024, scr, lane);
        }
    }
}

__device__ __forceinline__ void phase_norm1(const Params& p, LAS unsigned char* lds, int tid, int lane, int wave) {
    unsigned char* ws = p.ws;
    const float* x = p.in[0]; const float* g = p.in[2]; const float* w_in = p.in[6]; const float* mod = (const float*)(ws + WS_MOD);
    bf16_t* H = (bf16_t*)(ws + WS_H); float* IW = (float*)(ws + WS_IW);
    LAS float* wiw = (LAS float*)lds;
    for (int i = tid; i < 8192; i += NTHREADS) wiw[i] = w_in[(size_t)(i >> 3) * NIN + C_IW + (i & 7)];
    __syncthreads();
    const int gw = blockIdx.x * NWAVES + wave, NGW = gridDim.x * NWAVES;
    f32x4 gv[4];
#pragma unroll
    for (int j = 0; j < 4; ++j) gv[j] = *(const f32x4*)(g + 4 * (lane + 64 * j));
    for (int t = gw; t < NTOK; t += NGW) {
        const int b = t / SEQ; const float* sh = mod + b * 6144, * sc = sh + 1024;
        f32x4 v[4]; float ss = 0.f;
#pragma unroll
        for (int j = 0; j < 4; ++j) { v[j] = *(const f32x4*)(x + (size_t)t * DM + 4 * (lane + 64 * j)); ss += (v[j].x * v[j].x + v[j].y * v[j].y) + (v[j].z * v[j].z + v[j].w * v[j].w); }
        const float r = 1.0f / sqrtf(wave_sum(ss) * (1.f / DM) + RMS_EPS);
        float iw[8];
#pragma unroll
        for (int q = 0; q < 8; ++q) iw[q] = 0.f;
#pragma unroll
        for (int j = 0; j < 4; ++j) { const int k0 = 4 * (lane + 64 * j);
            const f32x4 s4 = *(const f32x4*)(sc + k0), h4 = *(const f32x4*)(sh + k0);
            f32x4 hv = (v[j] * r * gv[j]) * (s4 + 1.0f) + h4;
            *(uint2*)(H + (size_t)t * DM + k0) = make_uint2(pk2(hv.x, hv.y), pk2(hv.z, hv.w));
#pragma unroll
            for (int i = 0; i < 4; ++i) { const f32x4 w0 = *(const LAS f32x4*)(wiw + (k0 + i) * 8), w1 = *(const LAS f32x4*)(wiw + (k0 + i) * 8 + 4);
                iw[0] += hv[i] * w0.x; iw[1] += hv[i] * w0.y; iw[2] += hv[i] * w0.z; iw[3] += hv[i] * w0.w;
                iw[4] += hv[i] * w1.x; iw[5] += hv[i] * w1.y; iw[6] += hv[i] * w1.z; iw[7] += hv[i] * w1.w; } }
#pragma unroll
        for (int q = 0; q < 8; ++q) iw[q] = wave_sum(iw[q]);
        if (lane == 0) { *(f32x4*)(IW + (size_t)t * 8) = (f32x4){iw[0], iw[1], iw[2], iw[3]} * 0.04419417382415922f; *(f32x4*)(IW + (size_t)t * 8 + 4) = (f32x4){iw[4], iw[5], iw[6], iw[7]} * 0.04419417382415922f; }
    }
}

__device__ __forceinline__ void phase_norm2(const Params& p, LAS unsigned char* lds, int tid, int lane, int wave) {
    unsigned char* ws = p.ws;
    const float* x1 = p.out; const float* g = p.in[3]; const float* rw = p.in[16]; const float* rb = p.in[17]; const float* mod = (const float*)(ws + WS_MOD);
    bf16_t* H = (bf16_t*)(ws + WS_H); int* topi = (int*)(ws + WS_TOPI); float* topg = (float*)(ws + WS_TOPG); int* chcnt = (int*)(ws + WS_CHCNT);
    LAS float* rwl = (LAS float*)lds;
    for (int i = tid; i < 32768; i += NTHREADS) { const int k = i >> 5, e = i & 31; rwl[e * 1028 + k] = rw[i]; }
    LAS int* cnt = (LAS int*)(lds + 32 * 1028 * 4);
    LAS float* lg = (LAS float*)(lds + 32 * 1028 * 4 + 128) + wave * 32;
    __syncthreads();
    f32x4 gv[4];
#pragma unroll
    for (int j = 0; j < 4; ++j) gv[j] = *(const f32x4*)(g + 4 * (lane + 64 * j));
    for (int ch = blockIdx.x; ch < NCHUNK; ch += gridDim.x) {
        if (tid < 32) cnt[tid] = 0;
        __syncthreads();
        for (int rr = 0; rr < 16; ++rr) {
            const int t = ch * CHTOK + wave * 16 + rr, b = t / SEQ; const float* sh = mod + b * 6144 + 3 * 1024, * sc = sh + 1024;
            f32x4 v[4]; float ss = 0.f;
#pragma unroll
            for (int j = 0; j < 4; ++j) { v[j] = *(const f32x4*)(x1 + (size_t)t * DM + 4 * (lane + 64 * j)); ss += (v[j].x * v[j].x + v[j].y * v[j].y) + (v[j].z * v[j].z + v[j].w * v[j].w); }
            const float r = 1.0f / sqrtf(wave_sum(ss) * (1.f / DM) + RMS_EPS);
            f32x4 hv[4];
#pragma unroll
            for (int j = 0; j < 4; ++j) { const int k0 = 4 * (lane + 64 * j);
                const f32x4 s4 = *(const f32x4*)(sc + k0), h4 = *(const f32x4*)(sh + k0);
                hv[j] = (v[j] * r * gv[j]) * (s4 + 1.0f) + h4;
                *(uint2*)(H + (size_t)t * DM + k0) = make_uint2(pk2(hv[j].x, hv[j].y), pk2(hv[j].z, hv[j].w)); }
            float mylogit = 0.f;
            for (int e = 0; e < 32; ++e) { float pa = 0.f;
#pragma unroll
                for (int j = 0; j < 4; ++j) { const f32x4 w4 = *(const LAS f32x4*)(rwl + e * 1028 + 4 * (lane + 64 * j)); pa += (hv[j].x * w4.x + hv[j].y * w4.y) + (hv[j].z * w4.z + hv[j].w * w4.w); }
                pa = wave_sum(pa); if (lane == e) mylogit = pa + rb[e]; }
            if (lane < 32) lg[lane] = mylogit;
            asm volatile("s_waitcnt lgkmcnt(0)" ::: "memory");
            if (lane == 0) {
                int idx[4]; float val[4]; unsigned used = 0;
#pragma unroll
                for (int k = 0; k < 4; ++k) { int bi = -1; float bv = -INFINITY;
                    for (int j = 0; j < 32; ++j) { const float lv = lg[j]; if (!((used >> j) & 1u) && (bi < 0 || lv > bv)) { bi = j; bv = lv; } }
                    used |= 1u << bi; idx[k] = bi; val[k] = bv; }
                float ex[4], sum = 0.f;
#pragma unroll
                for (int k = 0; k < 4; ++k) { ex[k] = __expf(val[k] - val[0]); sum += ex[k]; }
                const float inv = 1.f / sum;
                *(int4*)(topi + t * 4) = make_int4(idx[0], idx[1], idx[2], idx[3]);
                *(f32x4*)(topg + t * 4) = (f32x4){ex[0] * inv, ex[1] * inv, ex[2] * inv, ex[3] * inv};
#pragma unroll
                for (int k = 0; k < 4; ++k) atomicAdd((int*)&cnt[idx[k]], 1);
            }
            asm volatile("s_waitcnt lgkmcnt(0)" ::: "memory");
        }
        __syncthreads();
        if (tid < 32) chcnt[ch * 32 + tid] = cnt[tid];
        __syncthreads();
    }
}

__device__ __forceinline__ void phase_scatter(const Params& p, LAS unsigned char* lds, int tid, int lane, int wave) {
    unsigned char* ws = p.ws;
    const int* topi = (const int*)(ws + WS_TOPI); const int* chcnt = (const int*)(ws + WS_CHCNT);
    int* rowtok = (int*)(ws + WS_ROWTOK); int* rowsrc = (int*)(ws + WS_ROWSRC); int* tile_e = (int*)(ws + WS_TILEE);
    LAS int* total = (LAS int*)lds; LAS int* before = total + 32; LAS int* padded = total + 64; LAS int* poff = total + 96; LAS int* ent = total + 160;
    for (int ch = blockIdx.x; ch < NCHUNK; ch += gridDim.x) {
        if (tid < 32) { int tt = 0, bb = 0; for (int c = 0; c < NCHUNK; ++c) { const int v = chcnt[c * 32 + tid]; tt += v; if (c < ch) bb += v; }
            total[tid] = tt; before[tid] = bb; padded[tid] = (tt + 255) / 256 * 256; }
        { const int i = tid; ent[i] = topi[ch * CHTOK * 4 + i]; }
        __syncthreads();
        if (tid == 0) { int a = 0; for (int e = 0; e < 32; ++e) { poff[e] = a; a += padded[e]; } poff[32] = a; }
        __syncthreads();
        if (tid < 32) { int pos = poff[tid] + before[tid];
            for (int i = 0; i < CHTOK * 4; ++i) if (ent[i] == tid) { const int en = ch * CHTOK * 4 + i; rowtok[pos] = en; rowsrc[pos] = en >> 2; ++pos; } }
        if (ch == 0) {
            for (int e = 0; e < 32; ++e) for (int r = poff[e] + total[e] + tid; r < poff[e] + padded[e]; r += NTHREADS) { rowtok[r] = -1; rowsrc[r] = 0; }
            for (int e = 0; e < 32; ++e) for (int ti = poff[e] / 256 + tid; ti < (poff[e] + padded[e]) / 256; ti += NTHREADS) tile_e[ti] = e;
            if (tid == 0) tile_e[MAXTILES] = poff[32] / 256;
        }
        __syncthreads();
    }
}

__device__ __forceinline__ void phase_combine(const Params& p, int tid) {
    unsigned char* ws = p.ws; float* out = p.out; const bf16_t* Y = (const bf16_t*)(ws + WS_Y); const float* mod = (const float*)(ws + WS_MOD);
    const size_t nvec = (size_t)NTOK * DM / 8;
    for (size_t i = (size_t)blockIdx.x * NTHREADS + tid; i < nvec; i += (size_t)gridDim.x * NTHREADS) {
        const size_t o = i * 8; const int t = (int)(o / DM), n = (int)(o % DM), b = t / SEQ;
        const u32x4 a = *(const u32x4*)(Y + o), c = *(const u32x4*)(Y + (size_t)NTOK * DM + o), d = *(const u32x4*)(Y + (size_t)2 * NTOK * DM + o);
        const float* g2 = mod + b * 6144 + 5 * 1024 + n;
        f32x4 o0 = *(const f32x4*)(out + o), o1 = *(const f32x4*)(out + o + 4);
        const f32x4 g0 = *(const f32x4*)g2, g1 = *(const f32x4*)(g2 + 4);
#define LO(u) __uint_as_float((u) << 16)
#define HI(u) __uint_as_float((u) & 0xffff0000u)
        o0.x += g0.x * (LO(a.x) + LO(c.x) + LO(d.x)); o0.y += g0.y * (HI(a.x) + HI(c.x) + HI(d.x));
        o0.z += g0.z * (LO(a.y) + LO(c.y) + LO(d.y)); o0.w += g0.w * (HI(a.y) + HI(c.y) + HI(d.y));
        o1.x += g1.x * (LO(a.z) + LO(c.z) + LO(d.z)); o1.y += g1.y * (HI(a.z) + HI(c.z) + HI(d.z));
        o1.z += g1.z * (LO(a.w) + LO(c.w) + LO(d.w)); o1.w += g1.w * (HI(a.w) + HI(c.w) + HI(d.w));
#undef LO
#undef HI
        *(f32x4*)(out + o) = o0; *(f32x4*)(out + o + 4) = o1;
    }
}

__device__ __forceinline__ float wg_sum(float v, LAS float* red, int tid) {
    v = wave_sum(v);
    __syncthreads();
    if ((tid & 63) == 0) red[tid >> 6] = v;
    __syncthreads();
    float s = 0.f;
#pragma unroll
    for (int i = 0; i < 8; ++i) s += red[i];
    return s;
}
__device__ __forceinline__ float wg_max(float v, LAS float* red, int tid) {
#pragma unroll
    for (int o = 1; o < 64; o <<= 1) v = fmaxf(v, __shfl_xor(v, o));
    __syncthreads();
    if ((tid & 63) == 0) red[tid >> 6] = v;
    __syncthreads();
    float s = red[0];
#pragma unroll
    for (int i = 1; i < 8; ++i) s = fmaxf(s, red[i]);
    return s;
}
__device__ __forceinline__ void phase_post_slow(const Params& p, int tid) {
    unsigned char* ws = p.ws; bf16_t* PROJ = (bf16_t*)(ws + WS_PROJ); const float* rope = (const float*)(ws + WS_ROPE);
    const long total = (long)NTOK * 44;
    for (long it = (long)blockIdx.x * NTHREADS + tid; it < total; it += (long)gridDim.x * NTHREADS) {
        const int t = (int)(it / 44), gidx = (int)(it % 44), pos = t % SEQ, c0 = gidx * 64;
        bf16_t* row = PROJ + (size_t)t * NPJ;
        bool donorm = false, dorope = false; const float* gg = nullptr;
        if (c0 < 512) { donorm = true; dorope = true; gg = p.in[8]; }
        else if (c0 < 1024) { donorm = true; dorope = true; gg = p.in[9]; }
        else if (c0 < 1536) { continue; }
        else if (c0 < 2048) { donorm = true; dorope = true; gg = p.in[12]; }
        else if (c0 < 2112) { donorm = true; dorope = true; gg = p.in[13]; }
        else if (c0 < 2240) {
            if (c0 != 2112) continue;
            float ss = 0.f;
            for (int i = 0; i < 128; ++i) { const float f = bf2f(row[c0 + i]); ss += f * f; }
            const float r = 1.0f / sqrtf(ss * (1.f / 128.f) + RMS_EPS);
            for (int i = 0; i < 128; ++i) row[c0 + i] = f2bf(bf2f(row[c0 + i]) * r * p.in[14][i]);
            continue;
        }
        else { dorope = true; }
        float ss = 0.f;
        for (int i = 0; i < 64; ++i) { const float f = bf2f(row[c0 + i]); ss += f * f; }
        const float r = donorm ? 1.0f / sqrtf(ss * (1.f / 64.f) + RMS_EPS) : 1.0f;
        float head[16];
#pragma unroll
        for (int i = 0; i < 16; ++i) head[i] = bf2f(row[c0 + i]) * r * (donorm ? gg[i] : 1.0f);
        if (dorope) {
#pragma unroll
            for (int i = 0; i < 8; ++i) { const float cs = rope[(pos * 8 + i) * 2], sn = rope[(pos * 8 + i) * 2 + 1];
                const float x1 = head[i], x2 = head[8 + i]; head[i] = x1 * cs - x2 * sn; head[8 + i] = x2 * cs + x1 * sn; }
        }
#pragma unroll
        for (int i = 0; i < 16; ++i) row[c0 + i] = f2bf(head[i]);
        if (donorm) for (int i = 16; i < 64; ++i) row[c0 + i] = f2bf(bf2f(row[c0 + i]) * r * gg[i]);
    }
}
__device__ __forceinline__ void phase_diffattn_slow(const Params& p, LAS unsigned char* lds, int tid) {
    unsigned char* ws = p.ws; const bf16_t* PROJ = (const bf16_t*)(ws + WS_PROJ); bf16_t* H = (bf16_t*)(ws + WS_H);
    const float lam = ((const float*)(ws + WS_LAM))[0]; const float* sub_g = p.in[11];
    LAS float* q1 = (LAS float*)lds; LAS float* q2 = q1 + 64; LAS float* red = q1 + 128; LAS float* osum = q1 + 160;
    LAS float* s1 = q1 + 1024; LAS float* s2 = s1 + 4096;
    for (int it = blockIdx.x; it < NTOK * 4; it += gridDim.x) {
        const int t = it >> 2, h = it & 3, b = t / SEQ, s = t % SEQ, N = (s / 64 + 1) * 64;
        const bf16_t* qrow = PROJ + (size_t)t * NPJ;
        __syncthreads();
        if (tid < 64) q1[tid] = bf2f(qrow[C_AQ1 + h * 64 + tid]);
        else if (tid < 128) q2[tid - 64] = bf2f(qrow[C_AQ2 + h * 64 + tid - 64]);
        __syncthreads();
        float m1 = -INFINITY, m2 = -INFINITY;
        for (int key = tid; key < N; key += NTHREADS) {
            const bf16_t* kr = PROJ + (size_t)(b * SEQ + key) * NPJ;
            float d1 = 0.f, d2 = 0.f;
            for (int d = 0; d < 64; ++d) { d1 += q1[d] * bf2f(kr[C_AK1 + h * 64 + d]); d2 += q2[d] * bf2f(kr[C_AK2 + h * 64 + d]); }
            d1 *= 0.125f; d2 *= 0.125f; s1[key] = d1; s2[key] = d2; m1 = fmaxf(m1, d1); m2 = fmaxf(m2, d2);
        }
        m1 = wg_max(m1, red, tid); m2 = wg_max(m2, red, tid);
        float l1 = 0.f, l2 = 0.f;
        for (int key = tid; key < N; key += NTHREADS) { const float e1 = __expf(s1[key] - m1), e2 = __expf(s2[key] - m2); s1[key] = e1; s2[key] = e2; l1 += e1; l2 += e2; }
        l1 = wg_sum(l1, red, tid); l2 = wg_sum(l2, red, tid);
        const float i1 = 1.f / l1, i2 = lam / l2;
        for (int key = tid; key < N; key += NTHREADS) s1[key] = s1[key] * i1 - s2[key] * i2;
        __syncthreads();
        const int e = tid & 127, part = tid >> 7;
        float o = 0.f;
        for (int key = part; key < N; key += 4) o += s1[key] * bf2f(PROJ[(size_t)(b * SEQ + key) * NPJ + C_AV + h * 128 + e]);
        osum[part * 128 + e] = o;
        __syncthreads();
        float ov = 0.f, sq = 0.f;
        if (tid < 128) { ov = (osum[tid] + osum[128 + tid]) + (osum[256 + tid] + osum[384 + tid]); sq = ov * ov; }
        const float ss = wg_sum(sq, red, tid);
        if (tid < 128) H[(size_t)t * DM + h * 128 + tid] = f2bf(ov * (1.0f / sqrtf(ss * (1.f / 128.f) + RMS_EPS)) * sub_g[tid] * (1.0f - LAMBDA_INIT));
    }
}
__device__ __forceinline__ void phase_dsa_slow(const Params& p, LAS unsigned char* lds, int tid) {
    unsigned char* ws = p.ws; const bf16_t* PROJ = (const bf16_t*)(ws + WS_PROJ); bf16_t* H = (bf16_t*)(ws + WS_H);
    const float* IW = (const float*)(ws + WS_IW); const float* w_uv = p.in[15];
    LAS float* iq = (LAS float*)lds; LAS float* bq = iq + 512; LAS float* w = iq + 1024; LAS float* score = iq + 1088;
    LAS float* pp = score + 4096;
    LAS float* o = pp + 2048;
    LAS int* sel = (LAS int*)(o + 1024);
    for (int t = blockIdx.x; t < NTOK; t += gridDim.x) {
        const int b = t / SEQ, s = t % SEQ, N = (s / 64 + 1) * 64;
        const bf16_t* qrow = PROJ + (size_t)t * NPJ;
        __syncthreads();
        { const int i = tid; iq[i] = bf2f(qrow[C_IQ + i]); bq[i] = bf2f(qrow[C_BQ + i]); }
        if (tid < 8) w[tid] = IW[(size_t)t * 8 + tid];
        __syncthreads();
        for (int key = tid; key < N; key += NTHREADS) {
            const bf16_t* kr = PROJ + (size_t)(b * SEQ + key) * NPJ + C_IK;
            float sc = 0.f;
            for (int hh = 0; hh < 8; ++hh) { float d0 = 0.f;
                for (int d = 0; d < 64; ++d) d0 += iq[hh * 64 + d] * bf2f(kr[d]);
                sc += w[hh] * fmaxf(d0, 0.f); }
            score[key] = sc;
        }
        __syncthreads();
        const int nsel = N < 256 ? N : 256;
        for (int key = tid; key < N; key += NTHREADS) {
            const float my = score[key]; int r = 0;
            for (int j = 0; j < N; ++j) { const float ot = score[j]; r += (ot > my || (ot == my && j < key)) ? 1 : 0; }
            if (r < 256) sel[r] = key;
        }
        __syncthreads();
        if (tid < nsel) {
            const bf16_t* kr = PROJ + (size_t)(b * SEQ + sel[tid]) * NPJ + C_BK;
            for (int hh = 0; hh < 8; ++hh) { float d0 = 0.f;
                for (int d = 0; d < 64; ++d) d0 += bq[hh * 64 + d] * bf2f(kr[d]);
                pp[hh * 256 + tid] = d0 * 0.125f; }
        }
        __syncthreads();
        {
            const int hh = tid >> 6, l = tid & 63;
            float m = -INFINITY;
            for (int j = l; j < nsel; j += 64) m = fmaxf(m, pp[hh * 256 + j]);
#pragma unroll
            for (int of = 32; of > 0; of >>= 1) m = fmaxf(m, __shfl_xor(m, of));
            float sum = 0.f;
            for (int j = l; j < nsel; j += 64) { const float ev = __expf(pp[hh * 256 + j] - m); pp[hh * 256 + j] = ev; sum += ev; }
            sum = wave_sum(sum);
            const float inv = 1.f / sum;
            for (int j = l; j < nsel; j += 64) pp[hh * 256 + j] *= inv;
        }
        __syncthreads();
        {
            const int hh = tid >> 6, l = tid & 63;
            float a0 = 0.f, a1 = 0.f;
            for (int j = 0; j < nsel; ++j) { const bf16_t* lr = PROJ + (size_t)(b * SEQ + sel[j]) * NPJ + C_BLAT; const float pv = pp[hh * 256 + j];
                a0 += pv * bf2f(lr[l]); a1 += pv * bf2f(lr[l + 64]); }
            o[hh * 128 + l] = a0; o[hh * 128 + l + 64] = a1;
        }
        __syncthreads();
        {
            const int hh = tid >> 6, l = tid & 63;
            float a0 = 0.f;
            for (int c = 0; c < 128; ++c) a0 += o[hh * 128 + c] * w_uv[(hh * 128 + c) * 64 + l];
            H[(size_t)t * DM + 512 + hh * 64 + l] = f2bf(a0);
        }
    }
}
constexpr int N_PHASES = 11;
__global__ void __launch_bounds__(NTHREADS, 2) mega(Params p) {
    extern __shared__ __attribute__((aligned(16))) unsigned char lds_raw[];
    LAS unsigned char* lds = (LAS unsigned char*)lds_raw;
    cg::grid_group grid = cg::this_grid();
    const int tid = threadIdx.x, lane = tid & 63, wave = __builtin_amdgcn_readfirstlane(tid >> 6);
    unsigned char* ws = p.ws;
    const int lo = p.ph_lo, hi = p.ph_hi;
#define IN(k) (lo <= (k) && (k) < hi)
#define SEAM(k) do { if (IN(k) && IN((k) + 1)) grid.sync(); } while (0)
    if (IN(0)) { phase_prep(p, lds, tid, lane, wave); } SEAM(0);
    if (IN(1)) { phase_norm1(p, lds, tid, lane, wave); } SEAM(1);
    if (IN(2)) {
        gp::Gemm g{(const bf16_t*)(ws + WS_H), (const bf16_t*)(ws + WS_WINT), NPJ, DM, nullptr};
        gp::StaticOrder S; S.init(NTOK, NPJ, gridDim.x, blockIdx.x);
        gp::EpiBf16 E{(bf16_t*)(ws + WS_PROJ), NPJ};
        gp::gemm_phase<gp::EpiBf16, gp::StaticOrder, false>(lds, g, S, E);
    } SEAM(2);
    if (IN(3)) { phase_post_slow(p, tid); } SEAM(3);
    if (IN(4)) { phase_diffattn_slow(p, lds, tid); phase_dsa_slow(p, lds, tid); } SEAM(4);
    if (IN(5)) {
        gp::Gemm g{(const bf16_t*)(ws + WS_H), (const bf16_t*)(ws + WS_WOUTT), DM, DM, nullptr};
        gp::StaticOrder S; S.init(NTOK, DM, gridDim.x, blockIdx.x);
        gp::EpiResid E{p.in[0], p.out, (const float*)(ws + WS_MOD)};
        gp::gemm_phase<gp::EpiResid, gp::StaticOrder, false>(lds, g, S, E);
    } SEAM(5);
    if (IN(6)) { phase_norm2(p, lds, tid, lane, wave); } SEAM(6);
    if (IN(7)) { phase_scatter(p, lds, tid, lane, wave); } SEAM(7);
    if (IN(8)) {
        const int* tile_e = (const int*)(ws + WS_TILEE);
        gp::Gemm g{(const bf16_t*)(ws + WS_H), (const bf16_t*)(ws + WS_WGUT), 2048, DM, (const int*)(ws + WS_ROWSRC)};
        gp::MoeOrder S{tile_e, tile_e[MAXTILES], 8, (int)blockIdx.x, (int)gridDim.x};
        gp::EpiSwiglu E{(bf16_t*)(ws + WS_ACT), p.in[19], p.in[21]};
        gp::gemm_phase<gp::EpiSwiglu, gp::MoeOrder, true>(lds, g, S, E);
    } SEAM(8);
    if (IN(9)) {
        const int* tile_e = (const int*)(ws + WS_TILEE);
        gp::Gemm g{(const bf16_t*)(ws + WS_ACT), (const bf16_t*)(ws + WS_WDT), DM, DM, nullptr};
        gp::MoeOrder S{tile_e, tile_e[MAXTILES], 4, (int)blockIdx.x, (int)gridDim.x};
        gp::EpiDown E{p.out, (bf16_t*)(ws + WS_Y), p.in[23], (const float*)(ws + WS_MOD), (const int*)(ws + WS_ROWTOK), (const float*)(ws + WS_TOPG)};
        gp::gemm_phase<gp::EpiDown, gp::MoeOrder, false>(lds, g, S, E);
    } SEAM(9);
    if (IN(10)) { phase_combine(p, tid); }
#undef IN
#undef SEAM
}

static int g_grid = 0;
static void launch_mega(const Params& base, int lo, int hi, hipStream_t stream) {
    Params p = base; p.ph_lo = lo; p.ph_hi = hi;
    void* args[] = {&p};
    hipError_t e = hipLaunchCooperativeKernel((const void*)mega, dim3(g_grid), dim3(NTHREADS), args, LDS_BYTES, stream);
    if (e != hipSuccess) fprintf(stderr, "kernel_launch: cooperative launch [%d,%d) failed: %s (grid %d)\n", lo, hi, hipGetErrorString(e), g_grid);
}
extern "C" void kernel_launch(void* const* d_in, const int* in_sizes, int n_in, void* d_out, int out_size, void* d_ws, size_t ws_size, hipStream_t stream) {
    if (ws_size < WS_END) { fprintf(stderr, "kernel_launch: workspace too small: %zu < %zu\n", ws_size, (size_t)WS_END); return; }
    if (g_grid == 0) {
        int dev = 0, cus = 0, per_cu = 0;
        hipGetDevice(&dev); hipDeviceGetAttribute(&cus, hipDeviceAttributeMultiprocessorCount, dev);
        if (hipFuncSetAttribute((const void*)mega, hipFuncAttributeMaxDynamicSharedMemorySize, LDS_BYTES) != hipSuccess) fprintf(stderr, "kernel_launch: hipFuncSetAttribute failed\n");
        hipOccupancyMaxActiveBlocksPerMultiprocessor(&per_cu, (const void*)mega, NTHREADS, LDS_BYTES);
        (void)hipGetLastError();
        if (per_cu < 1) { fprintf(stderr, "kernel_launch: occupancy query says %d blocks/CU\n", per_cu); per_cu = 1; }
        g_grid = cus * 1;
        fprintf(stderr, "kernel_launch: cus %d per_cu %d grid %d\n", cus, per_cu, g_grid);
    }
    const float* x = (const float*)d_in[0];
    float* out = (float*)d_out; char* ws = (char*)d_ws;
    float* mod = (float*)(ws + WS_MOD); float* rope = (float*)(ws + WS_ROPE); float* lam = (float*)(ws + WS_LAM);
    float* IW = (float*)(ws + WS_IW);
    bf16_t* H = (bf16_t*)(ws + WS_H); bf16_t* PROJ = (bf16_t*)(ws + WS_PROJ);
    Params P{};
    for (int i = 0; i < 24; ++i) P.in[i] = (const float*)d_in[i];
    P.out = out; P.ws = (unsigned char*)d_ws;

    launch_mega(P, 0, N_PHASES, stream);
    (void)rope; (void)lam; (void)IW; (void)H; (void)PROJ;
    (void)x; (void)mod;
}
```

```cpp
#include <hip/hip_runtime.h>
#include <stdint.h>
#include <cstdio>

typedef unsigned short bf16_t;
__device__ __forceinline__ float bf2f(bf16_t v) { return __uint_as_float(((unsigned)v) << 16); }
__device__ __forceinline__ bf16_t f2bf(float f) { unsigned u = __float_as_uint(f); return (bf16_t)((u + 0x7fffu + ((u >> 16) & 1u)) >> 16); }

constexpr int NB = 8, SEQ = 4096, DM = 1024, NTOK = NB * SEQ;
constexpr int NIN = 2824, NPJ = 2816;
constexpr int C_AQ1 = 0, C_AQ2 = 256, C_AK1 = 512, C_AK2 = 768, C_AV = 1024, C_BQ = 1536, C_BK = 2048, C_BLAT = 2112, C_IQ = 2240, C_IK = 2752, C_IW = 2816;
constexpr int NEXP = 32, TOPK = 4, NPAIR = NTOK * TOPK;
constexpr int MAXTILES = NPAIR / 256 + NEXP;
constexpr int PPAD = MAXTILES * 256;
constexpr int NCHUNK = 256, CHTOK = NTOK / NCHUNK;
constexpr float RMS_EPS = 1e-6f;
constexpr float LAMBDA_INIT = 0.2f;

constexpr size_t MiB = 1u << 20;
constexpr size_t WS_CTL = 0;
constexpr size_t WS_MOD = 1 * MiB;
constexpr size_t WS_ROPE = WS_MOD + 256 * 1024;
constexpr size_t WS_LAM = WS_ROPE + 256 * 1024;
constexpr size_t WS_CHCNT = WS_LAM + 4096;
constexpr size_t WS_TILEE = WS_CHCNT + 32768;
constexpr size_t WS_TOPI = 2 * MiB;
constexpr size_t WS_TOPG = WS_TOPI + 512 * 1024;
constexpr size_t WS_ROWTOK = 3 * MiB;
constexpr size_t WS_ROWSRC = 3 * MiB + 640 * 1024;
constexpr size_t WS_IW = 5 * MiB;
constexpr size_t WS_WINT = 8 * MiB;
constexpr size_t WS_WOUTT = 14 * MiB;
constexpr size_t WS_WUVT = 16 * MiB;
constexpr size_t WS_WDT = 17 * MiB;
constexpr size_t WS_WGUT = 81 * MiB;
constexpr size_t WS_H = 209 * MiB;
constexpr size_t WS_PROJ = 273 * MiB;
constexpr size_t WS_ACT = WS_PROJ;
constexpr size_t WS_Y = WS_WGUT;
constexpr size_t WS_END = WS_ACT + (size_t)PPAD * 1024 * 2;

__device__ __forceinline__ float block_sum_256(float v, float* red) {
#pragma unroll
    for (int o = 32; o > 0; o >>= 1) v += __shfl_xor(v, o);
    const int w = threadIdx.x >> 6;
    __syncthreads();
    if ((threadIdx.x & 63) == 0) red[w] = v;
    __syncthreads();
    return red[0] + red[1] + red[2] + red[3];
}
__device__ __forceinline__ float block_max_256(float v, float* red) {
#pragma unroll
    for (int o = 32; o > 0; o >>= 1) v = fmaxf(v, __shfl_xor(v, o));
    const int w = threadIdx.x >> 6;
    __syncthreads();
    if ((threadIdx.x & 63) == 0) red[w] = v;
    __syncthreads();
    return fmaxf(fmaxf(red[0], red[1]), fmaxf(red[2], red[3]));
}

__global__ __launch_bounds__(256) void nv_prep(float* rope, float* lam, const float* a_lambda) {
    const int i = blockIdx.x * 256 + threadIdx.x;
    if (i < SEQ * 8) {
        const int pos = i >> 3, f = i & 7;
        const float inv = (float)exp(-(double)f / 8.0 * log(500000.0));
        const float ang = (float)pos * inv;
        double a = (double)ang;
        const double TWO_PI = 6.283185307179586476925287;
        double k = rint(a / TWO_PI);
        double r = a - k * TWO_PI;
        double r2 = r * r, s = 0.0, c = 0.0;
        double ts = r, tc = 1.0;
        for (int n = 0; n < 14; ++n) {
            s += ts; c += tc;
            ts *= -r2 / (double)((2 * n + 2) * (2 * n + 3));
            tc *= -r2 / (double)((2 * n + 1) * (2 * n + 2));
        }
        rope[i * 2 + 0] = (float)c;
        rope[i * 2 + 1] = (float)s;
    }
    if (i == 0) {
        float d01 = 0.f, d23 = 0.f;
        for (int j = 0; j < 64; ++j) { d01 += a_lambda[j] * a_lambda[64 + j]; d23 += a_lambda[128 + j] * a_lambda[192 + j]; }
        lam[0] = expf(d01) - expf(d23) + LAMBDA_INIT;
    }
}

__global__ __launch_bounds__(256) void nv_mod(const float* c, const float* w_ada, const float* b_ada, float* mod) {
    __shared__ float sc[8 * 1024];
    for (int i = threadIdx.x; i < 8 * 1024; i += 256) { const float v = c[i]; sc[i] = v / (1.f + expf(-v)); }
    __syncthreads();
    const int j = blockIdx.x * 256 + threadIdx.x;
    float acc[8];
#pragma unroll
    for (int b = 0; b < 8; ++b) acc[b] = 0.f;
    for (int k = 0; k < 1024; ++k) {
        const float w = w_ada[(size_t)k * 6144 + j];
#pragma unroll
        for (int b = 0; b < 8; ++b) acc[b] += sc[b * 1024 + k] * w;
    }
#pragma unroll
    for (int b = 0; b < 8; ++b) mod[b * 6144 + j] = acc[b] + b_ada[j];
}

__global__ __launch_bounds__(256) void nv_norm1(const float* x, const float* g, const float* mod, const float* w_in, bf16_t* H, float* IW) {
    __shared__ float red[8];
    __shared__ float hrow[1024];
    const int t = blockIdx.x, b = t / SEQ, tid = threadIdx.x;
    const float4 v = ((const float4*)(x + (size_t)t * DM))[tid];
    const float ss = block_sum_256(v.x * v.x + v.y * v.y + v.z * v.z + v.w * v.w, red);
    const float r = 1.0f / sqrtf(ss * (1.f / DM) + RMS_EPS);
    const float* sh = mod + b * 6144, * sc = mod + b * 6144 + 1024;
    float hv[4]; const float xv[4] = {v.x, v.y, v.z, v.w};
#pragma unroll
    for (int i = 0; i < 4; ++i) { const int k = tid * 4 + i; hv[i] = (xv[i] * r * g[k]) * (1.f + sc[k]) + sh[k]; hrow[k] = hv[i]; H[(size_t)t * DM + k] = f2bf(hv[i]); }
    __syncthreads();
    const int col = tid & 7, part = tid >> 3;
    float p = 0.f;
    for (int k = part * 32; k < part * 32 + 32; ++k) p += hrow[k] * w_in[(size_t)k * NIN + C_IW + col];
    p += __shfl_xor(p, 8); p += __shfl_xor(p, 16); p += __shfl_xor(p, 32);
    __shared__ float pw[4][8];
    if ((tid & 63) < 8) pw[tid >> 6][tid & 7] = p;
    __syncthreads();
    if (tid < 8) IW[(size_t)t * 8 + tid] = (pw[0][tid] + pw[1][tid] + pw[2][tid] + pw[3][tid]) * 0.04419417382415922f;
}

struct NvGemm {
    const bf16_t* A; int lda;
    const float* B; const float* B2; int ldb;
    int K;
    bf16_t* Obf; int ldo;
    const float* x; float* out; const float* mod;
    const int* rowtok; const int* tile_e; const float* topg; const float* bias; const float* bias2; bf16_t* Y;
};
template <int MODE>
__global__ __launch_bounds__(256) void nv_gemm(NvGemm a) {
    __shared__ float As[16][68];
    __shared__ float Bs[16][64];
    __shared__ float Bs2[MODE == 2 ? 16 : 1][64];
    __shared__ int rows[64];
    const int tid = threadIdx.x, tx = tid & 15, ty = tid >> 4;
    const int n0 = blockIdx.x * 64, m0 = blockIdx.y * 64;
    int e = 0;
    if (MODE == 2 || MODE == 3) {
        const int ntiles = a.tile_e[MAXTILES];
        if ((int)(blockIdx.y >> 2) >= ntiles) return;
        e = a.tile_e[blockIdx.y >> 2];
    }
    if (tid < 64) {
        int r = m0 + tid;
        if (MODE == 2) { const int ent = a.rowtok[m0 + tid]; r = ent < 0 ? 0 : (ent >> 2); }
        rows[tid] = r;
    }
    __syncthreads();
    const float* Bp = a.B + ((MODE == 2 || MODE == 3) ? (size_t)e * 1024 * 1024 : 0);
    const float* Bp2 = MODE == 2 ? a.B2 + (size_t)e * 1024 * 1024 : nullptr;
    float acc[4][4], acc2[4][4];
#pragma unroll
    for (int i = 0; i < 4; ++i)
#pragma unroll
        for (int j = 0; j < 4; ++j) { acc[i][j] = 0.f; acc2[i][j] = 0.f; }
    const int ar = tid >> 2, ak = (tid & 3) * 4;
    const int bk = tid >> 4, bn = (tid & 15) * 4;
    for (int k0 = 0; k0 < a.K; k0 += 16) {
        const uint2 av = *(const uint2*)(a.A + (size_t)rows[ar] * a.lda + k0 + ak);
        As[ak + 0][ar] = __uint_as_float(av.x << 16); As[ak + 1][ar] = __uint_as_float(av.x & 0xffff0000u);
        As[ak + 2][ar] = __uint_as_float(av.y << 16); As[ak + 3][ar] = __uint_as_float(av.y & 0xffff0000u);
        const float4 bv = *(const float4*)(Bp + (size_t)(k0 + bk) * a.ldb + n0 + bn);
        Bs[bk][bn] = bv.x; Bs[bk][bn + 1] = bv.y; Bs[bk][bn + 2] = bv.z; Bs[bk][bn + 3] = bv.w;
        if (MODE == 2) { const float4 b2 = *(const float4*)(Bp2 + (size_t)(k0 + bk) * a.ldb + n0 + bn);
            Bs2[bk][bn] = b2.x; Bs2[bk][bn + 1] = b2.y; Bs2[bk][bn + 2] = b2.z; Bs2[bk][bn + 3] = b2.w; }
        __syncthreads();
#pragma unroll
        for (int k = 0; k < 16; ++k) {
            float av4[4], bv4[4], cv4[4];
#pragma unroll
            for (int i = 0; i < 4; ++i) av4[i] = As[k][ty * 4 + i];
#pragma unroll
            for (int j = 0; j < 4; ++j) { bv4[j] = Bs[k][tx * 4 + j]; if (MODE == 2) cv4[j] = Bs2[k][tx * 4 + j]; }
#pragma unroll
            for (int i = 0; i < 4; ++i)
#pragma unroll
                for (int j = 0; j < 4; ++j) { acc[i][j] += av4[i] * bv4[j]; if (MODE == 2) acc2[i][j] += av4[i] * cv4[j]; }
        }
        __syncthreads();
    }
#pragma unroll
    for (int i = 0; i < 4; ++i) {
        const int m = m0 + ty * 4 + i;
#pragma unroll
        for (int j = 0; j < 4; ++j) {
            const int n = n0 + tx * 4 + j;
            if (MODE == 0) a.Obf[(size_t)m * a.ldo + n] = f2bf(acc[i][j]);
            if (MODE == 1) { const int b = m / SEQ; a.out[(size_t)m * DM + n] = a.x[(size_t)m * DM + n] + a.mod[b * 6144 + 2 * 1024 + n] * acc[i][j]; }
            if (MODE == 2) {
                float g = acc[i][j] + a.bias[e * 1024 + n], u = acc2[i][j] + a.bias2[e * 1024 + n];
                g = fminf(g, 7.0f); u = fminf(fmaxf(u, -7.0f), 7.0f);
                const float act = g * (1.f / (1.f + expf(-1.702f * g))) * (u + 1.0f);
                a.Obf[(size_t)m * a.ldo + n] = f2bf(act);
            }
            if (MODE == 3) {
                const int ent = a.rowtok[m];
                if (ent >= 0) {
                    const int tok = ent >> 2, kk = ent & 3, b = tok / SEQ;
                    const float val = a.topg[ent] * (acc[i][j] + a.bias[e * 1024 + n]);
                    if (kk == 0) a.out[(size_t)tok * DM + n] += a.mod[b * 6144 + 5 * 1024 + n] * val;
                    else a.Y[((size_t)(kk - 1) * NTOK + tok) * DM + n] = f2bf(val);
                }
            }
        }
    }
}

__global__ __launch_bounds__(256) void nv_post(bf16_t* PROJ, const float* rope, const float* aq_g, const float* ak_g, const float* bq_g, const float* bk_g, const float* bkv_g) {
    const int t = blockIdx.x, pos = t % SEQ;
    bf16_t* row = PROJ + (size_t)t * NPJ;
    const int gidx = threadIdx.x;
    if (gidx >= 44) return;
    const int c0 = gidx * 64;
    float v[64];
    bool donorm = false, dorope = false; const float* gg = nullptr;
    if (c0 < 512) { donorm = true; dorope = true; gg = aq_g; }
    else if (c0 < 1024) { donorm = true; dorope = true; gg = ak_g; }
    else if (c0 < 1536) { return; }
    else if (c0 < 2048) { donorm = true; dorope = true; gg = bq_g; }
    else if (c0 < 2112) { donorm = true; dorope = true; gg = bk_g; }
    else if (c0 < 2240) {
        if (c0 != 2112) return;
        float ss = 0.f;
        for (int i = 0; i < 128; ++i) { const float f = bf2f(row[c0 + i]); ss += f * f; }
        const float r = 1.0f / sqrtf(ss * (1.f / 128.f) + RMS_EPS);
        for (int i = 0; i < 128; ++i) row[c0 + i] = f2bf(bf2f(row[c0 + i]) * r * bkv_g[i]);
        return;
    }
    else { dorope = true; }
    float ss = 0.f;
#pragma unroll
    for (int i = 0; i < 64; ++i) { v[i] = bf2f(row[c0 + i]); ss += v[i] * v[i]; }
    if (donorm) { const float r = 1.0f / sqrtf(ss * (1.f / 64.f) + RMS_EPS);
#pragma unroll
        for (int i = 0; i < 64; ++i) v[i] = v[i] * r * gg[i]; }
    if (dorope) {
#pragma unroll
        for (int i = 0; i < 8; ++i) { const float cs = rope[(pos * 8 + i) * 2], sn = rope[(pos * 8 + i) * 2 + 1];
            const float x1 = v[i], x2 = v[8 + i]; v[i] = x1 * cs - x2 * sn; v[8 + i] = x2 * cs + x1 * sn; }
    }
#pragma unroll
    for (int i = 0; i < 64; ++i) row[c0 + i] = f2bf(v[i]);
}

__global__ __launch_bounds__(256) void nv_diffattn(const bf16_t* PROJ, bf16_t* H, const float* lamp, const float* sub_g) {
    __shared__ float q1[64], q2[64], s1[4096], s2[4096], red[8], osum[2][128];
    const int t = blockIdx.x, h = blockIdx.y, b = t / SEQ, s = t % SEQ, N = (s / 64 + 1) * 64, tid = threadIdx.x;
    const bf16_t* qrow = PROJ + (size_t)t * NPJ;
    if (tid < 64) q1[tid] = bf2f(qrow[C_AQ1 + h * 64 + tid]);
    else if (tid < 128) q2[tid - 64] = bf2f(qrow[C_AQ2 + h * 64 + tid - 64]);
    __syncthreads();
    float m1 = -INFINITY, m2 = -INFINITY;
    for (int key = tid; key < N; key += 256) {
        const bf16_t* kr = PROJ + (size_t)(b * SEQ + key) * NPJ;
        float d1 = 0.f, d2 = 0.f;
        for (int d = 0; d < 64; ++d) { d1 += q1[d] * bf2f(kr[C_AK1 + h * 64 + d]); d2 += q2[d] * bf2f(kr[C_AK2 + h * 64 + d]); }
        d1 *= 0.125f; d2 *= 0.125f; s1[key] = d1; s2[key] = d2; m1 = fmaxf(m1, d1); m2 = fmaxf(m2, d2);
    }
    m1 = block_max_256(m1, red); m2 = block_max_256(m2, red);
    float l1 = 0.f, l2 = 0.f;
    for (int key = tid; key < N; key += 256) { const float e1 = expf(s1[key] - m1), e2 = expf(s2[key] - m2); s1[key] = e1; s2[key] = e2; l1 += e1; l2 += e2; }
    l1 = block_sum_256(l1, red); l2 = block_sum_256(l2, red);
    const float lam = lamp[0], i1 = 1.f / l1, i2 = lam / l2;
    for (int key = tid; key < N; key += 256) s1[key] = s1[key] * i1 - s2[key] * i2;
    __syncthreads();
    const int e = tid & 127, half = tid >> 7;
    float o = 0.f;
    for (int key = half; key < N; key += 2) o += s1[key] * bf2f(PROJ[(size_t)(b * SEQ + key) * NPJ + C_AV + h * 128 + e]);
    osum[half][e] = o;
    __syncthreads();
    float ov = 0.f, sq = 0.f;
    if (tid < 128) { ov = osum[0][tid] + osum[1][tid]; sq = ov * ov; }
    const float ss = block_sum_256(sq, red);
    if (tid < 128) H[(size_t)t * DM + h * 128 + tid] = f2bf(ov * (1.0f / sqrtf(ss * (1.f / 128.f) + RMS_EPS)) * sub_g[tid] * (1.0f - LAMBDA_INIT));
}

__global__ __launch_bounds__(256) void nv_dsa(const bf16_t* PROJ, const float* IW, const float* w_uv, bf16_t* H) {
    __shared__ float iq[8 * 64], bq[8 * 64], w[8], score[4096], p[8][256], o[8][128];
    __shared__ int sel[256];
    const int t = blockIdx.x, b = t / SEQ, s = t % SEQ, N = (s / 64 + 1) * 64, tid = threadIdx.x;
    const bf16_t* qrow = PROJ + (size_t)t * NPJ;
    for (int i = tid; i < 512; i += 256) { iq[i] = bf2f(qrow[C_IQ + i]); bq[i] = bf2f(qrow[C_BQ + i]); }
    if (tid < 8) w[tid] = IW[(size_t)t * 8 + tid];
    __syncthreads();
    for (int key = tid; key < N; key += 256) {
        const bf16_t* kr = PROJ + (size_t)(b * SEQ + key) * NPJ + C_IK;
        float kd[64];
#pragma unroll
        for (int d = 0; d < 64; ++d) kd[d] = bf2f(kr[d]);
        float sc = 0.f;
        for (int hh = 0; hh < 8; ++hh) { float d0 = 0.f;
#pragma unroll
            for (int d = 0; d < 64; ++d) d0 += iq[hh * 64 + d] * kd[d];
            sc += w[hh] * fmaxf(d0, 0.f); }
        score[key] = sc;
    }
    __syncthreads();
    const int nsel = N < 256 ? N : 256;
    for (int key = tid; key < N; key += 256) {
        const float my = score[key]; int r = 0;
        for (int j = 0; j < N; ++j) { const float ot = score[j]; r += (ot > my || (ot == my && j < key)) ? 1 : 0; }
        if (r < 256) sel[r] = key;
    }
    __syncthreads();
    if (tid < nsel) {
        const bf16_t* kr = PROJ + (size_t)(b * SEQ + sel[tid]) * NPJ + C_BK;
        float kd[64];
#pragma unroll
        for (int d = 0; d < 64; ++d) kd[d] = bf2f(kr[d]);
        for (int hh = 0; hh < 8; ++hh) { float d0 = 0.f;
#pragma unroll
            for (int d = 0; d < 64; ++d) d0 += bq[hh * 64 + d] * kd[d];
            p[hh][tid] = d0 * 0.125f; }
    }
    __syncthreads();
    {
        const int hh = tid >> 5, l = tid & 31;
        float m = -INFINITY;
        for (int j = l; j < nsel; j += 32) m = fmaxf(m, p[hh][j]);
#pragma unroll
        for (int of = 16; of > 0; of >>= 1) m = fmaxf(m, __shfl_xor(m, of));
        float sum = 0.f;
        for (int j = l; j < nsel; j += 32) { const float ev = expf(p[hh][j] - m); p[hh][j] = ev; sum += ev; }
#pragma unroll
        for (int of = 16; of > 0; of >>= 1) sum += __shfl_xor(sum, of);
        const float inv = 1.f / sum;
        for (int j = l; j < nsel; j += 32) p[hh][j] *= inv;
    }
    __syncthreads();
    {
        const int hh = tid >> 5, l = tid & 31;
        float a0 = 0.f, a1 = 0.f, a2 = 0.f, a3 = 0.f;
        for (int j = 0; j < nsel; ++j) {
            const bf16_t* lr = PROJ + (size_t)(b * SEQ + sel[j]) * NPJ + C_BLAT;
            const float pv = p[hh][j];
            a0 += pv * bf2f(lr[l]); a1 += pv * bf2f(lr[l + 32]); a2 += pv * bf2f(lr[l + 64]); a3 += pv * bf2f(lr[l + 96]);
        }
        o[hh][l] = a0; o[hh][l + 32] = a1; o[hh][l + 64] = a2; o[hh][l + 96] = a3;
    }
    __syncthreads();
    {
        const int hh = tid >> 5, l = tid & 31;
        float a0 = 0.f, a1 = 0.f;
        for (int c = 0; c < 128; ++c) { const float ov = o[hh][c]; a0 += ov * w_uv[(hh * 128 + c) * 64 + l]; a1 += ov * w_uv[(hh * 128 + c) * 64 + l + 32]; }
        H[(size_t)t * DM + 512 + hh * 64 + l] = f2bf(a0); H[(size_t)t * DM + 512 + hh * 64 + l + 32] = f2bf(a1);
    }
}

__global__ __launch_bounds__(256) void nv_norm2(const float* x1, const float* g, const float* mod, const float* rw, const float* rb, bf16_t* H, int* topi, float* topg) {
    __shared__ float red[8];
    __shared__ float hrow[1024];
    __shared__ float part[8][32];
    __shared__ float logit[32];
    const int t = blockIdx.x, b = t / SEQ, tid = threadIdx.x;
    const float4 v = ((const float4*)(x1 + (size_t)t * DM))[tid];
    const float ss = block_sum_256(v.x * v.x + v.y * v.y + v.z * v.z + v.w * v.w, red);
    const float r = 1.0f / sqrtf(ss * (1.f / DM) + RMS_EPS);
    const float* sh = mod + b * 6144 + 3 * 1024, * sc = mod + b * 6144 + 4 * 1024;
    const float xv[4] = {v.x, v.y, v.z, v.w};
#pragma unroll
    for (int i = 0; i < 4; ++i) { const int k = tid * 4 + i; const float hv = (xv[i] * r * g[k]) * (1.f + sc[k]) + sh[k]; hrow[k] = hv; H[(size_t)t * DM + k] = f2bf(hv); }
    __syncthreads();
    const int e = tid & 31, pt = tid >> 5;
    float pa = 0.f;
    for (int k = pt * 128; k < pt * 128 + 128; ++k) pa += hrow[k] * rw[k * 32 + e];
    part[pt][e] = pa;
    __syncthreads();
    if (tid < 32) { float l = rb[tid]; for (int q = 0; q < 8; ++q) l += part[q][tid]; logit[tid] = l; }
    __syncthreads();
    if (tid == 0) {
        int idx[4]; float val[4]; unsigned used = 0;
        for (int k = 0; k < 4; ++k) { int bi = -1; float bv = -INFINITY;
            for (int j = 0; j < 32; ++j) if (!((used >> j) & 1u) && (bi < 0 || logit[j] > bv)) { bi = j; bv = logit[j]; }
            used |= 1u << bi; idx[k] = bi; val[k] = bv; }
        float sum = 0.f, ex[4];
        for (int k = 0; k < 4; ++k) { ex[k] = expf(val[k] - val[0]); sum += ex[k]; }
        for (int k = 0; k < 4; ++k) { topi[t * 4 + k] = idx[k]; topg[t * 4 + k] = ex[k] / sum; }
    }
}

__global__ __launch_bounds__(256) void nv_count(const int* topi, int* chcnt) {
    __shared__ int cnt[32];
    const int ch = blockIdx.x, tid = threadIdx.x;
    if (tid < 32) cnt[tid] = 0;
    __syncthreads();
    for (int i = tid; i < CHTOK * 4; i += 256) atomicAdd(&cnt[topi[ch * CHTOK * 4 + i]], 1);
    __syncthreads();
    if (tid < 32) chcnt[ch * 32 + tid] = cnt[tid];
}
__global__ __launch_bounds__(256) void nv_scatter(const int* topi, const int* chcnt, int* rowtok, int* tile_e) {
    __shared__ int total[32], before[32], padded[32], poff[33];
    __shared__ int ent[CHTOK * 4];
    const int ch = blockIdx.x, tid = threadIdx.x;
    if (tid < 32) { int tt = 0, bb = 0; for (int c = 0; c < NCHUNK; ++c) { const int v = chcnt[c * 32 + tid]; tt += v; if (c < ch) bb += v; }
        total[tid] = tt; before[tid] = bb; padded[tid] = (tt + 255) / 256 * 256; }
    for (int i = tid; i < CHTOK * 4; i += 256) ent[i] = topi[ch * CHTOK * 4 + i];
    __syncthreads();
    if (tid == 0) { int acc = 0; for (int e = 0; e < 32; ++e) { poff[e] = acc; acc += padded[e]; } poff[32] = acc; }
    __syncthreads();
    if (tid < 32) { int pos = poff[tid] + before[tid];
        for (int i = 0; i < CHTOK * 4; ++i) if (ent[i] == tid) rowtok[pos++] = ch * CHTOK * 4 + i; }
    if (ch == 0) {
        for (int e = 0; e < 32; ++e) for (int r = poff[e] + total[e] + tid; r < poff[e] + padded[e]; r += 256) rowtok[r] = -1;
        for (int e = 0; e < 32; ++e) for (int ti = poff[e] / 256 + tid; ti < (poff[e] + padded[e]) / 256; ti += 256) tile_e[ti] = e;
        if (tid == 0) tile_e[MAXTILES] = poff[32] / 256;
    }
}
__global__ __launch_bounds__(256) void nv_combine(float* out, const bf16_t* Y, const float* mod) {
    const int t = blockIdx.x, b = t / SEQ, tid = threadIdx.x;
#pragma unroll
    for (int i = 0; i < 4; ++i) { const int n = tid + 256 * i; const size_t o = (size_t)t * DM + n;
        const float sum = bf2f(Y[o]) + bf2f(Y[(size_t)NTOK * DM + o]) + bf2f(Y[(size_t)2 * NTOK * DM + o]);
        out[o] += mod[b * 6144 + 5 * 1024 + n] * sum; }
}

namespace gp {
#define GP_LAS __attribute__((address_space(3)))
typedef short bf16x8 __attribute__((ext_vector_type(8)));
typedef float f32x4 __attribute__((ext_vector_type(4)));
typedef unsigned u32x4 __attribute__((ext_vector_type(4)));
constexpr int BM = 256, BK = 64, HALF = 128, HTB = HALF * BK * 2  , STAGE_BYTES = 8 * HTB;

__host__ __device__ __forceinline__ int lds_byte(int r, int c) { const int st = (r >> 4) * 2 + (c >> 5), rr = r & 15, cc = c & 31, ob = rr * 64 + cc * 2; return st * 1024 + (ob ^ (((ob >> 9) & 1) << 5)); }
__host__ __device__ __forceinline__ void stage_rc(int b, int& R, int& C) { const int st = b / 1024, sb = b % 1024, swz = sb ^ (((sb >> 9) & 1) << 5); R = (st >> 1) * 16 + swz / 64; C = (st & 1) * 32 + (swz % 64) / 2; }
__host__ __device__ __forceinline__ int perm32(int rho) { const int n = rho >> 4, i = rho & 15; return 8 * (i >> 2) + 4 * n + (i & 3); }

struct Unit { int pm, pn, e; };
struct Gemm { const bf16_t* A; const bf16_t* Bt; int N, K; const int* rowsrc; };

struct StaticOrder {
    int nM, nN, nwg, G, c;
    __device__ void init(int M, int N, int G_, int c_) { nM = M / BM; nN = N / BM; nwg = nM * nN; G = G_; c = c_; }
    __device__ bool next(int i, Unit& u) const {
        const long L = (long)i * G + c; if (L >= nwg) return false;
        int wgid = (int)L; { const int q = nwg / 8, r = nwg % 8, xcd = wgid % 8, off = wgid / 8; wgid = (xcd < r ? xcd * (q + 1) : r * (q + 1) + (xcd - r) * q) + off; }
        const int nig = 8 * nN, gid = wgid / nig, fm = gid * 8, gsz = (nM - fm) < 8 ? (nM - fm) : 8;
        u.pm = fm + ((wgid % nig) % gsz); u.pn = (wgid % nig) / gsz; u.e = 0; return true;
    }
};
struct MoeOrder {
    const int* tile_e; int ntiles, nN, c, G;
    __device__ bool next(int i, Unit& u) const {
        const int j = c >> 3, x = c & 7, tpx = (G >> 3) / nN;
        const int tile = i * (tpx * 8) + x * tpx + j / nN;
        if (tile >= ntiles) return false;
        u.pm = tile; u.pn = j % nN; u.e = tile_e[tile]; return true;
    }
};

__device__ __forceinline__ unsigned cvt_pk_bf16(float lo, float hi) { unsigned r; asm volatile("v_cvt_pk_bf16_f32 %0, %1, %2" : "=v"(r) : "v"(lo), "v"(hi)); return r; }

struct EpiBf16 {
    bf16_t* O; int ldc;
    __device__ __forceinline__ void operator()(const f32x4 (&acc)[2][2][4][2], const Unit& u, int wr, int wc, int fr, int fq) const {
        const int row0 = u.pm * BM + wr * 64 + fr, col0 = u.pn * BM + wc * 32 + 8 * fq;
#pragma unroll
        for (int ai = 0; ai < 2; ++ai)
#pragma unroll
            for (int m = 0; m < 4; ++m) { bf16_t* rowp = O + (size_t)(row0 + ai * HALF + m * 16) * ldc + col0;
#pragma unroll
                for (int bj = 0; bj < 2; ++bj) { const f32x4 v0 = acc[ai][bj][m][0], v1 = acc[ai][bj][m][1];
                    u32x4 w; w.x = cvt_pk_bf16(v0[0], v0[1]); w.y = cvt_pk_bf16(v0[2], v0[3]); w.z = cvt_pk_bf16(v1[0], v1[1]); w.w = cvt_pk_bf16(v1[2], v1[3]);
                    *(u32x4*)(rowp + bj * HALF) = w; } }
    }
};
struct EpiResid {
    const float* x; float* out; const float* mod;
    __device__ __forceinline__ void operator()(const f32x4 (&acc)[2][2][4][2], const Unit& u, int wr, int wc, int fr, int fq) const {
        const int row0 = u.pm * BM + wr * 64 + fr, col0 = u.pn * BM + wc * 32 + 8 * fq, b = (u.pm * BM) / SEQ;
        f32x4 gv[2][2];
#pragma unroll
        for (int bj = 0; bj < 2; ++bj)
#pragma unroll
            for (int n = 0; n < 2; ++n) gv[bj][n] = *(const f32x4*)(mod + b * 6144 + 2 * 1024 + col0 + bj * HALF + 4 * n);
#pragma unroll
        for (int ai = 0; ai < 2; ++ai)
#pragma unroll
            for (int m = 0; m < 4; ++m) { const size_t off = (size_t)(row0 + ai * HALF + m * 16) * DM + col0;
#pragma unroll
                for (int bj = 0; bj < 2; ++bj)
#pragma unroll
                    for (int n = 0; n < 2; ++n) { const f32x4 xv = *(const f32x4*)(x + off + bj * HALF + 4 * n);
                        *(f32x4*)(out + off + bj * HALF + 4 * n) = xv + gv[bj][n] * acc[ai][bj][m][n]; }
                asm volatile("" ::: "memory"); }
    }
};
struct EpiSwiglu {
    bf16_t* act; const float* bg; const float* bu;
    __device__ __forceinline__ void operator()(const f32x4 (&acc)[2][2][4][2], const Unit& u, int wr, int wc, int fr, int fq) const {
        const int row0 = u.pm * BM + wr * 64 + fr, ff0 = u.pn * HALF + wc * 32 + 8 * fq;
        f32x4 bgv[2], buv[2];
#pragma unroll
        for (int n = 0; n < 2; ++n) { bgv[n] = *(const f32x4*)(bg + u.e * 1024 + ff0 + 4 * n); buv[n] = *(const f32x4*)(bu + u.e * 1024 + ff0 + 4 * n); }
#pragma unroll
        for (int ai = 0; ai < 2; ++ai)
#pragma unroll
            for (int m = 0; m < 4; ++m) {
                float a[8];
#pragma unroll
                for (int n = 0; n < 2; ++n) { const f32x4 g4 = acc[ai][0][m][n] + bgv[n], u4 = acc[ai][1][m][n] + buv[n];
#pragma unroll
                    for (int j = 0; j < 4; ++j) { const float g = fminf(g4[j], 7.0f), uu = fminf(fmaxf(u4[j], -7.0f), 7.0f);
                        const float sg = __builtin_amdgcn_rcpf(1.0f + __builtin_amdgcn_exp2f(-1.702f * 1.4426950408889634f * g));
                        a[4 * n + j] = g * sg * (uu + 1.0f); } }
                u32x4 w; w.x = cvt_pk_bf16(a[0], a[1]); w.y = cvt_pk_bf16(a[2], a[3]); w.z = cvt_pk_bf16(a[4], a[5]); w.w = cvt_pk_bf16(a[6], a[7]);
                *(u32x4*)(act + (size_t)(row0 + ai * HALF + m * 16) * 1024 + ff0) = w; }
    }
};
struct EpiDown {
    float* out; bf16_t* Y; const float* bd; const float* mod; const int* rowtok; const float* topg;
    __device__ __forceinline__ void operator()(const f32x4 (&acc)[2][2][4][2], const Unit& u, int wr, int wc, int fr, int fq) const {
        const int row0 = u.pm * BM + wr * 64 + fr, col0 = u.pn * BM + wc * 32 + 8 * fq;
        f32x4 bv[2][2];
#pragma unroll
        for (int bj = 0; bj < 2; ++bj)
#pragma unroll
            for (int n = 0; n < 2; ++n) bv[bj][n] = *(const f32x4*)(bd + u.e * 1024 + col0 + bj * HALF + 4 * n);
#pragma unroll
        for (int ai = 0; ai < 2; ++ai)
#pragma unroll
            for (int m = 0; m < 4; ++m) {
                const int ent = rowtok[row0 + ai * HALF + m * 16];
                if (ent >= 0) {
                    const int tok = ent >> 2, kk = ent & 3; const float gt = topg[ent];
                    if (kk == 0) { const float* g2 = mod + (tok / SEQ) * 6144 + 5 * 1024 + col0; float* op = out + (size_t)tok * DM + col0;
#pragma unroll
                        for (int bj = 0; bj < 2; ++bj)
#pragma unroll
                            for (int n = 0; n < 2; ++n) { const f32x4 g4 = *(const f32x4*)(g2 + bj * HALF + 4 * n), o4 = *(const f32x4*)(op + bj * HALF + 4 * n);
                                *(f32x4*)(op + bj * HALF + 4 * n) = o4 + g4 * ((acc[ai][bj][m][n] + bv[bj][n]) * gt); }
                    } else { bf16_t* yp = Y + ((size_t)(kk - 1) * NTOK + tok) * DM + col0;
#pragma unroll
                        for (int bj = 0; bj < 2; ++bj) { const f32x4 v0 = (acc[ai][bj][m][0] + bv[bj][0]) * gt, v1 = (acc[ai][bj][m][1] + bv[bj][1]) * gt;
                            u32x4 w; w.x = cvt_pk_bf16(v0[0], v0[1]); w.y = cvt_pk_bf16(v0[2], v0[3]); w.z = cvt_pk_bf16(v1[0], v1[1]); w.w = cvt_pk_bf16(v1[2], v1[3]);
                            *(u32x4*)(yp + bj * HALF) = w; } }
                }
                asm volatile("" ::: "memory"); }
    }
};

template <class Epi, class Sched, bool GATHER>
__device__ __forceinline__ void gemm_phase(GP_LAS unsigned char* lds, const Gemm g, const Sched& S, const Epi& E) {
    const int tid = threadIdx.x, wid = __builtin_amdgcn_readfirstlane(tid >> 6), lane = tid & 63, wr = wid >> 2, wc = wid & 3, fr = lane & 15, fq = lane >> 4;
    const int K = g.K, nt = K / BK;
    int RA[2], CA[2]; unsigned voffB[2];
#pragma unroll
    for (int i = 0; i < 2; ++i) { int R, C; stage_rc(tid * 16 + i * 8192, R, C); RA[i] = R; CA[i] = C; const int Rb = (R & ~31) + perm32(R & 31); voffB[i] = (unsigned)(Rb * K + C) * 2u; }
    const size_t kstep = (size_t)(BK * 2);
    const size_t hstep = (size_t)HALF * K * 2;
    const size_t tstep = 2 * hstep;
    const unsigned ldsw = (unsigned)wid * 1024u;
    const int aoff = lds_byte(wr * 64 + fr, fq * 8), boff = lds_byte(wc * 32 + fr, fq * 8);
#define GP_SA(b, h) (((b) * 2 + (h)) * HTB)
#define GP_SB(b, h) ((4 + (b) * 2 + (h)) * HTB)
#define GP_STAGE(bufoff, gbase, voff) do { _Pragma("unroll") for (int _i = 0; _i < 2; ++_i) \
        __builtin_amdgcn_global_load_lds((const unsigned*)((const char*)(gbase) + (voff)[_i]), (GP_LAS unsigned*)(lds + (bufoff) + ldsw + _i * 8192), 16, 0, 0); } while (0)
#define GP_LDA(dst, b, h) do { _Pragma("unroll") for (int m = 0; m < 4; ++m) _Pragma("unroll") for (int k = 0; k < 2; ++k) dst[m][k] = *(const GP_LAS bf16x8*)(lds + GP_SA(b, h) + aoff + m * 2048 + k * 1024); } while (0)
#define GP_LDB(dst, b, h) do { _Pragma("unroll") for (int n = 0; n < 2; ++n) _Pragma("unroll") for (int k = 0; k < 2; ++k) dst[n][k] = *(const GP_LAS bf16x8*)(lds + GP_SB(b, h) + boff + n * 2048 + k * 1024); } while (0)
#define GP_MMA(ai, bj, At, Bt) do { __builtin_amdgcn_s_setprio(1); _Pragma("unroll") for (int m = 0; m < 4; ++m) _Pragma("unroll") for (int n = 0; n < 2; ++n) _Pragma("unroll") for (int k = 0; k < 2; ++k) \
        acc[ai][bj][m][n] = __builtin_amdgcn_mfma_f32_16x16x32_bf16(Bt[n][k], At[m][k], acc[ai][bj][m][n], 0, 0, 0); __builtin_amdgcn_s_setprio(0); } while (0)
#define GP_WAIT_V(n) asm volatile("s_waitcnt vmcnt(" #n ")" ::: "memory")
#define GP_WAIT_L(n) asm volatile("s_waitcnt lgkmcnt(" #n ")" ::: "memory")
#define GP_BAR __builtin_amdgcn_s_barrier()
#define GP_SCHED __builtin_amdgcn_sched_barrier(0)
#define GP_AOFFS(u_, v0_, v1_) do { _Pragma("unroll") for (int _i = 0; _i < 2; ++_i) { int r0_ = (u_).pm * BM + RA[_i], r1_ = r0_ + HALF; \
        if (GATHER) { r0_ = g.rowsrc[r0_]; r1_ = g.rowsrc[r1_]; } \
        v0_[_i] = (unsigned)(r0_ * K + CA[_i]) * 2u; v1_[_i] = (unsigned)(r1_ * K + CA[_i]) * 2u; } } while (0)
    Unit cur, nxt; int ui = 0;
    if (!S.next(0, cur)) return;
    f32x4 acc[2][2][4][2];
#pragma unroll
    for (int a = 0; a < 2; ++a)
#pragma unroll
        for (int b = 0; b < 2; ++b)
#pragma unroll
            for (int m = 0; m < 4; ++m)
#pragma unroll
                for (int n = 0; n < 2; ++n) acc[a][b][m][n] = (f32x4){0.f, 0.f, 0.f, 0.f};
    bf16x8 At[4][2], B0[2][2], B1[2][2];
    unsigned vA0[2], vA1[2], nA0[2], nA1[2];
    GP_AOFFS(cur, vA0, vA1);
    const char* Ab = (const char*)g.A;
    const char* cB = (const char*)g.Bt + ((size_t)cur.e * g.N + (size_t)cur.pn * BM) * K * 2;
    GP_STAGE(GP_SB(0, 0), cB, voffB); GP_STAGE(GP_SB(0, 1), cB + hstep, voffB); GP_STAGE(GP_SA(0, 0), Ab, vA0); GP_STAGE(GP_SA(0, 1), Ab, vA1);
    if (wr == 1) GP_BAR;
    GP_WAIT_V(2); GP_BAR;
    GP_STAGE(GP_SB(1, 0), cB + kstep, voffB); GP_STAGE(GP_SA(1, 0), Ab + kstep, vA0); GP_STAGE(GP_SB(1, 1), cB + hstep + kstep, voffB);
    GP_WAIT_V(6); GP_BAR;
    for (;;) {
        const bool has_next = S.next(ui + 1, nxt);
        const char* nB = cB;
        if (has_next) { nB = (const char*)g.Bt + ((size_t)nxt.e * g.N + (size_t)nxt.pn * BM) * K * 2; GP_AOFFS(nxt, nA0, nA1); }
        else { nA0[0] = vA0[0]; nA0[1] = vA0[1]; nA1[0] = vA1[0]; nA1[1] = vA1[1]; }
        for (int t = 0; t < nt; t += 2) {
            const bool last = (t == nt - 2);
            const char* a1 = Ab + (size_t)(t + 1) * kstep;
            const char* a2 = last ? Ab : Ab + (size_t)(t + 2) * kstep; const char* b2 = last ? nB : cB + (size_t)(t + 2) * kstep;
            const char* a3 = a2 + kstep; const char* b3 = b2 + kstep;
            GP_LDB(B0, 0, 0); GP_LDB(B1, 0, 1); GP_SCHED; GP_LDA(At, 0, 0); GP_STAGE(GP_SA(1, 1), a1, vA1);
            if (last) { vA0[0] = nA0[0]; vA0[1] = nA0[1]; vA1[0] = nA1[0]; vA1[1] = nA1[1]; }
            GP_WAIT_V(8); GP_WAIT_L(0); GP_BAR; GP_MMA(0, 0, At, B0); GP_MMA(0, 1, At, B1); GP_BAR; GP_SCHED;
            GP_LDA(At, 0, 1); GP_STAGE(GP_SB(0, 0), b2, voffB); GP_STAGE(GP_SB(0, 1), b2 + hstep, voffB); GP_STAGE(GP_SA(0, 0), a2, vA0);
            GP_WAIT_V(8); GP_WAIT_L(0); GP_BAR; GP_MMA(1, 0, At, B0); GP_MMA(1, 1, At, B1); GP_BAR; GP_SCHED;
            GP_LDB(B0, 1, 0); GP_LDB(B1, 1, 1); GP_SCHED; GP_LDA(At, 1, 0); GP_STAGE(GP_SA(0, 1), a2, vA1);
            GP_WAIT_V(8); GP_WAIT_L(0); GP_BAR; GP_MMA(0, 0, At, B0); GP_MMA(0, 1, At, B1); GP_BAR; GP_SCHED;
            GP_LDA(At, 1, 1); GP_STAGE(GP_SB(1, 0), b3, voffB); GP_STAGE(GP_SB(1, 1), b3 + hstep, voffB); GP_STAGE(GP_SA(1, 0), a3, vA0);
            GP_WAIT_V(8); GP_WAIT_L(0); GP_BAR; GP_MMA(1, 0, At, B0); GP_MMA(1, 1, At, B1); GP_BAR; GP_SCHED;
        }
        if (wr == 0) GP_BAR;
        E(acc, cur, wr, wc, fr, fq);
        if (!has_next) break;
#pragma unroll
        for (int a = 0; a < 2; ++a)
#pragma unroll
            for (int b = 0; b < 2; ++b)
#pragma unroll
                for (int m = 0; m < 4; ++m)
#pragma unroll
                    for (int n = 0; n < 2; ++n) acc[a][b][m][n] = (f32x4){0.f, 0.f, 0.f, 0.f};
        cur = nxt; cB = nB; ++ui;
        if (wr == 1) GP_BAR;
    }
    GP_WAIT_V(0);
    GP_BAR;
#undef GP_SA
#undef GP_SB
#undef GP_STAGE
#undef GP_LDA
#undef GP_LDB
#undef GP_MMA
#undef GP_WAIT_V
#undef GP_WAIT_L
#undef GP_BAR
#undef GP_SCHED
#undef GP_AOFFS
}
}
#include <hip/hip_cooperative_groups.h>
namespace cg = cooperative_groups;
#define LAS __attribute__((address_space(3)))
typedef float f32x4 __attribute__((ext_vector_type(4)));
typedef unsigned u32x4 __attribute__((ext_vector_type(4)));
typedef short bf16x8 __attribute__((ext_vector_type(8)));
constexpr int NWAVES = 8, NTHREADS = 512;
constexpr int LDS_RING = 131072;
constexpr int LDS_BYTES = 159744;

struct Params {
    const float* in[24];
    float* out; unsigned char* ws;
    int ph_lo, ph_hi;
};
__device__ __forceinline__ unsigned pk2(float lo, float hi) { return (unsigned)f2bf(lo) | ((unsigned)f2bf(hi) << 16); }
__device__ __forceinline__ float wave_sum(float v) {
#pragma unroll
    for (int o = 1; o < 64; o <<= 1) v += __shfl_xor(v, o);
    return v;
}

__device__ __forceinline__ void p0_transpose(const float* W, int ld, int k0, int n0, bf16_t* WT, int row0, int Kdst, LAS float* scr, int lane) {
#pragma unroll 8
    for (int i = 0; i < 32; ++i) { const int kk = 2 * i + (lane >> 5); scr[kk * 33 + (lane & 31)] = W[(size_t)(k0 + kk) * ld + n0 + (lane & 31)]; }
    asm volatile("s_waitcnt lgkmcnt(0)" ::: "memory");
    const int c = lane & 7;
#pragma unroll
    for (int j = 0; j < 4; ++j) { const int n = (lane >> 3) + 8 * j; const LAS float* s = scr + (8 * c) * 33 + n;
        u32x4 o; o.x = pk2(s[0 * 33], s[1 * 33]); o.y = pk2(s[2 * 33], s[3 * 33]); o.z = pk2(s[4 * 33], s[5 * 33]); o.w = pk2(s[6 * 33], s[7 * 33]);
        *(u32x4*)(WT + (size_t)(row0 + n) * Kdst + k0 + 8 * c) = o; }
    asm volatile("s_waitcnt lgkmcnt(0)" ::: "memory");
}
__device__ __forceinline__ void phase_prep(const Params& p, LAS unsigned char* lds, int tid, int lane, int wave) {
    unsigned char* ws = p.ws;
    {
        LAS float* sc = (LAS float*)lds;
        LAS float* part = (LAS float*)(lds + 32768);
        const float* c = p.in[1]; const float* w_ada = p.in[4]; const float* b_ada = p.in[5];
        for (int i = tid; i < 8192; i += NTHREADS) { const float v = c[i]; sc[i] = v / (1.f + __expf(-v)); }
        __syncthreads();
        for (int cb = blockIdx.x; cb < 256; cb += gridDim.x) {
            const int half = lane >> 5, cl = lane & 31;
            float acc[8];
#pragma unroll
            for (int b = 0; b < 8; ++b) acc[b] = 0.f;
            if (cl < 24) {
                for (int it = 0; it < 64; ++it) { const int k = 128 * wave + 2 * it + half; const float wv = w_ada[(size_t)k * 6144 + 24 * cb + cl];
#pragma unroll
                    for (int b = 0; b < 8; ++b) acc[b] += sc[b * 1024 + k] * wv; }
#pragma unroll
                for (int b = 0; b < 8; ++b) part[((wave * 2 + half) * 8 + b) * 24 + cl] = acc[b];
            }
            __syncthreads();
            if (tid < 192) { const int b = tid / 24, cc = tid % 24; float s = 0.f;
                for (int q = 0; q < 16; ++q) s += part[(q * 8 + b) * 24 + cc];
                ((float*)(ws + WS_MOD))[b * 6144 + 24 * cb + cc] = s + b_ada[24 * cb + cc]; }
            __syncthreads();
        }
    }
    {
        float* rope = (float*)(ws + WS_ROPE);
        for (int i = blockIdx.x * NTHREADS + tid; i < SEQ * 8; i += gridDim.x * NTHREADS) {
            const int pos = i >> 3, f = i & 7;
            const float inv = (float)exp(-(double)f / 8.0 * log(500000.0));
            const float ang = (float)pos * inv;
            const double TWO_PI = 6.283185307179586476925287;
            const double a = (double)ang, r = a - rint(a / TWO_PI) * TWO_PI, r2 = r * r;
            double s = 0.0, c = 0.0, ts = r, tc = 1.0;
            for (int n = 0; n < 14; ++n) { s += ts; c += tc; ts *= -r2 / (double)((2 * n + 2) * (2 * n + 3)); tc *= -r2 / (double)((2 * n + 1) * (2 * n + 2)); }
            rope[i * 2 + 0] = (float)c; rope[i * 2 + 1] = (float)s;
        }
        if (blockIdx.x == 0 && tid == 0) { const float* al = p.in[10]; float d01 = 0.f, d23 = 0.f;
            for (int j = 0; j < 64; ++j) { d01 += al[j] * al[64 + j]; d23 += al[128 + j] * al[192 + j]; }
            ((float*)(ws + WS_LAM))[0] = expf(d01) - expf(d23) + LAMBDA_INIT; }
    }
    __syncthreads();
    {
        LAS float* scr = (LAS float*)(lds + wave * 8704);
        const int gw = blockIdx.x * NWAVES + wave, NGW = gridDim.x * NWAVES;
        constexpr int I_IN = 16 * 88, I_OUT = 16 * 32, I_UV = 32, I_EXP = 32 * 3 * 512, NITEMS = I_IN + I_OUT + I_UV + I_EXP;
        for (int it = gw; it < NITEMS; it += NGW) {
            int r = it;
            if (r < I_IN) { p0_transpose(p.in[6], NIN, 64 * (r / 88), 32 * (r % 88), (bf16_t*)(ws + WS_WINT), 32 * (r % 88), 1024, scr, lane); continue; } r -= I_IN;
            if (r < I_OUT) { p0_transpose(p.in[7], 1024, 64 * (r / 32), 32 * (r % 32), (bf16_t*)(ws + WS_WOUTT), 32 * (r % 32), 1024, scr, lane); continue; } r -= I_OUT;
            if (r < I_UV) { const int h = r >> 2, rr = r & 3; p0_transpose(p.in[15] + h * 128 * 64, 64, 64 * (rr >> 1), 32 * (rr & 1), (bf16_t*)(ws + WS_WUVT) + h * 64 * 128, 32 * (rr & 1), 128, scr, lane); continue; } r -= I_UV;
            const int e = r / 1536, q = r % 1536, mat = q / 512, i2 = q % 512, kb = i2 / 32, nb = i2 % 32, n0 = 32 * nb;
            if (mat == 2) p0_transpose(p.in[22] + (size_t)e * 1048576, 1024, 64 * kb, n0, (bf16_t*)(ws + WS_WDT) + (size_t)e * 1048576, n0, 1024, scr, lane);
            else p0_transpose(p.in[mat == 0 ? 18 : 20] + (size_t)e * 1048576, 1024, 64 * kb, n0, (bf16_t*)(ws + WS_WGUT) + (size_t)e * 2097152, 256 * (n0 >> 7) + (n0 & 127) + (mat == 1 ? 128 : 0), 1024, scr, lane);
        }
    }
}

__device__ __forceinline__ void phase_norm1(const Params& p, LAS unsigned char* lds, int tid, int lane, int wave) {
    unsigned char* ws = p.ws;
    const float* x = p.in[0]; const float* g = p.in[2]; const float* w_in = p.in[6]; const float* mod = (const float*)(ws + WS_MOD);
    bf16_t* H = (bf16_t*)(ws + WS_H); float* IW = (float*)(ws + WS_IW);
    LAS float* wiw = (LAS float*)lds;
    for (int i = tid; i < 8192; i += NTHREADS) wiw[i] = w_in[(size_t)(i >> 3) * NIN + C_IW + (i & 7)];
    __syncthreads();
    const int gw = blockIdx.x * NWAVES + wave, NGW = gridDim.x * NWAVES;
    f32x4 gv[4];
#pragma unroll
    for (int j = 0; j < 4; ++j) gv[j] = *(const f32x4*)(g + 4 * (lane + 64 * j));
    for (int t = gw; t < NTOK; t += NGW) {
        const int b = t / SEQ; const float* sh = mod + b * 6144, * sc = sh + 1024;
        f32x4 v[4]; float ss = 0.f;
#pragma unroll
        for (int j = 0; j < 4; ++j) { v[j] = *(const f32x4*)(x + (size_t)t * DM + 4 * (lane + 64 * j)); ss += (v[j].x * v[j].x + v[j].y * v[j].y) + (v[j].z * v[j].z + v[j].w * v[j].w); }
        const float r = 1.0f / sqrtf(wave_sum(ss) * (1.f / DM) + RMS_EPS);
        float iw[8];
#pragma unroll
        for (int q = 0; q < 8; ++q) iw[q] = 0.f;
#pragma unroll
        for (int j = 0; j < 4; ++j) { const int k0 = 4 * (lane + 64 * j);
            const f32x4 s4 = *(const f32x4*)(sc + k0), h4 = *(const f32x4*)(sh + k0);
            f32x4 hv = (v[j] * r * gv[j]) * (s4 + 1.0f) + h4;
            *(uint2*)(H + (size_t)t * DM + k0) = make_uint2(pk2(hv.x, hv.y), pk2(hv.z, hv.w));
#pragma unroll
            for (int i = 0; i < 4; ++i) { const f32x4 w0 = *(const LAS f32x4*)(wiw + (k0 + i) * 8), w1 = *(const LAS f32x4*)(wiw + (k0 + i) * 8 + 4);
                iw[0] += hv[i] * w0.x; iw[1] += hv[i] * w0.y; iw[2] += hv[i] * w0.z; iw[3] += hv[i] * w0.w;
                iw[4] += hv[i] * w1.x; iw[5] += hv[i] * w1.y; iw[6] += hv[i] * w1.z; iw[7] += hv[i] * w1.w; } }
#pragma unroll
        for (int q = 0; q < 8; ++q) iw[q] = wave_sum(iw[q]);
        if (lane == 0) { *(f32x4*)(IW + (size_t)t * 8) = (f32x4){iw[0], iw[1], iw[2], iw[3]} * 0.04419417382415922f; *(f32x4*)(IW + (size_t)t * 8 + 4) = (f32x4){iw[4], iw[5], iw[6], iw[7]} * 0.04419417382415922f; }
    }
}

__device__ __forceinline__ void phase_norm2(const Params& p, LAS unsigned char* lds, int tid, int lane, int wave) {
    unsigned char* ws = p.ws;
    const float* x1 = p.out; const float* g = p.in[3]; const float* rw = p.in[16]; const float* rb = p.in[17]; const float* mod = (const float*)(ws + WS_MOD);
    bf16_t* H = (bf16_t*)(ws + WS_H); int* topi = (int*)(ws + WS_TOPI); float* topg = (float*)(ws + WS_TOPG); int* chcnt = (int*)(ws + WS_CHCNT);
    LAS float* rwl = (LAS float*)lds;
    for (int i = tid; i < 32768; i += NTHREADS) { const int k = i >> 5, e = i & 31; rwl[e * 1028 + k] = rw[i]; }
    LAS int* cnt = (LAS int*)(lds + 32 * 1028 * 4);
    LAS float* lg = (LAS float*)(lds + 32 * 1028 * 4 + 128) + wave * 32;
    __syncthreads();
    f32x4 gv[4];
#pragma unroll
    for (int j = 0; j < 4; ++j) gv[j] = *(const f32x4*)(g + 4 * (lane + 64 * j));
    for (int ch = blockIdx.x; ch < NCHUNK; ch += gridDim.x) {
        if (tid < 32) cnt[tid] = 0;
        __syncthreads();
        for (int rr = 0; rr < 16; ++rr) {
            const int t = ch * CHTOK + wave * 16 + rr, b = t / SEQ; const float* sh = mod + b * 6144 + 3 * 1024, * sc = sh + 1024;
            f32x4 v[4]; float ss = 0.f;
#pragma unroll
            for (int j = 0; j < 4; ++j) { v[j] = *(const f32x4*)(x1 + (size_t)t * DM + 4 * (lane + 64 * j)); ss += (v[j].x * v[j].x + v[j].y * v[j].y) + (v[j].z * v[j].z + v[j].w * v[j].w); }
            const float r = 1.0f / sqrtf(wave_sum(ss) * (1.f / DM) + RMS_EPS);
            f32x4 hv[4];
#pragma unroll
            for (int j = 0; j < 4; ++j) { const int k0 = 4 * (lane + 64 * j);
                const f32x4 s4 = *(const f32x4*)(sc + k0), h4 = *(const f32x4*)(sh + k0);
                hv[j] = (v[j] * r * gv[j]) * (s4 + 1.0f) + h4;
                *(uint2*)(H + (size_t)t * DM + k0) = make_uint2(pk2(hv[j].x, hv[j].y), pk2(hv[j].z, hv[j].w)); }
            float mylogit = 0.f;
            for (int e = 0; e < 32; ++e) { float pa = 0.f;
#pragma unroll
                for (int j = 0; j < 4; ++j) { const f32x4 w4 = *(const LAS f32x4*)(rwl + e * 1028 + 4 * (lane + 64 * j)); pa += (hv[j].x * w4.x + hv[j].y * w4.y) + (hv[j].z * w4.z + hv[j].w * w4.w); }
                pa = wave_sum(pa); if (lane == e) mylogit = pa + rb[e]; }
            if (lane < 32) lg[lane] = mylogit;
            asm volatile("s_waitcnt lgkmcnt(0)" ::: "memory");
            if (lane == 0) {
                int idx[4]; float val[4]; unsigned used = 0;
#pragma unroll
                for (int k = 0; k < 4; ++k) { int bi = -1; float bv = -INFINITY;
                    for (int j = 0; j < 32; ++j) { const float lv = lg[j]; if (!((used >> j) & 1u) && (bi < 0 || lv > bv)) { bi = j; bv = lv; } }
                    used |= 1u << bi; idx[k] = bi; val[k] = bv; }
                float ex[4], sum = 0.f;
#pragma unroll
                for (int k = 0; k < 4; ++k) { ex[k] = __expf(val[k] - val[0]); sum += ex[k]; }
                const float inv = 1.f / sum;
                *(int4*)(topi + t * 4) = make_int4(idx[0], idx[1], idx[2], idx[3]);
                *(f32x4*)(topg + t * 4) = (f32x4){ex[0] * inv, ex[1] * inv, ex[2] * inv, ex[3] * inv};
#pragma unroll
                for (int k = 0; k < 4; ++k) atomicAdd((int*)&cnt[idx[k]], 1);
            }
            asm volatile("s_waitcnt lgkmcnt(0)" ::: "memory");
        }
        __syncthreads();
        if (tid < 32) chcnt[ch * 32 + tid] = cnt[tid];
        __syncthreads();
    }
}

__device__ __forceinline__ void phase_scatter(const Params& p, LAS unsigned char* lds, int tid, int lane, int wave) {
    unsigned char* ws = p.ws;
    const int* topi = (const int*)(ws + WS_TOPI); const int* chcnt = (const int*)(ws + WS_CHCNT);
    int* rowtok = (int*)(ws + WS_ROWTOK); int* rowsrc = (int*)(ws + WS_ROWSRC); int* tile_e = (int*)(ws + WS_TILEE);
    LAS int* total = (LAS int*)lds; LAS int* before = total + 32; LAS int* padded = total + 64; LAS int* poff = total + 96; LAS int* ent = total + 160;
    for (int ch = blockIdx.x; ch < NCHUNK; ch += gridDim.x) {
        if (tid < 32) { int tt = 0, bb = 0; for (int c = 0; c < NCHUNK; ++c) { const int v = chcnt[c * 32 + tid]; tt += v; if (c < ch) bb += v; }
            total[tid] = tt; before[tid] = bb; padded[tid] = (tt + 255) / 256 * 256; }
        { const int i = tid; ent[i] = topi[ch * CHTOK * 4 + i]; }
        __syncthreads();
        if (tid == 0) { int a = 0; for (int e = 0; e < 32; ++e) { poff[e] = a; a += padded[e]; } poff[32] = a; }
        __syncthreads();
        if (tid < 32) { int pos = poff[tid] + before[tid];
            for (int i = 0; i < CHTOK * 4; ++i) if (ent[i] == tid) { const int en = ch * CHTOK * 4 + i; rowtok[pos] = en; rowsrc[pos] = en >> 2; ++pos; } }
        if (ch == 0) {
            for (int e = 0; e < 32; ++e) for (int r = poff[e] + total[e] + tid; r < poff[e] + padded[e]; r += NTHREADS) { rowtok[r] = -1; rowsrc[r] = 0; }
            for (int e = 0; e < 32; ++e) for (int ti = poff[e] / 256 + tid; ti < (poff[e] + padded[e]) / 256; ti += NTHREADS) tile_e[ti] = e;
            if (tid == 0) tile_e[MAXTILES] = poff[32] / 256;
        }
        __syncthreads();
    }
}

__device__ __forceinline__ void phase_combine(const Params& p, int tid) {
    unsigned char* ws = p.ws; float* out = p.out; const bf16_t* Y = (const bf16_t*)(ws + WS_Y); const float* mod = (const float*)(ws + WS_MOD);
    const size_t nvec = (size_t)NTOK * DM / 8;
    for (size_t i = (size_t)blockIdx.x * NTHREADS + tid; i < nvec; i += (size_t)gridDim.x * NTHREADS) {
        const size_t o = i * 8; const int t = (int)(o / DM), n = (int)(o % DM), b = t / SEQ;
        const u32x4 a = *(const u32x4*)(Y + o), c = *(const u32x4*)(Y + (size_t)NTOK * DM + o), d = *(const u32x4*)(Y + (size_t)2 * NTOK * DM + o);
        const float* g2 = mod + b * 6144 + 5 * 1024 + n;
        f32x4 o0 = *(const f32x4*)(out + o), o1 = *(const f32x4*)(out + o + 4);
        const f32x4 g0 = *(const f32x4*)g2, g1 = *(const f32x4*)(g2 + 4);
#define LO(u) __uint_as_float((u) << 16)
#define HI(u) __uint_as_float((u) & 0xffff0000u)
        o0.x += g0.x * (LO(a.x) + LO(c.x) + LO(d.x)); o0.y += g0.y * (HI(a.x) + HI(c.x) + HI(d.x));
        o0.z += g0.z * (LO(a.y) + LO(c.y) + LO(d.y)); o0.w += g0.w * (HI(a.y) + HI(c.y) + HI(d.y));
        o1.x += g1.x * (LO(a.z) + LO(c.z) + LO(d.z)); o1.y += g1.y * (HI(a.z) + HI(c.z) + HI(d.z));
        o1.z += g1.z * (LO(a.w) + LO(c.w) + LO(d.w)); o1.w += g1.w * (HI(a.w) + HI(c.w) + HI(d.w));
#undef LO
#undef HI
        *(f32x4*)(out + o) = o0; *(f32x4*)(out + o + 4) = o1;
    }
}

__device__ __forceinline__ float wg_sum(float v, LAS float* red, int tid) {
    v = wave_sum(v);
    __syncthreads();
    if ((tid & 63) == 0) red[tid >> 6] = v;
    __syncthreads();
    float s = 0.f;
#pragma unroll
    for (int i = 0; i < 8; ++i) s += red[i];
    return s;
}
__device__ __forceinline__ float wg_max(float v, LAS float* red, int tid) {
#pragma unroll
    for (int o = 1; o < 64; o <<= 1) v = fmaxf(v, __shfl_xor(v, o));
    __syncthreads();
    if ((tid & 63) == 0) red[tid >> 6] = v;
    __syncthreads();
    float s = red[0];
#pragma unroll
    for (int i = 1; i < 8; ++i) s = fmaxf(s, red[i]);
    return s;
}
__device__ __forceinline__ void phase_post_slow(const Params& p, int tid) {
    unsigned char* ws = p.ws; bf16_t* PROJ = (bf16_t*)(ws + WS_PROJ); const float* rope = (const float*)(ws + WS_ROPE);
    const long total = (long)NTOK * 44;
    for (long it = (long)blockIdx.x * NTHREADS + tid; it < total; it += (long)gridDim.x * NTHREADS) {
        const int t = (int)(it / 44), gidx = (int)(it % 44), pos = t % SEQ, c0 = gidx * 64;
        bf16_t* row = PROJ + (size_t)t * NPJ;
        bool donorm = false, dorope = false; const float* gg = nullptr;
        if (c0 < 512) { donorm = true; dorope = true; gg = p.in[8]; }
        else if (c0 < 1024) { donorm = true; dorope = true; gg = p.in[9]; }
        else if (c0 < 1536) { continue; }
        else if (c0 < 2048) { donorm = true; dorope = true; gg = p.in[12]; }
        else if (c0 < 2112) { donorm = true; dorope = true; gg = p.in[13]; }
        else if (c0 < 2240) {
            if (c0 != 2112) continue;
            float ss = 0.f;
            for (int i = 0; i < 128; ++i) { const float f = bf2f(row[c0 + i]); ss += f * f; }
            const float r = 1.0f / sqrtf(ss * (1.f / 128.f) + RMS_EPS);
            for (int i = 0; i < 128; ++i) row[c0 + i] = f2bf(bf2f(row[c0 + i]) * r * p.in[14][i]);
            continue;
        }
        else { dorope = true; }
        float ss = 0.f;
        for (int i = 0; i < 64; ++i) { const float f = bf2f(row[c0 + i]); ss += f * f; }
        const float r = donorm ? 1.0f / sqrtf(ss * (1.f / 64.f) + RMS_EPS) : 1.0f;
        float head[16];
#pragma unroll
        for (int i = 0; i < 16; ++i) head[i] = bf2f(row[c0 + i]) * r * (donorm ? gg[i] : 1.0f);
        if (dorope) {
#pragma unroll
            for (int i = 0; i < 8; ++i) { const float cs = rope[(pos * 8 + i) * 2], sn = rope[(pos * 8 + i) * 2 + 1];
                const float x1 = head[i], x2 = head[8 + i]; head[i] = x1 * cs - x2 * sn; head[8 + i] = x2 * cs + x1 * sn; }
        }
#pragma unroll
        for (int i = 0; i < 16; ++i) row[c0 + i] = f2bf(head[i]);
        if (donorm) for (int i = 16; i < 64; ++i) row[c0 + i] = f2bf(bf2f(row[c0 + i]) * r * gg[i]);
    }
}
__device__ __forceinline__ void phase_diffattn_slow(const Params& p, LAS unsigned char* lds, int tid) {
    unsigned char* ws = p.ws; const bf16_t* PROJ = (const bf16_t*)(ws + WS_PROJ); bf16_t* H = (bf16_t*)(ws + WS_H);
    const float lam = ((const float*)(ws + WS_LAM))[0]; const float* sub_g = p.in[11];
    LAS float* q1 = (LAS float*)lds; LAS float* q2 = q1 + 64; LAS float* red = q1 + 128; LAS float* osum = q1 + 160;
    LAS float* s1 = q1 + 1024; LAS float* s2 = s1 + 4096;
    for (int it = blockIdx.x; it < NTOK * 4; it += gridDim.x) {
        const int t = it >> 2, h = it & 3, b = t / SEQ, s = t % SEQ, N = (s / 64 + 1) * 64;
        const bf16_t* qrow = PROJ + (size_t)t * NPJ;
        __syncthreads();
        if (tid < 64) q1[tid] = bf2f(qrow[C_AQ1 + h * 64 + tid]);
        else if (tid < 128) q2[tid - 64] = bf2f(qrow[C_AQ2 + h * 64 + tid - 64]);
        __syncthreads();
        float m1 = -INFINITY, m2 = -INFINITY;
        for (int key = tid; key < N; key += NTHREADS) {
            const bf16_t* kr = PROJ + (size_t)(b * SEQ + key) * NPJ;
            float d1 = 0.f, d2 = 0.f;
            for (int d = 0; d < 64; ++d) { d1 += q1[d] * bf2f(kr[C_AK1 + h * 64 + d]); d2 += q2[d] * bf2f(kr[C_AK2 + h * 64 + d]); }
            d1 *= 0.125f; d2 *= 0.125f; s1[key] = d1; s2[key] = d2; m1 = fmaxf(m1, d1); m2 = fmaxf(m2, d2);
        }
        m1 = wg_max(m1, red, tid); m2 = wg_max(m2, red, tid);
        float l1 = 0.f, l2 = 0.f;
        for (int key = tid; key < N; key += NTHREADS) { const float e1 = __expf(s1[key] - m1), e2 = __expf(s2[key] - m2); s1[key] = e1; s2[key] = e2; l1 += e1; l2 += e2; }
        l1 = wg_sum(l1, red, tid); l2 = wg_sum(l2, red, tid);
        const float i1 = 1.f / l1, i2 = lam / l2;
        for (int key = tid; key < N; key += NTHREADS) s1[key] = s1[key] * i1 - s2[key] * i2;
        __syncthreads();
        const int e = tid & 127, part = tid >> 7;
        float o = 0.f;
        for (int key = part; key < N; key += 4) o += s1[key] * bf2f(PROJ[(size_t)(b * SEQ + key) * NPJ + C_AV + h * 128 + e]);
        osum[part * 128 + e] = o;
        __syncthreads();
        float ov = 0.f, sq = 0.f;
        if (tid < 128) { ov = (osum[tid] + osum[128 + tid]) + (osum[256 + tid] + osum[384 + tid]); sq = ov * ov; }
        const float ss = wg_sum(sq, red, tid);
        if (tid < 128) H[(size_t)t * DM + h * 128 + tid] = f2bf(ov * (1.0f / sqrtf(ss * (1.f / 128.f) + RMS_EPS)) * sub_g[tid] * (1.0f - LAMBDA_INIT));
    }
}
__device__ __forceinline__ void phase_dsa_slow(const Params& p, LAS unsigned char* lds, int tid) {
    unsigned char* ws = p.ws; const bf16_t* PROJ = (const bf16_t*)(ws + WS_PROJ); bf16_t* H = (bf16_t*)(ws + WS_H);
    const float* IW = (const float*)(ws + WS_IW); const float* w_uv = p.in[15];
    LAS float* iq = (LAS float*)lds; LAS float* bq = iq + 512; LAS float* w = iq + 1024; LAS float* score = iq + 1088;
    LAS float* pp = score + 4096;
    LAS float* o = pp + 2048;
    LAS int* sel = (LAS int*)(o + 1024);
    for (int t = blockIdx.x; t < NTOK; t += gridDim.x) {
        const int b = t / SEQ, s = t % SEQ, N = (s / 64 + 1) * 64;
        const bf16_t* qrow = PROJ + (size_t)t * NPJ;
        __syncthreads();
        { const int i = tid; iq[i] = bf2f(qrow[C_IQ + i]); bq[i] = bf2f(qrow[C_BQ + i]); }
        if (tid < 8) w[tid] = IW[(size_t)t * 8 + tid];
        __syncthreads();
        for (int key = tid; key < N; key += NTHREADS) {
            const bf16_t* kr = PROJ + (size_t)(b * SEQ + key) * NPJ + C_IK;
            float sc = 0.f;
            for (int hh = 0; hh < 8; ++hh) { float d0 = 0.f;
                for (int d = 0; d < 64; ++d) d0 += iq[hh * 64 + d] * bf2f(kr[d]);
                sc += w[hh] * fmaxf(d0, 0.f); }
            score[key] = sc;
        }
        __syncthreads();
        const int nsel = N < 256 ? N : 256;
        for (int key = tid; key < N; key += NTHREADS) {
            const float my = score[key]; int r = 0;
            for (int j = 0; j < N; ++j) { const float ot = score[j]; r += (ot > my || (ot == my && j < key)) ? 1 : 0; }
            if (r < 256) sel[r] = key;
        }
        __syncthreads();
        if (tid < nsel) {
            const bf16_t* kr = PROJ + (size_t)(b * SEQ + sel[tid]) * NPJ + C_BK;
            for (int hh = 0; hh < 8; ++hh) { float d0 = 0.f;
                for (int d = 0; d < 64; ++d) d0 += bq[hh * 64 + d] * bf2f(kr[d]);
                pp[hh * 256 + tid] = d0 * 0.125f; }
        }
        __syncthreads();
        {
            const int hh = tid >> 6, l = tid & 63;
            float m = -INFINITY;
            for (int j = l; j < nsel; j += 64) m = fmaxf(m, pp[hh * 256 + j]);
#pragma unroll
            for (int of = 32; of > 0; of >>= 1) m = fmaxf(m, __shfl_xor(m, of));
            float sum = 0.f;
            for (int j = l; j < nsel; j += 64) { const float ev = __expf(pp[hh * 256 + j] - m); pp[hh * 256 + j] = ev; sum += ev; }
            sum = wave_sum(sum);
            const float inv = 1.f / sum;
            for (int j = l; j < nsel; j += 64) pp[hh * 256 + j] *= inv;
        }
        __syncthreads();
        {
            const int hh = tid >> 6, l = tid & 63;
            float a0 = 0.f, a1 = 0.f;
            for (int j = 0; j < nsel; ++j) { const bf16_t* lr = PROJ + (size_t)(b * SEQ + sel[j]) * NPJ + C_BLAT; const float pv = pp[hh * 256 + j];
                a0 += pv * bf2f(lr[l]); a1 += pv * bf2f(lr[l + 64]); }
            o[hh * 128 + l] = a0; o[hh * 128 + l + 64] = a1;
        }
        __syncthreads();
        {
            const int hh = tid >> 6, l = tid & 63;
            float a0 = 0.f;
            for (int c = 0; c < 128; ++c) a0 += o[hh * 128 + c] * w_uv[(hh * 128 + c) * 64 + l];
            H[(size_t)t * DM + 512 + hh * 64 + l] = f2bf(a0);
        }
    }
}
namespace da {
typedef float f32x16 __attribute__((ext_vector_type(16)));
typedef short s16x4 __attribute__((ext_vector_type(4)));
constexpr int KPL = 1040;
constexpr int KT_BYTES = 8 * KPL;
constexpr int VRS = 320;
constexpr int VT_BYTES = 64 * VRS;
constexpr int BUF_BYTES = 2 * KT_BYTES + VT_BYTES;
constexpr int OB_STRIDE = 132;
constexpr int WSF_OFF = 139264;
constexpr float C2 = 0.125f * 1.4426950408889634f;
__device__ __forceinline__ int crow(int r, int hi) { return (r & 3) + 8 * (r >> 2) + 4 * hi; }
__device__ __forceinline__ s16x4 vtr(const LAS unsigned char* p) { return __builtin_bit_cast(s16x4, __builtin_amdgcn_ds_read_tr16_b64_v4i16((LAS s16x4*)p)); }

__device__ __forceinline__ void phase(const Params& p, LAS unsigned char* lds, int tid, int lane, int wave) {
    unsigned char* ws = p.ws; const bf16_t* PROJ = (const bf16_t*)(ws + WS_PROJ); bf16_t* H = (bf16_t*)(ws + WS_H);
    const float lam = ((const float*)(ws + WS_LAM))[0]; const float* sub_g = p.in[11];
    const int wsel = wave >> 2, wq = wave & 3, r32 = lane & 31, hi = lane >> 5;
    LAS float* wsf = (LAS float*)(lds + WSF_OFF) + wave * 64;
    const int G = gridDim.x, vcu = (G % 8 == 0) ? ((int)blockIdx.x % 8) * (G / 8) + (int)blockIdx.x / 8 : (int)blockIdx.x;
    for (int id = vcu; id < 1024; id += G) {
        const int bh = (id >> 3) & 31, s = id & 7, ii = id >> 8;
        const int qb = (ii == 0) ? s : (ii == 1) ? 15 - s : (ii == 2) ? 16 + s : 31 - s;
        const int b = bh >> 2, h = bh & 3, q0 = qb * 128, NT = 2 * qb + 2, ntw = 2 * qb + 1 + (wq >> 1);
        const bf16_t* base = PROJ + (size_t)b * SEQ * NPJ;
        bf16x8 qr[4];
        { const bf16_t* Qrow = base + (size_t)(q0 + 32 * wq + r32) * NPJ + (wsel ? C_AQ2 : C_AQ1) + h * 64;
#pragma unroll
          for (int d0 = 0; d0 < 4; ++d0) qr[d0] = *(const bf16x8*)(Qrow + 16 * d0 + 8 * hi); }
        float m = -INFINITY, l = 0.f;
        f32x16 o[4];
#pragma unroll
        for (int d0 = 0; d0 < 4; ++d0)
#pragma unroll
            for (int r = 0; r < 16; ++r) o[d0][r] = 0.f;
        const int skey = tid >> 3, sc = tid & 7, vkey = tid >> 4, vch = tid & 15;
        const bf16_t* srcK1 = base + (size_t)skey * NPJ + C_AK1 + h * 64 + 8 * sc;
        const bf16_t* srcK2 = base + (size_t)skey * NPJ + C_AK2 + h * 64 + 8 * sc;
        const bf16_t* srcV = base + (size_t)vkey * NPJ + C_AV + h * 128 + 8 * vch;
        const int dK = sc * KPL + skey * 16, dV = vkey * VRS + vch * 16;
        u32x4 st0, st1, st2, st3;
#define DA_LOAD(kt) do { const size_t ro = (size_t)(kt) * 64 * NPJ; st0 = *(const u32x4*)(srcK1 + ro); st1 = *(const u32x4*)(srcK2 + ro); \
        st2 = *(const u32x4*)(srcV + ro); st3 = *(const u32x4*)(srcV + ro + (size_t)32 * NPJ); } while (0)
#define DA_WRITE(bufi) do { LAS unsigned char* bb = lds + (bufi) * BUF_BYTES; *(LAS u32x4*)(bb + dK) = st0; *(LAS u32x4*)(bb + KT_BYTES + dK) = st1; \
        *(LAS u32x4*)(bb + 2 * KT_BYTES + dV) = st2; *(LAS u32x4*)(bb + 2 * KT_BYTES + dV + 32 * VRS) = st3; } while (0)
        DA_LOAD(0); DA_WRITE(0);
        __syncthreads();
        for (int kt = 0; kt < NT; ++kt) {
            if (kt + 1 < NT) DA_LOAD(kt + 1);
            if (kt < ntw) {
                const LAS unsigned char* bb = lds + (kt & 1) * BUF_BYTES;
                const LAS unsigned char* Kb = bb + wsel * KT_BYTES;
                const LAS unsigned char* Vb = bb + 2 * KT_BYTES;
                f32x16 p0, p1;
#pragma unroll
                for (int r = 0; r < 16; ++r) { p0[r] = 0.f; p1[r] = 0.f; }
#pragma unroll
                for (int d0 = 0; d0 < 4; ++d0) {
                    const bf16x8 a0 = *(const LAS bf16x8*)(Kb + (2 * d0 + hi) * KPL + r32 * 16);
                    const bf16x8 a1 = *(const LAS bf16x8*)(Kb + (2 * d0 + hi) * KPL + (r32 + 32) * 16);
                    p0 = __builtin_amdgcn_mfma_f32_32x32x16_bf16(a0, qr[d0], p0, 0, 0, 0);
                    p1 = __builtin_amdgcn_mfma_f32_32x32x16_bf16(a1, qr[d0], p1, 0, 0, 0);
                }
                float mx = fmaxf(p0[0], p1[0]);
#pragma unroll
                for (int r = 1; r < 16; ++r) mx = fmaxf(mx, fmaxf(p0[r], p1[r]));
                mx = fmaxf(mx, __shfl_xor(mx, 32)) * C2;
                const float mnew = fmaxf(m, mx);
                if (__any(mnew > m)) {
                    const float f = __builtin_amdgcn_exp2f(m - mnew);
                    l *= f; m = mnew;
                    if (hi == 0) wsf[r32] = f;
                    asm volatile("s_waitcnt lgkmcnt(0)" ::: "memory");
#pragma unroll
                    for (int r = 0; r < 16; ++r) { const float fr = wsf[crow(r, hi)];
#pragma unroll
                        for (int d0 = 0; d0 < 4; ++d0) o[d0][r] *= fr; }
                }
                float ls = 0.f;
#pragma unroll
                for (int r = 0; r < 16; ++r) { p0[r] = __builtin_amdgcn_exp2f(p0[r] * C2 - m); p1[r] = __builtin_amdgcn_exp2f(p1[r] * C2 - m); ls += p0[r] + p1[r]; }
                l += ls;
                bf16x8 pa[4];
#pragma unroll
                for (int ks = 0; ks < 2; ++ks) {
                    u32x4 w0, w1;
                    w0.x = gp::cvt_pk_bf16(p0[8 * ks + 0], p0[8 * ks + 1]); w0.y = gp::cvt_pk_bf16(p0[8 * ks + 2], p0[8 * ks + 3]);
                    w0.z = gp::cvt_pk_bf16(p0[8 * ks + 4], p0[8 * ks + 5]); w0.w = gp::cvt_pk_bf16(p0[8 * ks + 6], p0[8 * ks + 7]);
                    w1.x = gp::cvt_pk_bf16(p1[8 * ks + 0], p1[8 * ks + 1]); w1.y = gp::cvt_pk_bf16(p1[8 * ks + 2], p1[8 * ks + 3]);
                    w1.z = gp::cvt_pk_bf16(p1[8 * ks + 4], p1[8 * ks + 5]); w1.w = gp::cvt_pk_bf16(p1[8 * ks + 6], p1[8 * ks + 7]);
                    pa[ks] = __builtin_bit_cast(bf16x8, w0); pa[2 + ks] = __builtin_bit_cast(bf16x8, w1);
                }
                const LAS unsigned char* vp = Vb + (4 * hi + ((lane & 15) >> 2)) * VRS + (16 * ((lane >> 4) & 1) + 4 * (lane & 3)) * 2;
#pragma unroll
                for (int d0 = 0; d0 < 4; ++d0)
#pragma unroll
                    for (int ks = 0; ks < 4; ++ks) {
                        const s16x4 lo = vtr(vp + (16 * ks) * VRS + d0 * 64), hv = vtr(vp + (16 * ks + 8) * VRS + d0 * 64);
                        const bf16x8 vf = (bf16x8){lo[0], lo[1], lo[2], lo[3], hv[0], hv[1], hv[2], hv[3]};
                        o[d0] = __builtin_amdgcn_mfma_f32_32x32x16_bf16(pa[ks], vf, o[d0], 0, 0, 0);
                    }
            }
            if (kt + 1 < NT) DA_WRITE((kt + 1) & 1);
            __syncthreads();
        }
#undef DA_LOAD
#undef DA_WRITE
        l += __shfl_xor(l, 32);
        { const float fac = (wsel ? lam : 1.0f) / l;
          if (hi == 0) wsf[r32] = fac;
          asm volatile("s_waitcnt lgkmcnt(0)" ::: "memory"); }
        LAS float* Ob = (LAS float*)lds + wsel * (128 * OB_STRIDE);
#pragma unroll
        for (int r = 0; r < 16; ++r) { const float fr = wsf[crow(r, hi)]; const int row = 32 * wq + crow(r, hi);
#pragma unroll
            for (int d0 = 0; d0 < 4; ++d0) Ob[row * OB_STRIDE + 32 * d0 + r32] = o[d0][r] * fr; }
        __syncthreads();
        { const LAS float* O1 = (const LAS float*)lds; const LAS float* O2 = O1 + 128 * OB_STRIDE;
          const float g0 = sub_g[2 * lane], g1 = sub_g[2 * lane + 1];
          for (int rr = 0; rr < 16; ++rr) { const int row = 16 * wave + rr;
              const float d0v = O1[row * OB_STRIDE + 2 * lane] - O2[row * OB_STRIDE + 2 * lane], d1v = O1[row * OB_STRIDE + 2 * lane + 1] - O2[row * OB_STRIDE + 2 * lane + 1];
              const float ss = wave_sum(d0v * d0v + d1v * d1v);
              const float rs = (1.0f - LAMBDA_INIT) / sqrtf(ss * (1.f / 128.f) + RMS_EPS);
              *(unsigned*)(H + (size_t)(b * SEQ + q0 + row) * DM + h * 128 + 2 * lane) = pk2(d0v * rs * g0, d1v * rs * g1); } }
        __syncthreads();
    }
}
}
namespace ds {
typedef float f32x16 __attribute__((ext_vector_type(16)));
typedef short s16x4 __attribute__((ext_vector_type(4)));
typedef int i32x4 __attribute__((ext_vector_type(4)));
typedef unsigned u32x2 __attribute__((ext_vector_type(2)));
constexpr int HIST_OFF = 131072, SEL_OFF = 139264, OALL_OFF = 143360;
constexpr float C2 = 0.125f * 1.4426950408889634f;
__device__ __forceinline__ s16x4 vtr(const LAS unsigned char* p) { return __builtin_bit_cast(s16x4, __builtin_amdgcn_ds_read_tr16_b64_v4i16((LAS s16x4*)p)); }
__device__ __forceinline__ unsigned skey(float f) { unsigned u = __float_as_uint(f); if (u == 0x80000000u) u = 0u; return u ^ ((unsigned)((int)u >> 31) | 0x80000000u); }

__device__ __forceinline__ void unit(const Params& p, LAS unsigned char* lds, int tid, int lane, int wave, int b, int qt) {
    unsigned char* ws = p.ws; const bf16_t* PROJ = (const bf16_t*)(ws + WS_PROJ); bf16_t* H = (bf16_t*)(ws + WS_H);
    const float* IW = (const float*)(ws + WS_IW);
    const int q0 = qt * 8, N = (q0 / 64 + 1) * 64, t0 = b * SEQ + q0;
    const bf16_t* base = PROJ + (size_t)b * SEQ * NPJ;
    LAS float* S = (LAS float*)lds;
    const int r32 = lane & 31, hi = lane >> 5;
    {
        bf16x8 aq[2][4]; f32x4 wv[2][4];
#pragma unroll
        for (int rb = 0; rb < 2; ++rb) {
            const bf16_t* qrow = base + (size_t)(q0 + 4 * rb + (r32 >> 3)) * NPJ + C_IQ + (r32 & 7) * 64 + 8 * hi;
#pragma unroll
            for (int d0 = 0; d0 < 4; ++d0) aq[rb][d0] = *(const bf16x8*)(qrow + 16 * d0);
#pragma unroll
            for (int qq = 0; qq < 4; ++qq) wv[rb][qq] = *(const f32x4*)(IW + (size_t)(t0 + 4 * rb + qq) * 8 + 4 * hi);
        }
        for (int kt = wave; kt < N / 32; kt += NWAVES) {
            const bf16_t* krow = base + (size_t)(32 * kt + r32) * NPJ + C_IK + 8 * hi;
            bf16x8 bk[4];
#pragma unroll
            for (int d0 = 0; d0 < 4; ++d0) bk[d0] = *(const bf16x8*)(krow + 16 * d0);
#pragma unroll
            for (int rb = 0; rb < 2; ++rb) {
                f32x16 acc;
#pragma unroll
                for (int r = 0; r < 16; ++r) acc[r] = 0.f;
#pragma unroll
                for (int d0 = 0; d0 < 4; ++d0) acc = __builtin_amdgcn_mfma_f32_32x32x16_bf16(aq[rb][d0], bk[d0], acc, 0, 0, 0);
                float full[4];
#pragma unroll
                for (int qq = 0; qq < 4; ++qq) {
                    float pr = wv[rb][qq][0] * fmaxf(acc[4 * qq + 0], 0.f);
                    pr += wv[rb][qq][1] * fmaxf(acc[4 * qq + 1], 0.f);
                    pr += wv[rb][qq][2] * fmaxf(acc[4 * qq + 2], 0.f);
                    pr += wv[rb][qq][3] * fmaxf(acc[4 * qq + 3], 0.f);
                    full[qq] = pr + __shfl_xor(pr, 32);
                }
                const float v0 = hi ? full[2] : full[0], v1 = hi ? full[3] : full[1];
                S[(4 * rb + 2 * hi) * 4096 + 32 * kt + r32] = v0;
                S[(4 * rb + 2 * hi + 1) * 4096 + 32 * kt + r32] = v1;
            }
        }
    }
    __syncthreads();
    LAS float* Sw = S + wave * 4096;
    LAS unsigned short* sel = (LAS unsigned short*)(lds + SEL_OFF) + wave * 256;
    const int nsel = N < 256 ? N : 256;
    if (N <= 256) {
        for (int i = lane; i < N; i += 64) sel[i] = (unsigned short)i;
    } else {
        LAS int* hist = (LAS int*)(lds + HIST_OFF) + wave * 256;
        unsigned prefix = 0u; int need = 256;
        const int nj = N / 64;
#pragma unroll 1
        for (int pass = 0; pass < 4; ++pass) {
            const int shift = 24 - 8 * pass;
            *(LAS i32x4*)(hist + 4 * lane) = (i32x4){0, 0, 0, 0};
            asm volatile("s_waitcnt lgkmcnt(0)" ::: "memory");
            for (int j = 0; j < nj; ++j) {
                const unsigned u = skey(Sw[64 * j + lane]);
                const bool match = (pass == 0) || ((u >> (shift + 8)) == prefix);
                if (match) __hip_atomic_fetch_add((int*)(hist + ((u >> shift) & 255u)), 1, __ATOMIC_RELAXED, __HIP_MEMORY_SCOPE_WORKGROUP);
            }
            asm volatile("s_waitcnt lgkmcnt(0)" ::: "memory");
            const i32x4 c = *(LAS i32x4*)(hist + 4 * lane);
            const int sl = c.x + c.y + c.z + c.w;
            int v = sl;
#pragma unroll
            for (int o = 1; o < 64; o <<= 1) { const int t = __shfl_down(v, o); v += (lane + o < 64) ? t : 0; }
            const int above = v - sl;
            const int a3 = above, a2 = a3 + c.w, a1 = a2 + c.z, a0 = a1 + c.y;
            int myB = -1, myAbove = 0;
            if (a3 < need && need <= a3 + c.w) { myB = 4 * lane + 3; myAbove = a3; }
            else if (a2 < need && need <= a2 + c.z) { myB = 4 * lane + 2; myAbove = a2; }
            else if (a1 < need && need <= a1 + c.y) { myB = 4 * lane + 1; myAbove = a1; }
            else if (a0 < need && need <= a0 + c.x) { myB = 4 * lane; myAbove = a0; }
            const unsigned long long bal = __ballot(myB >= 0);
            const int src = __builtin_ctzll(bal);
            const int B = __shfl(myB, src), ab = __shfl(myAbove, src);
            need -= ab; prefix = (prefix << 8) | (unsigned)B;
        }
        const unsigned long long ltmask = (1ull << lane) - 1ull;
        int outpos = 0, eqtaken = 0;
        for (int j = 0; j < nj; ++j) {
            const unsigned u = skey(Sw[64 * j + lane]);
            const bool eq = (u == prefix);
            const unsigned long long beq = __ballot(eq);
            const bool take = (u > prefix) || (eq && (eqtaken + __popcll(beq & ltmask) < need));
            const unsigned long long bt = __ballot(take);
            if (take) sel[outpos + __popcll(bt & ltmask)] = (unsigned short)(64 * j + lane);
            outpos += __popcll(bt); eqtaken += __popcll(beq);
        }
    }
    asm volatile("s_waitcnt lgkmcnt(0)" ::: "memory");
    {
        const int n16 = lane & 15, g = lane >> 4, t = t0 + wave;
        bf16x8 bqf[2];
#pragma unroll
        for (int ks = 0; ks < 2; ++ks) { bqf[ks] = (bf16x8){0, 0, 0, 0, 0, 0, 0, 0};
            if (n16 < 8) bqf[ks] = *(const bf16x8*)(PROJ + (size_t)t * NPJ + C_BQ + n16 * 64 + 32 * ks + 8 * g); }
        const int ntile = nsel / 16;
        f32x4 sc[16];
#pragma unroll
        for (int kt = 0; kt < 16; ++kt) {
            sc[kt] = (f32x4){-INFINITY, -INFINITY, -INFINITY, -INFINITY};
            if (kt < ntile) {
                const int idx = sel[16 * kt + n16];
                const bf16_t* kr = base + (size_t)idx * NPJ + C_BK + 8 * g;
                const bf16x8 k0 = *(const bf16x8*)kr, k1 = *(const bf16x8*)(kr + 32);
                f32x4 a = (f32x4){0.f, 0.f, 0.f, 0.f};
                a = __builtin_amdgcn_mfma_f32_16x16x32_bf16(k0, bqf[0], a, 0, 0, 0);
                a = __builtin_amdgcn_mfma_f32_16x16x32_bf16(k1, bqf[1], a, 0, 0, 0);
                sc[kt] = a;
            }
        }
        float mx = -INFINITY;
#pragma unroll
        for (int kt = 0; kt < 16; ++kt) mx = fmaxf(mx, fmaxf(fmaxf(sc[kt][0], sc[kt][1]), fmaxf(sc[kt][2], sc[kt][3])));
        mx = fmaxf(mx, __shfl_xor(mx, 16)); mx = fmaxf(mx, __shfl_xor(mx, 32));
        const float mc = mx * C2;
        float lsum = 0.f;
        bf16x8 pb[8];
#pragma unroll
        for (int s = 0; s < 8; ++s) {
            float e[8];
#pragma unroll
            for (int i = 0; i < 4; ++i) { e[i] = __builtin_amdgcn_exp2f(sc[2 * s][i] * C2 - mc); e[4 + i] = __builtin_amdgcn_exp2f(sc[2 * s + 1][i] * C2 - mc); }
#pragma unroll
            for (int i = 0; i < 8; ++i) lsum += e[i];
            u32x4 w; w.x = gp::cvt_pk_bf16(e[0], e[1]); w.y = gp::cvt_pk_bf16(e[2], e[3]); w.z = gp::cvt_pk_bf16(e[4], e[5]); w.w = gp::cvt_pk_bf16(e[6], e[7]);
            pb[s] = __builtin_bit_cast(bf16x8, w);
        }
        lsum += __shfl_xor(lsum, 16); lsum += __shfl_xor(lsum, 32);
        LAS unsigned char* Lw = (LAS unsigned char*)Sw;
        f32x4 ot[8];
#pragma unroll
        for (int cb = 0; cb < 8; ++cb) ot[cb] = (f32x4){0.f, 0.f, 0.f, 0.f};
        const int nstep = nsel / 32;
#pragma unroll
        for (int s = 0; s < 8; ++s) {
            if (s < nstep) {
                LAS unsigned char* Lb = Lw + (s & 1) * 8192;
                u32x4 stg[8];
#pragma unroll
                for (int i = 0; i < 8; ++i) { const int sig = 4 * i + g, ch = n16;
                    stg[i] = *(const u32x4*)(base + (size_t)sel[32 * s + sig] * NPJ + C_BLAT + 8 * ch); }
#pragma unroll
                for (int i = 0; i < 8; ++i) { const int sig = 4 * i + g, ch = n16;
                    *(LAS u32x4*)(Lb + sig * 256 + (((ch >> 1) ^ (sig & 7)) * 32) + (ch & 1) * 16) = stg[i]; }
                asm volatile("s_waitcnt lgkmcnt(0)" ::: "memory");
                const int rq = 4 * g + (n16 >> 2);
#pragma unroll
                for (int cb = 0; cb < 8; ++cb) {
                    const s16x4 lo = vtr(Lb + rq * 256 + ((cb ^ (rq & 7)) * 32) + 8 * (lane & 3));
                    const s16x4 hv = vtr(Lb + (16 + rq) * 256 + ((cb ^ (rq & 7)) * 32) + 8 * (lane & 3));
                    const bf16x8 af = (bf16x8){lo[0], lo[1], lo[2], lo[3], hv[0], hv[1], hv[2], hv[3]};
                    ot[cb] = __builtin_amdgcn_mfma_f32_16x16x32_bf16(af, pb[s], ot[cb], 0, 0, 0);
                }
            }
        }
        const float linv = 1.0f / lsum;
        if (n16 < 8) {
            LAS bf16_t* Oall = (LAS bf16_t*)(lds + OALL_OFF) + (wave * 8 + n16) * 128;
#pragma unroll
            for (int cb = 0; cb < 8; ++cb) *(LAS u32x2*)(Oall + 16 * cb + 4 * g) = (u32x2){pk2(ot[cb][0] * linv, ot[cb][1] * linv), pk2(ot[cb][2] * linv, ot[cb][3] * linv)};
        }
    }
    __syncthreads();
    {
        const int n16 = lane & 15, g = lane >> 4, hh = wave;
        const bf16_t* WuvT = (const bf16_t*)(ws + WS_WUVT) + hh * 64 * 128;
        const LAS bf16_t* Oall = (const LAS bf16_t*)(lds + OALL_OFF) + ((n16 & 7) * 8 + hh) * 128;
        bf16x8 af[4];
#pragma unroll
        for (int ks = 0; ks < 4; ++ks) af[ks] = *(const LAS bf16x8*)(Oall + 32 * ks + 8 * g);
#pragma unroll
        for (int nb = 0; nb < 4; ++nb) {
            f32x4 a = (f32x4){0.f, 0.f, 0.f, 0.f};
#pragma unroll
            for (int ks = 0; ks < 4; ++ks) { const bf16x8 bf = *(const bf16x8*)(WuvT + (16 * nb + n16) * 128 + 32 * ks + 8 * g);
                a = __builtin_amdgcn_mfma_f32_16x16x32_bf16(af[ks], bf, a, 0, 0, 0); }
            if (g < 2) {
#pragma unroll
                for (int i = 0; i < 4; ++i) H[(size_t)(t0 + 4 * g + i) * DM + 512 + hh * 64 + 16 * nb + n16] = f2bf(a[i]);
            }
        }
    }
    __syncthreads();
}

__device__ __forceinline__ void phase(const Params& p, LAS unsigned char* lds, int tid, int lane, int wave) {
    const int G = gridDim.x, k = blockIdx.x;
    if (G == 256) {
        const int b = k & 7, j = k >> 3;
        for (int i = 0; i < 16; ++i) { const int idx = i * 32 + ((i & 1) ? 31 - j : j);
            unit(p, lds, tid, lane, wave, b, 511 - idx); }
    } else {
        for (int u = k; u < 4096; u += G) unit(p, lds, tid, lane, wave, u & 7, 511 - (u >> 3));
    }
}
}
constexpr int N_PHASES = 11;
__global__ void __launch_bounds__(NTHREADS, 2) mega(Params p) {
    extern __shared__ __attribute__((aligned(16))) unsigned char lds_raw[];
    LAS unsigned char* lds = (LAS unsigned char*)lds_raw;
    cg::grid_group grid = cg::this_grid();
    const int tid = threadIdx.x, lane = tid & 63, wave = __builtin_amdgcn_readfirstlane(tid >> 6);
    unsigned char* ws = p.ws;
    const int lo = p.ph_lo, hi = p.ph_hi;
#define IN(k) (lo <= (k) && (k) < hi)
#define SEAM(k) do { if (IN(k) && IN((k) + 1)) grid.sync(); } while (0)
    if (IN(0)) { phase_prep(p, lds, tid, lane, wave); } SEAM(0);
    if (IN(1)) { phase_norm1(p, lds, tid, lane, wave); } SEAM(1);
    if (IN(2)) {
        gp::Gemm g{(const bf16_t*)(ws + WS_H), (const bf16_t*)(ws + WS_WINT), NPJ, DM, nullptr};
        gp::StaticOrder S; S.init(NTOK, NPJ, gridDim.x, blockIdx.x);
        gp::EpiBf16 E{(bf16_t*)(ws + WS_PROJ), NPJ};
        gp::gemm_phase<gp::EpiBf16, gp::StaticOrder, false>(lds, g, S, E);
    } SEAM(2);
    if (IN(3)) { phase_post_slow(p, tid); } SEAM(3);
    if (IN(4)) { da::phase(p, lds, tid, lane, wave); ds::phase(p, lds, tid, lane, wave); } SEAM(4);
    if (IN(5)) {
        gp::Gemm g{(const bf16_t*)(ws + WS_H), (const bf16_t*)(ws + WS_WOUTT), DM, DM, nullptr};
        gp::StaticOrder S; S.init(NTOK, DM, gridDim.x, blockIdx.x);
        gp::EpiResid E{p.in[0], p.out, (const float*)(ws + WS_MOD)};
        gp::gemm_phase<gp::EpiResid, gp::StaticOrder, false>(lds, g, S, E);
    } SEAM(5);
    if (IN(6)) { phase_norm2(p, lds, tid, lane, wave); } SEAM(6);
    if (IN(7)) { phase_scatter(p, lds, tid, lane, wave); } SEAM(7);
    if (IN(8)) {
        const int* tile_e = (const int*)(ws + WS_TILEE);
        gp::Gemm g{(const bf16_t*)(ws + WS_H), (const bf16_t*)(ws + WS_WGUT), 2048, DM, (const int*)(ws + WS_ROWSRC)};
        gp::MoeOrder S{tile_e, tile_e[MAXTILES], 8, (int)blockIdx.x, (int)gridDim.x};
        gp::EpiSwiglu E{(bf16_t*)(ws + WS_ACT), p.in[19], p.in[21]};
        gp::gemm_phase<gp::EpiSwiglu, gp::MoeOrder, true>(lds, g, S, E);
    } SEAM(8);
    if (IN(9)) {
        const int* tile_e = (const int*)(ws + WS_TILEE);
        gp::Gemm g{(const bf16_t*)(ws + WS_ACT), (const bf16_t*)(ws + WS_WDT), DM, DM, nullptr};
        gp::MoeOrder S{tile_e, tile_e[MAXTILES], 4, (int)blockIdx.x, (int)gridDim.x};
        gp::EpiDown E{p.out, (bf16_t*)(ws + WS_Y), p.in[23], (const float*)(ws + WS_MOD), (const int*)(ws + WS_ROWTOK), (const float*)(ws + WS_TOPG)};
        gp::gemm_phase<gp::EpiDown, gp::MoeOrder, false>(lds, g, S, E);
    } SEAM(9);
    if (IN(10)) { phase_combine(p, tid); }
#undef IN
#undef SEAM
}

static int g_grid = 0;
static void launch_mega(const Params& base, int lo, int hi, hipStream_t stream) {
    Params p = base; p.ph_lo = lo; p.ph_hi = hi;
    void* args[] = {&p};
    hipError_t e = hipLaunchCooperativeKernel((const void*)mega, dim3(g_grid), dim3(NTHREADS), args, LDS_BYTES, stream);
    if (e != hipSuccess) fprintf(stderr, "kernel_launch: cooperative launch [%d,%d) failed: %s (grid %d)\n", lo, hi, hipGetErrorString(e), g_grid);
}
extern "C" void kernel_launch(void* const* d_in, const int* in_sizes, int n_in, void* d_out, int out_size, void* d_ws, size_t ws_size, hipStream_t stream) {
    if (ws_size < WS_END) { fprintf(stderr, "kernel_launch: workspace too small: %zu < %zu\n", ws_size, (size_t)WS_END); return; }
    if (g_grid == 0) {
        int dev = 0, cus = 0, per_cu = 0;
        hipGetDevice(&dev); hipDeviceGetAttribute(&cus, hipDeviceAttributeMultiprocessorCount, dev);
        if (hipFuncSetAttribute((const void*)mega, hipFuncAttributeMaxDynamicSharedMemorySize, LDS_BYTES) != hipSuccess) fprintf(stderr, "kernel_launch: hipFuncSetAttribute failed\n");
        hipOccupancyMaxActiveBlocksPerMultiprocessor(&per_cu, (const void*)mega, NTHREADS, LDS_BYTES);
        (void)hipGetLastError();
        if (per_cu < 1) { fprintf(stderr, "kernel_launch: occupancy query says %d blocks/CU\n", per_cu); per_cu = 1; }
        g_grid = cus * 1;
        fprintf(stderr, "kernel_launch: cus %d per_cu %d grid %d\n", cus, per_cu, g_grid);
    }
    const float* x = (const float*)d_in[0];
    float* out = (float*)d_out; char* ws = (char*)d_ws;
    float* mod = (float*)(ws + WS_MOD); float* rope = (float*)(ws + WS_ROPE); float* lam = (float*)(ws + WS_LAM);
    float* IW = (float*)(ws + WS_IW);
    bf16_t* H = (bf16_t*)(ws + WS_H); bf16_t* PROJ = (bf16_t*)(ws + WS_PROJ);
    Params P{};
    for (int i = 0; i < 24; ++i) P.in[i] = (const float*)d_in[i];
    P.out = out; P.ws = (unsigned char*)d_ws;

    launch_mega(P, 0, N_PHASES, stream);
    (void)rope; (void)lam; (void)IW; (void)H; (void)PROJ;
    (void)x; (void)mod;
}
```

```cpp
#include <hip/hip_runtime.h>
#include <stdint.h>
#include <cstdio>

typedef unsigned short bf16_t;
__device__ __forceinline__ float bf2f(bf16_t v) { return __uint_as_float(((unsigned)v) << 16); }
__device__ __forceinline__ bf16_t f2bf(float f) { unsigned u = __float_as_uint(f); return (bf16_t)((u + 0x7fffu + ((u >> 16) & 1u)) >> 16); }

constexpr int NB = 8, SEQ = 4096, DM = 1024, NTOK = NB * SEQ;
constexpr int NIN = 2824, NPJ = 2816;
constexpr int C_AQ1 = 0, C_AQ2 = 256, C_AK1 = 512, C_AK2 = 768, C_AV = 1024, C_BQ = 1536, C_BK = 2048, C_BLAT = 2112, C_IQ = 2240, C_IK = 2752, C_IW = 2816;
constexpr int NEXP = 32, TOPK = 4, NPAIR = NTOK * TOPK;
constexpr int MAXTILES = NPAIR / 256 + NEXP;
constexpr int PPAD = MAXTILES * 256;
constexpr int NCHUNK = 256, CHTOK = NTOK / NCHUNK;
constexpr float RMS_EPS = 1e-6f;
constexpr float LAMBDA_INIT = 0.2f;

constexpr size_t MiB = 1u << 20;
constexpr size_t WS_CTL = 0;
constexpr size_t WS_MOD = 1 * MiB;
constexpr size_t WS_ROPE = WS_MOD + 256 * 1024;
constexpr size_t WS_LAM = WS_ROPE + 256 * 1024;
constexpr size_t WS_CHCNT = WS_LAM + 4096;
constexpr size_t WS_TILEE = WS_CHCNT + 32768;
constexpr size_t WS_TOPI = 2 * MiB;
constexpr size_t WS_TOPG = WS_TOPI + 512 * 1024;
constexpr size_t WS_ROWTOK = 3 * MiB;
constexpr size_t WS_ROWSRC = 3 * MiB + 640 * 1024;
constexpr size_t WS_IW = 5 * MiB;
constexpr size_t WS_WINT = 8 * MiB;
constexpr size_t WS_WOUTT = 14 * MiB;
constexpr size_t WS_WUVT = 16 * MiB;
constexpr size_t WS_WDT = 17 * MiB;
constexpr size_t WS_WGUT = 81 * MiB;
constexpr size_t WS_H = 209 * MiB;
constexpr size_t WS_PROJ = 273 * MiB;
constexpr size_t WS_ACT = WS_PROJ;
constexpr size_t WS_Y = WS_WGUT;
constexpr size_t WS_IKF = WS_ACT + (size_t)PPAD * 1024 * 2;
constexpr size_t WS_END = WS_IKF + 4 * MiB;

__device__ __forceinline__ float block_sum_256(float v, float* red) {
#pragma unroll
    for (int o = 32; o > 0; o >>= 1) v += __shfl_xor(v, o);
    const int w = threadIdx.x >> 6;
    __syncthreads();
    if ((threadIdx.x & 63) == 0) red[w] = v;
    __syncthreads();
    return red[0] + red[1] + red[2] + red[3];
}
__device__ __forceinline__ float block_max_256(float v, float* red) {
#pragma unroll
    for (int o = 32; o > 0; o >>= 1) v = fmaxf(v, __shfl_xor(v, o));
    const int w = threadIdx.x >> 6;
    __syncthreads();
    if ((threadIdx.x & 63) == 0) red[w] = v;
    __syncthreads();
    return fmaxf(fmaxf(red[0], red[1]), fmaxf(red[2], red[3]));
}

__global__ __launch_bounds__(256) void nv_prep(float* rope, float* lam, const float* a_lambda) {
    const int i = blockIdx.x * 256 + threadIdx.x;
    if (i < SEQ * 8) {
        const int pos = i >> 3, f = i & 7;
        const float inv = (float)exp(-(double)f / 8.0 * log(500000.0));
        const float ang = (float)pos * inv;
        double a = (double)ang;
        const double TWO_PI = 6.283185307179586476925287;
        double k = rint(a / TWO_PI);
        double r = a - k * TWO_PI;
        double r2 = r * r, s = 0.0, c = 0.0;
        double ts = r, tc = 1.0;
        for (int n = 0; n < 14; ++n) {
            s += ts; c += tc;
            ts *= -r2 / (double)((2 * n + 2) * (2 * n + 3));
            tc *= -r2 / (double)((2 * n + 1) * (2 * n + 2));
        }
        rope[i * 2 + 0] = (float)c;
        rope[i * 2 + 1] = (float)s;
    }
    if (i == 0) {
        float d01 = 0.f, d23 = 0.f;
        for (int j = 0; j < 64; ++j) { d01 += a_lambda[j] * a_lambda[64 + j]; d23 += a_lambda[128 + j] * a_lambda[192 + j]; }
        lam[0] = expf(d01) - expf(d23) + LAMBDA_INIT;
    }
}

__global__ __launch_bounds__(256) void nv_mod(const float* c, const float* w_ada, const float* b_ada, float* mod) {
    __shared__ float sc[8 * 1024];
    for (int i = threadIdx.x; i < 8 * 1024; i += 256) { const float v = c[i]; sc[i] = v / (1.f + expf(-v)); }
    __syncthreads();
    const int j = blockIdx.x * 256 + threadIdx.x;
    float acc[8];
#pragma unroll
    for (int b = 0; b < 8; ++b) acc[b] = 0.f;
    for (int k = 0; k < 1024; ++k) {
        const float w = w_ada[(size_t)k * 6144 + j];
#pragma unroll
        for (int b = 0; b < 8; ++b) acc[b] += sc[b * 1024 + k] * w;
    }
#pragma unroll
    for (int b = 0; b < 8; ++b) mod[b * 6144 + j] = acc[b] + b_ada[j];
}

__global__ __launch_bounds__(256) void nv_norm1(const float* x, const float* g, const float* mod, const float* w_in, bf16_t* H, float* IW) {
    __shared__ float red[8];
    __shared__ float hrow[1024];
    const int t = blockIdx.x, b = t / SEQ, tid = threadIdx.x;
    const float4 v = ((const float4*)(x + (size_t)t * DM))[tid];
    const float ss = block_sum_256(v.x * v.x + v.y * v.y + v.z * v.z + v.w * v.w, red);
    const float r = 1.0f / sqrtf(ss * (1.f / DM) + RMS_EPS);
    const float* sh = mod + b * 6144, * sc = mod + b * 6144 + 1024;
    float hv[4]; const float xv[4] = {v.x, v.y, v.z, v.w};
#pragma unroll
    for (int i = 0; i < 4; ++i) { const int k = tid * 4 + i; hv[i] = (xv[i] * r * g[k]) * (1.f + sc[k]) + sh[k]; hrow[k] = hv[i]; H[(size_t)t * DM + k] = f2bf(hv[i]); }
    __syncthreads();
    const int col = tid & 7, part = tid >> 3;
    float p = 0.f;
    for (int k = part * 32; k < part * 32 + 32; ++k) p += hrow[k] * w_in[(size_t)k * NIN + C_IW + col];
    p += __shfl_xor(p, 8); p += __shfl_xor(p, 16); p += __shfl_xor(p, 32);
    __shared__ float pw[4][8];
    if ((tid & 63) < 8) pw[tid >> 6][tid & 7] = p;
    __syncthreads();
    if (tid < 8) IW[(size_t)t * 8 + tid] = (pw[0][tid] + pw[1][tid] + pw[2][tid] + pw[3][tid]) * 0.04419417382415922f;
}

struct NvGemm {
    const bf16_t* A; int lda;
    const float* B; const float* B2; int ldb;
    int K;
    bf16_t* Obf; int ldo;
    const float* x; float* out; const float* mod;
    const int* rowtok; const int* tile_e; const float* topg; const float* bias; const float* bias2; bf16_t* Y;
};
template <int MODE>
__global__ __launch_bounds__(256) void nv_gemm(NvGemm a) {
    __shared__ float As[16][68];
    __shared__ float Bs[16][64];
    __shared__ float Bs2[MODE == 2 ? 16 : 1][64];
    __shared__ int rows[64];
    const int tid = threadIdx.x, tx = tid & 15, ty = tid >> 4;
    const int n0 = blockIdx.x * 64, m0 = blockIdx.y * 64;
    int e = 0;
    if (MODE == 2 || MODE == 3) {
        const int ntiles = a.tile_e[MAXTILES];
        if ((int)(blockIdx.y >> 2) >= ntiles) return;
        e = a.tile_e[blockIdx.y >> 2];
    }
    if (tid < 64) {
        int r = m0 + tid;
        if (MODE == 2) { const int ent = a.rowtok[m0 + tid]; r = ent < 0 ? 0 : (ent >> 2); }
        rows[tid] = r;
    }
    __syncthreads();
    const float* Bp = a.B + ((MODE == 2 || MODE == 3) ? (size_t)e * 1024 * 1024 : 0);
    const float* Bp2 = MODE == 2 ? a.B2 + (size_t)e * 1024 * 1024 : nullptr;
    float acc[4][4], acc2[4][4];
#pragma unroll
    for (int i = 0; i < 4; ++i)
#pragma unroll
        for (int j = 0; j < 4; ++j) { acc[i][j] = 0.f; acc2[i][j] = 0.f; }
    const int ar = tid >> 2, ak = (tid & 3) * 4;
    const int bk = tid >> 4, bn = (tid & 15) * 4;
    for (int k0 = 0; k0 < a.K; k0 += 16) {
        const uint2 av = *(const uint2*)(a.A + (size_t)rows[ar] * a.lda + k0 + ak);
        As[ak + 0][ar] = __uint_as_float(av.x << 16); As[ak + 1][ar] = __uint_as_float(av.x & 0xffff0000u);
        As[ak + 2][ar] = __uint_as_float(av.y << 16); As[ak + 3][ar] = __uint_as_float(av.y & 0xffff0000u);
        const float4 bv = *(const float4*)(Bp + (size_t)(k0 + bk) * a.ldb + n0 + bn);
        Bs[bk][bn] = bv.x; Bs[bk][bn + 1] = bv.y; Bs[bk][bn + 2] = bv.z; Bs[bk][bn + 3] = bv.w;
        if (MODE == 2) { const float4 b2 = *(const float4*)(Bp2 + (size_t)(k0 + bk) * a.ldb + n0 + bn);
            Bs2[bk][bn] = b2.x; Bs2[bk][bn + 1] = b2.y; Bs2[bk][bn + 2] = b2.z; Bs2[bk][bn + 3] = b2.w; }
        __syncthreads();
#pragma unroll
        for (int k = 0; k < 16; ++k) {
            float av4[4], bv4[4], cv4[4];
#pragma unroll
            for (int i = 0; i < 4; ++i) av4[i] = As[k][ty * 4 + i];
#pragma unroll
            for (int j = 0; j < 4; ++j) { bv4[j] = Bs[k][tx * 4 + j]; if (MODE == 2) cv4[j] = Bs2[k][tx * 4 + j]; }
#pragma unroll
            for (int i = 0; i < 4; ++i)
#pragma unroll
                for (int j = 0; j < 4; ++j) { acc[i][j] += av4[i] * bv4[j]; if (MODE == 2) acc2[i][j] += av4[i] * cv4[j]; }
        }
        __syncthreads();
    }
#pragma unroll
    for (int i = 0; i < 4; ++i) {
        const int m = m0 + ty * 4 + i;
#pragma unroll
        for (int j = 0; j < 4; ++j) {
            const int n = n0 + tx * 4 + j;
            if (MODE == 0) a.Obf[(size_t)m * a.ldo + n] = f2bf(acc[i][j]);
            if (MODE == 1) { const int b = m / SEQ; a.out[(size_t)m * DM + n] = a.x[(size_t)m * DM + n] + a.mod[b * 6144 + 2 * 1024 + n] * acc[i][j]; }
            if (MODE == 2) {
                float g = acc[i][j] + a.bias[e * 1024 + n], u = acc2[i][j] + a.bias2[e * 1024 + n];
                g = fminf(g, 7.0f); u = fminf(fmaxf(u, -7.0f), 7.0f);
                const float act = g * (1.f / (1.f + expf(-1.702f * g))) * (u + 1.0f);
                a.Obf[(size_t)m * a.ldo + n] = f2bf(act);
            }
            if (MODE == 3) {
                const int ent = a.rowtok[m];
                if (ent >= 0) {
                    const int tok = ent >> 2, kk = ent & 3, b = tok / SEQ;
                    const float val = a.topg[ent] * (acc[i][j] + a.bias[e * 1024 + n]);
                    if (kk == 0) a.out[(size_t)tok * DM + n] += a.mod[b * 6144 + 5 * 1024 + n] * val;
                    else a.Y[((size_t)(kk - 1) * NTOK + tok) * DM + n] = f2bf(val);
                }
            }
        }
    }
}

__global__ __launch_bounds__(256) void nv_post(bf16_t* PROJ, const float* rope, const float* aq_g, const float* ak_g, const float* bq_g, const float* bk_g, const float* bkv_g) {
    const int t = blockIdx.x, pos = t % SEQ;
    bf16_t* row = PROJ + (size_t)t * NPJ;
    const int gidx = threadIdx.x;
    if (gidx >= 44) return;
    const int c0 = gidx * 64;
    float v[64];
    bool donorm = false, dorope = false; const float* gg = nullptr;
    if (c0 < 512) { donorm = true; dorope = true; gg = aq_g; }
    else if (c0 < 1024) { donorm = true; dorope = true; gg = ak_g; }
    else if (c0 < 1536) { return; }
    else if (c0 < 2048) { donorm = true; dorope = true; gg = bq_g; }
    else if (c0 < 2112) { donorm = true; dorope = true; gg = bk_g; }
    else if (c0 < 2240) {
        if (c0 != 2112) return;
        float ss = 0.f;
        for (int i = 0; i < 128; ++i) { const float f = bf2f(row[c0 + i]); ss += f * f; }
        const float r = 1.0f / sqrtf(ss * (1.f / 128.f) + RMS_EPS);
        for (int i = 0; i < 128; ++i) row[c0 + i] = f2bf(bf2f(row[c0 + i]) * r * bkv_g[i]);
        return;
    }
    else { dorope = true; }
    float ss = 0.f;
#pragma unroll
    for (int i = 0; i < 64; ++i) { v[i] = bf2f(row[c0 + i]); ss += v[i] * v[i]; }
    if (donorm) { const float r = 1.0f / sqrtf(ss * (1.f / 64.f) + RMS_EPS);
#pragma unroll
        for (int i = 0; i < 64; ++i) v[i] = v[i] * r * gg[i]; }
    if (dorope) {
#pragma unroll
        for (int i = 0; i < 8; ++i) { const float cs = rope[(pos * 8 + i) * 2], sn = rope[(pos * 8 + i) * 2 + 1];
            const float x1 = v[i], x2 = v[8 + i]; v[i] = x1 * cs - x2 * sn; v[8 + i] = x2 * cs + x1 * sn; }
    }
#pragma unroll
    for (int i = 0; i < 64; ++i) row[c0 + i] = f2bf(v[i]);
}

__global__ __launch_bounds__(256) void nv_diffattn(const bf16_t* PROJ, bf16_t* H, const float* lamp, const float* sub_g) {
    __shared__ float q1[64], q2[64], s1[4096], s2[4096], red[8], osum[2][128];
    const int t = blockIdx.x, h = blockIdx.y, b = t / SEQ, s = t % SEQ, N = (s / 64 + 1) * 64, tid = threadIdx.x;
    const bf16_t* qrow = PROJ + (size_t)t * NPJ;
    if (tid < 64) q1[tid] = bf2f(qrow[C_AQ1 + h * 64 + tid]);
    else if (tid < 128) q2[tid - 64] = bf2f(qrow[C_AQ2 + h * 64 + tid - 64]);
    __syncthreads();
    float m1 = -INFINITY, m2 = -INFINITY;
    for (int key = tid; key < N; key += 256) {
        const bf16_t* kr = PROJ + (size_t)(b * SEQ + key) * NPJ;
        float d1 = 0.f, d2 = 0.f;
        for (int d = 0; d < 64; ++d) { d1 += q1[d] * bf2f(kr[C_AK1 + h * 64 + d]); d2 += q2[d] * bf2f(kr[C_AK2 + h * 64 + d]); }
        d1 *= 0.125f; d2 *= 0.125f; s1[key] = d1; s2[key] = d2; m1 = fmaxf(m1, d1); m2 = fmaxf(m2, d2);
    }
    m1 = block_max_256(m1, red); m2 = block_max_256(m2, red);
    float l1 = 0.f, l2 = 0.f;
    for (int key = tid; key < N; key += 256) { const float e1 = expf(s1[key] - m1), e2 = expf(s2[key] - m2); s1[key] = e1; s2[key] = e2; l1 += e1; l2 += e2; }
    l1 = block_sum_256(l1, red); l2 = block_sum_256(l2, red);
    const float lam = lamp[0], i1 = 1.f / l1, i2 = lam / l2;
    for (int key = tid; key < N; key += 256) s1[key] = s1[key] * i1 - s2[key] * i2;
    __syncthreads();
    const int e = tid & 127, half = tid >> 7;
    float o = 0.f;
    for (int key = half; key < N; key += 2) o += s1[key] * bf2f(PROJ[(size_t)(b * SEQ + key) * NPJ + C_AV + h * 128 + e]);
    osum[half][e] = o;
    __syncthreads();
    float ov = 0.f, sq = 0.f;
    if (tid < 128) { ov = osum[0][tid] + osum[1][tid]; sq = ov * ov; }
    const float ss = block_sum_256(sq, red);
    if (tid < 128) H[(size_t)t * DM + h * 128 + tid] = f2bf(ov * (1.0f / sqrtf(ss * (1.f / 128.f) + RMS_EPS)) * sub_g[tid] * (1.0f - LAMBDA_INIT));
}

__global__ __launch_bounds__(256) void nv_dsa(const bf16_t* PROJ, const float* IW, const float* w_uv, bf16_t* H) {
    __shared__ float iq[8 * 64], bq[8 * 64], w[8], score[4096], p[8][256], o[8][128];
    __shared__ int sel[256];
    const int t = blockIdx.x, b = t / SEQ, s = t % SEQ, N = (s / 64 + 1) * 64, tid = threadIdx.x;
    const bf16_t* qrow = PROJ + (size_t)t * NPJ;
    for (int i = tid; i < 512; i += 256) { iq[i] = bf2f(qrow[C_IQ + i]); bq[i] = bf2f(qrow[C_BQ + i]); }
    if (tid < 8) w[tid] = IW[(size_t)t * 8 + tid];
    __syncthreads();
    for (int key = tid; key < N; key += 256) {
        const bf16_t* kr = PROJ + (size_t)(b * SEQ + key) * NPJ + C_IK;
        float kd[64];
#pragma unroll
        for (int d = 0; d < 64; ++d) kd[d] = bf2f(kr[d]);
        float sc = 0.f;
        for (int hh = 0; hh < 8; ++hh) { float d0 = 0.f;
#pragma unroll
            for (int d = 0; d < 64; ++d) d0 += iq[hh * 64 + d] * kd[d];
            sc += w[hh] * fmaxf(d0, 0.f); }
        score[key] = sc;
    }
    __syncthreads();
    const int nsel = N < 256 ? N : 256;
    for (int key = tid; key < N; key += 256) {
        const float my = score[key]; int r = 0;
        for (int j = 0; j < N; ++j) { const float ot = score[j]; r += (ot > my || (ot == my && j < key)) ? 1 : 0; }
        if (r < 256) sel[r] = key;
    }
    __syncthreads();
    if (tid < nsel) {
        const bf16_t* kr = PROJ + (size_t)(b * SEQ + sel[tid]) * NPJ + C_BK;
        float kd[64];
#pragma unroll
        for (int d = 0; d < 64; ++d) kd[d] = bf2f(kr[d]);
        for (int hh = 0; hh < 8; ++hh) { float d0 = 0.f;
#pragma unroll
            for (int d = 0; d < 64; ++d) d0 += bq[hh * 64 + d] * kd[d];
            p[hh][tid] = d0 * 0.125f; }
    }
    __syncthreads();
    {
        const int hh = tid >> 5, l = tid & 31;
        float m = -INFINITY;
        for (int j = l; j < nsel; j += 32) m = fmaxf(m, p[hh][j]);
#pragma unroll
        for (int of = 16; of > 0; of >>= 1) m = fmaxf(m, __shfl_xor(m, of));
        float sum = 0.f;
        for (int j = l; j < nsel; j += 32) { const float ev = expf(p[hh][j] - m); p[hh][j] = ev; sum += ev; }
#pragma unroll
        for (int of = 16; of > 0; of >>= 1) sum += __shfl_xor(sum, of);
        const float inv = 1.f / sum;
        for (int j = l; j < nsel; j += 32) p[hh][j] *= inv;
    }
    __syncthreads();
    {
        const int hh = tid >> 5, l = tid & 31;
        float a0 = 0.f, a1 = 0.f, a2 = 0.f, a3 = 0.f;
        for (int j = 0; j < nsel; ++j) {
            const bf16_t* lr = PROJ + (size_t)(b * SEQ + sel[j]) * NPJ + C_BLAT;
            const float pv = p[hh][j];
            a0 += pv * bf2f(lr[l]); a1 += pv * bf2f(lr[l + 32]); a2 += pv * bf2f(lr[l + 64]); a3 += pv * bf2f(lr[l + 96]);
        }
        o[hh][l] = a0; o[hh][l + 32] = a1; o[hh][l + 64] = a2; o[hh][l + 96] = a3;
    }
    __syncthreads();
    {
        const int hh = tid >> 5, l = tid & 31;
        float a0 = 0.f, a1 = 0.f;
        for (int c = 0; c < 128; ++c) { const float ov = o[hh][c]; a0 += ov * w_uv[(hh * 128 + c) * 64 + l]; a1 += ov * w_uv[(hh * 128 + c) * 64 + l + 32]; }
        H[(size_t)t * DM + 512 + hh * 64 + l] = f2bf(a0); H[(size_t)t * DM + 512 + hh * 64 + l + 32] = f2bf(a1);
    }
}

__global__ __launch_bounds__(256) void nv_norm2(const float* x1, const float* g, const float* mod, const float* rw, const float* rb, bf16_t* H, int* topi, float* topg) {
    __shared__ float red[8];
    __shared__ float hrow[1024];
    __shared__ float part[8][32];
    __shared__ float logit[32];
    const int t = blockIdx.x, b = t / SEQ, tid = threadIdx.x;
    const float4 v = ((const float4*)(x1 + (size_t)t * DM))[tid];
    const float ss = block_sum_256(v.x * v.x + v.y * v.y + v.z * v.z + v.w * v.w, red);
    const float r = 1.0f / sqrtf(ss * (1.f / DM) + RMS_EPS);
    const float* sh = mod + b * 6144 + 3 * 1024, * sc = mod + b * 6144 + 4 * 1024;
    const float xv[4] = {v.x, v.y, v.z, v.w};
#pragma unroll
    for (int i = 0; i < 4; ++i) { const int k = tid * 4 + i; const float hv = (xv[i] * r * g[k]) * (1.f + sc[k]) + sh[k]; hrow[k] = hv; H[(size_t)t * DM + k] = f2bf(hv); }
    __syncthreads();
    const int e = tid & 31, pt = tid >> 5;
    float pa = 0.f;
    for (int k = pt * 128; k < pt * 128 + 128; ++k) pa += hrow[k] * rw[k * 32 + e];
    part[pt][e] = pa;
    __syncthreads();
    if (tid < 32) { float l = rb[tid]; for (int q = 0; q < 8; ++q) l += part[q][tid]; logit[tid] = l; }
    __syncthreads();
    if (tid == 0) {
        int idx[4]; float val[4]; unsigned used = 0;
        for (int k = 0; k < 4; ++k) { int bi = -1; float bv = -INFINITY;
            for (int j = 0; j < 32; ++j) if (!((used >> j) & 1u) && (bi < 0 || logit[j] > bv)) { bi = j; bv = logit[j]; }
            used |= 1u << bi; idx[k] = bi; val[k] = bv; }
        float sum = 0.f, ex[4];
        for (int k = 0; k < 4; ++k) { ex[k] = expf(val[k] - val[0]); sum += ex[k]; }
        for (int k = 0; k < 4; ++k) { topi[t * 4 + k] = idx[k]; topg[t * 4 + k] = ex[k] / sum; }
    }
}

__global__ __launch_bounds__(256) void nv_count(const int* topi, int* chcnt) {
    __shared__ int cnt[32];
    const int ch = blockIdx.x, tid = threadIdx.x;
    if (tid < 32) cnt[tid] = 0;
    __syncthreads();
    for (int i = tid; i < CHTOK * 4; i += 256) atomicAdd(&cnt[topi[ch * CHTOK * 4 + i]], 1);
    __syncthreads();
    if (tid < 32) chcnt[ch * 32 + tid] = cnt[tid];
}
__global__ __launch_bounds__(256) void nv_scatter(const int* topi, const int* chcnt, int* rowtok, int* tile_e) {
    __shared__ int total[32], before[32], padded[32], poff[33];
    __shared__ int ent[CHTOK * 4];
    const int ch = blockIdx.x, tid = threadIdx.x;
    if (tid < 32) { int tt = 0, bb = 0; for (int c = 0; c < NCHUNK; ++c) { const int v = chcnt[c * 32 + tid]; tt += v; if (c < ch) bb += v; }
        total[tid] = tt; before[tid] = bb; padded[tid] = (tt + 255) / 256 * 256; }
    for (int i = tid; i < CHTOK * 4; i += 256) ent[i] = topi[ch * CHTOK * 4 + i];
    __syncthreads();
    if (tid == 0) { int acc = 0; for (int e = 0; e < 32; ++e) { poff[e] = acc; acc += padded[e]; } poff[32] = acc; }
    __syncthreads();
    if (tid < 32) { int pos = poff[tid] + before[tid];
        for (int i = 0; i < CHTOK * 4; ++i) if (ent[i] == tid) rowtok[pos++] = ch * CHTOK * 4 + i; }
    if (ch == 0) {
        for (int e = 0; e < 32; ++e) for (int r = poff[e] + total[e] + tid; r < poff[e] + padded[e]; r += 256) rowtok[r] = -1;
        for (int e = 0; e < 32; ++e) for (int ti = poff[e] / 256 + tid; ti < (poff[e] + padded[e]) / 256; ti += 256) tile_e[ti] = e;
        if (tid == 0) tile_e[MAXTILES] = poff[32] / 256;
    }
}
__global__ __launch_bounds__(256) void nv_combine(float* out, const bf16_t* Y, const float* mod) {
    const int t = blockIdx.x, b = t / SEQ, tid = threadIdx.x;
#pragma unroll
    for (int i = 0; i < 4; ++i) { const int n = tid + 256 * i; const size_t o = (size_t)t * DM + n;
        const float sum = bf2f(Y[o]) + bf2f(Y[(size_t)NTOK * DM + o]) + bf2f(Y[(size_t)2 * NTOK * DM + o]);
        out[o] += mod[b * 6144 + 5 * 1024 + n] * sum; }
}

namespace gp {
#define GP_LAS __attribute__((address_space(3)))
typedef short bf16x8 __attribute__((ext_vector_type(8)));
typedef float f32x4 __attribute__((ext_vector_type(4)));
typedef unsigned u32x4 __attribute__((ext_vector_type(4)));
constexpr int BM = 256, BK = 64, HALF = 128, HTB = HALF * BK * 2  , STAGE_BYTES = 8 * HTB;

__host__ __device__ __forceinline__ int lds_byte(int r, int c) { const int st = (r >> 4) * 2 + (c >> 5), rr = r & 15, cc = c & 31, ob = rr * 64 + cc * 2; return st * 1024 + (ob ^ (((ob >> 9) & 1) << 5)); }
__host__ __device__ __forceinline__ void stage_rc(int b, int& R, int& C) { const int st = b / 1024, sb = b % 1024, swz = sb ^ (((sb >> 9) & 1) << 5); R = (st >> 1) * 16 + swz / 64; C = (st & 1) * 32 + (swz % 64) / 2; }
__host__ __device__ __forceinline__ int perm32(int rho) { const int n = rho >> 4, i = rho & 15; return 8 * (i >> 2) + 4 * n + (i & 3); }

struct Unit { int pm, pn, e; };
struct Gemm { const bf16_t* A; const bf16_t* Bt; int N, K; const int* rowsrc; };

struct StaticOrder {
    int nM, nN, nwg, G, c;
    __device__ void init(int M, int N, int G_, int c_) { nM = M / BM; nN = N / BM; nwg = nM * nN; G = G_; c = c_; }
    __device__ bool next(int i, Unit& u) const {
        const long L = (long)i * G + c; if (L >= nwg) return false;
        int wgid = (int)L; { const int q = nwg / 8, r = nwg % 8, xcd = wgid % 8, off = wgid / 8; wgid = (xcd < r ? xcd * (q + 1) : r * (q + 1) + (xcd - r) * q) + off; }
        const int nig = 8 * nN, gid = wgid / nig, fm = gid * 8, gsz = (nM - fm) < 8 ? (nM - fm) : 8;
        u.pm = fm + ((wgid % nig) % gsz); u.pn = (wgid % nig) / gsz; u.e = 0; return true;
    }
};
struct MoeOrder {
    const int* tile_e; int ntiles, nN, c, G;
    __device__ bool next(int i, Unit& u) const {
        const int j = c >> 3, x = c & 7, tpx = (G >> 3) / nN;
        const int tile = i * (tpx * 8) + x * tpx + j / nN;
        if (tile >= ntiles) return false;
        u.pm = tile; u.pn = j % nN; u.e = tile_e[tile]; return true;
    }
};

__device__ __forceinline__ unsigned cvt_pk_bf16(float lo, float hi) { unsigned r; asm volatile("v_cvt_pk_bf16_f32 %0, %1, %2" : "=v"(r) : "v"(lo), "v"(hi)); return r; }

struct EpiBf16 {
    bf16_t* O; int ldc;
    __device__ __forceinline__ void operator()(const f32x4 (&acc)[2][2][4][2], const Unit& u, int wr, int wc, int fr, int fq) const {
        const int row0 = u.pm * BM + wr * 64 + fr, col0 = u.pn * BM + wc * 32 + 8 * fq;
#pragma unroll
        for (int ai = 0; ai < 2; ++ai)
#pragma unroll
            for (int m = 0; m < 4; ++m) { bf16_t* rowp = O + (size_t)(row0 + ai * HALF + m * 16) * ldc + col0;
#pragma unroll
                for (int bj = 0; bj < 2; ++bj) { const f32x4 v0 = acc[ai][bj][m][0], v1 = acc[ai][bj][m][1];
                    u32x4 w; w.x = cvt_pk_bf16(v0[0], v0[1]); w.y = cvt_pk_bf16(v0[2], v0[3]); w.z = cvt_pk_bf16(v1[0], v1[1]); w.w = cvt_pk_bf16(v1[2], v1[3]);
                    *(u32x4*)(rowp + bj * HALF) = w; } }
    }
};

struct EpiInproj {
    bf16_t* O; const float* rope; GP_LAS const float* gl; GP_LAS float* xch; unsigned char* ikf;
    __device__ __forceinline__ void operator()(const f32x4 (&acc)[2][2][4][2], const Unit& u, int wr, int wc, int fr, int fq) const {
        const int wid = wr * 4 + wc, row0 = u.pm * BM + wr * 64 + fr, col0 = u.pn * BM + wc * 32 + 8 * fq, lc = (wc & 1) * 32 + 8 * fq;
        int mode[2]; int goff[2];
#pragma unroll
        for (int bj = 0; bj < 2; ++bj) { const int gc = u.pn * BM + bj * HALF + (wc >> 1) * 64; goff[bj] = 0;
            if (gc < 512) { mode[bj] = 1; goff[bj] = lc; } else if (gc < 1024) { mode[bj] = 1; goff[bj] = 64 + lc; } else if (gc < 1536) { mode[bj] = 0; }
            else if (gc < 2048) { mode[bj] = 1; goff[bj] = 128 + lc; } else if (gc < 2112) { mode[bj] = 1; goff[bj] = 192 + lc; }
            else if (gc < 2240) { mode[bj] = 3; goff[bj] = 256 + (gc - 2112) + lc; } else { mode[bj] = 2; } }
#pragma unroll
        for (int ai = 0; ai < 2; ++ai)
#pragma unroll
            for (int m = 0; m < 4; ++m)
#pragma unroll
                for (int bj = 0; bj < 2; ++bj) { const f32x4 a = acc[ai][bj][m][0], b = acc[ai][bj][m][1];
                    float s = ((a[0] * a[0] + a[1] * a[1]) + (a[2] * a[2] + a[3] * a[3])) + ((b[0] * b[0] + b[1] * b[1]) + (b[2] * b[2] + b[3] * b[3]));
                    s += __shfl_xor(s, 16); s += __shfl_xor(s, 32);
                    if (fq == 0) xch[(wid * 2 + bj) * 128 + ai * 64 + m * 16 + fr] = s; }
        asm volatile("s_waitcnt lgkmcnt(0)" ::: "memory"); __builtin_amdgcn_s_barrier(); asm volatile("" ::: "memory");
#pragma unroll
        for (int ai = 0; ai < 2; ++ai)
#pragma unroll
            for (int m = 0; m < 4; ++m) { int rl = ai * 64 + m * 16 + fr, row = row0 + ai * HALF + m * 16; asm volatile("" : "+v"(rl), "+v"(row)); const int pos = row % SEQ;
                bf16_t* rowp = O + (size_t)row * NPJ + col0;
#pragma unroll
                for (int bj = 0; bj < 2; ++bj) { f32x4 v0 = acc[ai][bj][m][0], v1 = acc[ai][bj][m][1];
                    if (mode[bj] == 1 || mode[bj] == 3) {
                        float tot = xch[(wid * 2 + bj) * 128 + rl] + xch[((wid ^ 1) * 2 + bj) * 128 + rl];
                        if (mode[bj] == 3) tot += xch[((wr * 4 + (wc ^ 2)) * 2 + (bj ^ 1)) * 128 + rl] + xch[((wr * 4 + (wc ^ 3)) * 2 + (bj ^ 1)) * 128 + rl];
                        const float r = 1.0f / sqrtf(tot * (mode[bj] == 3 ? (1.f / 128.f) : (1.f / 64.f)) + RMS_EPS);
                        const f32x4 g0 = *(GP_LAS const f32x4*)(gl + goff[bj]), g1 = *(GP_LAS const f32x4*)(gl + goff[bj] + 4);
                        v0 = v0 * r * g0; v1 = v1 * r * g1; }
                    if ((mode[bj] == 1 || mode[bj] == 2) && (wc & 1) == 0) {
                        f32x4 o0, o1;
#pragma unroll
                        for (int i = 0; i < 4; ++i) { o0[i] = __shfl_xor(v0[i], 16); o1[i] = __shfl_xor(v1[i], 16); }
                        if (fq < 2) { const float* rp = rope + pos * 16; const float sg = fq == 0 ? -1.0f : 1.0f;
                            const f32x4 t0 = *(const f32x4*)(rp), t1 = *(const f32x4*)(rp + 4), t2 = *(const f32x4*)(rp + 8), t3 = *(const f32x4*)(rp + 12);
                            v0[0] = v0[0] * t0[0] + sg * o0[0] * t0[1]; v0[1] = v0[1] * t0[2] + sg * o0[1] * t0[3];
                            v0[2] = v0[2] * t1[0] + sg * o0[2] * t1[1]; v0[3] = v0[3] * t1[2] + sg * o0[3] * t1[3];
                            v1[0] = v1[0] * t2[0] + sg * o1[0] * t2[1]; v1[1] = v1[1] * t2[2] + sg * o1[1] * t2[3];
                            v1[2] = v1[2] * t3[0] + sg * o1[2] * t3[1]; v1[3] = v1[3] * t3[2] + sg * o1[3] * t3[3]; } }
                    u32x4 w; w.x = cvt_pk_bf16(v0[0], v0[1]); w.y = cvt_pk_bf16(v0[2], v0[3]); w.z = cvt_pk_bf16(v1[0], v1[1]); w.w = cvt_pk_bf16(v1[2], v1[3]);
                    *(u32x4*)(rowp + bj * HALF) = w;
                    if (u.pn == 10 && bj == 1 && wc >= 2) {
                        const int key = row % SEQ, c8 = (wc & 1) * 4 + fq;
                        *(u32x4*)(ikf + ((size_t)((((row / SEQ) * 128 + (key >> 5)) * 4 + (c8 >> 1)) * 64 + (c8 & 1) * 32 + (key & 31)) << 4)) = w; } }
                asm volatile("" ::: "memory"); }
    }
};
struct EpiResid {
    const float* x; float* out; const float* mod;
    __device__ __forceinline__ void operator()(const f32x4 (&acc)[2][2][4][2], const Unit& u, int wr, int wc, int fr, int fq) const {
        const int row0 = u.pm * BM + wr * 64 + fr, col0 = u.pn * BM + wc * 32 + 8 * fq, b = (u.pm * BM) / SEQ;
        f32x4 gv[2][2];
#pragma unroll
        for (int bj = 0; bj < 2; ++bj)
#pragma unroll
            for (int n = 0; n < 2; ++n) gv[bj][n] = *(const f32x4*)(mod + b * 6144 + 2 * 1024 + col0 + bj * HALF + 4 * n);
#pragma unroll
        for (int ai = 0; ai < 2; ++ai)
#pragma unroll
            for (int m = 0; m < 4; ++m) { const size_t off = (size_t)(row0 + ai * HALF + m * 16) * DM + col0;
#pragma unroll
                for (int bj = 0; bj < 2; ++bj)
#pragma unroll
                    for (int n = 0; n < 2; ++n) { const f32x4 xv = *(const f32x4*)(x + off + bj * HALF + 4 * n);
                        *(f32x4*)(out + off + bj * HALF + 4 * n) = xv + gv[bj][n] * acc[ai][bj][m][n]; }
                asm volatile("" ::: "memory"); }
    }
};
struct EpiSwiglu {
    bf16_t* act; const float* bg; const float* bu;
    __device__ __forceinline__ void operator()(const f32x4 (&acc)[2][2][4][2], const Unit& u, int wr, int wc, int fr, int fq) const {
        const int row0 = u.pm * BM + wr * 64 + fr, ff0 = u.pn * HALF + wc * 32 + 8 * fq;
        f32x4 bgv[2], buv[2];
#pragma unroll
        for (int n = 0; n < 2; ++n) { bgv[n] = *(const f32x4*)(bg + u.e * 1024 + ff0 + 4 * n); buv[n] = *(const f32x4*)(bu + u.e * 1024 + ff0 + 4 * n); }
#pragma unroll
        for (int ai = 0; ai < 2; ++ai)
#pragma unroll
            for (int m = 0; m < 4; ++m) {
                float a[8];
#pragma unroll
                for (int n = 0; n < 2; ++n) { const f32x4 g4 = acc[ai][0][m][n] + bgv[n], u4 = acc[ai][1][m][n] + buv[n];
#pragma unroll
                    for (int j = 0; j < 4; ++j) { const float g = fminf(g4[j], 7.0f), uu = fminf(fmaxf(u4[j], -7.0f), 7.0f);
                        const float sg = __builtin_amdgcn_rcpf(1.0f + __builtin_amdgcn_exp2f(-1.702f * 1.4426950408889634f * g));
                        a[4 * n + j] = g * sg * (uu + 1.0f); } }
                u32x4 w; w.x = cvt_pk_bf16(a[0], a[1]); w.y = cvt_pk_bf16(a[2], a[3]); w.z = cvt_pk_bf16(a[4], a[5]); w.w = cvt_pk_bf16(a[6], a[7]);
                *(u32x4*)(act + (size_t)(row0 + ai * HALF + m * 16) * 1024 + ff0) = w; }
    }
};
struct EpiDown {
    float* out; bf16_t* Y; const float* bd; const float* mod; const int* rowtok; const float* topg;
    __device__ __forceinline__ void operator()(const f32x4 (&acc)[2][2][4][2], const Unit& u, int wr, int wc, int fr, int fq) const {
        const int row0 = u.pm * BM + wr * 64 + fr, col0 = u.pn * BM + wc * 32 + 8 * fq;
        f32x4 bv[2][2];
#pragma unroll
        for (int bj = 0; bj < 2; ++bj)
#pragma unroll
            for (int n = 0; n < 2; ++n) bv[bj][n] = *(const f32x4*)(bd + u.e * 1024 + col0 + bj * HALF + 4 * n);
#pragma unroll
        for (int ai = 0; ai < 2; ++ai)
#pragma unroll
            for (int m = 0; m < 4; ++m) {
                const int ent = rowtok[row0 + ai * HALF + m * 16];
                if (ent >= 0) {
                    const int tok = ent >> 2, kk = ent & 3; const float gt = topg[ent];
                    if (kk == 0) { const float* g2 = mod + (tok / SEQ) * 6144 + 5 * 1024 + col0; float* op = out + (size_t)tok * DM + col0;
#pragma unroll
                        for (int bj = 0; bj < 2; ++bj)
#pragma unroll
                            for (int n = 0; n < 2; ++n) { const f32x4 g4 = *(const f32x4*)(g2 + bj * HALF + 4 * n), o4 = *(const f32x4*)(op + bj * HALF + 4 * n);
                                *(f32x4*)(op + bj * HALF + 4 * n) = o4 + g4 * ((acc[ai][bj][m][n] + bv[bj][n]) * gt); }
                    } else { bf16_t* yp = Y + ((size_t)(kk - 1) * NTOK + tok) * DM + col0;
#pragma unroll
                        for (int bj = 0; bj < 2; ++bj) { const f32x4 v0 = (acc[ai][bj][m][0] + bv[bj][0]) * gt, v1 = (acc[ai][bj][m][1] + bv[bj][1]) * gt;
                            u32x4 w; w.x = cvt_pk_bf16(v0[0], v0[1]); w.y = cvt_pk_bf16(v0[2], v0[3]); w.z = cvt_pk_bf16(v1[0], v1[1]); w.w = cvt_pk_bf16(v1[2], v1[3]);
                            *(u32x4*)(yp + bj * HALF) = w; } }
                }
                asm volatile("" ::: "memory"); }
    }
};

template <class Epi, class Sched, bool GATHER>
__device__ __forceinline__ void gemm_phase(GP_LAS unsigned char* lds, const Gemm g, const Sched& S, const Epi& E) {
    const int tid = threadIdx.x, wid = __builtin_amdgcn_readfirstlane(tid >> 6), lane = tid & 63, wr = wid >> 2, wc = wid & 3, fr = lane & 15, fq = lane >> 4;
    const int K = g.K, nt = K / BK;
    unsigned voffB[2];
#pragma unroll
    for (int i = 0; i < 2; ++i) { int R, C; stage_rc(tid * 16 + i * 8192, R, C); const int Rb = (R & ~31) + perm32(R & 31); voffB[i] = (unsigned)(Rb * K + C) * 2u; }
    const size_t kstep = (size_t)(BK * 2);
    const size_t hstep = (size_t)HALF * K * 2;
    const size_t tstep = 2 * hstep;
    const unsigned ldsw = (unsigned)wid * 1024u;
    const int aoff = lds_byte(wr * 64 + fr, fq * 8), boff = lds_byte(wc * 32 + fr, fq * 8);
#define GP_SA(b, h) (((b) * 2 + (h)) * HTB)
#define GP_SB(b, h) ((4 + (b) * 2 + (h)) * HTB)
#define GP_STAGE(bufoff, gbase, voff) do { _Pragma("unroll") for (int _i = 0; _i < 2; ++_i) \
        __builtin_amdgcn_global_load_lds((const unsigned*)((const char*)(gbase) + (voff)[_i]), (GP_LAS unsigned*)(lds + (bufoff) + ldsw + _i * 8192), 16, 0, 0); } while (0)
#define GP_LDA(dst, b, h) do { _Pragma("unroll") for (int m = 0; m < 4; ++m) _Pragma("unroll") for (int k = 0; k < 2; ++k) dst[m][k] = *(const GP_LAS bf16x8*)(lds + GP_SA(b, h) + aoff + m * 2048 + k * 1024); } while (0)
#define GP_LDB(dst, b, h) do { _Pragma("unroll") for (int n = 0; n < 2; ++n) _Pragma("unroll") for (int k = 0; k < 2; ++k) dst[n][k] = *(const GP_LAS bf16x8*)(lds + GP_SB(b, h) + boff + n * 2048 + k * 1024); } while (0)
#define GP_MMA(ai, bj, At, Bt) do { __builtin_amdgcn_s_setprio(1); _Pragma("unroll") for (int m = 0; m < 4; ++m) _Pragma("unroll") for (int n = 0; n < 2; ++n) _Pragma("unroll") for (int k = 0; k < 2; ++k) \
        acc[ai][bj][m][n] = __builtin_amdgcn_mfma_f32_16x16x32_bf16(Bt[n][k], At[m][k], acc[ai][bj][m][n], 0, 0, 0); __builtin_amdgcn_s_setprio(0); } while (0)
#define GP_WAIT_V(n) asm volatile("s_waitcnt vmcnt(" #n ")" ::: "memory")
#define GP_WAIT_L(n) asm volatile("s_waitcnt lgkmcnt(" #n ")" ::: "memory")
#define GP_BAR __builtin_amdgcn_s_barrier()
#define GP_SCHED __builtin_amdgcn_sched_barrier(0)
#define GP_AOFFS(u_, v0_, v1_) do { _Pragma("unroll") for (int _i = 0; _i < 2; ++_i) { int R_, C_; stage_rc(tid * 16 + _i * 8192, R_, C_); int r0_ = (u_).pm * BM + R_, r1_ = r0_ + HALF; \
        if (GATHER) { r0_ = g.rowsrc[r0_]; r1_ = g.rowsrc[r1_]; } \
        v0_[_i] = (unsigned)(r0_ * K + C_) * 2u; v1_[_i] = (unsigned)(r1_ * K + C_) * 2u; } } while (0)
    Unit cur, nxt; int ui = 0;
    if (!S.next(0, cur)) return;
    f32x4 acc[2][2][4][2];
#pragma unroll
    for (int a = 0; a < 2; ++a)
#pragma unroll
        for (int b = 0; b < 2; ++b)
#pragma unroll
            for (int m = 0; m < 4; ++m)
#pragma unroll
                for (int n = 0; n < 2; ++n) acc[a][b][m][n] = (f32x4){0.f, 0.f, 0.f, 0.f};
    bf16x8 At[4][2], B0[2][2], B1[2][2];
    unsigned vA0[2], vA1[2], nA0[2], nA1[2];
    GP_AOFFS(cur, vA0, vA1);
    const char* Ab = (const char*)g.A;
    const char* cB = (const char*)g.Bt + ((size_t)cur.e * g.N + (size_t)cur.pn * BM) * K * 2;
    GP_STAGE(GP_SB(0, 0), cB, voffB); GP_STAGE(GP_SB(0, 1), cB + hstep, voffB); GP_STAGE(GP_SA(0, 0), Ab, vA0); GP_STAGE(GP_SA(0, 1), Ab, vA1);
    if (wr == 1) GP_BAR;
    GP_WAIT_V(2); GP_BAR;
    GP_STAGE(GP_SB(1, 0), cB + kstep, voffB); GP_STAGE(GP_SA(1, 0), Ab + kstep, vA0); GP_STAGE(GP_SB(1, 1), cB + hstep + kstep, voffB);
    GP_WAIT_V(6); GP_BAR;
    for (;;) {
        const bool has_next = S.next(ui + 1, nxt);
        const char* nB = cB;
        if (has_next) { nB = (const char*)g.Bt + ((size_t)nxt.e * g.N + (size_t)nxt.pn * BM) * K * 2; GP_AOFFS(nxt, nA0, nA1); }
        else { nA0[0] = vA0[0]; nA0[1] = vA0[1]; nA1[0] = vA1[0]; nA1[1] = vA1[1]; }
        for (int t = 0; t < nt; t += 2) {
            const bool last = (t == nt - 2);
            const char* a1 = Ab + (size_t)(t + 1) * kstep;
            const char* a2 = last ? Ab : Ab + (size_t)(t + 2) * kstep; const char* b2 = last ? nB : cB + (size_t)(t + 2) * kstep;
            const char* a3 = a2 + kstep; const char* b3 = b2 + kstep;
            GP_LDB(B0, 0, 0); GP_LDB(B1, 0, 1); GP_SCHED; GP_LDA(At, 0, 0); GP_STAGE(GP_SA(1, 1), a1, vA1);
            if (last) { vA0[0] = nA0[0]; vA0[1] = nA0[1]; vA1[0] = nA1[0]; vA1[1] = nA1[1]; }
            GP_WAIT_V(8); GP_WAIT_L(0); GP_BAR; GP_MMA(0, 0, At, B0); GP_MMA(0, 1, At, B1); GP_BAR; GP_SCHED;
            GP_LDA(At, 0, 1); GP_STAGE(GP_SB(0, 0), b2, voffB); GP_STAGE(GP_SB(0, 1), b2 + hstep, voffB); GP_STAGE(GP_SA(0, 0), a2, vA0);
            GP_WAIT_V(8); GP_WAIT_L(0); GP_BAR; GP_MMA(1, 0, At, B0); GP_MMA(1, 1, At, B1); GP_BAR; GP_SCHED;
            GP_LDB(B0, 1, 0); GP_LDB(B1, 1, 1); GP_SCHED; GP_LDA(At, 1, 0); GP_STAGE(GP_SA(0, 1), a2, vA1);
            GP_WAIT_V(8); GP_WAIT_L(0); GP_BAR; GP_MMA(0, 0, At, B0); GP_MMA(0, 1, At, B1); GP_BAR; GP_SCHED;
            GP_LDA(At, 1, 1); GP_STAGE(GP_SB(1, 0), b3, voffB); GP_STAGE(GP_SB(1, 1), b3 + hstep, voffB); GP_STAGE(GP_SA(1, 0), a3, vA0);
            GP_WAIT_V(8); GP_WAIT_L(0); GP_BAR; GP_MMA(1, 0, At, B0); GP_MMA(1, 1, At, B1); GP_BAR; GP_SCHED;
        }
        if (wr == 0) GP_BAR;
        E(acc, cur, wr, wc, fr, fq);
        if (!has_next) break;
#pragma unroll
        for (int a = 0; a < 2; ++a)
#pragma unroll
            for (int b = 0; b < 2; ++b)
#pragma unroll
                for (int m = 0; m < 4; ++m)
#pragma unroll
                    for (int n = 0; n < 2; ++n) acc[a][b][m][n] = (f32x4){0.f, 0.f, 0.f, 0.f};
        cur = nxt; cB = nB; ++ui;
        if (wr == 1) GP_BAR;
    }
    GP_WAIT_V(0);
    GP_BAR;
#undef GP_SA
#undef GP_SB
#undef GP_STAGE
#undef GP_LDA
#undef GP_LDB
#undef GP_MMA
#undef GP_WAIT_V
#undef GP_WAIT_L
#undef GP_BAR
#undef GP_SCHED
#undef GP_AOFFS
}
}
#include <hip/hip_cooperative_groups.h>
namespace cg = cooperative_groups;
#define LAS __attribute__((address_space(3)))
typedef float f32x4 __attribute__((ext_vector_type(4)));
typedef unsigned u32x4 __attribute__((ext_vector_type(4)));
typedef short bf16x8 __attribute__((ext_vector_type(8)));
constexpr int NWAVES = 8, NTHREADS = 512;
constexpr int LDS_RING = 131072;
constexpr int LDS_MISC = 159744;
constexpr int LDS_BYTES = 159744 + 256;

struct Params {
    const float* in[24];
    float* out; unsigned char* ws;
    int ph_lo, ph_hi;
};
__device__ __forceinline__ unsigned pk2(float lo, float hi) { return (unsigned)f2bf(lo) | ((unsigned)f2bf(hi) << 16); }
__device__ __forceinline__ float wave_sum(float v) {
#pragma unroll
    for (int o = 1; o < 64; o <<= 1) v += __shfl_xor(v, o);
    return v;
}

__device__ __forceinline__ void p0_transpose(const float* W, int ld, int k0, int n0, bf16_t* WT, int row0, int Kdst, LAS float* scr, int lane) {
    f32x4 v[8];
#pragma unroll
    for (int i = 0; i < 8; ++i) v[i] = *(const f32x4*)(W + (size_t)(k0 + 8 * i + (lane >> 3)) * ld + n0 + 4 * (lane & 7));
#pragma unroll
    for (int i = 0; i < 8; ++i) { LAS float* d = scr + (8 * i + (lane >> 3)) * 33 + 4 * (lane & 7); d[0] = v[i][0]; d[1] = v[i][1]; d[2] = v[i][2]; d[3] = v[i][3]; }
    asm volatile("s_waitcnt lgkmcnt(0)" ::: "memory");
    const int c = lane & 7;
#pragma unroll
    for (int j = 0; j < 4; ++j) { const int n = (lane >> 3) + 8 * j; const LAS float* s = scr + (8 * c) * 33 + n;
        u32x4 o; o.x = pk2(s[0 * 33], s[1 * 33]); o.y = pk2(s[2 * 33], s[3 * 33]); o.z = pk2(s[4 * 33], s[5 * 33]); o.w = pk2(s[6 * 33], s[7 * 33]);
        *(u32x4*)(WT + (size_t)(row0 + n) * Kdst + k0 + 8 * c) = o; }
    asm volatile("s_waitcnt lgkmcnt(0)" ::: "memory");
}
__device__ __forceinline__ void phase_prep(const Params& p, LAS unsigned char* lds, int tid, int lane, int wave) {
    unsigned char* ws = p.ws;
    {
        LAS float* sc = (LAS float*)lds;
        LAS float* part = (LAS float*)(lds + 32768);
        const float* c = p.in[1]; const float* w_ada = p.in[4]; const float* b_ada = p.in[5];
        for (int i = tid; i < 8192; i += NTHREADS) { const float v = c[i]; sc[i] = v / (1.f + __expf(-v)); }
        __syncthreads();
        for (int cb = blockIdx.x; cb < 256; cb += gridDim.x) {
            const int half = lane >> 5, cl = lane & 31;
            float acc[8];
#pragma unroll
            for (int b = 0; b < 8; ++b) acc[b] = 0.f;
            if (cl < 24) {
                for (int it = 0; it < 64; ++it) { const int k = 128 * wave + 2 * it + half; const float wv = w_ada[(size_t)k * 6144 + 24 * cb + cl];
#pragma unroll
                    for (int b = 0; b < 8; ++b) acc[b] += sc[b * 1024 + k] * wv; }
#pragma unroll
                for (int b = 0; b < 8; ++b) part[((wave * 2 + half) * 8 + b) * 24 + cl] = acc[b];
            }
            __syncthreads();
            if (tid < 192) { const int b = tid / 24, cc = tid % 24; float s = 0.f;
                for (int q = 0; q < 16; ++q) s += part[(q * 8 + b) * 24 + cc];
                ((float*)(ws + WS_MOD))[b * 6144 + 24 * cb + cc] = s + b_ada[24 * cb + cc]; }
            __syncthreads();
        }
    }
    {
        float* rope = (float*)(ws + WS_ROPE);
        for (int i = blockIdx.x * NTHREADS + tid; i < SEQ * 8; i += gridDim.x * NTHREADS) {
            const int pos = i >> 3, f = i & 7;
            const float inv = (float)exp(-(double)f / 8.0 * log(500000.0));
            const float ang = (float)pos * inv;
            const double TWO_PI = 6.283185307179586476925287;
            const double a = (double)ang, r = a - rint(a / TWO_PI) * TWO_PI, r2 = r * r;
            double s = 0.0, c = 0.0, ts = r, tc = 1.0;
            for (int n = 0; n < 14; ++n) { s += ts; c += tc; ts *= -r2 / (double)((2 * n + 2) * (2 * n + 3)); tc *= -r2 / (double)((2 * n + 1) * (2 * n + 2)); }
            rope[i * 2 + 0] = (float)c; rope[i * 2 + 1] = (float)s;
        }
        if (blockIdx.x == 0 && tid == 0) { const float* al = p.in[10]; float d01 = 0.f, d23 = 0.f;
            for (int j = 0; j < 64; ++j) { d01 += al[j] * al[64 + j]; d23 += al[128 + j] * al[192 + j]; }
            ((float*)(ws + WS_LAM))[0] = expf(d01) - expf(d23) + LAMBDA_INIT; }
    }
    __syncthreads();
    {
        LAS float* scr = (LAS float*)(lds + wave * 8704);
        const int gw = blockIdx.x * NWAVES + wave, NGW = gridDim.x * NWAVES;
        constexpr int I_IN = 16 * 88, I_OUT = 16 * 32, I_UV = 32, I_EXP = 32 * 3 * 512, NITEMS = I_IN + I_OUT + I_UV + I_EXP;
        for (int it = gw; it < NITEMS; it += NGW) {
            int r = it;
            if (r < I_IN) { p0_transpose(p.in[6], NIN, 64 * (r / 88), 32 * (r % 88), (bf16_t*)(ws + WS_WINT), 32 * (r % 88), 1024, scr, lane); continue; } r -= I_IN;
            if (r < I_OUT) { p0_transpose(p.in[7], 1024, 64 * (r / 32), 32 * (r % 32), (bf16_t*)(ws + WS_WOUTT), 32 * (r % 32), 1024, scr, lane); continue; } r -= I_OUT;
            if (r < I_UV) { const int h = r >> 2, rr = r & 3; p0_transpose(p.in[15] + h * 128 * 64, 64, 64 * (rr >> 1), 32 * (rr & 1), (bf16_t*)(ws + WS_WUVT) + h * 64 * 128, 32 * (rr & 1), 128, scr, lane); continue; } r -= I_UV;
            const int e = r / 1536, q = r % 1536, mat = q / 512, i2 = q % 512, kb = i2 / 32, nb = i2 % 32, n0 = 32 * nb;
            if (mat == 2) p0_transpose(p.in[22] + (size_t)e * 1048576, 1024, 64 * kb, n0, (bf16_t*)(ws + WS_WDT) + (size_t)e * 1048576, n0, 1024, scr, lane);
            else p0_transpose(p.in[mat == 0 ? 18 : 20] + (size_t)e * 1048576, 1024, 64 * kb, n0, (bf16_t*)(ws + WS_WGUT) + (size_t)e * 2097152, 256 * (n0 >> 7) + (n0 & 127) + (mat == 1 ? 128 : 0), 1024, scr, lane);
        }
    }
}

__device__ __forceinline__ void phase_norm1(const Params& p, LAS unsigned char* lds, int tid, int lane, int wave) {
    unsigned char* ws = p.ws;
    const float* x = p.in[0]; const float* g = p.in[2]; const float* w_in = p.in[6]; const float* mod = (const float*)(ws + WS_MOD);
    bf16_t* H = (bf16_t*)(ws + WS_H); float* IW = (float*)(ws + WS_IW);
    LAS float* wiw = (LAS float*)lds;
    for (int i = tid; i < 8192; i += NTHREADS) wiw[i] = w_in[(size_t)(i >> 3) * NIN + C_IW + (i & 7)];
    __syncthreads();
    const int gw = blockIdx.x * NWAVES + wave, NGW = gridDim.x * NWAVES;
    f32x4 gv[4];
#pragma unroll
    for (int j = 0; j < 4; ++j) gv[j] = *(const f32x4*)(g + 4 * (lane + 64 * j));
    f32x4 vn[4];
#pragma unroll
    for (int j = 0; j < 4; ++j) vn[j] = *(const f32x4*)(x + (size_t)(gw < NTOK ? gw : 0) * DM + 4 * (lane + 64 * j));
    for (int t = gw; t < NTOK; t += NGW) {
        const int b = t / SEQ; const float* sh = mod + b * 6144, * sc = sh + 1024;
        f32x4 v[4]; float ss = 0.f;
#pragma unroll
        for (int j = 0; j < 4; ++j) { v[j] = vn[j]; ss += (v[j].x * v[j].x + v[j].y * v[j].y) + (v[j].z * v[j].z + v[j].w * v[j].w); }
        if (t + NGW < NTOK) {
#pragma unroll
            for (int j = 0; j < 4; ++j) vn[j] = *(const f32x4*)(x + (size_t)(t + NGW) * DM + 4 * (lane + 64 * j)); }
        const float r = 1.0f / sqrtf(wave_sum(ss) * (1.f / DM) + RMS_EPS);
        float iw[8];
#pragma unroll
        for (int q = 0; q < 8; ++q) iw[q] = 0.f;
#pragma unroll
        for (int j = 0; j < 4; ++j) { const int k0 = 4 * (lane + 64 * j);
            const f32x4 s4 = *(const f32x4*)(sc + k0), h4 = *(const f32x4*)(sh + k0);
            f32x4 hv = (v[j] * r * gv[j]) * (s4 + 1.0f) + h4;
            *(uint2*)(H + (size_t)t * DM + k0) = make_uint2(pk2(hv.x, hv.y), pk2(hv.z, hv.w));
#pragma unroll
            for (int i = 0; i < 4; ++i) { const f32x4 w0 = *(const LAS f32x4*)(wiw + (k0 + i) * 8), w1 = *(const LAS f32x4*)(wiw + (k0 + i) * 8 + 4);
                iw[0] += hv[i] * w0.x; iw[1] += hv[i] * w0.y; iw[2] += hv[i] * w0.z; iw[3] += hv[i] * w0.w;
                iw[4] += hv[i] * w1.x; iw[5] += hv[i] * w1.y; iw[6] += hv[i] * w1.z; iw[7] += hv[i] * w1.w; } }
#pragma unroll
        for (int i = 0; i < 4; ++i) { const bool up = (lane & 32) != 0; const float snd = up ? iw[i] : iw[i + 4], kp = up ? iw[i + 4] : iw[i]; iw[i] = kp + __shfl_xor(snd, 32); }
#pragma unroll
        for (int i = 0; i < 2; ++i) { const bool up = (lane & 16) != 0; const float snd = up ? iw[i] : iw[i + 2], kp = up ? iw[i + 2] : iw[i]; iw[i] = kp + __shfl_xor(snd, 16); }
        { const bool up = (lane & 8) != 0; const float snd = up ? iw[0] : iw[1], kp = up ? iw[1] : iw[0]; iw[0] = kp + __shfl_xor(snd, 8); }
        { float r8 = iw[0]; r8 += __shfl_xor(r8, 4); r8 += __shfl_xor(r8, 2); r8 += __shfl_xor(r8, 1);
          if ((lane & 7) == 0) IW[(size_t)t * 8 + (lane >> 3)] = r8 * 0.04419417382415922f; }
    }
}


__device__ __forceinline__ void router_tail(float (&pe)[32], const float* rb, int lane, int t, int* topi, float* topg, LAS int* cnt) {
#pragma unroll
    for (int i = 0; i < 8; ++i) { const bool up = (lane & 16) != 0; const float snd = up ? pe[i] : pe[i + 8], kp = up ? pe[i + 8] : pe[i]; pe[i] = kp + __shfl_xor(snd, 16); }
#pragma unroll
    for (int i = 0; i < 4; ++i) { const bool up = (lane & 8) != 0; const float snd = up ? pe[i] : pe[i + 4], kp = up ? pe[i + 4] : pe[i]; pe[i] = kp + __shfl_xor(snd, 8); }
#pragma unroll
    for (int i = 0; i < 2; ++i) { const bool up = (lane & 4) != 0; const float snd = up ? pe[i] : pe[i + 2], kp = up ? pe[i + 2] : pe[i]; pe[i] = kp + __shfl_xor(snd, 4); }
    { const bool up = (lane & 2) != 0; const float snd = up ? pe[0] : pe[1], kp = up ? pe[1] : pe[0]; pe[0] = kp + __shfl_xor(snd, 2); }
    const int myE = lane >> 1;
    float lv = pe[0] + __shfl_xor(pe[0], 1) + rb[myE];
    int idx[4]; float val[4];
#pragma unroll
    for (int k = 0; k < 4; ++k) { float m = lv;
#pragma unroll
        for (int o = 1; o < 64; o <<= 1) m = fmaxf(m, __shfl_xor(m, o));
        const unsigned long long bm = __ballot(lv == m);
        const int e = __builtin_ctzll(bm) >> 1;
        idx[k] = e; val[k] = m; if (myE == e) lv = -INFINITY; }
    if (lane == 0) {
        float ex[4], sum = 0.f;
#pragma unroll
        for (int k = 0; k < 4; ++k) { ex[k] = __expf(val[k] - val[0]); sum += ex[k]; }
        const float inv = 1.f / sum;
        *(int4*)(topi + t * 4) = make_int4(idx[0], idx[1], idx[2], idx[3]);
        *(f32x4*)(topg + t * 4) = (f32x4){ex[0] * inv, ex[1] * inv, ex[2] * inv, ex[3] * inv};
#pragma unroll
        for (int k = 0; k < 4; ++k) atomicAdd((int*)&cnt[idx[k]], 1);
    }
}
__device__ __forceinline__ void phase_norm2(const Params& p, LAS unsigned char* lds, int tid, int lane, int wave) {
    unsigned char* ws = p.ws;
    const float* x1 = p.out; const float* g = p.in[3]; const float* rw = p.in[16]; const float* rb = p.in[17]; const float* mod = (const float*)(ws + WS_MOD);
    bf16_t* H = (bf16_t*)(ws + WS_H); int* topi = (int*)(ws + WS_TOPI); float* topg = (float*)(ws + WS_TOPG); int* chcnt = (int*)(ws + WS_CHCNT);
    LAS float* rwl = (LAS float*)lds;
    for (int i = tid; i < 32768; i += NTHREADS) { const int k = i >> 5, e = i & 31; rwl[e * 1028 + k] = rw[i]; }
    LAS int* cnt = (LAS int*)(lds + 32 * 1028 * 4);
    LAS float* lg = (LAS float*)(lds + 32 * 1028 * 4 + 128) + wave * 32;
    __syncthreads();
    for (int ch = blockIdx.x; ch < NCHUNK; ch += gridDim.x) {
        if (tid < 32) cnt[tid] = 0;
        __syncthreads();
        for (int rr = 0; rr < 16; rr += 2) {
            const int t0r = ch * CHTOK + wave * 16 + rr, b = t0r / SEQ; const float* sh = mod + b * 6144 + 3 * 1024, * sc = sh + 1024;
            f32x4 hv0[4], hv1[4];
#define N2_ROW(HV, T_) do { f32x4 v[4]; float ss = 0.f; \
                _Pragma("unroll") for (int j = 0; j < 4; ++j) { v[j] = *(const f32x4*)(x1 + (size_t)(T_) * DM + 4 * (lane + 64 * j)); ss += (v[j].x * v[j].x + v[j].y * v[j].y) + (v[j].z * v[j].z + v[j].w * v[j].w); } \
                const float r = 1.0f / sqrtf(wave_sum(ss) * (1.f / DM) + RMS_EPS); \
                _Pragma("unroll") for (int j = 0; j < 4; ++j) { const int k0 = 4 * (lane + 64 * j); \
                    const f32x4 s4 = *(const f32x4*)(sc + k0), h4 = *(const f32x4*)(sh + k0); \
                    HV[j] = (v[j] * r * *(const f32x4*)(g + k0)) * (s4 + 1.0f) + h4; \
                    *(uint2*)(H + (size_t)(T_) * DM + k0) = make_uint2(pk2(HV[j].x, HV[j].y), pk2(HV[j].z, HV[j].w)); } } while (0)
            N2_ROW(hv0, t0r); N2_ROW(hv1, t0r + 1);
#undef N2_ROW
            float pe0[32], pe1[32];
#pragma unroll
            for (int i = 0; i < 16; ++i) { float a0 = 0.f, a1 = 0.f, b0 = 0.f, b1 = 0.f;
#pragma unroll
                for (int j = 0; j < 4; ++j) { const f32x4 wa = *(const LAS f32x4*)(rwl + i * 1028 + 4 * (lane + 64 * j)), wb = *(const LAS f32x4*)(rwl + (i + 16) * 1028 + 4 * (lane + 64 * j));
                    a0 += (hv0[j].x * wa.x + hv0[j].y * wa.y) + (hv0[j].z * wa.z + hv0[j].w * wa.w); a1 += (hv1[j].x * wa.x + hv1[j].y * wa.y) + (hv1[j].z * wa.z + hv1[j].w * wa.w);
                    b0 += (hv0[j].x * wb.x + hv0[j].y * wb.y) + (hv0[j].z * wb.z + hv0[j].w * wb.w); b1 += (hv1[j].x * wb.x + hv1[j].y * wb.y) + (hv1[j].z * wb.z + hv1[j].w * wb.w); }
                const bool up = (lane & 32) != 0;
                pe0[i] = (up ? b0 : a0) + __shfl_xor(up ? a0 : b0, 32); pe1[i] = (up ? b1 : a1) + __shfl_xor(up ? a1 : b1, 32);
                asm volatile("" ::: "memory"); }
            router_tail(pe0, rb, lane, t0r, topi, topg, cnt);
            router_tail(pe1, rb, lane, t0r + 1, topi, topg, cnt);
        }
        __syncthreads();
        if (tid < 32) chcnt[ch * 32 + tid] = cnt[tid];
        __syncthreads();
    }
}

__device__ __forceinline__ void phase_scatter(const Params& p, LAS unsigned char* lds, int tid, int lane, int wave) {
    unsigned char* ws = p.ws;
    const int* topi = (const int*)(ws + WS_TOPI); const int* chcnt = (const int*)(ws + WS_CHCNT);
    int* rowtok = (int*)(ws + WS_ROWTOK); int* rowsrc = (int*)(ws + WS_ROWSRC); int* tile_e = (int*)(ws + WS_TILEE);
    LAS int* total = (LAS int*)lds; LAS int* before = total + 32; LAS int* padded = total + 64; LAS int* poff = total + 96; LAS int* ent = total + 160; LAS int* psum = total + 1024;
    for (int ch = blockIdx.x; ch < NCHUNK; ch += gridDim.x) {
        { const int e = tid & 31, part = tid >> 5; int tt = 0, bb = 0;
#pragma unroll
          for (int q = 0; q < 16; ++q) { const int c = part * 16 + q; const int v = chcnt[c * 32 + e]; tt += v; bb += (c < ch) ? v : 0; }
          psum[tid] = tt; psum[512 + tid] = bb; }
        { const int i = tid; ent[i] = topi[ch * CHTOK * 4 + i]; }
        __syncthreads();
        if (tid < 32) { int tt = 0, bb = 0;
#pragma unroll
            for (int q = 0; q < 16; ++q) { tt += psum[q * 32 + tid]; bb += psum[512 + q * 32 + tid]; }
            total[tid] = tt; before[tid] = bb; padded[tid] = (tt + 255) / 256 * 256; }
        __syncthreads();
        if (tid == 0) { int a = 0; for (int e = 0; e < 32; ++e) { poff[e] = a; a += padded[e]; } poff[32] = a; }
        __syncthreads();
        if (tid < 32) { int pos = poff[tid] + before[tid];
            for (int i = 0; i < CHTOK * 4; ++i) if (ent[i] == tid) { const int en = ch * CHTOK * 4 + i; rowtok[pos] = en; rowsrc[pos] = en >> 2; ++pos; } }
        if (ch == 0) {
            for (int e = 0; e < 32; ++e) for (int r = poff[e] + total[e] + tid; r < poff[e] + padded[e]; r += NTHREADS) { rowtok[r] = -1; rowsrc[r] = 0; }
            for (int e = 0; e < 32; ++e) for (int ti = poff[e] / 256 + tid; ti < (poff[e] + padded[e]) / 256; ti += NTHREADS) tile_e[ti] = e;
            if (tid == 0) tile_e[MAXTILES] = poff[32] / 256;
        }
        __syncthreads();
    }
}

__device__ __forceinline__ void phase_combine(const Params& p, int tid) {
    unsigned char* ws = p.ws; float* out = p.out; const bf16_t* Y = (const bf16_t*)(ws + WS_Y); const float* mod = (const float*)(ws + WS_MOD);
    const size_t nvec = (size_t)NTOK * DM / 8;
#pragma unroll 4
    for (size_t i = (size_t)blockIdx.x * NTHREADS + tid; i < nvec; i += (size_t)gridDim.x * NTHREADS) {
        const size_t o = i * 8; const int t = (int)(o / DM), n = (int)(o % DM), b = t / SEQ;
        const u32x4 a = *(const u32x4*)(Y + o), c = *(const u32x4*)(Y + (size_t)NTOK * DM + o), d = *(const u32x4*)(Y + (size_t)2 * NTOK * DM + o);
        const float* g2 = mod + b * 6144 + 5 * 1024 + n;
        f32x4 o0 = *(const f32x4*)(out + o), o1 = *(const f32x4*)(out + o + 4);
        const f32x4 g0 = *(const f32x4*)g2, g1 = *(const f32x4*)(g2 + 4);
#define LO(u) __uint_as_float((u) << 16)
#define HI(u) __uint_as_float((u) & 0xffff0000u)
        o0.x += g0.x * (LO(a.x) + LO(c.x) + LO(d.x)); o0.y += g0.y * (HI(a.x) + HI(c.x) + HI(d.x));
        o0.z += g0.z * (LO(a.y) + LO(c.y) + LO(d.y)); o0.w += g0.w * (HI(a.y) + HI(c.y) + HI(d.y));
        o1.x += g1.x * (LO(a.z) + LO(c.z) + LO(d.z)); o1.y += g1.y * (HI(a.z) + HI(c.z) + HI(d.z));
        o1.z += g1.z * (LO(a.w) + LO(c.w) + LO(d.w)); o1.w += g1.w * (HI(a.w) + HI(c.w) + HI(d.w));
#undef LO
#undef HI
        *(f32x4*)(out + o) = o0; *(f32x4*)(out + o + 4) = o1;
    }
}

__device__ __forceinline__ float wg_sum(float v, LAS float* red, int tid) {
    v = wave_sum(v);
    __syncthreads();
    if ((tid & 63) == 0) red[tid >> 6] = v;
    __syncthreads();
    float s = 0.f;
#pragma unroll
    for (int i = 0; i < 8; ++i) s += red[i];
    return s;
}
__device__ __forceinline__ float wg_max(float v, LAS float* red, int tid) {
#pragma unroll
    for (int o = 1; o < 64; o <<= 1) v = fmaxf(v, __shfl_xor(v, o));
    __syncthreads();
    if ((tid & 63) == 0) red[tid >> 6] = v;
    __syncthreads();
    float s = red[0];
#pragma unroll
    for (int i = 1; i < 8; ++i) s = fmaxf(s, red[i]);
    return s;
}
__device__ __forceinline__ void phase_post_slow(const Params& p, int tid) {
    unsigned char* ws = p.ws; bf16_t* PROJ = (bf16_t*)(ws + WS_PROJ); const float* rope = (const float*)(ws + WS_ROPE);
    const long total = (long)NTOK * 44;
    for (long it = (long)blockIdx.x * NTHREADS + tid; it < total; it += (long)gridDim.x * NTHREADS) {
        const int t = (int)(it / 44), gidx = (int)(it % 44), pos = t % SEQ, c0 = gidx * 64;
        bf16_t* row = PROJ + (size_t)t * NPJ;
        bool donorm = false, dorope = false; const float* gg = nullptr;
        if (c0 < 512) { donorm = true; dorope = true; gg = p.in[8]; }
        else if (c0 < 1024) { donorm = true; dorope = true; gg = p.in[9]; }
        else if (c0 < 1536) { continue; }
        else if (c0 < 2048) { donorm = true; dorope = true; gg = p.in[12]; }
        else if (c0 < 2112) { donorm = true; dorope = true; gg = p.in[13]; }
        else if (c0 < 2240) {
            if (c0 != 2112) continue;
            float ss = 0.f;
            for (int i = 0; i < 128; ++i) { const float f = bf2f(row[c0 + i]); ss += f * f; }
            const float r = 1.0f / sqrtf(ss * (1.f / 128.f) + RMS_EPS);
            for (int i = 0; i < 128; ++i) row[c0 + i] = f2bf(bf2f(row[c0 + i]) * r * p.in[14][i]);
            continue;
        }
        else { dorope = true; }
        float ss = 0.f;
        for (int i = 0; i < 64; ++i) { const float f = bf2f(row[c0 + i]); ss += f * f; }
        const float r = donorm ? 1.0f / sqrtf(ss * (1.f / 64.f) + RMS_EPS) : 1.0f;
        float head[16];
#pragma unroll
        for (int i = 0; i < 16; ++i) head[i] = bf2f(row[c0 + i]) * r * (donorm ? gg[i] : 1.0f);
        if (dorope) {
#pragma unroll
            for (int i = 0; i < 8; ++i) { const float cs = rope[(pos * 8 + i) * 2], sn = rope[(pos * 8 + i) * 2 + 1];
                const float x1 = head[i], x2 = head[8 + i]; head[i] = x1 * cs - x2 * sn; head[8 + i] = x2 * cs + x1 * sn; }
        }
#pragma unroll
        for (int i = 0; i < 16; ++i) row[c0 + i] = f2bf(head[i]);
        if (donorm) for (int i = 16; i < 64; ++i) row[c0 + i] = f2bf(bf2f(row[c0 + i]) * r * gg[i]);
    }
}
__device__ __forceinline__ void phase_diffattn_slow(const Params& p, LAS unsigned char* lds, int tid) {
    unsigned char* ws = p.ws; const bf16_t* PROJ = (const bf16_t*)(ws + WS_PROJ); bf16_t* H = (bf16_t*)(ws + WS_H);
    const float lam = ((const float*)(ws + WS_LAM))[0]; const float* sub_g = p.in[11];
    LAS float* q1 = (LAS float*)lds; LAS float* q2 = q1 + 64; LAS float* red = q1 + 128; LAS float* osum = q1 + 160;
    LAS float* s1 = q1 + 1024; LAS float* s2 = s1 + 4096;
    for (int it = blockIdx.x; it < NTOK * 4; it += gridDim.x) {
        const int t = it >> 2, h = it & 3, b = t / SEQ, s = t % SEQ, N = (s / 64 + 1) * 64;
        const bf16_t* qrow = PROJ + (size_t)t * NPJ;
        __syncthreads();
        if (tid < 64) q1[tid] = bf2f(qrow[C_AQ1 + h * 64 + tid]);
        else if (tid < 128) q2[tid - 64] = bf2f(qrow[C_AQ2 + h * 64 + tid - 64]);
        __syncthreads();
        float m1 = -INFINITY, m2 = -INFINITY;
        for (int key = tid; key < N; key += NTHREADS) {
            const bf16_t* kr = PROJ + (size_t)(b * SEQ + key) * NPJ;
            float d1 = 0.f, d2 = 0.f;
            for (int d = 0; d < 64; ++d) { d1 += q1[d] * bf2f(kr[C_AK1 + h * 64 + d]); d2 += q2[d] * bf2f(kr[C_AK2 + h * 64 + d]); }
            d1 *= 0.125f; d2 *= 0.125f; s1[key] = d1; s2[key] = d2; m1 = fmaxf(m1, d1); m2 = fmaxf(m2, d2);
        }
        m1 = wg_max(m1, red, tid); m2 = wg_max(m2, red, tid);
        float l1 = 0.f, l2 = 0.f;
        for (int key = tid; key < N; key += NTHREADS) { const float e1 = __expf(s1[key] - m1), e2 = __expf(s2[key] - m2); s1[key] = e1; s2[key] = e2; l1 += e1; l2 += e2; }
        l1 = wg_sum(l1, red, tid); l2 = wg_sum(l2, red, tid);
        const float i1 = 1.f / l1, i2 = lam / l2;
        for (int key = tid; key < N; key += NTHREADS) s1[key] = s1[key] * i1 - s2[key] * i2;
        __syncthreads();
        const int e = tid & 127, part = tid >> 7;
        float o = 0.f;
        for (int key = part; key < N; key += 4) o += s1[key] * bf2f(PROJ[(size_t)(b * SEQ + key) * NPJ + C_AV + h * 128 + e]);
        osum[part * 128 + e] = o;
        __syncthreads();
        float ov = 0.f, sq = 0.f;
        if (tid < 128) { ov = (osum[tid] + osum[128 + tid]) + (osum[256 + tid] + osum[384 + tid]); sq = ov * ov; }
        const float ss = wg_sum(sq, red, tid);
        if (tid < 128) H[(size_t)t * DM + h * 128 + tid] = f2bf(ov * (1.0f / sqrtf(ss * (1.f / 128.f) + RMS_EPS)) * sub_g[tid] * (1.0f - LAMBDA_INIT));
    }
}
__device__ __forceinline__ void phase_dsa_slow(const Params& p, LAS unsigned char* lds, int tid) {
    unsigned char* ws = p.ws; const bf16_t* PROJ = (const bf16_t*)(ws + WS_PROJ); bf16_t* H = (bf16_t*)(ws + WS_H);
    const float* IW = (const float*)(ws + WS_IW); const float* w_uv = p.in[15];
    LAS float* iq = (LAS float*)lds; LAS float* bq = iq + 512; LAS float* w = iq + 1024; LAS float* score = iq + 1088;
    LAS float* pp = score + 4096;
    LAS float* o = pp + 2048;
    LAS int* sel = (LAS int*)(o + 1024);
    for (int t = blockIdx.x; t < NTOK; t += gridDim.x) {
        const int b = t / SEQ, s = t % SEQ, N = (s / 64 + 1) * 64;
        const bf16_t* qrow = PROJ + (size_t)t * NPJ;
        __syncthreads();
        { const int i = tid; iq[i] = bf2f(qrow[C_IQ + i]); bq[i] = bf2f(qrow[C_BQ + i]); }
        if (tid < 8) w[tid] = IW[(size_t)t * 8 + tid];
        __syncthreads();
        for (int key = tid; key < N; key += NTHREADS) {
            const bf16_t* kr = PROJ + (size_t)(b * SEQ + key) * NPJ + C_IK;
            float sc = 0.f;
            for (int hh = 0; hh < 8; ++hh) { float d0 = 0.f;
                for (int d = 0; d < 64; ++d) d0 += iq[hh * 64 + d] * bf2f(kr[d]);
                sc += w[hh] * fmaxf(d0, 0.f); }
            score[key] = sc;
        }
        __syncthreads();
        const int nsel = N < 256 ? N : 256;
        for (int key = tid; key < N; key += NTHREADS) {
            const float my = score[key]; int r = 0;
            for (int j = 0; j < N; ++j) { const float ot = score[j]; r += (ot > my || (ot == my && j < key)) ? 1 : 0; }
            if (r < 256) sel[r] = key;
        }
        __syncthreads();
        if (tid < nsel) {
            const bf16_t* kr = PROJ + (size_t)(b * SEQ + sel[tid]) * NPJ + C_BK;
            for (int hh = 0; hh < 8; ++hh) { float d0 = 0.f;
                for (int d = 0; d < 64; ++d) d0 += bq[hh * 64 + d] * bf2f(kr[d]);
                pp[hh * 256 + tid] = d0 * 0.125f; }
        }
        __syncthreads();
        {
            const int hh = tid >> 6, l = tid & 63;
            float m = -INFINITY;
            for (int j = l; j < nsel; j += 64) m = fmaxf(m, pp[hh * 256 + j]);
#pragma unroll
            for (int of = 32; of > 0; of >>= 1) m = fmaxf(m, __shfl_xor(m, of));
            float sum = 0.f;
            for (int j = l; j < nsel; j += 64) { const float ev = __expf(pp[hh * 256 + j] - m); pp[hh * 256 + j] = ev; sum += ev; }
            sum = wave_sum(sum);
            const float inv = 1.f / sum;
            for (int j = l; j < nsel; j += 64) pp[hh * 256 + j] *= inv;
        }
        __syncthreads();
        {
            const int hh = tid >> 6, l = tid & 63;
            float a0 = 0.f, a1 = 0.f;
            for (int j = 0; j < nsel; ++j) { const bf16_t* lr = PROJ + (size_t)(b * SEQ + sel[j]) * NPJ + C_BLAT; const float pv = pp[hh * 256 + j];
                a0 += pv * bf2f(lr[l]); a1 += pv * bf2f(lr[l + 64]); }
            o[hh * 128 + l] = a0; o[hh * 128 + l + 64] = a1;
        }
        __syncthreads();
        {
            const int hh = tid >> 6, l = tid & 63;
            float a0 = 0.f;
            for (int c = 0; c < 128; ++c) a0 += o[hh * 128 + c] * w_uv[(hh * 128 + c) * 64 + l];
            H[(size_t)t * DM + 512 + hh * 64 + l] = f2bf(a0);
        }
    }
}
namespace da {
typedef float f32x16 __attribute__((ext_vector_type(16)));
typedef short s16x4 __attribute__((ext_vector_type(4)));
constexpr int KPL = 1040;
constexpr int KT_BYTES = 8 * KPL;
constexpr int VRS = 320;
constexpr int VT_BYTES = 64 * VRS;
constexpr int BUF_BYTES = 2 * KT_BYTES + VT_BYTES;
constexpr int OB_STRIDE = 132;
constexpr int WSF_OFF = 139264;
constexpr float C2 = 0.125f * 1.4426950408889634f;
__device__ __forceinline__ int crow(int r, int hi) { return (r & 3) + 8 * (r >> 2) + 4 * hi; }
__device__ __forceinline__ s16x4 vtr(const LAS unsigned char* p) { return __builtin_bit_cast(s16x4, __builtin_amdgcn_ds_read_tr16_b64_v4i16((LAS s16x4*)p)); }

__device__ __forceinline__ void phase(const Params& p, LAS unsigned char* lds, int tid, int lane, int wave) {
    unsigned char* ws = p.ws; const bf16_t* PROJ = (const bf16_t*)(ws + WS_PROJ); bf16_t* H = (bf16_t*)(ws + WS_H);
    const float lam = ((const float*)(ws + WS_LAM))[0]; const float* sub_g = p.in[11];
    const int wsel = wave >> 2, wq = wave & 3, r32 = lane & 31, hi = lane >> 5;
    LAS float* wsf = (LAS float*)(lds + WSF_OFF) + wave * 64;
    const int G = gridDim.x, vcu = (G % 8 == 0) ? ((int)blockIdx.x % 8) * (G / 8) + (int)blockIdx.x / 8 : (int)blockIdx.x;
    for (int id = vcu; id < 1024; id += G) {
        const int bh = (id >> 3) & 31, s = id & 7, ii = id >> 8;
        const int qb = (ii == 0) ? s : (ii == 1) ? 15 - s : (ii == 2) ? 16 + s : 31 - s;
        const int b = bh >> 2, h = bh & 3, q0 = qb * 128, NT = 2 * qb + 2, ntw = 2 * qb + 1 + (wq >> 1);
        const bf16_t* base = PROJ + (size_t)b * SEQ * NPJ;
        bf16x8 qr[4];
        { const bf16_t* Qrow = base + (size_t)(q0 + 32 * wq + r32) * NPJ + (wsel ? C_AQ2 : C_AQ1) + h * 64;
#pragma unroll
          for (int d0 = 0; d0 < 4; ++d0) qr[d0] = *(const bf16x8*)(Qrow + 16 * d0 + 8 * hi); }
        float m = -INFINITY, l = 0.f;
        f32x16 o[4];
#pragma unroll
        for (int d0 = 0; d0 < 4; ++d0)
#pragma unroll
            for (int r = 0; r < 16; ++r) o[d0][r] = 0.f;
        const int skey = tid >> 3, sc = tid & 7, vkey = tid >> 4, vch = tid & 15;
        const bf16_t* srcK1 = base + (size_t)skey * NPJ + C_AK1 + h * 64 + 8 * sc;
        const bf16_t* srcK2 = base + (size_t)skey * NPJ + C_AK2 + h * 64 + 8 * sc;
        const bf16_t* srcV = base + (size_t)vkey * NPJ + C_AV + h * 128 + 8 * vch;
        const int dK = sc * KPL + skey * 16, dV = vkey * VRS + vch * 16;
        u32x4 st0, st1, st2, st3;
#define DA_LOAD(kt) do { const size_t ro = (size_t)(kt) * 64 * NPJ; st0 = *(const u32x4*)(srcK1 + ro); st1 = *(const u32x4*)(srcK2 + ro); \
        st2 = *(const u32x4*)(srcV + ro); st3 = *(const u32x4*)(srcV + ro + (size_t)32 * NPJ); } while (0)
#define DA_WRITE(bufi) do { LAS unsigned char* bb = lds + (bufi) * BUF_BYTES; *(LAS u32x4*)(bb + dK) = st0; *(LAS u32x4*)(bb + KT_BYTES + dK) = st1; \
        *(LAS u32x4*)(bb + 2 * KT_BYTES + dV) = st2; *(LAS u32x4*)(bb + 2 * KT_BYTES + dV + 32 * VRS) = st3; } while (0)
        DA_LOAD(0); DA_WRITE(0);
        __syncthreads();
        for (int kt = 0; kt < NT; ++kt) {
            if (kt + 1 < NT) DA_LOAD(kt + 1);
            if (kt < ntw) {
                const LAS unsigned char* bb = lds + (kt & 1) * BUF_BYTES;
                const LAS unsigned char* Kb = bb + wsel * KT_BYTES;
                const LAS unsigned char* Vb = bb + 2 * KT_BYTES;
                f32x16 p0, p1;
#pragma unroll
                for (int r = 0; r < 16; ++r) { p0[r] = 0.f; p1[r] = 0.f; }
#pragma unroll
                for (int d0 = 0; d0 < 4; ++d0) {
                    const bf16x8 a0 = *(const LAS bf16x8*)(Kb + (2 * d0 + hi) * KPL + r32 * 16);
                    const bf16x8 a1 = *(const LAS bf16x8*)(Kb + (2 * d0 + hi) * KPL + (r32 + 32) * 16);
                    p0 = __builtin_amdgcn_mfma_f32_32x32x16_bf16(a0, qr[d0], p0, 0, 0, 0);
                    p1 = __builtin_amdgcn_mfma_f32_32x32x16_bf16(a1, qr[d0], p1, 0, 0, 0);
                }
                float mx = fmaxf(p0[0], p1[0]);
#pragma unroll
                for (int r = 1; r < 16; ++r) mx = fmaxf(mx, fmaxf(p0[r], p1[r]));
                mx = fmaxf(mx, __shfl_xor(mx, 32)) * C2;
                const float mnew = fmaxf(m, mx);
                if (__any(mnew > m)) {
                    const float f = __builtin_amdgcn_exp2f(m - mnew);
                    l *= f; m = mnew;
                    if (hi == 0) wsf[r32] = f;
                    asm volatile("s_waitcnt lgkmcnt(0)" ::: "memory");
#pragma unroll
                    for (int r = 0; r < 16; ++r) { const float fr = wsf[crow(r, hi)];
#pragma unroll
                        for (int d0 = 0; d0 < 4; ++d0) o[d0][r] *= fr; }
                }
                float ls = 0.f;
#pragma unroll
                for (int r = 0; r < 16; ++r) { p0[r] = __builtin_amdgcn_exp2f(p0[r] * C2 - m); p1[r] = __builtin_amdgcn_exp2f(p1[r] * C2 - m); ls += p0[r] + p1[r]; }
                l += ls;
                bf16x8 pa[4];
#pragma unroll
                for (int ks = 0; ks < 2; ++ks) {
                    u32x4 w0, w1;
                    w0.x = gp::cvt_pk_bf16(p0[8 * ks + 0], p0[8 * ks + 1]); w0.y = gp::cvt_pk_bf16(p0[8 * ks + 2], p0[8 * ks + 3]);
                    w0.z = gp::cvt_pk_bf16(p0[8 * ks + 4], p0[8 * ks + 5]); w0.w = gp::cvt_pk_bf16(p0[8 * ks + 6], p0[8 * ks + 7]);
                    w1.x = gp::cvt_pk_bf16(p1[8 * ks + 0], p1[8 * ks + 1]); w1.y = gp::cvt_pk_bf16(p1[8 * ks + 2], p1[8 * ks + 3]);
                    w1.z = gp::cvt_pk_bf16(p1[8 * ks + 4], p1[8 * ks + 5]); w1.w = gp::cvt_pk_bf16(p1[8 * ks + 6], p1[8 * ks + 7]);
                    pa[ks] = __builtin_bit_cast(bf16x8, w0); pa[2 + ks] = __builtin_bit_cast(bf16x8, w1);
                }
                const LAS unsigned char* vp = Vb + (4 * hi + ((lane & 15) >> 2)) * VRS + (16 * ((lane >> 4) & 1) + 4 * (lane & 3)) * 2;
#pragma unroll
                for (int d0 = 0; d0 < 4; ++d0)
#pragma unroll
                    for (int ks = 0; ks < 4; ++ks) {
                        const s16x4 lo = vtr(vp + (16 * ks) * VRS + d0 * 64), hv = vtr(vp + (16 * ks + 8) * VRS + d0 * 64);
                        const bf16x8 vf = (bf16x8){lo[0], lo[1], lo[2], lo[3], hv[0], hv[1], hv[2], hv[3]};
                        o[d0] = __builtin_amdgcn_mfma_f32_32x32x16_bf16(pa[ks], vf, o[d0], 0, 0, 0);
                        if (ks == 3) __builtin_amdgcn_sched_barrier(0);
                    }
            }
            if (kt + 1 < NT) DA_WRITE((kt + 1) & 1);
            __syncthreads();
        }
#undef DA_LOAD
#undef DA_WRITE
        l += __shfl_xor(l, 32);
        { const float fac = (wsel ? lam : 1.0f) / l;
          if (hi == 0) wsf[r32] = fac;
          asm volatile("s_waitcnt lgkmcnt(0)" ::: "memory"); }
        LAS float* Ob = (LAS float*)lds + wsel * (128 * OB_STRIDE);
#pragma unroll
        for (int r = 0; r < 16; ++r) { const float fr = wsf[crow(r, hi)]; const int row = 32 * wq + crow(r, hi);
#pragma unroll
            for (int d0 = 0; d0 < 4; ++d0) Ob[row * OB_STRIDE + 32 * d0 + r32] = o[d0][r] * fr; }
        __syncthreads();
        { const LAS float* O1 = (const LAS float*)lds; const LAS float* O2 = O1 + 128 * OB_STRIDE;
          const float g0 = sub_g[2 * lane], g1 = sub_g[2 * lane + 1];
          for (int rr = 0; rr < 16; ++rr) { const int row = 16 * wave + rr;
              const float d0v = O1[row * OB_STRIDE + 2 * lane] - O2[row * OB_STRIDE + 2 * lane], d1v = O1[row * OB_STRIDE + 2 * lane + 1] - O2[row * OB_STRIDE + 2 * lane + 1];
              const float ss = wave_sum(d0v * d0v + d1v * d1v);
              const float rs = (1.0f - LAMBDA_INIT) / sqrtf(ss * (1.f / 128.f) + RMS_EPS);
              *(unsigned*)(H + (size_t)(b * SEQ + q0 + row) * DM + h * 128 + 2 * lane) = pk2(d0v * rs * g0, d1v * rs * g1); } }
        __syncthreads();
    }
}
}
namespace ds {
typedef float f32x16 __attribute__((ext_vector_type(16)));
typedef short s16x4 __attribute__((ext_vector_type(4)));
typedef int i32x4 __attribute__((ext_vector_type(4)));
typedef unsigned u32x2 __attribute__((ext_vector_type(2)));
constexpr int HIST_OFF = 131072, SEL_OFF = 139264, OALL_OFF = 143360;
constexpr float C2 = 0.125f * 1.4426950408889634f;
__device__ __forceinline__ s16x4 vtr(const LAS unsigned char* p) { return __builtin_bit_cast(s16x4, __builtin_amdgcn_ds_read_tr16_b64_v4i16((LAS s16x4*)p)); }
__device__ __forceinline__ unsigned skey(float f) { unsigned u = __float_as_uint(f); if (u == 0x80000000u) u = 0u; return u ^ ((unsigned)((int)u >> 31) | 0x80000000u); }

template <int STOP> __device__ __forceinline__ void unit(const Params& p, LAS unsigned char* lds, int tid, int lane_in, int wave, int b, int qt) {
    int lane = lane_in; asm volatile("" : "+v"(lane));
    unsigned char* ws = p.ws; const bf16_t* PROJ = (const bf16_t*)(ws + WS_PROJ); bf16_t* H = (bf16_t*)(ws + WS_H);
    const float* IW = (const float*)(ws + WS_IW);
    const int q0 = qt * 8, N = (q0 / 64 + 1) * 64, t0 = b * SEQ + q0;
    const bf16_t* base = PROJ + (size_t)b * SEQ * NPJ;
    LAS float* S = (LAS float*)lds;
    const int r32 = lane & 31, hi = lane >> 5;
    {
        bf16x8 aq[2][4]; f32x4 wv[2][4];
#pragma unroll
        for (int rb = 0; rb < 2; ++rb) {
            const bf16_t* qrow = base + (size_t)(q0 + 4 * rb + 2 * ((r32 >> 2) & 1) + (r32 >> 4)) * NPJ + C_IQ + (4 * ((r32 >> 3) & 1) + (r32 & 3)) * 64 + 8 * hi;
#pragma unroll
            for (int d0 = 0; d0 < 4; ++d0) aq[rb][d0] = *(const bf16x8*)(qrow + 16 * d0);
#pragma unroll
            for (int qq = 0; qq < 4; ++qq) wv[rb][qq] = *(const f32x4*)(IW + (size_t)(t0 + 4 * rb + 2 * hi + (qq >> 1)) * 8 + 4 * (qq & 1));
        }
        const int ntk = N / 32;
        bf16x8 bk[4], bkn[4];
        const unsigned char* ikf = ws + WS_IKF + (size_t)b * 128 * 4096 + lane * 16;
        { const unsigned char* kp = ikf + (size_t)(wave < ntk ? wave : 0) * 4096;
#pragma unroll
          for (int d0 = 0; d0 < 4; ++d0) bkn[d0] = *(const bf16x8*)(kp + d0 * 1024); }
        for (int kt = wave; kt < ntk; kt += NWAVES) {
#pragma unroll
            for (int d0 = 0; d0 < 4; ++d0) bk[d0] = bkn[d0];
            if (kt + NWAVES < ntk) { const unsigned char* kp = ikf + (size_t)(kt + NWAVES) * 4096;
#pragma unroll
                for (int d0 = 0; d0 < 4; ++d0) bkn[d0] = *(const bf16x8*)(kp + d0 * 1024); }
#pragma unroll
            for (int rb = 0; rb < 2; ++rb) {
                f32x16 acc;
#pragma unroll
                for (int r = 0; r < 16; ++r) acc[r] = 0.f;
#pragma unroll
                for (int d0 = 0; d0 < 4; ++d0) acc = __builtin_amdgcn_mfma_f32_32x32x16_bf16(aq[rb][d0], bk[d0], acc, 0, 0, 0);
                float v0 = 0.f, v1 = 0.f;
#pragma unroll
                for (int i = 0; i < 4; ++i) { v0 += wv[rb][0][i] * fmaxf(acc[i], 0.f) + wv[rb][1][i] * fmaxf(acc[4 + i], 0.f);
                                               v1 += wv[rb][2][i] * fmaxf(acc[8 + i], 0.f) + wv[rb][3][i] * fmaxf(acc[12 + i], 0.f); }
                S[(4 * rb + 2 * hi) * 4096 + 32 * kt + r32] = v0;
                S[(4 * rb + 2 * hi + 1) * 4096 + 32 * kt + r32] = v1;
            }
        }
    }
    __syncthreads();
    if (STOP == 1) return;
    asm volatile("" : "+v"(lane));
    LAS float* Sw = S + wave * 4096;
    LAS unsigned short* sel = (LAS unsigned short*)(lds + SEL_OFF) + wave * 256;
    const int nsel = N < 256 ? N : 256;
    if (N <= 256) {
        for (int i = lane; i < N; i += 64) sel[i] = (unsigned short)i;
    } else {
        LAS unsigned* hist = (LAS unsigned*)(lds + OALL_OFF) + wave * 512;
        LAS float* cv = (LAS float*)(lds + HIST_OFF) + wave * 256; LAS int* ci = (LAS int*)cv + 128;
        const unsigned long long ltmask = (1ull << lane) - 1ull;
        const int nit = (N + 255) / 256;
        float mn = INFINITY, mx = -INFINITY;
        for (int it = 0; it < nit; ++it) { if (256 * it + 4 * lane < N) { const f32x4 v4 = *(const LAS f32x4*)(Sw + 256 * it + 4 * lane);
            mn = fminf(fminf(mn, v4[0]), fminf(v4[1], fminf(v4[2], v4[3]))); mx = fmaxf(fmaxf(mx, v4[0]), fmaxf(v4[1], fmaxf(v4[2], v4[3]))); } }
#pragma unroll
        for (int o = 1; o < 64; o <<= 1) { mn = fminf(mn, __shfl_xor(mn, o)); mx = fmaxf(mx, __shfl_xor(mx, o)); }
        if (!(mx > mn)) {
            for (int i = lane; i < 256; i += 64) sel[i] = (unsigned short)i;
        } else {
            const float scale = 1024.0f / (mx - mn);
            *(LAS u32x4*)(hist + 8 * lane) = (u32x4){0u, 0u, 0u, 0u}; *(LAS u32x4*)(hist + 8 * lane + 4) = (u32x4){0u, 0u, 0u, 0u};
            asm volatile("s_waitcnt lgkmcnt(0)" ::: "memory");
            for (int it = 0; it < nit; ++it) { if (256 * it + 4 * lane < N) { const f32x4 v4 = *(const LAS f32x4*)(Sw + 256 * it + 4 * lane);
#pragma unroll
                for (int q = 0; q < 4; ++q) { int bn = (int)((v4[q] - mn) * scale); bn = bn > 1023 ? 1023 : bn;
                    __hip_atomic_fetch_add(hist + (bn >> 1), 1u << (16 * (bn & 1)), __ATOMIC_RELAXED, __HIP_MEMORY_SCOPE_WORKGROUP); } } }
            asm volatile("s_waitcnt lgkmcnt(0)" ::: "memory");
            unsigned wq[8];
            { const u32x4 h0 = *(LAS u32x4*)(hist + 8 * lane), h1 = *(LAS u32x4*)(hist + 8 * lane + 4);
              wq[0] = h0.x; wq[1] = h0.y; wq[2] = h0.z; wq[3] = h0.w; wq[4] = h1.x; wq[5] = h1.y; wq[6] = h1.z; wq[7] = h1.w; }
            int sl = 0;
#pragma unroll
            for (int q = 0; q < 8; ++q) sl += (int)(wq[q] & 0xffffu) + (int)(wq[q] >> 16);
            int v = sl;
#pragma unroll
            for (int o = 1; o < 64; o <<= 1) { const int t = __shfl_down(v, o); v += (lane + o < 64) ? t : 0; }
            int ab = v - sl, myB = -1, myAbove = 0, myCnt = 0;
#pragma unroll
            for (int q = 15; q >= 0; --q) { const int cq = (int)((wq[q >> 1] >> (16 * (q & 1))) & 0xffffu);
                if (myB < 0 && ab < 256 && 256 <= ab + cq) { myB = 16 * lane + q; myAbove = ab; myCnt = cq; }
                ab += cq; }
            const unsigned long long bal = __ballot(myB >= 0);
            const int src = __builtin_ctzll(bal);
            const int B = __shfl(myB, src), C = __shfl(myCnt, src), need = 256 - __shfl(myAbove, src);
            if (C <= 128) {
                int outpos = 0, cp = 0;
                for (int it = 0; it < nit; ++it) { const bool inr = 256 * it + 4 * lane < N; const f32x4 v4 = *(const LAS f32x4*)(Sw + 256 * it + 4 * (inr ? lane : 0));
#pragma unroll
                    for (int q = 0; q < 4; ++q) { int bn = (int)((v4[q] - mn) * scale); bn = bn > 1023 ? 1023 : bn;
                        const bool take = inr && bn > B, cd = inr && bn == B; const int idx = 256 * it + 4 * lane + q;
                        const unsigned long long bt = __ballot(take), bc = __ballot(cd);
                        if (take) sel[outpos + __popcll(bt & ltmask)] = (unsigned short)idx;
                        if (cd) { const int pos = cp + __popcll(bc & ltmask); cv[pos] = v4[q]; ci[pos] = idx; }
                        outpos += __popcll(bt); cp += __popcll(bc); } }
                asm volatile("s_waitcnt lgkmcnt(0)" ::: "memory");
                const float v0 = lane < C ? cv[lane] : -INFINITY, v1 = lane + 64 < C ? cv[lane + 64] : -INFINITY;
                const int i0 = lane < C ? ci[lane] : 0x7fffffff, i1 = lane + 64 < C ? ci[lane + 64] : 0x7fffffff;
                int r0 = 0, r1 = 0;
                for (int q = 0; q < C; ++q) { const float ov = cv[q]; const int oi = ci[q];
                    r0 += (ov > v0 || (ov == v0 && oi < i0)) ? 1 : 0; r1 += (ov > v1 || (ov == v1 && oi < i1)) ? 1 : 0; }
                const bool t0 = lane < C && r0 < need, t1 = lane + 64 < C && r1 < need;
                const unsigned long long b0 = __ballot(t0);
                if (t0) sel[outpos + __popcll(b0 & ltmask)] = (unsigned short)i0;
                outpos += __popcll(b0);
                const unsigned long long b1 = __ballot(t1);
                if (t1) sel[outpos + __popcll(b1 & ltmask)] = (unsigned short)i1;
            } else {
                LAS int* h8 = (LAS int*)hist;
                unsigned prefix = 0u; int need8 = 256;
#pragma unroll 1
                for (int pass = 0; pass < 4; ++pass) {
                    const int shift = 24 - 8 * pass;
                    *(LAS i32x4*)(h8 + 4 * lane) = (i32x4){0, 0, 0, 0};
                    asm volatile("s_waitcnt lgkmcnt(0)" ::: "memory");
                    for (int j = 0; j < N / 64; ++j) { const unsigned u = skey(Sw[64 * j + lane]);
                        if (pass == 0 || (u >> (shift + 8)) == prefix) __hip_atomic_fetch_add((int*)(h8 + ((u >> shift) & 255u)), 1, __ATOMIC_RELAXED, __HIP_MEMORY_SCOPE_WORKGROUP); }
                    asm volatile("s_waitcnt lgkmcnt(0)" ::: "memory");
                    const i32x4 c = *(LAS i32x4*)(h8 + 4 * lane);
                    const int s4 = c.x + c.y + c.z + c.w; int vv = s4;
#pragma unroll
                    for (int o = 1; o < 64; o <<= 1) { const int t = __shfl_down(vv, o); vv += (lane + o < 64) ? t : 0; }
                    const int a3 = vv - s4, a2 = a3 + c.w, a1 = a2 + c.z, a0 = a1 + c.y;
                    int mB = -1, mA = 0;
                    if (a3 < need8 && need8 <= a3 + c.w) { mB = 4 * lane + 3; mA = a3; }
                    else if (a2 < need8 && need8 <= a2 + c.z) { mB = 4 * lane + 2; mA = a2; }
                    else if (a1 < need8 && need8 <= a1 + c.y) { mB = 4 * lane + 1; mA = a1; }
                    else if (a0 < need8 && need8 <= a0 + c.x) { mB = 4 * lane; mA = a0; }
                    const int sr = __builtin_ctzll(__ballot(mB >= 0));
                    need8 -= __shfl(mA, sr); prefix = (prefix << 8) | (unsigned)__shfl(mB, sr);
                }
                int outpos = 0, eqtaken = 0;
                for (int j = 0; j < N / 64; ++j) { const unsigned u = skey(Sw[64 * j + lane]);
                    const bool eq = (u == prefix); const unsigned long long beq = __ballot(eq);
                    const bool take = (u > prefix) || (eq && (eqtaken + __popcll(beq & ltmask) < need8));
                    const unsigned long long bt = __ballot(take);
                    if (take) sel[outpos + __popcll(bt & ltmask)] = (unsigned short)(64 * j + lane);
                    outpos += __popcll(bt); eqtaken += __popcll(beq); }
            }
        }
    }
    asm volatile("s_waitcnt lgkmcnt(0)" ::: "memory");
    if (STOP == 2) { __syncthreads(); return; }
    asm volatile("" : "+v"(lane));
    {
        const int n16 = lane & 15, g = lane >> 4, t = t0 + wave;
        bf16x8 bqf[2];
#pragma unroll
        for (int ks = 0; ks < 2; ++ks) { bqf[ks] = (bf16x8){0, 0, 0, 0, 0, 0, 0, 0};
            if (n16 < 8) bqf[ks] = *(const bf16x8*)(PROJ + (size_t)t * NPJ + C_BQ + n16 * 64 + 32 * ks + 8 * g); }
        const int ntile = nsel / 16;
        f32x4 sc[16];
        int idxv[16];
#pragma unroll
        for (int kt = 0; kt < 16; ++kt) { int pos = 16 * kt + n16; pos = pos < nsel ? pos : 0; idxv[kt] = sel[pos]; }
#pragma unroll
        for (int hb = 0; hb < 2; ++hb) {
#pragma unroll
            for (int kk = 0; kk < 8; ++kk) sc[8 * hb + kk] = (f32x4){-INFINITY, -INFINITY, -INFINITY, -INFINITY};
            if (8 * hb < ntile) {
                bf16x8 ka0[8], ka1[8];
#pragma unroll
                for (int kk = 0; kk < 8; ++kk) { const bf16_t* kr = base + (size_t)idxv[8 * hb + kk] * NPJ + C_BK + 8 * g; ka0[kk] = *(const bf16x8*)kr; ka1[kk] = *(const bf16x8*)(kr + 32); }
#pragma unroll
                for (int kk = 0; kk < 8; ++kk) { f32x4 a = (f32x4){0.f, 0.f, 0.f, 0.f};
                    a = __builtin_amdgcn_mfma_f32_16x16x32_bf16(ka0[kk], bqf[0], a, 0, 0, 0);
                    a = __builtin_amdgcn_mfma_f32_16x16x32_bf16(ka1[kk], bqf[1], a, 0, 0, 0);
                    if (8 * hb + kk < ntile) sc[8 * hb + kk] = a; }
            }
        }
        float mx = -INFINITY;
#pragma unroll
        for (int kt = 0; kt < 16; ++kt) mx = fmaxf(mx, fmaxf(fmaxf(sc[kt][0], sc[kt][1]), fmaxf(sc[kt][2], sc[kt][3])));
        mx = fmaxf(mx, __shfl_xor(mx, 16)); mx = fmaxf(mx, __shfl_xor(mx, 32));
        const float mc = mx * C2;
        float lsum = 0.f;
        bf16x8 pb[8];
#pragma unroll
        for (int s = 0; s < 8; ++s) {
            float e[8];
#pragma unroll
            for (int i = 0; i < 4; ++i) { e[i] = __builtin_amdgcn_exp2f(sc[2 * s][i] * C2 - mc); e[4 + i] = __builtin_amdgcn_exp2f(sc[2 * s + 1][i] * C2 - mc); }
#pragma unroll
            for (int i = 0; i < 8; ++i) lsum += e[i];
            u32x4 w; w.x = gp::cvt_pk_bf16(e[0], e[1]); w.y = gp::cvt_pk_bf16(e[2], e[3]); w.z = gp::cvt_pk_bf16(e[4], e[5]); w.w = gp::cvt_pk_bf16(e[6], e[7]);
            pb[s] = __builtin_bit_cast(bf16x8, w);
        }
        lsum += __shfl_xor(lsum, 16); lsum += __shfl_xor(lsum, 32);
        LAS unsigned char* Lw = (LAS unsigned char*)Sw;
        f32x4 ot[8];
#pragma unroll
        for (int cb = 0; cb < 8; ++cb) ot[cb] = (f32x4){0.f, 0.f, 0.f, 0.f};
        const int nstep = nsel / 32;
        u32x4 stgA[8], stgB[8], stgC[8];
#define DS_LOADC(dst, s_) do { if ((s_) < nstep) { _Pragma("unroll") for (int i = 0; i < 8; ++i) { const int sig = 4 * i + g; \
            dst[i] = *(const u32x4*)(base + (size_t)sel[32 * (s_) + sig] * NPJ + C_BLAT + 8 * n16); } } } while (0)
#define DS_STEP(cur, s_) do { if ((s_) < nstep) { \
            LAS unsigned char* Lb = Lw + ((s_) & 1) * 8192; \
            _Pragma("unroll") for (int i = 0; i < 8; ++i) { const int sig = 4 * i + g, ch = n16; \
                *(LAS u32x4*)(Lb + sig * 256 + (((ch >> 1) ^ (sig & 7)) * 32) + (ch & 1) * 16) = cur[i]; } \
            DS_LOADC(cur, (s_) + 3); \
            asm volatile("s_waitcnt lgkmcnt(0)" ::: "memory"); \
            const int rq = 4 * g + (n16 >> 2); \
            _Pragma("unroll") for (int cb = 0; cb < 8; ++cb) { \
                const s16x4 lo = vtr(Lb + rq * 256 + ((cb ^ (rq & 7)) * 32) + 8 * (lane & 3)); \
                const s16x4 hv = vtr(Lb + (16 + rq) * 256 + ((cb ^ (rq & 7)) * 32) + 8 * (lane & 3)); \
                const bf16x8 af = (bf16x8){lo[0], lo[1], lo[2], lo[3], hv[0], hv[1], hv[2], hv[3]}; \
                ot[cb] = __builtin_amdgcn_mfma_f32_16x16x32_bf16(af, pb[s_], ot[cb], 0, 0, 0); } } } while (0)
        DS_LOADC(stgA, 0); DS_LOADC(stgB, 1); DS_LOADC(stgC, 2);
        DS_STEP(stgA, 0); DS_STEP(stgB, 1); DS_STEP(stgC, 2); DS_STEP(stgA, 3); DS_STEP(stgB, 4); DS_STEP(stgC, 5); DS_STEP(stgA, 6); DS_STEP(stgB, 7);
#undef DS_LOADC
#undef DS_STEP
        const float linv = 1.0f / lsum;
        if (n16 < 8) {
            LAS bf16_t* Oall = (LAS bf16_t*)(lds + OALL_OFF) + (wave * 8 + n16) * 128;
#pragma unroll
            for (int cb = 0; cb < 8; ++cb) *(LAS u32x2*)(Oall + 16 * cb + 4 * g) = (u32x2){pk2(ot[cb][0] * linv, ot[cb][1] * linv), pk2(ot[cb][2] * linv, ot[cb][3] * linv)};
        }
    }
    __syncthreads();
    if (STOP == 3) return;
    asm volatile("" : "+v"(lane));
    {
        const int n16 = lane & 15, g = lane >> 4, hh = wave;
        const bf16_t* WuvT = (const bf16_t*)(ws + WS_WUVT) + hh * 64 * 128;
        const LAS bf16_t* Oall = (const LAS bf16_t*)(lds + OALL_OFF) + ((n16 & 7) * 8 + hh) * 128;
        bf16x8 af[4];
#pragma unroll
        for (int ks = 0; ks < 4; ++ks) af[ks] = *(const LAS bf16x8*)(Oall + 32 * ks + 8 * g);
#pragma unroll
        for (int nb = 0; nb < 4; ++nb) {
            f32x4 a = (f32x4){0.f, 0.f, 0.f, 0.f};
#pragma unroll
            for (int ks = 0; ks < 4; ++ks) { const bf16x8 bf = *(const bf16x8*)(WuvT + (16 * nb + n16) * 128 + 32 * ks + 8 * g);
                a = __builtin_amdgcn_mfma_f32_16x16x32_bf16(af[ks], bf, a, 0, 0, 0); }
            if (g < 2) {
#pragma unroll
                for (int i = 0; i < 4; ++i) H[(size_t)(t0 + 4 * g + i) * DM + 512 + hh * 64 + 16 * nb + n16] = f2bf(a[i]);
            }
        }
    }
    __syncthreads();
}

template <int STOP> __device__ __forceinline__ void phase(const Params& p, LAS unsigned char* lds, int tid, int lane, int wave) {
    const int G = gridDim.x, k = blockIdx.x;
    const bool nice = (G == 256);
    const int nit = nice ? 16 : (4096 - k + G - 1) / G;
    for (int i = 0; i < nit; ++i) {
        int b, qt;
        if (nice) { const int j = k >> 3; b = k & 7; qt = 511 - (i * 32 + ((i & 1) ? 31 - j : j)); }
        else { const int u = k + i * G; b = u & 7; qt = 511 - (u >> 3); }
        unit<STOP>(p, lds, tid, lane, wave, b, qt);
    }
}
}

#define XB_TMO      128
#define XB_XCNT(j)  (256  + 64 * (j))
#define XB_XSUB(j)  (1280 + 64 * (j))
#define XB_XGEN(j)  (2304 + 64 * (j))
#define XB_TOP      3328
#define XB_TOPGEN   3392
#define XCD_BAR_WORDS 3456
#define XB_SPIN_CAP (1u << 22)
__device__ __forceinline__ unsigned xb_ld(unsigned* p)              { return __hip_atomic_load(p, __ATOMIC_RELAXED, __HIP_MEMORY_SCOPE_AGENT); }
__device__ __forceinline__ unsigned xb_add(unsigned* p, unsigned v) { return __hip_atomic_fetch_add(p, v, __ATOMIC_RELAXED, __HIP_MEMORY_SCOPE_AGENT); }
__device__ __forceinline__ unsigned xb_xcc_id() { return (unsigned)__builtin_amdgcn_s_getreg((3 << 11) | 20) & 0xFu; }
#define XB_SPIN(cond, bar) do { unsigned _sp = 0; while (cond) { __builtin_amdgcn_s_sleep(1); \
    if ((++_sp & 255u) == 0u) { if (xb_ld(&(bar)[XB_TMO])) break; if (_sp > XB_SPIN_CAP) { atomicAdd(&(bar)[XB_TMO], 1u); break; } } } } while (0)
struct XcdBarrier { unsigned* bar; unsigned x; volatile LAS unsigned* st; };
__device__ __forceinline__ XcdBarrier xcd_barrier_post(unsigned* bar, volatile LAS unsigned* st) {
    XcdBarrier b; b.bar = bar; b.x = xb_xcc_id(); b.st = st;
    if (threadIdx.x == 0) (void)xb_add(&bar[XB_XCNT(b.x)], 1u);
    return b;
}
__device__ __forceinline__ void xcd_barrier_complete(unsigned* bar, unsigned x, unsigned& nloc, unsigned& nx) {
    const unsigned G = gridDim.x * gridDim.y * gridDim.z;
    unsigned sum, cnt, mine, sp = 0u;
    for (;;) {
        sum = 0u; cnt = 0u; mine = 0u;
#pragma unroll
        for (unsigned j = 0; j < 16; ++j) { const unsigned c = xb_ld(&bar[XB_XCNT(j)]); sum += c; cnt += (c > 0u) ? 1u : 0u; mine = (j == x) ? c : mine; }
        if (sum == G) break;
        __builtin_amdgcn_s_sleep(1);
        if ((++sp & 255u) == 0u) { if (xb_ld(&bar[XB_TMO])) break; if (sp > XB_SPIN_CAP) { atomicAdd(&bar[XB_TMO], 1u); break; } }
    }
    nloc = mine > 0u ? mine : 1u; nx = cnt > 0u ? cnt : 1u;
}
__device__ __forceinline__ void xcd_barrier(const XcdBarrier& b) {
    asm volatile("s_waitcnt vmcnt(0)" ::: "memory");
    __syncthreads();
    if (threadIdx.x == 0) {
        unsigned* bar = b.bar;
        __builtin_amdgcn_s_waitcnt(0);
        unsigned nloc = b.st[0], nx = b.st[1];
        if (nloc == 0u) { xcd_barrier_complete(bar, b.x, nloc, nx); b.st[0] = nloc; b.st[1] = nx; }
        const unsigned old = xb_add(&bar[XB_XSUB(b.x)], 1u);
        const unsigned gen = old / nloc;
        if (old + 1u == (gen + 1u) * nloc) {
            __builtin_amdgcn_fence(__ATOMIC_RELEASE, "agent");
            asm volatile("s_waitcnt vmcnt(0)" ::: "memory");
            const unsigned og = xb_add(&bar[XB_TOP], 1u);
            const unsigned tg = og / nx;
            if (og + 1u == (tg + 1u) * nx) xb_add(&bar[XB_TOPGEN], 1u);
            else XB_SPIN(xb_ld(&bar[XB_TOPGEN]) == tg, bar);
            __builtin_amdgcn_fence(__ATOMIC_ACQUIRE, "agent");
            xb_add(&bar[XB_XGEN(b.x)], 1u);
            asm volatile("s_waitcnt vmcnt(0)" ::: "memory");
        } else {
            XB_SPIN(xb_ld(&bar[XB_XGEN(b.x)]) == gen, bar);
            __builtin_amdgcn_fence(__ATOMIC_ACQUIRE, "agent");
            asm volatile("s_waitcnt vmcnt(0)" ::: "memory");
        }
    }
    __syncthreads();
}
constexpr int N_PHASES = 10;
__global__ void __launch_bounds__(NTHREADS, 2) mega(Params p) {
    extern __shared__ __attribute__((aligned(16))) unsigned char lds_raw[];
    LAS unsigned char* lds = (LAS unsigned char*)lds_raw;
    cg::grid_group grid = cg::this_grid();
    int tid = threadIdx.x, lane = tid & 63; const int wave = __builtin_amdgcn_readfirstlane(tid >> 6);
#define FRESH() do { tid = threadIdx.x; asm volatile("" : "+v"(tid)); lane = tid & 63; } while (0)
    unsigned char* ws = p.ws;
    const int lo = p.ph_lo, hi = p.ph_hi;
    volatile LAS unsigned* MISC = (volatile LAS unsigned*)(lds + LDS_MISC);
    if (tid < 16) MISC[tid] = 0u;
    __syncthreads();
    XcdBarrier bar = xcd_barrier_post((unsigned*)(ws + WS_CTL), MISC);
#define IN(k) (lo <= (k) && (k) < hi)
#define SEAM(k) do { if (IN(k) && IN((k) + 1)) { if ((k) == 0) grid.sync(); else xcd_barrier(bar); } } while (0)
    if (IN(0)) { FRESH(); phase_prep(p, lds, tid, lane, wave); } SEAM(0);
    if (IN(1)) { FRESH(); phase_norm1(p, lds, tid, lane, wave); } SEAM(1);
    if (IN(2)) { FRESH();
        gp::Gemm g{(const bf16_t*)(ws + WS_H), (const bf16_t*)(ws + WS_WINT), NPJ, DM, nullptr};
        gp::StaticOrder S; S.init(NTOK, NPJ, gridDim.x, blockIdx.x);
        LAS float* gl = (LAS float*)(lds + LDS_RING + 8192);
        if (tid < 64) { gl[tid] = p.in[8][tid]; gl[64 + tid] = p.in[9][tid]; gl[128 + tid] = p.in[12][tid]; gl[192 + tid] = p.in[13][tid]; }
        if (tid < 128) gl[256 + tid] = p.in[14][tid];
        __syncthreads();
        gp::EpiInproj E{(bf16_t*)(ws + WS_PROJ), (const float*)(ws + WS_ROPE), gl, (LAS float*)(lds + LDS_RING), ws + WS_IKF};
        gp::gemm_phase<gp::EpiInproj, gp::StaticOrder, false>(lds, g, S, E);
    } SEAM(2);
    if (IN(3)) { FRESH(); da::phase(p, lds, tid, lane, wave); FRESH(); ds::phase<0>(p, lds, tid, lane, wave);  } SEAM(3);
    if (IN(4)) { FRESH();
        gp::Gemm g{(const bf16_t*)(ws + WS_H), (const bf16_t*)(ws + WS_WOUTT), DM, DM, nullptr};
        gp::StaticOrder S; S.init(NTOK, DM, gridDim.x, blockIdx.x);
        gp::EpiResid E{p.in[0], p.out, (const float*)(ws + WS_MOD)};
        gp::gemm_phase<gp::EpiResid, gp::StaticOrder, false>(lds, g, S, E);
    } SEAM(4);
    if (IN(5)) { FRESH(); phase_norm2(p, lds, tid, lane, wave); } SEAM(5);
    if (IN(6)) { FRESH(); phase_scatter(p, lds, tid, lane, wave); } SEAM(6);
    if (IN(7)) { FRESH();
        const int* tile_e = (const int*)(ws + WS_TILEE);
        gp::Gemm g{(const bf16_t*)(ws + WS_H), (const bf16_t*)(ws + WS_WGUT), 2048, DM, (const int*)(ws + WS_ROWSRC)};
        gp::MoeOrder S{tile_e, tile_e[MAXTILES], 8, (int)blockIdx.x, (int)gridDim.x};
        gp::EpiSwiglu E{(bf16_t*)(ws + WS_ACT), p.in[19], p.in[21]};
        gp::gemm_phase<gp::EpiSwiglu, gp::MoeOrder, true>(lds, g, S, E);
    } SEAM(7);
    if (IN(8)) { FRESH();
        const int* tile_e = (const int*)(ws + WS_TILEE);
        gp::Gemm g{(const bf16_t*)(ws + WS_ACT), (const bf16_t*)(ws + WS_WDT), DM, DM, nullptr};
        gp::MoeOrder S{tile_e, tile_e[MAXTILES], 4, (int)blockIdx.x, (int)gridDim.x};
        gp::EpiDown E{p.out, (bf16_t*)(ws + WS_Y), p.in[23], (const float*)(ws + WS_MOD), (const int*)(ws + WS_ROWTOK), (const float*)(ws + WS_TOPG)};
        gp::gemm_phase<gp::EpiDown, gp::MoeOrder, false>(lds, g, S, E);
    } SEAM(8);
    if (IN(9)) { FRESH(); phase_combine(p, tid); }
#undef IN
#undef SEAM
}

static int g_grid = 0;
static void launch_mega(const Params& base, int lo, int hi, hipStream_t stream) {
    Params p = base; p.ph_lo = lo; p.ph_hi = hi;
    void* args[] = {&p};
    hipError_t e = hipLaunchCooperativeKernel((const void*)mega, dim3(g_grid), dim3(NTHREADS), args, LDS_BYTES, stream);
    if (e != hipSuccess) fprintf(stderr, "kernel_launch: cooperative launch [%d,%d) failed: %s (grid %d)\n", lo, hi, hipGetErrorString(e), g_grid);
}
extern "C" void kernel_launch(void* const* d_in, const int* in_sizes, int n_in, void* d_out, int out_size, void* d_ws, size_t ws_size, hipStream_t stream) {
    if (ws_size < WS_END) { fprintf(stderr, "kernel_launch: workspace too small: %zu < %zu\n", ws_size, (size_t)WS_END); return; }
    if (g_grid == 0) {
        int dev = 0, cus = 0, per_cu = 0;
        hipGetDevice(&dev); hipDeviceGetAttribute(&cus, hipDeviceAttributeMultiprocessorCount, dev);
        if (hipFuncSetAttribute((const void*)mega, hipFuncAttributeMaxDynamicSharedMemorySize, LDS_BYTES) != hipSuccess) fprintf(stderr, "kernel_launch: hipFuncSetAttribute failed\n");
        hipOccupancyMaxActiveBlocksPerMultiprocessor(&per_cu, (const void*)mega, NTHREADS, LDS_BYTES);
        (void)hipGetLastError();
        if (per_cu < 1) { fprintf(stderr, "kernel_launch: occupancy query says %d blocks/CU\n", per_cu); per_cu = 1; }
        g_grid = cus * 1;
        fprintf(stderr, "kernel_launch: cus %d per_cu %d grid %d\n", cus, per_cu, g_grid);
    }
    const float* x = (const float*)d_in[0];
    float* out = (float*)d_out; char* ws = (char*)d_ws;
    float* mod = (float*)(ws + WS_MOD); float* rope = (float*)(ws + WS_ROPE); float* lam = (float*)(ws + WS_LAM);
    float* IW = (float*)(ws + WS_IW);
    bf16_t* H = (bf16_t*)(ws + WS_H); bf16_t* PROJ = (bf16_t*)(ws + WS_PROJ);
    Params P{};
    for (int i = 0; i < 24; ++i) P.in[i] = (const float*)d_in[i];
    P.out = out; P.ws = (unsigned char*)d_ws;

    (void)hipMemsetAsync((char*)d_ws + WS_CTL, 0, 16384, stream);
    launch_mega(P, 0, N_PHASES, stream);
    (void)rope; (void)lam; (void)IW; (void)H; (void)PROJ;
    (void)x; (void)mod;
}
```

```cpp
#include <hip/hip_runtime.h>
#include <stdint.h>
#include <cstdio>

typedef unsigned short bf16_t;
__device__ __forceinline__ float bf2f(bf16_t v) { return __uint_as_float(((unsigned)v) << 16); }
__device__ __forceinline__ bf16_t f2bf(float f) { unsigned u = __float_as_uint(f); return (bf16_t)((u + 0x7fffu + ((u >> 16) & 1u)) >> 16); }

constexpr int NB = 8, SEQ = 4096, DM = 1024, NTOK = NB * SEQ;
constexpr int NIN = 2824, NPJ = 2816;
constexpr int C_AQ1 = 0, C_AQ2 = 256, C_AK1 = 512, C_AK2 = 768, C_AV = 1024, C_BQ = 1536, C_BK = 2048, C_BLAT = 2112, C_IQ = 2240, C_IK = 2752, C_IW = 2816;
constexpr int NEXP = 32, TOPK = 4, NPAIR = NTOK * TOPK;
constexpr int MAXTILES = NPAIR / 256 + NEXP;
constexpr int PPAD = MAXTILES * 256;
constexpr int NCHUNK = 256, CHTOK = NTOK / NCHUNK;
constexpr float RMS_EPS = 1e-6f;
constexpr float LAMBDA_INIT = 0.2f;

constexpr size_t MiB = 1u << 20;
constexpr size_t WS_CTL = 0;
constexpr size_t WS_MOD = 1 * MiB;
constexpr size_t WS_ROPE = WS_MOD + 256 * 1024;
constexpr size_t WS_LAM = WS_ROPE + 256 * 1024;
constexpr size_t WS_CHCNT = WS_LAM + 4096;
constexpr size_t WS_TILEE = WS_CHCNT + 32768;
constexpr size_t WS_TOPI = 2 * MiB;
constexpr size_t WS_TOPG = WS_TOPI + 512 * 1024;
constexpr size_t WS_ROWTOK = 3 * MiB;
constexpr size_t WS_ROWSRC = 3 * MiB + 640 * 1024;
constexpr size_t WS_IW = 5 * MiB;
constexpr size_t WS_ROWMETA = 6 * MiB;
constexpr size_t WS_WINT = 8 * MiB;
constexpr size_t WS_WOUTT = 14 * MiB;
constexpr size_t WS_WUVT = 16 * MiB;
constexpr size_t WS_WDT = 17 * MiB;
constexpr size_t WS_WGUT = 81 * MiB;
constexpr size_t WS_H = 209 * MiB;
constexpr size_t WS_PROJ = 273 * MiB;
constexpr size_t WS_ACT = WS_PROJ;
constexpr size_t WS_Y = WS_WGUT;
constexpr size_t WS_IKF = WS_ACT + (size_t)PPAD * 1024 * 2;
constexpr size_t WS_END = WS_IKF + 4 * MiB;

namespace gp {
#define GP_LAS __attribute__((address_space(3)))
typedef short bf16x8 __attribute__((ext_vector_type(8)));
typedef float f32x4 __attribute__((ext_vector_type(4)));
typedef unsigned u32x4 __attribute__((ext_vector_type(4)));
constexpr int BM = 256, BK = 64, HALF = 128, HTB = HALF * BK * 2  , STAGE_BYTES = 8 * HTB;

__host__ __device__ __forceinline__ int lds_byte(int r, int c) { const int st = (r >> 4) * 2 + (c >> 5), rr = r & 15, cc = c & 31, ob = rr * 64 + cc * 2; return st * 1024 + (ob ^ (((ob >> 9) & 1) << 5)); }
__host__ __device__ __forceinline__ void stage_rc(int b, int& R, int& C) { const int st = b / 1024, sb = b % 1024, swz = sb ^ (((sb >> 9) & 1) << 5); R = (st >> 1) * 16 + swz / 64; C = (st & 1) * 32 + (swz % 64) / 2; }
__host__ __device__ __forceinline__ int perm32(int rho) { const int n = rho >> 4, i = rho & 15; return 8 * (i >> 2) + 4 * n + (i & 3); }

struct Unit { int pm, pn, e; };
struct Gemm { const bf16_t* A; const bf16_t* Bt; int N, K; const int* rowsrc; };

struct StaticOrder {
    int nM, nN, nwg, G, c;
    __device__ void init(int M, int N, int G_, int c_) { nM = M / BM; nN = N / BM; nwg = nM * nN; G = G_; c = c_; }
    __device__ bool next(int i, Unit& u) const {
        const long L = (long)i * G + c; if (L >= nwg) return false;
        int wgid = (int)L; { const int q = nwg / 8, r = nwg % 8, xcd = wgid % 8, off = wgid / 8; wgid = (xcd < r ? xcd * (q + 1) : r * (q + 1) + (xcd - r) * q) + off; }
        const int nig = 8 * nN, gid = wgid / nig, fm = gid * 8, gsz = (nM - fm) < 8 ? (nM - fm) : 8;
        u.pm = fm + ((wgid % nig) % gsz); u.pn = (wgid % nig) / gsz; u.e = 0; return true;
    }
};
struct MoeOrder {
    const int* tile_e; int ntiles, nN, c, G;
    __device__ bool next(int i, Unit& u) const {
        const int j = c >> 3, x = c & 7, tpx = (G >> 3) / nN;
        const int tile = i * (tpx * 8) + x * tpx + j / nN;
        if (tile >= ntiles) return false;
        u.pm = tile; u.pn = j % nN; u.e = tile_e[tile]; return true;
    }
};

__device__ __forceinline__ unsigned cvt_pk_bf16(float lo, float hi) { unsigned r; asm volatile("v_cvt_pk_bf16_f32 %0, %1, %2" : "=v"(r) : "v"(lo), "v"(hi)); return r; }

struct EpiBf16 {
    bf16_t* O; int ldc;
    __device__ __forceinline__ void operator()(const f32x4 (&acc)[2][2][4][2], const Unit& u, int wr, int wc, int fr, int fq) const {
        const int row0 = u.pm * BM + wr * 64 + fr, col0 = u.pn * BM + wc * 32 + 8 * fq;
#pragma unroll
        for (int ai = 0; ai < 2; ++ai)
#pragma unroll
            for (int m = 0; m < 4; ++m) { bf16_t* rowp = O + (size_t)(row0 + ai * HALF + m * 16) * ldc + col0;
#pragma unroll
                for (int bj = 0; bj < 2; ++bj) { const f32x4 v0 = acc[ai][bj][m][0], v1 = acc[ai][bj][m][1];
                    u32x4 w; w.x = cvt_pk_bf16(v0[0], v0[1]); w.y = cvt_pk_bf16(v0[2], v0[3]); w.z = cvt_pk_bf16(v1[0], v1[1]); w.w = cvt_pk_bf16(v1[2], v1[3]);
                    *(u32x4*)(rowp + bj * HALF) = w; } }
    }
};

struct EpiInproj {
    bf16_t* O; const float* rope; GP_LAS const float* gl; GP_LAS float* xch; unsigned char* ikf;
    __device__ __forceinline__ void operator()(const f32x4 (&acc)[2][2][4][2], const Unit& u, int wr, int wc, int fr, int fq) const {
        const int wid = wr * 4 + wc, row0 = u.pm * BM + wr * 64 + fr, col0 = u.pn * BM + wc * 32 + 8 * fq, lc = (wc & 1) * 32 + 8 * fq;
        int mode[2]; int goff[2];
#pragma unroll
        for (int bj = 0; bj < 2; ++bj) { const int gc = u.pn * BM + bj * HALF + (wc >> 1) * 64; goff[bj] = 0;
            if (gc < 512) { mode[bj] = 1; goff[bj] = lc; } else if (gc < 1024) { mode[bj] = 1; goff[bj] = 64 + lc; } else if (gc < 1536) { mode[bj] = 0; }
            else if (gc < 2048) { mode[bj] = 1; goff[bj] = 128 + lc; } else if (gc < 2112) { mode[bj] = 1; goff[bj] = 192 + lc; }
            else if (gc < 2240) { mode[bj] = 3; goff[bj] = 256 + (gc - 2112) + lc; } else { mode[bj] = 2; } }
#pragma unroll
        for (int ai = 0; ai < 2; ++ai)
#pragma unroll
            for (int m = 0; m < 4; ++m)
#pragma unroll
                for (int bj = 0; bj < 2; ++bj) { const f32x4 a = acc[ai][bj][m][0], b = acc[ai][bj][m][1];
                    float s = ((a[0] * a[0] + a[1] * a[1]) + (a[2] * a[2] + a[3] * a[3])) + ((b[0] * b[0] + b[1] * b[1]) + (b[2] * b[2] + b[3] * b[3]));
                    s += __shfl_xor(s, 16); s += __shfl_xor(s, 32);
                    if (fq == 0) xch[(wid * 2 + bj) * 128 + ai * 64 + m * 16 + fr] = s; }
        asm volatile("s_waitcnt lgkmcnt(0)" ::: "memory"); __builtin_amdgcn_s_barrier(); asm volatile("" ::: "memory");
#pragma unroll
        for (int ai = 0; ai < 2; ++ai)
#pragma unroll
            for (int m = 0; m < 4; ++m) { int rl = ai * 64 + m * 16 + fr, row = row0 + ai * HALF + m * 16; asm volatile("" : "+v"(rl), "+v"(row)); const int pos = row % SEQ;
                bf16_t* rowp = O + (size_t)row * NPJ + col0;
#pragma unroll
                for (int bj = 0; bj < 2; ++bj) { f32x4 v0 = acc[ai][bj][m][0], v1 = acc[ai][bj][m][1];
                    if (mode[bj] == 1 || mode[bj] == 3) {
                        float tot = xch[(wid * 2 + bj) * 128 + rl] + xch[((wid ^ 1) * 2 + bj) * 128 + rl];
                        if (mode[bj] == 3) tot += xch[((wr * 4 + (wc ^ 2)) * 2 + (bj ^ 1)) * 128 + rl] + xch[((wr * 4 + (wc ^ 3)) * 2 + (bj ^ 1)) * 128 + rl];
                        const float r = 1.0f / sqrtf(tot * (mode[bj] == 3 ? (1.f / 128.f) : (1.f / 64.f)) + RMS_EPS);
                        const f32x4 g0 = *(GP_LAS const f32x4*)(gl + goff[bj]), g1 = *(GP_LAS const f32x4*)(gl + goff[bj] + 4);
                        v0 = v0 * r * g0; v1 = v1 * r * g1; }
                    if ((mode[bj] == 1 || mode[bj] == 2) && (wc & 1) == 0) {
                        f32x4 o0, o1;
#pragma unroll
                        for (int i = 0; i < 4; ++i) { o0[i] = __shfl_xor(v0[i], 16); o1[i] = __shfl_xor(v1[i], 16); }
                        if (fq < 2) { const float* rp = rope + pos * 16; const float sg = fq == 0 ? -1.0f : 1.0f;
                            const f32x4 t0 = *(const f32x4*)(rp), t1 = *(const f32x4*)(rp + 4), t2 = *(const f32x4*)(rp + 8), t3 = *(const f32x4*)(rp + 12);
                            v0[0] = v0[0] * t0[0] + sg * o0[0] * t0[1]; v0[1] = v0[1] * t0[2] + sg * o0[1] * t0[3];
                            v0[2] = v0[2] * t1[0] + sg * o0[2] * t1[1]; v0[3] = v0[3] * t1[2] + sg * o0[3] * t1[3];
                            v1[0] = v1[0] * t2[0] + sg * o1[0] * t2[1]; v1[1] = v1[1] * t2[2] + sg * o1[1] * t2[3];
                            v1[2] = v1[2] * t3[0] + sg * o1[2] * t3[1]; v1[3] = v1[3] * t3[2] + sg * o1[3] * t3[3]; } }
                    u32x4 w; w.x = cvt_pk_bf16(v0[0], v0[1]); w.y = cvt_pk_bf16(v0[2], v0[3]); w.z = cvt_pk_bf16(v1[0], v1[1]); w.w = cvt_pk_bf16(v1[2], v1[3]);
                    *(u32x4*)(rowp + bj * HALF) = w;
                    if (u.pn == 10 && bj == 1 && wc >= 2) {
                        const int key = row % SEQ, c8 = (wc & 1) * 4 + fq;
                        *(u32x4*)(ikf + ((size_t)((((row / SEQ) * 128 + (key >> 5)) * 4 + (c8 >> 1)) * 64 + (c8 & 1) * 32 + (key & 31)) << 4)) = w; } }
                asm volatile("" ::: "memory"); }
    }
};
struct EpiResid {
    const float* x; float* out; const float* mod;
    __device__ __forceinline__ void operator()(const f32x4 (&acc)[2][2][4][2], const Unit& u, int wr, int wc, int fr, int fq) const {
        const int row0 = u.pm * BM + wr * 64 + fr, col0 = u.pn * BM + wc * 32 + 8 * fq, b = (u.pm * BM) / SEQ;
        f32x4 gv[2][2];
#pragma unroll
        for (int bj = 0; bj < 2; ++bj)
#pragma unroll
            for (int n = 0; n < 2; ++n) gv[bj][n] = *(const f32x4*)(mod + b * 6144 + 2 * 1024 + col0 + bj * HALF + 4 * n);
#pragma unroll
        for (int ai = 0; ai < 2; ++ai)
#pragma unroll
            for (int m = 0; m < 4; ++m) { const size_t off = (size_t)(row0 + ai * HALF + m * 16) * DM + col0;
#pragma unroll
                for (int bj = 0; bj < 2; ++bj)
#pragma unroll
                    for (int n = 0; n < 2; ++n) { const f32x4 xv = *(const f32x4*)(x + off + bj * HALF + 4 * n);
                        *(f32x4*)(out + off + bj * HALF + 4 * n) = xv + gv[bj][n] * acc[ai][bj][m][n]; }
                asm volatile("" ::: "memory"); }
    }
};
struct EpiSwiglu {
    bf16_t* act; const float* bg; const float* bu;
    __device__ __forceinline__ void operator()(const f32x4 (&acc)[2][2][4][2], const Unit& u, int wr, int wc, int fr, int fq) const {
        const int row0 = u.pm * BM + wr * 64 + fr, ff0 = u.pn * HALF + wc * 32 + 8 * fq;
        f32x4 bgv[2], buv[2];
#pragma unroll
        for (int n = 0; n < 2; ++n) { bgv[n] = *(const f32x4*)(bg + u.e * 1024 + ff0 + 4 * n); buv[n] = *(const f32x4*)(bu + u.e * 1024 + ff0 + 4 * n); }
#pragma unroll
        for (int ai = 0; ai < 2; ++ai)
#pragma unroll
            for (int m = 0; m < 4; ++m) {
                float a[8];
#pragma unroll
                for (int n = 0; n < 2; ++n) { const f32x4 g4 = acc[ai][0][m][n] + bgv[n], u4 = acc[ai][1][m][n] + buv[n];
#pragma unroll
                    for (int j = 0; j < 4; ++j) { const float g = fminf(g4[j], 7.0f), uu = fminf(fmaxf(u4[j], -7.0f), 7.0f);
                        const float sg = __builtin_amdgcn_rcpf(1.0f + __builtin_amdgcn_exp2f(-1.702f * 1.4426950408889634f * g));
                        a[4 * n + j] = g * sg * (uu + 1.0f); } }
                u32x4 w; w.x = cvt_pk_bf16(a[0], a[1]); w.y = cvt_pk_bf16(a[2], a[3]); w.z = cvt_pk_bf16(a[4], a[5]); w.w = cvt_pk_bf16(a[6], a[7]);
                *(u32x4*)(act + (size_t)(row0 + ai * HALF + m * 16) * 1024 + ff0) = w; }
    }
};
struct EpiDown {
    float* out; bf16_t* Y; const float* bd; const float* mod; const int2* rowmeta;
    __device__ __forceinline__ void operator()(const f32x4 (&acc)[2][2][4][2], const Unit& u, int wr, int wc, int fr, int fq) const {
        const int row0 = u.pm * BM + wr * 64 + fr, col0 = u.pn * BM + wc * 32 + 8 * fq;
        f32x4 bv[2][2];
#pragma unroll
        for (int bj = 0; bj < 2; ++bj)
#pragma unroll
            for (int n = 0; n < 2; ++n) bv[bj][n] = *(const f32x4*)(bd + u.e * 1024 + col0 + bj * HALF + 4 * n);
        int2 meta[2][4];
#pragma unroll
        for (int ai = 0; ai < 2; ++ai)
#pragma unroll
            for (int m = 0; m < 4; ++m) meta[ai][m] = rowmeta[row0 + ai * HALF + m * 16];
#pragma unroll
        for (int ai = 0; ai < 2; ++ai)
#pragma unroll
            for (int m = 0; m < 4; ++m) {
                const int ent = meta[ai][m].x;
                if (ent >= 0) {
                    const int tok = ent >> 2, kk = ent & 3; const float gt = __int_as_float(meta[ai][m].y);
                    if (kk == 0) { const float* g2 = mod + (tok / SEQ) * 6144 + 5 * 1024 + col0; float* op = out + (size_t)tok * DM + col0;
#pragma unroll
                        for (int bj = 0; bj < 2; ++bj)
#pragma unroll
                            for (int n = 0; n < 2; ++n) { const f32x4 g4 = *(const f32x4*)(g2 + bj * HALF + 4 * n), o4 = *(const f32x4*)(op + bj * HALF + 4 * n);
                                *(f32x4*)(op + bj * HALF + 4 * n) = o4 + g4 * ((acc[ai][bj][m][n] + bv[bj][n]) * gt); }
                    } else { bf16_t* yp = Y + ((size_t)(kk - 1) * NTOK + tok) * DM + col0;
#pragma unroll
                        for (int bj = 0; bj < 2; ++bj) { const f32x4 v0 = (acc[ai][bj][m][0] + bv[bj][0]) * gt, v1 = (acc[ai][bj][m][1] + bv[bj][1]) * gt;
                            u32x4 w; w.x = cvt_pk_bf16(v0[0], v0[1]); w.y = cvt_pk_bf16(v0[2], v0[3]); w.z = cvt_pk_bf16(v1[0], v1[1]); w.w = cvt_pk_bf16(v1[2], v1[3]);
                            *(u32x4*)(yp + bj * HALF) = w; } }
                }
                asm volatile("" ::: "memory"); }
    }
};

template <class Epi, class Sched, bool GATHER>
__device__ __forceinline__ void gemm_phase(GP_LAS unsigned char* lds, const Gemm g, const Sched& S, const Epi& E) {
    const int tid = threadIdx.x, wid = __builtin_amdgcn_readfirstlane(tid >> 6), lane = tid & 63, wr = wid >> 2, wc = wid & 3, fr = lane & 15, fq = lane >> 4;
    const int K = g.K, nt = K / BK;
    unsigned voffB[2];
#pragma unroll
    for (int i = 0; i < 2; ++i) { int R, C; stage_rc(tid * 16 + i * 8192, R, C); const int Rb = (R & ~31) + perm32(R & 31); voffB[i] = (unsigned)(Rb * K + C) * 2u; }
    const size_t kstep = (size_t)(BK * 2);
    const size_t hstep = (size_t)HALF * K * 2;
    const size_t tstep = 2 * hstep;
    const unsigned ldsw = (unsigned)wid * 1024u;
    const int aoff = lds_byte(wr * 64 + fr, fq * 8), boff = lds_byte(wc * 32 + fr, fq * 8);
#define GP_SA(b, h) (((b) * 2 + (h)) * HTB)
#define GP_SB(b, h) ((4 + (b) * 2 + (h)) * HTB)
#define GP_STAGE(bufoff, gbase, voff) do { _Pragma("unroll") for (int _i = 0; _i < 2; ++_i) \
        __builtin_amdgcn_global_load_lds((const unsigned*)((const char*)(gbase) + (voff)[_i]), (GP_LAS unsigned*)(lds + (bufoff) + ldsw + _i * 8192), 16, 0, 0); } while (0)
#define GP_LDA(dst, b, h) do { _Pragma("unroll") for (int m = 0; m < 4; ++m) _Pragma("unroll") for (int k = 0; k < 2; ++k) dst[m][k] = *(const GP_LAS bf16x8*)(lds + GP_SA(b, h) + aoff + m * 2048 + k * 1024); } while (0)
#define GP_LDB(dst, b, h) do { _Pragma("unroll") for (int n = 0; n < 2; ++n) _Pragma("unroll") for (int k = 0; k < 2; ++k) dst[n][k] = *(const GP_LAS bf16x8*)(lds + GP_SB(b, h) + boff + n * 2048 + k * 1024); } while (0)
#define GP_MMA(ai, bj, At, Bt) do { __builtin_amdgcn_s_setprio(1); _Pragma("unroll") for (int m = 0; m < 4; ++m) _Pragma("unroll") for (int n = 0; n < 2; ++n) _Pragma("unroll") for (int k = 0; k < 2; ++k) \
        acc[ai][bj][m][n] = __builtin_amdgcn_mfma_f32_16x16x32_bf16(Bt[n][k], At[m][k], acc[ai][bj][m][n], 0, 0, 0); __builtin_amdgcn_s_setprio(0); } while (0)
#define GP_WAIT_V(n) asm volatile("s_waitcnt vmcnt(" #n ")" ::: "memory")
#define GP_WAIT_L(n) asm volatile("s_waitcnt lgkmcnt(" #n ")" ::: "memory")
#define GP_BAR __builtin_amdgcn_s_barrier()
#define GP_SCHED __builtin_amdgcn_sched_barrier(0)
#define GP_AOFFS(u_, v0_, v1_) do { _Pragma("unroll") for (int _i = 0; _i < 2; ++_i) { int R_, C_; stage_rc(tid * 16 + _i * 8192, R_, C_); int r0_ = (u_).pm * BM + R_, r1_ = r0_ + HALF; \
        if (GATHER) { r0_ = g.rowsrc[r0_]; r1_ = g.rowsrc[r1_]; } \
        v0_[_i] = (unsigned)(r0_ * K + C_) * 2u; v1_[_i] = (unsigned)(r1_ * K + C_) * 2u; } } while (0)
    Unit cur, nxt; int ui = 0;
    if (!S.next(0, cur)) return;
    f32x4 acc[2][2][4][2];
#pragma unroll
    for (int a = 0; a < 2; ++a)
#pragma unroll
        for (int b = 0; b < 2; ++b)
#pragma unroll
            for (int m = 0; m < 4; ++m)
#pragma unroll
                for (int n = 0; n < 2; ++n) acc[a][b][m][n] = (f32x4){0.f, 0.f, 0.f, 0.f};
    bf16x8 At[4][2], B0[2][2], B1[2][2];
    unsigned vA0[2], vA1[2], nA0[2], nA1[2];
    GP_AOFFS(cur, vA0, vA1);
    const char* Ab = (const char*)g.A;
    const char* cB = (const char*)g.Bt + ((size_t)cur.e * g.N + (size_t)cur.pn * BM) * K * 2;
    GP_STAGE(GP_SB(0, 0), cB, voffB); GP_STAGE(GP_SB(0, 1), cB + hstep, voffB); GP_STAGE(GP_SA(0, 0), Ab, vA0); GP_STAGE(GP_SA(0, 1), Ab, vA1);
    if (wr == 1) GP_BAR;
    GP_WAIT_V(2); GP_BAR;
    GP_STAGE(GP_SB(1, 0), cB + kstep, voffB); GP_STAGE(GP_SA(1, 0), Ab + kstep, vA0); GP_STAGE(GP_SB(1, 1), cB + hstep + kstep, voffB);
    GP_WAIT_V(6); GP_BAR;
    for (;;) {
        const bool has_next = S.next(ui + 1, nxt);
        const char* nB = cB;
        if (has_next) { nB = (const char*)g.Bt + ((size_t)nxt.e * g.N + (size_t)nxt.pn * BM) * K * 2; GP_AOFFS(nxt, nA0, nA1); }
        else { nA0[0] = vA0[0]; nA0[1] = vA0[1]; nA1[0] = vA1[0]; nA1[1] = vA1[1]; }
        for (int t = 0; t < nt; t += 2) {
            const bool last = (t == nt - 2);
            const char* a1 = Ab + (size_t)(t + 1) * kstep;
            const char* a2 = last ? Ab : Ab + (size_t)(t + 2) * kstep; const char* b2 = last ? nB : cB + (size_t)(t + 2) * kstep;
            const char* a3 = a2 + kstep; const char* b3 = b2 + kstep;
            GP_LDB(B0, 0, 0); GP_LDB(B1, 0, 1); GP_SCHED; GP_LDA(At, 0, 0); GP_STAGE(GP_SA(1, 1), a1, vA1);
            if (last) { vA0[0] = nA0[0]; vA0[1] = nA0[1]; vA1[0] = nA1[0]; vA1[1] = nA1[1]; }
            GP_WAIT_V(8); GP_WAIT_L(0); GP_BAR; GP_MMA(0, 0, At, B0); GP_MMA(0, 1, At, B1); GP_BAR; GP_SCHED;
            GP_LDA(At, 0, 1); GP_STAGE(GP_SB(0, 0), b2, voffB); GP_STAGE(GP_SB(0, 1), b2 + hstep, voffB); GP_STAGE(GP_SA(0, 0), a2, vA0);
            GP_WAIT_V(8); GP_WAIT_L(0); GP_BAR; GP_MMA(1, 0, At, B0); GP_MMA(1, 1, At, B1); GP_BAR; GP_SCHED;
            GP_LDB(B0, 1, 0); GP_LDB(B1, 1, 1); GP_SCHED; GP_LDA(At, 1, 0); GP_STAGE(GP_SA(0, 1), a2, vA1);
            GP_WAIT_V(8); GP_WAIT_L(0); GP_BAR; GP_MMA(0, 0, At, B0); GP_MMA(0, 1, At, B1); GP_BAR; GP_SCHED;
            GP_LDA(At, 1, 1); GP_STAGE(GP_SB(1, 0), b3, voffB); GP_STAGE(GP_SB(1, 1), b3 + hstep, voffB); GP_STAGE(GP_SA(1, 0), a3, vA0);
            GP_WAIT_V(8); GP_WAIT_L(0); GP_BAR; GP_MMA(1, 0, At, B0); GP_MMA(1, 1, At, B1); GP_BAR; GP_SCHED;
        }
        if (wr == 0) GP_BAR;
        E(acc, cur, wr, wc, fr, fq);
        if (!has_next) break;
#pragma unroll
        for (int a = 0; a < 2; ++a)
#pragma unroll
            for (int b = 0; b < 2; ++b)
#pragma unroll
                for (int m = 0; m < 4; ++m)
#pragma unroll
                    for (int n = 0; n < 2; ++n) acc[a][b][m][n] = (f32x4){0.f, 0.f, 0.f, 0.f};
        cur = nxt; cB = nB; ++ui;
        if (wr == 1) GP_BAR;
    }
    GP_WAIT_V(0);
    GP_BAR;
#undef GP_SA
#undef GP_SB
#undef GP_STAGE
#undef GP_LDA
#undef GP_LDB
#undef GP_MMA
#undef GP_WAIT_V
#undef GP_WAIT_L
#undef GP_BAR
#undef GP_SCHED
#undef GP_AOFFS
}
}
#include <hip/hip_cooperative_groups.h>
namespace cg = cooperative_groups;
#define LAS __attribute__((address_space(3)))
typedef float f32x4 __attribute__((ext_vector_type(4)));
typedef unsigned u32x4 __attribute__((ext_vector_type(4)));
typedef short bf16x8 __attribute__((ext_vector_type(8)));
constexpr int NWAVES = 8, NTHREADS = 512;
constexpr int LDS_RING = 131072;
constexpr int LDS_MISC = 159744;
constexpr int LDS_BYTES = 159744 + 256;

struct Params {
    const float* in[24];
    float* out; unsigned char* ws;
    int ph_lo, ph_hi;
};
__device__ __forceinline__ unsigned pk2(float lo, float hi) { return (unsigned)f2bf(lo) | ((unsigned)f2bf(hi) << 16); }
__device__ __forceinline__ float wave_sum(float v) {
#pragma unroll
    for (int o = 1; o < 64; o <<= 1) v += __shfl_xor(v, o);
    return v;
}

struct P0Item { const float* W; int ld, k0, n0; bf16_t* WT; int row0, Kdst; };
__device__ __forceinline__ void p0_load(const P0Item& it, f32x4 (&v)[8], int lane) {
#pragma unroll
    for (int i = 0; i < 8; ++i) v[i] = __builtin_nontemporal_load((const f32x4*)(it.W + (size_t)(it.k0 + 8 * i + (lane >> 3)) * it.ld + it.n0 + 4 * (lane & 7)));
}
__device__ __forceinline__ void p0_finish(const P0Item& it, const f32x4 (&v)[8], LAS float* scr, int lane) {
#pragma unroll
    for (int i = 0; i < 8; ++i) { LAS float* d = scr + (8 * i + (lane >> 3)) * 33 + 4 * (lane & 7); d[0] = v[i][0]; d[1] = v[i][1]; d[2] = v[i][2]; d[3] = v[i][3]; }
    asm volatile("s_waitcnt lgkmcnt(0)" ::: "memory");
    const int c = lane & 7;
#pragma unroll
    for (int j = 0; j < 4; ++j) { const int n = (lane >> 3) + 8 * j; const LAS float* s = scr + (8 * c) * 33 + n;
        u32x4 o; o.x = pk2(s[0 * 33], s[1 * 33]); o.y = pk2(s[2 * 33], s[3 * 33]); o.z = pk2(s[4 * 33], s[5 * 33]); o.w = pk2(s[6 * 33], s[7 * 33]);
        *(u32x4*)(it.WT + (size_t)(it.row0 + n) * it.Kdst + it.k0 + 8 * c) = o; }
    asm volatile("s_waitcnt lgkmcnt(0)" ::: "memory");
}
__device__ __forceinline__ void phase_prep(const Params& p, LAS unsigned char* lds, int tid, int lane, int wave) {
    unsigned char* ws = p.ws;
    {
        LAS float* sc = (LAS float*)lds;
        LAS float* part = (LAS float*)(lds + 32768);
        const float* c = p.in[1]; const float* w_ada = p.in[4]; const float* b_ada = p.in[5];
        for (int i = tid; i < 8192; i += NTHREADS) { const float v = c[i]; sc[i] = v / (1.f + __expf(-v)); }
        __syncthreads();
        for (int cb = blockIdx.x; cb < 256; cb += gridDim.x) {
            const int half = lane >> 5, cl = lane & 31;
            float acc[8];
#pragma unroll
            for (int b = 0; b < 8; ++b) acc[b] = 0.f;
            if (cl < 24) {
#pragma unroll 16
                for (int it = 0; it < 64; ++it) { const int k = 128 * wave + 2 * it + half; const float wv = __builtin_nontemporal_load(w_ada + (size_t)k * 6144 + 24 * cb + cl);
#pragma unroll
                    for (int b = 0; b < 8; ++b) acc[b] += sc[b * 1024 + k] * wv; }
#pragma unroll
                for (int b = 0; b < 8; ++b) part[((wave * 2 + half) * 8 + b) * 24 + cl] = acc[b];
            }
            __syncthreads();
            if (tid < 192) { const int b = tid / 24, cc = tid % 24; float s = 0.f;
                for (int q = 0; q < 16; ++q) s += part[(q * 8 + b) * 24 + cc];
                ((float*)(ws + WS_MOD))[b * 6144 + 24 * cb + cc] = s + b_ada[24 * cb + cc]; }
            __syncthreads();
        }
    }
    {
        float* rope = (float*)(ws + WS_ROPE);
        for (int i = blockIdx.x * NTHREADS + tid; i < SEQ * 8; i += gridDim.x * NTHREADS) {
            const int pos = i >> 3, f = i & 7;
            const float inv = (float)exp(-(double)f / 8.0 * log(500000.0));
            const float ang = (float)pos * inv;
            const double TWO_PI = 6.283185307179586476925287;
            const double a = (double)ang, r = a - rint(a / TWO_PI) * TWO_PI, r2 = r * r;
            double s = 0.0, c = 0.0, ts = r, tc = 1.0;
            for (int n = 0; n < 14; ++n) { s += ts; c += tc; ts *= -r2 / (double)((2 * n + 2) * (2 * n + 3)); tc *= -r2 / (double)((2 * n + 1) * (2 * n + 2)); }
            rope[i * 2 + 0] = (float)c; rope[i * 2 + 1] = (float)s;
        }
        if (blockIdx.x == 0 && tid == 0) { const float* al = p.in[10]; float d01 = 0.f, d23 = 0.f;
            for (int j = 0; j < 64; ++j) { d01 += al[j] * al[64 + j]; d23 += al[128 + j] * al[192 + j]; }
            ((float*)(ws + WS_LAM))[0] = expf(d01) - expf(d23) + LAMBDA_INIT; }
    }
    __syncthreads();
    {
        LAS float* scr = (LAS float*)(lds + wave * 8704);
        const int gw = blockIdx.x * NWAVES + wave, NGW = gridDim.x * NWAVES;
        constexpr int I_IN = 16 * 88, I_OUT = 16 * 32, I_UV = 32, NITEMS = I_IN + I_OUT + I_UV;
        auto decode = [&](int r) -> P0Item {
            if (r < I_IN) return P0Item{p.in[6], NIN, 64 * (r / 88), 32 * (r % 88), (bf16_t*)(ws + WS_WINT), 32 * (r % 88), 1024};
            r -= I_IN;
            if (r < I_OUT) return P0Item{p.in[7], 1024, 64 * (r / 32), 32 * (r % 32), (bf16_t*)(ws + WS_WOUTT), 32 * (r % 32), 1024};
            r -= I_OUT;
            const int h = r >> 2, rr = r & 3; return P0Item{p.in[15] + h * 128 * 64, 64, 64 * (rr >> 1), 32 * (rr & 1), (bf16_t*)(ws + WS_WUVT) + h * 64 * 128, 32 * (rr & 1), 128};
        };
        for (int it = gw; it < NITEMS; it += NGW) { const P0Item a = decode(it); f32x4 va[8]; p0_load(a, va, lane); p0_finish(a, va, scr, lane); }
    }
}
constexpr int N_EXPERT_ITEMS = 32 * 3 * 512;
__device__ __forceinline__ bool conv_expert_issue(const Params& p, int lane, int wave, int& cur, P0Item& a, f32x4 (&va)[8]) {
    unsigned char* ws = p.ws;
    const int gw = blockIdx.x * NWAVES + wave, NGW = gridDim.x * NWAVES, r = gw + NGW * cur;
    if (r >= N_EXPERT_ITEMS) return false;
    ++cur;
    const int e = r / 1536, qq = r % 1536, mat = qq / 512, i2 = qq % 512, kb = i2 / 32, nb = i2 % 32, n0 = 32 * nb;
    a = (mat == 2) ? P0Item{p.in[22] + (size_t)e * 1048576, 1024, 64 * kb, n0, (bf16_t*)(ws + WS_WDT) + (size_t)e * 1048576, n0, 1024}
                   : P0Item{p.in[mat == 0 ? 18 : 20] + (size_t)e * 1048576, 1024, 64 * kb, n0, (bf16_t*)(ws + WS_WGUT) + (size_t)e * 2097152, 256 * (n0 >> 7) + (n0 & 127) + (mat == 1 ? 128 : 0), 1024};
    p0_load(a, va, lane);
    return true;
}
__device__ __forceinline__ void conv_expert_items(const Params& p, LAS unsigned char* lds, int lane, int wave, int& cur, int n) {
    unsigned char* ws = p.ws;
    LAS float* scr = (LAS float*)(lds + wave * 8704);
    const int gw = blockIdx.x * NWAVES + wave, NGW = gridDim.x * NWAVES;
    for (int q = 0; q < n; ++q) {
        const int r = gw + NGW * cur;
        if (r >= N_EXPERT_ITEMS) break;
        ++cur;
        const int e = r / 1536, qq = r % 1536, mat = qq / 512, i2 = qq % 512, kb = i2 / 32, nb = i2 % 32, n0 = 32 * nb;
        const P0Item a = (mat == 2) ? P0Item{p.in[22] + (size_t)e * 1048576, 1024, 64 * kb, n0, (bf16_t*)(ws + WS_WDT) + (size_t)e * 1048576, n0, 1024}
                                    : P0Item{p.in[mat == 0 ? 18 : 20] + (size_t)e * 1048576, 1024, 64 * kb, n0, (bf16_t*)(ws + WS_WGUT) + (size_t)e * 2097152, 256 * (n0 >> 7) + (n0 & 127) + (mat == 1 ? 128 : 0), 1024};
        f32x4 va[8]; p0_load(a, va, lane); p0_finish(a, va, scr, lane);
    }
}

__device__ __forceinline__ void phase_norm1(const Params& p, LAS unsigned char* lds, int tid, int lane, int wave) {
    unsigned char* ws = p.ws;
    const float* x = p.in[0]; const float* g = p.in[2]; const float* w_in = p.in[6]; const float* mod = (const float*)(ws + WS_MOD);
    bf16_t* H = (bf16_t*)(ws + WS_H); float* IW = (float*)(ws + WS_IW);
    LAS float* wiw = (LAS float*)lds;
    for (int i = tid; i < 8192; i += NTHREADS) wiw[i] = w_in[(size_t)(i >> 3) * NIN + C_IW + (i & 7)];
    __syncthreads();
    const int gw = blockIdx.x * NWAVES + wave, NGW = gridDim.x * NWAVES;
    f32x4 gv[4];
#pragma unroll
    for (int j = 0; j < 4; ++j) gv[j] = *(const f32x4*)(g + 4 * (lane + 64 * j));
    f32x4 vn[4];
#pragma unroll
    for (int j = 0; j < 4; ++j) vn[j] = *(const f32x4*)(x + (size_t)(gw < NTOK ? gw : 0) * DM + 4 * (lane + 64 * j));
    for (int t = gw; t < NTOK; t += NGW) {
        const int b = t / SEQ; const float* sh = mod + b * 6144, * sc = sh + 1024;
        f32x4 v[4]; float ss = 0.f;
#pragma unroll
        for (int j = 0; j < 4; ++j) { v[j] = vn[j]; ss += (v[j].x * v[j].x + v[j].y * v[j].y) + (v[j].z * v[j].z + v[j].w * v[j].w); }
        if (t + NGW < NTOK) {
#pragma unroll
            for (int j = 0; j < 4; ++j) vn[j] = *(const f32x4*)(x + (size_t)(t + NGW) * DM + 4 * (lane + 64 * j)); }
        const float r = 1.0f / sqrtf(wave_sum(ss) * (1.f / DM) + RMS_EPS);
        float iw[8];
#pragma unroll
        for (int q = 0; q < 8; ++q) iw[q] = 0.f;
#pragma unroll
        for (int j = 0; j < 4; ++j) { const int k0 = 4 * (lane + 64 * j);
            const f32x4 s4 = *(const f32x4*)(sc + k0), h4 = *(const f32x4*)(sh + k0);
            f32x4 hv = (v[j] * r * gv[j]) * (s4 + 1.0f) + h4;
            *(uint2*)(H + (size_t)t * DM + k0) = make_uint2(pk2(hv.x, hv.y), pk2(hv.z, hv.w));
#pragma unroll
            for (int i = 0; i < 4; ++i) { const f32x4 w0 = *(const LAS f32x4*)(wiw + (k0 + i) * 8), w1 = *(const LAS f32x4*)(wiw + (k0 + i) * 8 + 4);
                iw[0] += hv[i] * w0.x; iw[1] += hv[i] * w0.y; iw[2] += hv[i] * w0.z; iw[3] += hv[i] * w0.w;
                iw[4] += hv[i] * w1.x; iw[5] += hv[i] * w1.y; iw[6] += hv[i] * w1.z; iw[7] += hv[i] * w1.w; } }
#pragma unroll
        for (int i = 0; i < 4; ++i) { const bool up = (lane & 32) != 0; const float snd = up ? iw[i] : iw[i + 4], kp = up ? iw[i + 4] : iw[i]; iw[i] = kp + __shfl_xor(snd, 32); }
#pragma unroll
        for (int i = 0; i < 2; ++i) { const bool up = (lane & 16) != 0; const float snd = up ? iw[i] : iw[i + 2], kp = up ? iw[i + 2] : iw[i]; iw[i] = kp + __shfl_xor(snd, 16); }
        { const bool up = (lane & 8) != 0; const float snd = up ? iw[0] : iw[1], kp = up ? iw[1] : iw[0]; iw[0] = kp + __shfl_xor(snd, 8); }
        { float r8 = iw[0]; r8 += __shfl_xor(r8, 4); r8 += __shfl_xor(r8, 2); r8 += __shfl_xor(r8, 1);
          if ((lane & 7) == 0) IW[(size_t)t * 8 + (lane >> 3)] = r8 * 0.04419417382415922f; }
    }
}


__device__ __forceinline__ void router_tail(float (&pe)[32], const float* rb, int lane, int t, int* topi, float* topg, LAS int* cnt) {
#pragma unroll
    for (int i = 0; i < 8; ++i) { const bool up = (lane & 16) != 0; const float snd = up ? pe[i] : pe[i + 8], kp = up ? pe[i + 8] : pe[i]; pe[i] = kp + __shfl_xor(snd, 16); }
#pragma unroll
    for (int i = 0; i < 4; ++i) { const bool up = (lane & 8) != 0; const float snd = up ? pe[i] : pe[i + 4], kp = up ? pe[i + 4] : pe[i]; pe[i] = kp + __shfl_xor(snd, 8); }
#pragma unroll
    for (int i = 0; i < 2; ++i) { const bool up = (lane & 4) != 0; const float snd = up ? pe[i] : pe[i + 2], kp = up ? pe[i + 2] : pe[i]; pe[i] = kp + __shfl_xor(snd, 4); }
    { const bool up = (lane & 2) != 0; const float snd = up ? pe[0] : pe[1], kp = up ? pe[1] : pe[0]; pe[0] = kp + __shfl_xor(snd, 2); }
    const int myE = lane >> 1;
    float lv = pe[0] + __shfl_xor(pe[0], 1) + rb[myE];
    int idx[4]; float val[4];
#pragma unroll
    for (int k = 0; k < 4; ++k) { float m = lv;
#pragma unroll
        for (int o = 1; o < 64; o <<= 1) m = fmaxf(m, __shfl_xor(m, o));
        const unsigned long long bm = __ballot(lv == m);
        const int e = __builtin_ctzll(bm) >> 1;
        idx[k] = e; val[k] = m; if (myE == e) lv = -INFINITY; }
    if (lane == 0) {
        float ex[4], sum = 0.f;
#pragma unroll
        for (int k = 0; k < 4; ++k) { ex[k] = __expf(val[k] - val[0]); sum += ex[k]; }
        const float inv = 1.f / sum;
        *(int4*)(topi + t * 4) = make_int4(idx[0], idx[1], idx[2], idx[3]);
        *(f32x4*)(topg + t * 4) = (f32x4){ex[0] * inv, ex[1] * inv, ex[2] * inv, ex[3] * inv};
#pragma unroll
        for (int k = 0; k < 4; ++k) atomicAdd((int*)&cnt[idx[k]], 1);
    }
}
__device__ __forceinline__ void phase_norm2(const Params& p, LAS unsigned char* lds, int tid, int lane, int wave) {
    unsigned char* ws = p.ws;
    const float* x1 = p.out; const float* g = p.in[3]; const float* rw = p.in[16]; const float* rb = p.in[17]; const float* mod = (const float*)(ws + WS_MOD);
    bf16_t* H = (bf16_t*)(ws + WS_H); int* topi = (int*)(ws + WS_TOPI); float* topg = (float*)(ws + WS_TOPG); int* chcnt = (int*)(ws + WS_CHCNT);
    LAS float* rwl = (LAS float*)lds;
    for (int i = tid; i < 32768; i += NTHREADS) { const int k = i >> 5, e = i & 31; rwl[e * 1028 + k] = rw[i]; }
    LAS int* cnt = (LAS int*)(lds + 32 * 1028 * 4);
    __syncthreads();
    for (int ch = blockIdx.x; ch < NCHUNK; ch += gridDim.x) {
        if (tid < 32) cnt[tid] = 0;
        __syncthreads();
        for (int rr = 0; rr < 16; rr += 2) {
            const int t0r = ch * CHTOK + wave * 16 + rr, b = t0r / SEQ; const float* sh = mod + b * 6144 + 3 * 1024, * sc = sh + 1024;
            f32x4 hv0[4], hv1[4];
#define N2_ROW(HV, T_) do { f32x4 v[4]; float ss = 0.f; \
                _Pragma("unroll") for (int j = 0; j < 4; ++j) { v[j] = *(const f32x4*)(x1 + (size_t)(T_) * DM + 4 * (lane + 64 * j)); ss += (v[j].x * v[j].x + v[j].y * v[j].y) + (v[j].z * v[j].z + v[j].w * v[j].w); } \
                const float r = 1.0f / sqrtf(wave_sum(ss) * (1.f / DM) + RMS_EPS); \
                _Pragma("unroll") for (int j = 0; j < 4; ++j) { const int k0 = 4 * (lane + 64 * j); \
                    const f32x4 s4 = *(const f32x4*)(sc + k0), h4 = *(const f32x4*)(sh + k0); \
                    HV[j] = (v[j] * r * *(const f32x4*)(g + k0)) * (s4 + 1.0f) + h4; \
                    *(uint2*)(H + (size_t)(T_) * DM + k0) = make_uint2(pk2(HV[j].x, HV[j].y), pk2(HV[j].z, HV[j].w)); } } while (0)
            N2_ROW(hv0, t0r); N2_ROW(hv1, t0r + 1);
#undef N2_ROW
            float pe0[32], pe1[32];
#pragma unroll
            for (int i = 0; i < 16; ++i) { float a0 = 0.f, a1 = 0.f, b0 = 0.f, b1 = 0.f;
#pragma unroll
                for (int j = 0; j < 4; ++j) { const f32x4 wa = *(const LAS f32x4*)(rwl + i * 1028 + 4 * (lane + 64 * j)), wb = *(const LAS f32x4*)(rwl + (i + 16) * 1028 + 4 * (lane + 64 * j));
                    a0 += (hv0[j].x * wa.x + hv0[j].y * wa.y) + (hv0[j].z * wa.z + hv0[j].w * wa.w); a1 += (hv1[j].x * wa.x + hv1[j].y * wa.y) + (hv1[j].z * wa.z + hv1[j].w * wa.w);
                    b0 += (hv0[j].x * wb.x + hv0[j].y * wb.y) + (hv0[j].z * wb.z + hv0[j].w * wb.w); b1 += (hv1[j].x * wb.x + hv1[j].y * wb.y) + (hv1[j].z * wb.z + hv1[j].w * wb.w); }
                const bool up = (lane & 32) != 0;
                pe0[i] = (up ? b0 : a0) + __shfl_xor(up ? a0 : b0, 32); pe1[i] = (up ? b1 : a1) + __shfl_xor(up ? a1 : b1, 32);
                asm volatile("" ::: "memory"); }
            router_tail(pe0, rb, lane, t0r, topi, topg, cnt);
            router_tail(pe1, rb, lane, t0r + 1, topi, topg, cnt);
        }
        __syncthreads();
        if (tid < 32) chcnt[ch * 32 + tid] = cnt[tid];
        __syncthreads();
    }
}

__device__ __forceinline__ void phase_scatter(const Params& p, LAS unsigned char* lds, int tid, int lane, int wave) {
    unsigned char* ws = p.ws;
    const int* topi = (const int*)(ws + WS_TOPI); const int* chcnt = (const int*)(ws + WS_CHCNT);
    int* rowtok = (int*)(ws + WS_ROWTOK); int* rowsrc = (int*)(ws + WS_ROWSRC); int* tile_e = (int*)(ws + WS_TILEE); int2* rowmeta = (int2*)(ws + WS_ROWMETA); const float* topg = (const float*)(ws + WS_TOPG);
    LAS int* total = (LAS int*)lds; LAS int* before = total + 32; LAS int* padded = total + 64; LAS int* poff = total + 96; LAS int* ent = total + 160; LAS int* psum = total + 1024; LAS int* wcnt = total + 2048;
    for (int ch = blockIdx.x; ch < NCHUNK; ch += gridDim.x) {
        { const int e = tid & 31, part = tid >> 5; int tt = 0, bb = 0;
#pragma unroll
          for (int q = 0; q < 16; ++q) { const int c = part * 16 + q; const int v = chcnt[c * 32 + e]; tt += v; bb += (c < ch) ? v : 0; }
          psum[tid] = tt; psum[512 + tid] = bb; }
        { const int i = tid; ent[i] = topi[ch * CHTOK * 4 + i]; }
        __syncthreads();
        if (tid < 32) { int tt = 0, bb = 0;
#pragma unroll
            for (int q = 0; q < 16; ++q) { tt += psum[q * 32 + tid]; bb += psum[512 + q * 32 + tid]; }
            total[tid] = tt; before[tid] = bb; padded[tid] = (tt + 255) / 256 * 256; }
        __syncthreads();
        if (tid == 0) { int a = 0; for (int e = 0; e < 32; ++e) { poff[e] = a; a += padded[e]; } poff[32] = a; }
        __syncthreads();
        {
            const int myE = ent[tid]; int myRank = 0;
            const unsigned long long ltm = (1ull << lane) - 1ull;
            for (int e = 0; e < 32; ++e) { const unsigned long long mk = __ballot(myE == e);
                if (myE == e) myRank = __popcll(mk & ltm);
                if (lane == 0) wcnt[wave * 32 + e] = __popcll(mk); }
            __syncthreads();
            int pos = poff[myE] + before[myE] + myRank;
            for (int w2 = 0; w2 < wave; ++w2) pos += wcnt[w2 * 32 + myE];
            const int en = ch * CHTOK * 4 + tid; rowtok[pos] = en; rowsrc[pos] = en >> 2; rowmeta[pos] = make_int2(en, __float_as_int(topg[en]));
        }
        if (ch == 0) {
            for (int e = wave; e < 32; e += NWAVES) {
                const int p0 = poff[e], te = p0 + total[e], pe = p0 + padded[e];
                for (int r = te + lane; r < pe; r += 64) { rowtok[r] = -1; rowsrc[r] = 0; rowmeta[r] = make_int2(-1, 0); }
                for (int ti = p0 / 256 + lane; ti < pe / 256; ti += 64) tile_e[ti] = e; }
            if (tid == 0) tile_e[MAXTILES] = poff[32] / 256;
        }
        __syncthreads();
    }
}

__device__ __forceinline__ void phase_combine(const Params& p, int tid) {
    unsigned char* ws = p.ws; float* out = p.out; const bf16_t* Y = (const bf16_t*)(ws + WS_Y); const float* mod = (const float*)(ws + WS_MOD);
    const size_t nvec = (size_t)NTOK * DM / 8;
#pragma unroll 4
    for (size_t i = (size_t)blockIdx.x * NTHREADS + tid; i < nvec; i += (size_t)gridDim.x * NTHREADS) {
        const size_t o = i * 8; const int t = (int)(o / DM), n = (int)(o % DM), b = t / SEQ;
        const u32x4 a = __builtin_nontemporal_load((const u32x4*)(Y + o)), c = __builtin_nontemporal_load((const u32x4*)(Y + (size_t)NTOK * DM + o)), d = __builtin_nontemporal_load((const u32x4*)(Y + (size_t)2 * NTOK * DM + o));
        const float* g2 = mod + b * 6144 + 5 * 1024 + n;
        f32x4 o0 = *(const f32x4*)(out + o), o1 = *(const f32x4*)(out + o + 4);
        const f32x4 g0 = *(const f32x4*)g2, g1 = *(const f32x4*)(g2 + 4);
#define LO(u) __uint_as_float((u) << 16)
#define HI(u) __uint_as_float((u) & 0xffff0000u)
        o0.x += g0.x * (LO(a.x) + LO(c.x) + LO(d.x)); o0.y += g0.y * (HI(a.x) + HI(c.x) + HI(d.x));
        o0.z += g0.z * (LO(a.y) + LO(c.y) + LO(d.y)); o0.w += g0.w * (HI(a.y) + HI(c.y) + HI(d.y));
        o1.x += g1.x * (LO(a.z) + LO(c.z) + LO(d.z)); o1.y += g1.y * (HI(a.z) + HI(c.z) + HI(d.z));
        o1.z += g1.z * (LO(a.w) + LO(c.w) + LO(d.w)); o1.w += g1.w * (HI(a.w) + HI(c.w) + HI(d.w));
#undef LO
#undef HI
        *(f32x4*)(out + o) = o0; *(f32x4*)(out + o + 4) = o1;
    }
}

namespace da {
typedef float f32x16 __attribute__((ext_vector_type(16)));
typedef short s16x4 __attribute__((ext_vector_type(4)));
constexpr int KPL = 1040;
constexpr int KT_BYTES = 8 * KPL;
constexpr int VRS = 320;
constexpr int VT_BYTES = 64 * VRS;
constexpr int BUF_BYTES = 2 * KT_BYTES + VT_BYTES;
constexpr int OB_STRIDE = 132;
constexpr int WSF_OFF = 139264;
constexpr float C2 = 0.125f * 1.4426950408889634f;
__device__ __forceinline__ int crow(int r, int hi) { return (r & 3) + 8 * (r >> 2) + 4 * hi; }
__device__ __forceinline__ s16x4 vtr(const LAS unsigned char* p) { return __builtin_bit_cast(s16x4, __builtin_amdgcn_ds_read_tr16_b64_v4i16((LAS s16x4*)p)); }

__device__ __forceinline__ void phase(const Params& p, LAS unsigned char* lds, int tid, int lane, int wave, int& cvcur) {
    unsigned char* ws = p.ws; const bf16_t* PROJ = (const bf16_t*)(ws + WS_PROJ); bf16_t* H = (bf16_t*)(ws + WS_H);
    const float lam = ((const float*)(ws + WS_LAM))[0]; const float* sub_g = p.in[11];
    const int wsel = wave >> 2, wq = wave & 3, r32 = lane & 31, hi = lane >> 5;
    LAS float* wsf = (LAS float*)(lds + WSF_OFF) + wave * 64;
    const int G = gridDim.x, vcu = (G % 8 == 0) ? ((int)blockIdx.x % 8) * (G / 8) + (int)blockIdx.x / 8 : (int)blockIdx.x;
    for (int id = vcu; id < 1024; id += G) {
        const int bh = (id >> 3) & 31, s = id & 7, ii = id >> 8;
        const int qb = (ii == 0) ? s : (ii == 1) ? 15 - s : (ii == 2) ? 16 + s : 31 - s;
        const int b = bh >> 2, h = bh & 3, q0 = qb * 128, NT = 2 * qb + 2, ntw = 2 * qb + 1 + (wq >> 1);
        const bf16_t* base = PROJ + (size_t)b * SEQ * NPJ;
        bf16x8 qr[4];
        { const bf16_t* Qrow = base + (size_t)(q0 + 32 * wq + r32) * NPJ + (wsel ? C_AQ2 : C_AQ1) + h * 64;
#pragma unroll
          for (int d0 = 0; d0 < 4; ++d0) qr[d0] = *(const bf16x8*)(Qrow + 16 * d0 + 8 * hi); }
        float m = -INFINITY, l = 0.f;
        f32x16 o[4];
#pragma unroll
        for (int d0 = 0; d0 < 4; ++d0)
#pragma unroll
            for (int r = 0; r < 16; ++r) o[d0][r] = 0.f;
        const int skey = tid >> 3, sc = tid & 7, vkey = tid >> 4, vch = tid & 15;
        const bf16_t* srcK1 = base + (size_t)skey * NPJ + C_AK1 + h * 64 + 8 * sc;
        const bf16_t* srcK2 = base + (size_t)skey * NPJ + C_AK2 + h * 64 + 8 * sc;
        const bf16_t* srcV = base + (size_t)vkey * NPJ + C_AV + h * 128 + 8 * vch;
        const int dK = sc * KPL + skey * 16, dV = vkey * VRS + vch * 16;
        u32x4 st0, st1, st2, st3;
#define DA_LOAD(kt) do { const size_t ro = (size_t)(kt) * 64 * NPJ; st0 = *(const u32x4*)(srcK1 + ro); st1 = *(const u32x4*)(srcK2 + ro); \
        st2 = *(const u32x4*)(srcV + ro); st3 = *(const u32x4*)(srcV + ro + (size_t)32 * NPJ); } while (0)
#define DA_WRITE(bufi) do { LAS unsigned char* bb = lds + (bufi) * BUF_BYTES; *(LAS u32x4*)(bb + dK) = st0; *(LAS u32x4*)(bb + KT_BYTES + dK) = st1; \
        *(LAS u32x4*)(bb + 2 * KT_BYTES + dV) = st2; *(LAS u32x4*)(bb + 2 * KT_BYTES + dV + 32 * VRS) = st3; } while (0)
        DA_LOAD(0); DA_WRITE(0);
        __syncthreads();
        for (int kt = 0; kt < NT; ++kt) {
            if (kt + 1 < NT) DA_LOAD(kt + 1);
            if (kt < ntw) {
                const LAS unsigned char* bb = lds + (kt & 1) * BUF_BYTES;
                const LAS unsigned char* Kb = bb + wsel * KT_BYTES;
                const LAS unsigned char* Vb = bb + 2 * KT_BYTES;
                f32x16 p0, p1;
#pragma unroll
                for (int r = 0; r < 16; ++r) { p0[r] = 0.f; p1[r] = 0.f; }
#pragma unroll
                for (int d0 = 0; d0 < 4; ++d0) {
                    const bf16x8 a0 = *(const LAS bf16x8*)(Kb + (2 * d0 + hi) * KPL + r32 * 16);
                    const bf16x8 a1 = *(const LAS bf16x8*)(Kb + (2 * d0 + hi) * KPL + (r32 + 32) * 16);
                    p0 = __builtin_amdgcn_mfma_f32_32x32x16_bf16(a0, qr[d0], p0, 0, 0, 0);
                    p1 = __builtin_amdgcn_mfma_f32_32x32x16_bf16(a1, qr[d0], p1, 0, 0, 0);
                }
                float mxa = fmaxf(p0[0], p1[0]), mxb = fmaxf(p0[1], p1[1]), mxc = fmaxf(p0[2], p1[2]), mxd = fmaxf(p0[3], p1[3]);
#pragma unroll
                for (int r = 4; r < 16; r += 4) { mxa = fmaxf(mxa, fmaxf(p0[r], p1[r])); mxb = fmaxf(mxb, fmaxf(p0[r + 1], p1[r + 1])); mxc = fmaxf(mxc, fmaxf(p0[r + 2], p1[r + 2])); mxd = fmaxf(mxd, fmaxf(p0[r + 3], p1[r + 3])); }
                float mx = fmaxf(fmaxf(mxa, mxb), fmaxf(mxc, mxd));
                mx = fmaxf(mx, __shfl_xor(mx, 32)) * C2;
                const float mnew = fmaxf(m, mx);
                if (__any(mnew > m)) {
                    const float f = __builtin_amdgcn_exp2f(m - mnew);
                    l *= f; m = mnew;
                    if (hi == 0) wsf[r32] = f;
                    asm volatile("s_waitcnt lgkmcnt(0)" ::: "memory");
#pragma unroll
                    for (int r = 0; r < 16; ++r) { const float fr = wsf[crow(r, hi)];
#pragma unroll
                        for (int d0 = 0; d0 < 4; ++d0) o[d0][r] *= fr; }
                }
                float lsa = 0.f, lsb = 0.f, lsc = 0.f, lsd = 0.f;
#pragma unroll
                for (int r = 0; r < 16; r += 4) {
                    p0[r] = __builtin_amdgcn_exp2f(p0[r] * C2 - m); p1[r] = __builtin_amdgcn_exp2f(p1[r] * C2 - m); lsa += p0[r] + p1[r];
                    p0[r + 1] = __builtin_amdgcn_exp2f(p0[r + 1] * C2 - m); p1[r + 1] = __builtin_amdgcn_exp2f(p1[r + 1] * C2 - m); lsb += p0[r + 1] + p1[r + 1];
                    p0[r + 2] = __builtin_amdgcn_exp2f(p0[r + 2] * C2 - m); p1[r + 2] = __builtin_amdgcn_exp2f(p1[r + 2] * C2 - m); lsc += p0[r + 2] + p1[r + 2];
                    p0[r + 3] = __builtin_amdgcn_exp2f(p0[r + 3] * C2 - m); p1[r + 3] = __builtin_amdgcn_exp2f(p1[r + 3] * C2 - m); lsd += p0[r + 3] + p1[r + 3]; }
                l += (lsa + lsb) + (lsc + lsd);
                bf16x8 pa[4];
#pragma unroll
                for (int ks = 0; ks < 2; ++ks) {
                    u32x4 w0, w1;
                    w0.x = gp::cvt_pk_bf16(p0[8 * ks + 0], p0[8 * ks + 1]); w0.y = gp::cvt_pk_bf16(p0[8 * ks + 2], p0[8 * ks + 3]);
                    w0.z = gp::cvt_pk_bf16(p0[8 * ks + 4], p0[8 * ks + 5]); w0.w = gp::cvt_pk_bf16(p0[8 * ks + 6], p0[8 * ks + 7]);
                    w1.x = gp::cvt_pk_bf16(p1[8 * ks + 0], p1[8 * ks + 1]); w1.y = gp::cvt_pk_bf16(p1[8 * ks + 2], p1[8 * ks + 3]);
                    w1.z = gp::cvt_pk_bf16(p1[8 * ks + 4], p1[8 * ks + 5]); w1.w = gp::cvt_pk_bf16(p1[8 * ks + 6], p1[8 * ks + 7]);
                    pa[ks] = __builtin_bit_cast(bf16x8, w0); pa[2 + ks] = __builtin_bit_cast(bf16x8, w1);
                }
                const LAS unsigned char* vp = Vb + (4 * hi + ((lane & 15) >> 2)) * VRS + (16 * ((lane >> 4) & 1) + 4 * (lane & 3)) * 2;
#pragma unroll
                for (int d0 = 0; d0 < 4; ++d0)
#pragma unroll
                    for (int ks = 0; ks < 4; ++ks) {
                        const s16x4 lo = vtr(vp + (16 * ks) * VRS + d0 * 64), hv = vtr(vp + (16 * ks + 8) * VRS + d0 * 64);
                        const bf16x8 vf = (bf16x8){lo[0], lo[1], lo[2], lo[3], hv[0], hv[1], hv[2], hv[3]};
                        o[d0] = __builtin_amdgcn_mfma_f32_32x32x16_bf16(pa[ks], vf, o[d0], 0, 0, 0);
                        if (ks == 3) __builtin_amdgcn_sched_barrier(0);
                    }
            }
            if (kt + 1 < NT) DA_WRITE((kt + 1) & 1);
            __syncthreads();
        }
#undef DA_LOAD
#undef DA_WRITE
        l += __shfl_xor(l, 32);
        { const float fac = (wsel ? lam : 1.0f) / l;
          if (hi == 0) wsf[r32] = fac;
          asm volatile("s_waitcnt lgkmcnt(0)" ::: "memory"); }
        LAS float* Ob = (LAS float*)lds + wsel * (128 * OB_STRIDE);
#pragma unroll
        for (int r = 0; r < 16; ++r) { const float fr = wsf[crow(r, hi)]; const int row = 32 * wq + crow(r, hi);
#pragma unroll
            for (int d0 = 0; d0 < 4; ++d0) Ob[row * OB_STRIDE + 32 * d0 + r32] = o[d0][r] * fr; }
        __syncthreads();
        { const LAS float* O1 = (const LAS float*)lds; const LAS float* O2 = O1 + 128 * OB_STRIDE;
          const float g0 = sub_g[2 * lane], g1 = sub_g[2 * lane + 1];
          for (int rr = 0; rr < 16; ++rr) { const int row = 16 * wave + rr;
              const float d0v = O1[row * OB_STRIDE + 2 * lane] - O2[row * OB_STRIDE + 2 * lane], d1v = O1[row * OB_STRIDE + 2 * lane + 1] - O2[row * OB_STRIDE + 2 * lane + 1];
              const float ss = wave_sum(d0v * d0v + d1v * d1v);
              const float rs = (1.0f - LAMBDA_INIT) / sqrtf(ss * (1.f / 128.f) + RMS_EPS);
              *(unsigned*)(H + (size_t)(b * SEQ + q0 + row) * DM + h * 128 + 2 * lane) = pk2(d0v * rs * g0, d1v * rs * g1); } }
        __syncthreads();

    }
}
}
namespace ds {
typedef float f32x16 __attribute__((ext_vector_type(16)));
typedef short s16x4 __attribute__((ext_vector_type(4)));
typedef int i32x4 __attribute__((ext_vector_type(4)));
typedef unsigned u32x2 __attribute__((ext_vector_type(2)));
constexpr int HIST_OFF = 131072, SEL_OFF = 139264, OALL_OFF = 143360;
constexpr float C2 = 0.125f * 1.4426950408889634f;
__device__ __forceinline__ s16x4 vtr(const LAS unsigned char* p) { return __builtin_bit_cast(s16x4, __builtin_amdgcn_ds_read_tr16_b64_v4i16((LAS s16x4*)p)); }
__device__ __forceinline__ unsigned skey(float f) { unsigned u = __float_as_uint(f); if (u == 0x80000000u) u = 0u; return u ^ ((unsigned)((int)u >> 31) | 0x80000000u); }

template <int STOP> __device__ __forceinline__ void unit(const Params& p, LAS unsigned char* lds, int tid, int lane_in, int wave, int b, int qt, int& cvcur) {
    int lane = lane_in; asm volatile("" : "+v"(lane));
    unsigned char* ws = p.ws; const bf16_t* PROJ = (const bf16_t*)(ws + WS_PROJ); bf16_t* H = (bf16_t*)(ws + WS_H);
    const float* IW = (const float*)(ws + WS_IW);
    const int q0 = qt * 8, N = (q0 / 64 + 1) * 64, t0 = b * SEQ + q0;
    const bf16_t* base = PROJ + (size_t)b * SEQ * NPJ;
    LAS float* S = (LAS float*)lds;
    const int r32 = lane & 31, hi = lane >> 5;
    {
        bf16x8 aq[2][4]; f32x4 wv[2][4];
#pragma unroll
        for (int rb = 0; rb < 2; ++rb) {
            const bf16_t* qrow = base + (size_t)(q0 + 4 * rb + 2 * ((r32 >> 2) & 1) + (r32 >> 4)) * NPJ + C_IQ + (4 * ((r32 >> 3) & 1) + (r32 & 3)) * 64 + 8 * hi;
#pragma unroll
            for (int d0 = 0; d0 < 4; ++d0) aq[rb][d0] = *(const bf16x8*)(qrow + 16 * d0);
#pragma unroll
            for (int qq = 0; qq < 4; ++qq) wv[rb][qq] = *(const f32x4*)(IW + (size_t)(t0 + 4 * rb + 2 * hi + (qq >> 1)) * 8 + 4 * (qq & 1));
        }
        const int ntk = N / 32;
        bf16x8 bk[4], bkn[4];
        const unsigned char* ikf = ws + WS_IKF + (size_t)b * 128 * 4096 + lane * 16;
        { const unsigned char* kp = ikf + (size_t)(wave < ntk ? wave : 0) * 4096;
#pragma unroll
          for (int d0 = 0; d0 < 4; ++d0) bkn[d0] = *(const bf16x8*)(kp + d0 * 1024); }
        for (int kt = wave; kt < ntk; kt += NWAVES) {
#pragma unroll
            for (int d0 = 0; d0 < 4; ++d0) bk[d0] = bkn[d0];
            if (kt + NWAVES < ntk) { const unsigned char* kp = ikf + (size_t)(kt + NWAVES) * 4096;
#pragma unroll
                for (int d0 = 0; d0 < 4; ++d0) bkn[d0] = *(const bf16x8*)(kp + d0 * 1024); }
#pragma unroll
            for (int rb = 0; rb < 2; ++rb) {
                f32x16 acc;
#pragma unroll
                for (int r = 0; r < 16; ++r) acc[r] = 0.f;
#pragma unroll
                for (int d0 = 0; d0 < 4; ++d0) acc = __builtin_amdgcn_mfma_f32_32x32x16_bf16(aq[rb][d0], bk[d0], acc, 0, 0, 0);
                float v0 = 0.f, v1 = 0.f;
#pragma unroll
                for (int i = 0; i < 4; ++i) { v0 += wv[rb][0][i] * fmaxf(acc[i], 0.f) + wv[rb][1][i] * fmaxf(acc[4 + i], 0.f);
                                               v1 += wv[rb][2][i] * fmaxf(acc[8 + i], 0.f) + wv[rb][3][i] * fmaxf(acc[12 + i], 0.f); }
                S[(4 * rb + 2 * hi) * 4096 + 32 * kt + r32] = v0;
                S[(4 * rb + 2 * hi + 1) * 4096 + 32 * kt + r32] = v1;
            }
        }
    }
    __syncthreads();
    if (STOP == 1) return;
    asm volatile("" : "+v"(lane));
    LAS float* Sw = S + wave * 4096;
    LAS unsigned short* sel = (LAS unsigned short*)(lds + SEL_OFF) + wave * 256;
    const int nsel = N < 256 ? N : 256;
    if (N <= 256) {
        for (int i = lane; i < N; i += 64) sel[i] = (unsigned short)i;
    } else {
        LAS unsigned* hist = (LAS unsigned*)(lds + OALL_OFF) + wave * 512;
        LAS float* cv = (LAS float*)(lds + HIST_OFF) + wave * 256; LAS int* ci = (LAS int*)cv + 128;
        const unsigned long long ltmask = (1ull << lane) - 1ull;
        const int nit = (N + 255) / 256;
        float t0 = -INFINITY, t1 = -INFINITY, t2 = -INFINITY, t3 = -INFINITY;
#pragma unroll 4
        for (int it = 0; it < nit; ++it) { if (256 * it + 4 * lane < N) { const f32x4 v4 = *(const LAS f32x4*)(Sw + 256 * it + 4 * lane);
#pragma unroll
            for (int q = 0; q < 4; ++q) { const float v = v4[q];
                const float n3 = fmaxf(t3, fminf(t2, v)), n2 = fmaxf(t2, fminf(t1, v)), n1 = fmaxf(t1, fminf(t0, v)); t0 = fmaxf(t0, v); t1 = n1; t2 = n2; t3 = n3; } } }
        float mn = t3, mx = t0;
#pragma unroll
        for (int o = 1; o < 64; o <<= 1) { mn = fminf(mn, __shfl_xor(mn, o)); mx = fmaxf(mx, __shfl_xor(mx, o)); }
        bool done = false;
        if (mx > mn) {
            const float scale = 1024.0f / (mx - mn);
            *(LAS u32x4*)(hist + 8 * lane) = (u32x4){0u, 0u, 0u, 0u}; *(LAS u32x4*)(hist + 8 * lane + 4) = (u32x4){0u, 0u, 0u, 0u};
            asm volatile("s_waitcnt lgkmcnt(0)" ::: "memory");
#pragma unroll 4
            for (int it = 0; it < nit; ++it) { if (256 * it + 4 * lane < N) { const f32x4 v4 = *(const LAS f32x4*)(Sw + 256 * it + 4 * lane);
#pragma unroll
                for (int q = 0; q < 4; ++q) { if (v4[q] >= mn) { int bn = (int)((v4[q] - mn) * scale); bn = bn > 1023 ? 1023 : bn;
                    __hip_atomic_fetch_add(hist + (bn >> 1), 1u << (16 * (bn & 1)), __ATOMIC_RELAXED, __HIP_MEMORY_SCOPE_WORKGROUP); } } } }
            asm volatile("s_waitcnt lgkmcnt(0)" ::: "memory");
            unsigned wq[8];
            { const u32x4 h0 = *(LAS u32x4*)(hist + 8 * lane), h1 = *(LAS u32x4*)(hist + 8 * lane + 4);
              wq[0] = h0.x; wq[1] = h0.y; wq[2] = h0.z; wq[3] = h0.w; wq[4] = h1.x; wq[5] = h1.y; wq[6] = h1.z; wq[7] = h1.w; }
            int sl = 0;
#pragma unroll
            for (int q = 0; q < 8; ++q) sl += (int)(wq[q] & 0xffffu) + (int)(wq[q] >> 16);
            int v = sl;
#pragma unroll
            for (int o = 1; o < 64; o <<= 1) { const int t = __shfl_down(v, o); v += (lane + o < 64) ? t : 0; }
            int ab = v - sl, myB = -1, myAbove = 0, myCnt = 0;
#pragma unroll
            for (int q = 15; q >= 0; --q) { const int cq = (int)((wq[q >> 1] >> (16 * (q & 1))) & 0xffffu);
                if (myB < 0 && ab < 256 && 256 <= ab + cq) { myB = 16 * lane + q; myAbove = ab; myCnt = cq; }
                ab += cq; }
            const unsigned long long bal = __ballot(myB >= 0);
            const int src = __builtin_ctzll(bal);
            const int B = __shfl(myB, src), C = __shfl(myCnt, src), need = 256 - __shfl(myAbove, src);
            if (C <= 128) {
                int outpos = 0, cp = 0;
#pragma unroll 2
                for (int it = 0; it < nit; ++it) { const bool inr = 256 * it + 4 * lane < N; const f32x4 v4 = *(const LAS f32x4*)(Sw + 256 * it + 4 * (inr ? lane : 0));
#pragma unroll
                    for (int q = 0; q < 4; ++q) { int bn = (int)((v4[q] - mn) * scale); bn = bn > 1023 ? 1023 : bn;
                        const bool inb = inr && v4[q] >= mn, take = inb && bn > B, cd = inb && bn == B; const int idx = 256 * it + 4 * lane + q;
                        const unsigned long long bt = __ballot(take), bc = __ballot(cd);
                        if (take) sel[outpos + __popcll(bt & ltmask)] = (unsigned short)idx;
                        if (cd) { const int pos = cp + __popcll(bc & ltmask); cv[pos] = v4[q]; ci[pos] = idx; }
                        outpos += __popcll(bt); cp += __popcll(bc); } }
                asm volatile("s_waitcnt lgkmcnt(0)" ::: "memory");
                const float v0 = lane < C ? cv[lane] : -INFINITY, v1 = lane + 64 < C ? cv[lane + 64] : -INFINITY;
                const int i0 = lane < C ? ci[lane] : 0x7fffffff, i1 = lane + 64 < C ? ci[lane + 64] : 0x7fffffff;
                int r0 = 0, r1 = 0;
                for (int q = 0; q < C; ++q) { const float ov = cv[q]; const int oi = ci[q];
                    r0 += (ov > v0 || (ov == v0 && oi < i0)) ? 1 : 0; r1 += (ov > v1 || (ov == v1 && oi < i1)) ? 1 : 0; }
                const bool t0 = lane < C && r0 < need, t1 = lane + 64 < C && r1 < need;
                const unsigned long long b0 = __ballot(t0);
                if (t0) sel[outpos + __popcll(b0 & ltmask)] = (unsigned short)i0;
                outpos += __popcll(b0);
                const unsigned long long b1 = __ballot(t1);
                if (t1) sel[outpos + __popcll(b1 & ltmask)] = (unsigned short)i1;
                done = true;
            }
        }
        if (!done) {
            {
                LAS int* h8 = (LAS int*)hist;
                unsigned prefix = 0u; int need8 = 256;
#pragma unroll 1
                for (int pass = 0; pass < 4; ++pass) {
                    const int shift = 24 - 8 * pass;
                    *(LAS i32x4*)(h8 + 4 * lane) = (i32x4){0, 0, 0, 0};
                    asm volatile("s_waitcnt lgkmcnt(0)" ::: "memory");
                    for (int j = 0; j < N / 64; ++j) { const unsigned u = skey(Sw[64 * j + lane]);
                        if (pass == 0 || (u >> (shift + 8)) == prefix) __hip_atomic_fetch_add((int*)(h8 + ((u >> shift) & 255u)), 1, __ATOMIC_RELAXED, __HIP_MEMORY_SCOPE_WORKGROUP); }
                    asm volatile("s_waitcnt lgkmcnt(0)" ::: "memory");
                    const i32x4 c = *(LAS i32x4*)(h8 + 4 * lane);
                    const int s4 = c.x + c.y + c.z + c.w; int vv = s4;
#pragma unroll
                    for (int o = 1; o < 64; o <<= 1) { const int t = __shfl_down(vv, o); vv += (lane + o < 64) ? t : 0; }
                    const int a3 = vv - s4, a2 = a3 + c.w, a1 = a2 + c.z, a0 = a1 + c.y;
                    int mB = -1, mA = 0;
                    if (a3 < need8 && need8 <= a3 + c.w) { mB = 4 * lane + 3; mA = a3; }
                    else if (a2 < need8 && need8 <= a2 + c.z) { mB = 4 * lane + 2; mA = a2; }
                    else if (a1 < need8 && need8 <= a1 + c.y) { mB = 4 * lane + 1; mA = a1; }
                    else if (a0 < need8 && need8 <= a0 + c.x) { mB = 4 * lane; mA = a0; }
                    const int sr = __builtin_ctzll(__ballot(mB >= 0));
                    need8 -= __shfl(mA, sr); prefix = (prefix << 8) | (unsigned)__shfl(mB, sr);
                }
                int outpos = 0, eqtaken = 0;
                for (int j = 0; j < N / 64; ++j) { const unsigned u = skey(Sw[64 * j + lane]);
                    const bool eq = (u == prefix); const unsigned long long beq = __ballot(eq);
                    const bool take = (u > prefix) || (eq && (eqtaken + __popcll(beq & ltmask) < need8));
                    const unsigned long long bt = __ballot(take);
                    if (take) sel[outpos + __popcll(bt & ltmask)] = (unsigned short)(64 * j + lane);
                    outpos += __popcll(bt); eqtaken += __popcll(beq); }
            }
        }
    }
    asm volatile("s_waitcnt lgkmcnt(0)" ::: "memory");
    if (STOP == 2) { __syncthreads(); return; }
    asm volatile("" : "+v"(lane));
    {
        const int n16 = lane & 15, g = lane >> 4, t = t0 + wave;
        bf16x8 bqf[2];
#pragma unroll
        for (int ks = 0; ks < 2; ++ks) { bqf[ks] = (bf16x8){0, 0, 0, 0, 0, 0, 0, 0};
            if (n16 < 8) bqf[ks] = *(const bf16x8*)(PROJ + (size_t)t * NPJ + C_BQ + n16 * 64 + 32 * ks + 8 * g); }
        const int ntile = nsel / 16;
        f32x4 sc[16];
        int idxv[16];
#pragma unroll
        for (int kt = 0; kt < 16; ++kt) { int pos = 16 * kt + n16; pos = pos < nsel ? pos : 0; idxv[kt] = sel[pos]; }
#pragma unroll
        for (int hb = 0; hb < 2; ++hb) {
#pragma unroll
            for (int kk = 0; kk < 8; ++kk) sc[8 * hb + kk] = (f32x4){-INFINITY, -INFINITY, -INFINITY, -INFINITY};
            if (8 * hb < ntile) {
                bf16x8 ka0[8], ka1[8];
#pragma unroll
                for (int kk = 0; kk < 8; ++kk) { const bf16_t* kr = base + (size_t)idxv[8 * hb + kk] * NPJ + C_BK + 8 * g; ka0[kk] = *(const bf16x8*)kr; ka1[kk] = *(const bf16x8*)(kr + 32); }
#pragma unroll
                for (int kk = 0; kk < 8; ++kk) { f32x4 a = (f32x4){0.f, 0.f, 0.f, 0.f};
                    a = __builtin_amdgcn_mfma_f32_16x16x32_bf16(ka0[kk], bqf[0], a, 0, 0, 0);
                    a = __builtin_amdgcn_mfma_f32_16x16x32_bf16(ka1[kk], bqf[1], a, 0, 0, 0);
                    if (8 * hb + kk < ntile) sc[8 * hb + kk] = a; }
            }
        }
        float mx = -INFINITY;
#pragma unroll
        for (int kt = 0; kt < 16; ++kt) mx = fmaxf(mx, fmaxf(fmaxf(sc[kt][0], sc[kt][1]), fmaxf(sc[kt][2], sc[kt][3])));
        mx = fmaxf(mx, __shfl_xor(mx, 16)); mx = fmaxf(mx, __shfl_xor(mx, 32));
        const float mc = mx * C2;
        float lsum = 0.f;
        bf16x8 pb[8];
#pragma unroll
        for (int s = 0; s < 8; ++s) {
            float e[8];
#pragma unroll
            for (int i = 0; i < 4; ++i) { e[i] = __builtin_amdgcn_exp2f(sc[2 * s][i] * C2 - mc); e[4 + i] = __builtin_amdgcn_exp2f(sc[2 * s + 1][i] * C2 - mc); }
#pragma unroll
            for (int i = 0; i < 8; ++i) lsum += e[i];
            u32x4 w; w.x = gp::cvt_pk_bf16(e[0], e[1]); w.y = gp::cvt_pk_bf16(e[2], e[3]); w.z = gp::cvt_pk_bf16(e[4], e[5]); w.w = gp::cvt_pk_bf16(e[6], e[7]);
            pb[s] = __builtin_bit_cast(bf16x8, w);
        }
        lsum += __shfl_xor(lsum, 16); lsum += __shfl_xor(lsum, 32);
        LAS unsigned char* Lw = (LAS unsigned char*)Sw;
        f32x4 ot[8];
#pragma unroll
        for (int cb = 0; cb < 8; ++cb) ot[cb] = (f32x4){0.f, 0.f, 0.f, 0.f};
        const int nstep = nsel / 32;
        u32x4 stgA[8], stgB[8], stgC[8];
#define DS_LOADC(dst, s_) do { if ((s_) < nstep) { _Pragma("unroll") for (int i = 0; i < 8; ++i) { const int sig = 4 * i + g; \
            dst[i] = *(const u32x4*)(base + (size_t)sel[32 * (s_) + sig] * NPJ + C_BLAT + 8 * n16); } } } while (0)
#define DS_STEP(cur, s_) do { if ((s_) < nstep) { \
            LAS unsigned char* Lb = Lw + ((s_) & 1) * 8192; \
            _Pragma("unroll") for (int i = 0; i < 8; ++i) { const int sig = 4 * i + g, ch = n16; \
                *(LAS u32x4*)(Lb + sig * 256 + (((ch >> 1) ^ (sig & 7)) * 32) + (ch & 1) * 16) = cur[i]; } \
            DS_LOADC(cur, (s_) + 3); \
            asm volatile("s_waitcnt lgkmcnt(0)" ::: "memory"); \
            const int rq = 4 * g + (n16 >> 2); \
            _Pragma("unroll") for (int cb = 0; cb < 8; ++cb) { \
                const s16x4 lo = vtr(Lb + rq * 256 + ((cb ^ (rq & 7)) * 32) + 8 * (lane & 3)); \
                const s16x4 hv = vtr(Lb + (16 + rq) * 256 + ((cb ^ (rq & 7)) * 32) + 8 * (lane & 3)); \
                const bf16x8 af = (bf16x8){lo[0], lo[1], lo[2], lo[3], hv[0], hv[1], hv[2], hv[3]}; \
                ot[cb] = __builtin_amdgcn_mfma_f32_16x16x32_bf16(af, pb[s_], ot[cb], 0, 0, 0); } } } while (0)
        DS_LOADC(stgA, 0); DS_LOADC(stgB, 1); DS_LOADC(stgC, 2);
        DS_STEP(stgA, 0); DS_STEP(stgB, 1); DS_STEP(stgC, 2); DS_STEP(stgA, 3); DS_STEP(stgB, 4); DS_STEP(stgC, 5); DS_STEP(stgA, 6); DS_STEP(stgB, 7);
#undef DS_LOADC
#undef DS_STEP
        const float linv = 1.0f / lsum;
        if (n16 < 8) {
            LAS bf16_t* Oall = (LAS bf16_t*)(lds + OALL_OFF) + (wave * 8 + n16) * 128;
#pragma unroll
            for (int cb = 0; cb < 8; ++cb) *(LAS u32x2*)(Oall + 16 * cb + 4 * g) = (u32x2){pk2(ot[cb][0] * linv, ot[cb][1] * linv), pk2(ot[cb][2] * linv, ot[cb][3] * linv)};
        }
    }
    __syncthreads();
    if (STOP == 3) return;
    asm volatile("" : "+v"(lane));
    P0Item cvi, cvj; f32x4 cva[8], cvb[8];
    const bool cvok = conv_expert_issue(p, lane, wave, cvcur, cvi, cva);
    const bool cvok2 = conv_expert_issue(p, lane, wave, cvcur, cvj, cvb);
    {
        const int n16 = lane & 15, g = lane >> 4, hh = wave;
        const bf16_t* WuvT = (const bf16_t*)(ws + WS_WUVT) + hh * 64 * 128;
        const LAS bf16_t* Oall = (const LAS bf16_t*)(lds + OALL_OFF) + ((n16 & 7) * 8 + hh) * 128;
        bf16x8 af[4];
#pragma unroll
        for (int ks = 0; ks < 4; ++ks) af[ks] = *(const LAS bf16x8*)(Oall + 32 * ks + 8 * g);
#pragma unroll
        for (int nb = 0; nb < 4; ++nb) {
            f32x4 a = (f32x4){0.f, 0.f, 0.f, 0.f};
#pragma unroll
            for (int ks = 0; ks < 4; ++ks) { const bf16x8 bf = *(const bf16x8*)(WuvT + (16 * nb + n16) * 128 + 32 * ks + 8 * g);
                a = __builtin_amdgcn_mfma_f32_16x16x32_bf16(af[ks], bf, a, 0, 0, 0); }
            if (g < 2) {
#pragma unroll
                for (int i = 0; i < 4; ++i) H[(size_t)(t0 + 4 * g + i) * DM + 512 + hh * 64 + 16 * nb + n16] = f2bf(a[i]);
            }
        }
    }
    __syncthreads();
    if (cvok) p0_finish(cvi, cva, (LAS float*)(lds + wave * 8704), lane);
    if (cvok2) p0_finish(cvj, cvb, (LAS float*)(lds + wave * 8704), lane);
    __syncthreads();
}

template <int STOP> __device__ __forceinline__ void phase(const Params& p, LAS unsigned char* lds, int tid, int lane, int wave, int& cvcur) {
    const int G = gridDim.x, k = blockIdx.x;
    const bool nice = (G == 256);
    const int nit = nice ? 16 : (4096 - k + G - 1) / G;
    for (int i = 0; i < nit; ++i) {
        int b, qt;
        if (nice) { const int j = k >> 3; b = k & 7; qt = 511 - (i * 32 + ((i & 1) ? 31 - j : j)); }
        else { const int u = k + i * G; b = u & 7; qt = 511 - (u >> 3); }
        unit<STOP>(p, lds, tid, lane, wave, b, qt, cvcur);
    }
}
}

#define XB_TMO      128
#define XB_XCNT(j)  (256  + 64 * (j))
#define XB_XSUB(j)  (1280 + 64 * (j))
#define XB_XGEN(j)  (2304 + 64 * (j))
#define XB_TOP      3328
#define XB_TOPGEN   3392
#define XCD_BAR_WORDS 3456
#define XB_SPIN_CAP (1u << 22)
__device__ __forceinline__ unsigned xb_ld(unsigned* p)              { return __hip_atomic_load(p, __ATOMIC_RELAXED, __HIP_MEMORY_SCOPE_AGENT); }
__device__ __forceinline__ unsigned xb_add(unsigned* p, unsigned v) { return __hip_atomic_fetch_add(p, v, __ATOMIC_RELAXED, __HIP_MEMORY_SCOPE_AGENT); }
__device__ __forceinline__ unsigned xb_xcc_id() { return (unsigned)__builtin_amdgcn_s_getreg((3 << 11) | 20) & 0xFu; }
#define XB_SPIN(cond, bar) do { unsigned _sp = 0; while (cond) { __builtin_amdgcn_s_sleep(1); \
    if ((++_sp & 255u) == 0u) { if (xb_ld(&(bar)[XB_TMO])) break; if (_sp > XB_SPIN_CAP) { atomicAdd(&(bar)[XB_TMO], 1u); break; } } } } while (0)
struct XcdBarrier { unsigned* bar; unsigned x; volatile LAS unsigned* st; };
__device__ __forceinline__ XcdBarrier xcd_barrier_post(unsigned* bar, volatile LAS unsigned* st) {
    XcdBarrier b; b.bar = bar; b.x = xb_xcc_id(); b.st = st;
    if (threadIdx.x == 0) (void)xb_add(&bar[XB_XCNT(b.x)], 1u);
    return b;
}
__device__ __forceinline__ void xcd_barrier_complete(unsigned* bar, unsigned x, unsigned& nloc, unsigned& nx) {
    const unsigned G = gridDim.x * gridDim.y * gridDim.z;
    unsigned sum, cnt, mine, sp = 0u;
    for (;;) {
        sum = 0u; cnt = 0u; mine = 0u;
#pragma unroll
        for (unsigned j = 0; j < 16; ++j) { const unsigned c = xb_ld(&bar[XB_XCNT(j)]); sum += c; cnt += (c > 0u) ? 1u : 0u; mine = (j == x) ? c : mine; }
        if (sum == G) break;
        __builtin_amdgcn_s_sleep(1);
        if ((++sp & 255u) == 0u) { if (xb_ld(&bar[XB_TMO])) break; if (sp > XB_SPIN_CAP) { atomicAdd(&bar[XB_TMO], 1u); break; } }
    }
    nloc = mine > 0u ? mine : 1u; nx = cnt > 0u ? cnt : 1u;
}
__device__ __forceinline__ void xcd_barrier(const XcdBarrier& b) {
    asm volatile("s_waitcnt vmcnt(0)" ::: "memory");
    __syncthreads();
    if (threadIdx.x == 0) {
        unsigned* bar = b.bar;
        __builtin_amdgcn_s_waitcnt(0);
        unsigned nloc = b.st[0], nx = b.st[1];
        if (nloc == 0u) { xcd_barrier_complete(bar, b.x, nloc, nx); b.st[0] = nloc; b.st[1] = nx; }
        const unsigned old = xb_add(&bar[XB_XSUB(b.x)], 1u);
        const unsigned gen = old / nloc;
        if (old + 1u == (gen + 1u) * nloc) {
            __builtin_amdgcn_fence(__ATOMIC_RELEASE, "agent");
            asm volatile("s_waitcnt vmcnt(0)" ::: "memory");
            const unsigned og = xb_add(&bar[XB_TOP], 1u);
            const unsigned tg = og / nx;
            if (og + 1u == (tg + 1u) * nx) xb_add(&bar[XB_TOPGEN], 1u);
            else XB_SPIN(xb_ld(&bar[XB_TOPGEN]) == tg, bar);
            __builtin_amdgcn_fence(__ATOMIC_ACQUIRE, "agent");
            xb_add(&bar[XB_XGEN(b.x)], 1u);
            asm volatile("s_waitcnt vmcnt(0)" ::: "memory");
        } else {
            XB_SPIN(xb_ld(&bar[XB_XGEN(b.x)]) == gen, bar);
            __builtin_amdgcn_fence(__ATOMIC_ACQUIRE, "agent");
            asm volatile("s_waitcnt vmcnt(0)" ::: "memory");
        }
    }
    __syncthreads();
}
constexpr int N_PHASES = 10;
__global__ void __launch_bounds__(NTHREADS, 2) mega(Params p) {
    extern __shared__ __attribute__((aligned(16))) unsigned char lds_raw[];
    LAS unsigned char* lds = (LAS unsigned char*)lds_raw;
    cg::grid_group grid = cg::this_grid();
    int tid = threadIdx.x, lane = tid & 63; const int wave = __builtin_amdgcn_readfirstlane(tid >> 6);
#define FRESH() do { tid = threadIdx.x; asm volatile("" : "+v"(tid)); lane = tid & 63; } while (0)
    unsigned char* ws = p.ws;
    const int lo = p.ph_lo, hi = p.ph_hi;
    volatile LAS unsigned* MISC = (volatile LAS unsigned*)(lds + LDS_MISC);
    if (tid < 16) MISC[tid] = 0u;
    __syncthreads();
    XcdBarrier bar = xcd_barrier_post((unsigned*)(ws + WS_CTL), MISC);
#define IN(k) (lo <= (k) && (k) < hi)
#define SEAM(k) do { if (IN(k) && IN((k) + 1)) xcd_barrier(bar); } while (0)
    if (lo < 0) grid.sync();
    if (IN(0)) { FRESH(); phase_prep(p, lds, tid, lane, wave); } SEAM(0);
    if (IN(1)) { FRESH(); phase_norm1(p, lds, tid, lane, wave); } SEAM(1);
    if (IN(2)) { FRESH();
        gp::Gemm g{(const bf16_t*)(ws + WS_H), (const bf16_t*)(ws + WS_WINT), NPJ, DM, nullptr};
        gp::StaticOrder S; S.init(NTOK, NPJ, gridDim.x, blockIdx.x);
        LAS float* gl = (LAS float*)(lds + LDS_RING + 8192);
        if (tid < 64) { gl[tid] = p.in[8][tid]; gl[64 + tid] = p.in[9][tid]; gl[128 + tid] = p.in[12][tid]; gl[192 + tid] = p.in[13][tid]; }
        if (tid < 128) gl[256 + tid] = p.in[14][tid];
        __syncthreads();
        gp::EpiInproj E{(bf16_t*)(ws + WS_PROJ), (const float*)(ws + WS_ROPE), gl, (LAS float*)(lds + LDS_RING), ws + WS_IKF};
        gp::gemm_phase<gp::EpiInproj, gp::StaticOrder, false>(lds, g, S, E);
    } SEAM(2);
    if (IN(3)) { int cvcur = 0;
        const bool dsa_first = (((int)blockIdx.x >> 3) & 1) != 0;
        if (!dsa_first) { FRESH(); da::phase(p, lds, tid, lane, wave, cvcur); }
        FRESH(); ds::phase<0>(p, lds, tid, lane, wave, cvcur);
        if (dsa_first) { FRESH(); da::phase(p, lds, tid, lane, wave, cvcur); }
        conv_expert_items(p, lds, lane, wave, cvcur, 1 << 20); } SEAM(3);
    if (IN(4)) { FRESH();
        gp::Gemm g{(const bf16_t*)(ws + WS_H), (const bf16_t*)(ws + WS_WOUTT), DM, DM, nullptr};
        gp::StaticOrder S; S.init(NTOK, DM, gridDim.x, blockIdx.x);
        gp::EpiResid E{p.in[0], p.out, (const float*)(ws + WS_MOD)};
        gp::gemm_phase<gp::EpiResid, gp::StaticOrder, false>(lds, g, S, E);
    } SEAM(4);
    if (IN(5)) { FRESH(); phase_norm2(p, lds, tid, lane, wave); } SEAM(5);
    if (IN(6)) { FRESH(); phase_scatter(p, lds, tid, lane, wave); } SEAM(6);
    if (IN(7)) { FRESH();
        const int* tile_e = (const int*)(ws + WS_TILEE);
        gp::Gemm g{(const bf16_t*)(ws + WS_H), (const bf16_t*)(ws + WS_WGUT), 2048, DM, (const int*)(ws + WS_ROWSRC)};
        gp::MoeOrder S{tile_e, tile_e[MAXTILES], 8, (int)blockIdx.x, (int)gridDim.x};
        gp::EpiSwiglu E{(bf16_t*)(ws + WS_ACT), p.in[19], p.in[21]};
        gp::gemm_phase<gp::EpiSwiglu, gp::MoeOrder, true>(lds, g, S, E);
    } SEAM(7);
    if (IN(8)) { FRESH();
        const int* tile_e = (const int*)(ws + WS_TILEE);
        gp::Gemm g{(const bf16_t*)(ws + WS_ACT), (const bf16_t*)(ws + WS_WDT), DM, DM, nullptr};
        gp::MoeOrder S{tile_e, tile_e[MAXTILES], 4, (int)blockIdx.x, (int)gridDim.x};
        gp::EpiDown E{p.out, (bf16_t*)(ws + WS_Y), p.in[23], (const float*)(ws + WS_MOD), (const int2*)(ws + WS_ROWMETA)};
        gp::gemm_phase<gp::EpiDown, gp::MoeOrder, false>(lds, g, S, E);
    } SEAM(8);
    if (IN(9)) { FRESH(); phase_combine(p, tid); }
#undef IN
#undef SEAM
}

static int g_grid = 0;
static void launch_mega(const Params& base, int lo, int hi, hipStream_t stream) {
    Params p = base; p.ph_lo = lo; p.ph_hi = hi;
    void* args[] = {&p};
    hipError_t e = hipLaunchCooperativeKernel((const void*)mega, dim3(g_grid), dim3(NTHREADS), args, LDS_BYTES, stream);
    if (e != hipSuccess) fprintf(stderr, "kernel_launch: cooperative launch [%d,%d) failed: %s (grid %d)\n", lo, hi, hipGetErrorString(e), g_grid);
}
extern "C" void kernel_launch(void* const* d_in, const int* in_sizes, int n_in, void* d_out, int out_size, void* d_ws, size_t ws_size, hipStream_t stream) {
    if (ws_size < WS_END) { fprintf(stderr, "kernel_launch: workspace too small: %zu < %zu\n", ws_size, (size_t)WS_END); return; }
    if (g_grid == 0) {
        int dev = 0, cus = 0, per_cu = 0;
        hipGetDevice(&dev); hipDeviceGetAttribute(&cus, hipDeviceAttributeMultiprocessorCount, dev);
        if (hipFuncSetAttribute((const void*)mega, hipFuncAttributeMaxDynamicSharedMemorySize, LDS_BYTES) != hipSuccess) fprintf(stderr, "kernel_launch: hipFuncSetAttribute failed\n");
        hipOccupancyMaxActiveBlocksPerMultiprocessor(&per_cu, (const void*)mega, NTHREADS, LDS_BYTES);
        (void)hipGetLastError();
        if (per_cu < 1) { fprintf(stderr, "kernel_launch: occupancy query says %d blocks/CU\n", per_cu); per_cu = 1; }
        g_grid = cus * 1;
        fprintf(stderr, "kernel_launch: cus %d per_cu %d grid %d\n", cus, per_cu, g_grid);
    }
    const float* x = (const float*)d_in[0];
    float* out = (float*)d_out; char* ws = (char*)d_ws;
    float* mod = (float*)(ws + WS_MOD); float* rope = (float*)(ws + WS_ROPE); float* lam = (float*)(ws + WS_LAM);
    float* IW = (float*)(ws + WS_IW);
    bf16_t* H = (bf16_t*)(ws + WS_H); bf16_t* PROJ = (bf16_t*)(ws + WS_PROJ);
    Params P{};
    for (int i = 0; i < 24; ++i) P.in[i] = (const float*)d_in[i];
    P.out = out; P.ws = (unsigned char*)d_ws;

    (void)hipMemsetAsync((char*)d_ws + WS_CTL, 0, 16384, stream);
    launch_mega(P, 0, N_PHASES, stream);
    (void)rope; (void)lam; (void)IW; (void)H; (void)PROJ;
    (void)x; (void)mod;
}
```

```cpp
#include <hip/hip_runtime.h>
#include <stdint.h>
#include <cstdio>

typedef unsigned short bf16_t;
__device__ __forceinline__ float bf2f(bf16_t v) { return __uint_as_float(((unsigned)v) << 16); }
__device__ __forceinline__ bf16_t f2bf(float f) { unsigned u = __float_as_uint(f); return (bf16_t)((u + 0x7fffu + ((u >> 16) & 1u)) >> 16); }

constexpr int NB = 8, SEQ = 4096, DM = 1024, NTOK = NB * SEQ;
constexpr int NIN = 2824, NPJ = 2816;
constexpr int C_AQ1 = 0, C_AQ2 = 256, C_AK1 = 512, C_AK2 = 768, C_AV = 1024, C_BQ = 1536, C_BK = 2048, C_BLAT = 2112, C_IQ = 2240, C_IK = 2752, C_IW = 2816;
constexpr int NEXP = 32, TOPK = 4, NPAIR = NTOK * TOPK;
constexpr int MAXTILES = NPAIR / 256 + NEXP;
constexpr int PPAD = MAXTILES * 256;
constexpr int NCHUNK = 256, CHTOK = NTOK / NCHUNK;
constexpr float RMS_EPS = 1e-6f;
constexpr float LAMBDA_INIT = 0.2f;

constexpr size_t MiB = 1u << 20;
constexpr size_t WS_CTL = 0;
constexpr size_t WS_MOD = 1 * MiB;
constexpr size_t WS_ROPE = WS_MOD + 256 * 1024;
constexpr size_t WS_LAM = WS_ROPE + 256 * 1024;
constexpr size_t WS_CHCNT = WS_LAM + 4096;
constexpr size_t WS_TILEE = WS_CHCNT + 32768;
constexpr size_t WS_TOPI = 2 * MiB;
constexpr size_t WS_TOPG = WS_TOPI + 512 * 1024;
constexpr size_t WS_ROWTOK = 3 * MiB;
constexpr size_t WS_ROWSRC = 3 * MiB + 640 * 1024;
constexpr size_t WS_IW = 5 * MiB;
constexpr size_t WS_ROWMETA = 6 * MiB;
constexpr size_t WS_WINT = 8 * MiB;
constexpr size_t WS_WOUTT = 14 * MiB;
constexpr size_t WS_WUVT = 16 * MiB;
constexpr size_t WS_WDT = 17 * MiB;
constexpr size_t WS_WGUT = 81 * MiB;
constexpr size_t WS_H = 209 * MiB;
constexpr size_t WS_PROJ = 273 * MiB;
constexpr size_t WS_ACT = WS_PROJ;
constexpr size_t WS_Y = WS_WGUT;
constexpr size_t WS_IKF = WS_ACT + (size_t)PPAD * 1024 * 2;
constexpr size_t WS_END = WS_IKF + 4 * MiB;

namespace gp {
#define GP_LAS __attribute__((address_space(3)))
typedef short bf16x8 __attribute__((ext_vector_type(8)));
typedef float f32x4 __attribute__((ext_vector_type(4)));
typedef unsigned u32x4 __attribute__((ext_vector_type(4)));
constexpr int BM = 256, BK = 64, HALF = 128, HTB = HALF * BK * 2  , STAGE_BYTES = 8 * HTB;

__host__ __device__ __forceinline__ int lds_byte(int r, int c) { const int st = (r >> 4) * 2 + (c >> 5), rr = r & 15, cc = c & 31, ob = rr * 64 + cc * 2; return st * 1024 + (ob ^ (((ob >> 9) & 1) << 5)); }
__host__ __device__ __forceinline__ void stage_rc(int b, int& R, int& C) { const int st = b / 1024, sb = b % 1024, swz = sb ^ (((sb >> 9) & 1) << 5); R = (st >> 1) * 16 + swz / 64; C = (st & 1) * 32 + (swz % 64) / 2; }
__host__ __device__ __forceinline__ int perm32(int rho) { const int n = rho >> 4, i = rho & 15; return 8 * (i >> 2) + 4 * n + (i & 3); }

struct Unit { int pm, pn, e; };
struct Gemm { const bf16_t* A; const bf16_t* Bt; int N, K; const int* rowsrc; };

struct StaticOrder {
    int nM, nN, nwg, G, c;
    __device__ void init(int M, int N, int G_, int c_) { nM = M / BM; nN = N / BM; nwg = nM * nN; G = G_; c = c_; }
    __device__ bool next(int i, Unit& u) const {
        const long L = (long)i * G + c; if (L >= nwg) return false;
        int wgid = (int)L; { const int q = nwg / 8, r = nwg % 8, xcd = wgid % 8, off = wgid / 8; wgid = (xcd < r ? xcd * (q + 1) : r * (q + 1) + (xcd - r) * q) + off; }
        const int nig = 8 * nN, gid = wgid / nig, fm = gid * 8, gsz = (nM - fm) < 8 ? (nM - fm) : 8;
        u.pm = fm + ((wgid % nig) % gsz); u.pn = (wgid % nig) / gsz; u.e = 0; return true;
    }
};
struct MoeOrder {
    const int* tile_e; int ntiles, nN, c, G;
    __device__ bool next(int i, Unit& u) const {
        const int j = c >> 3, x = c & 7, tpx = (G >> 3) / nN;
        const int tile = i * (tpx * 8) + x * tpx + j / nN;
        if (tile >= ntiles) return false;
        u.pm = tile; u.pn = j % nN; u.e = tile_e[tile]; return true;
    }
};

__device__ __forceinline__ unsigned cvt_pk_bf16(float lo, float hi) { unsigned r; asm volatile("v_cvt_pk_bf16_f32 %0, %1, %2" : "=v"(r) : "v"(lo), "v"(hi)); return r; }

struct EpiBf16 {
    bf16_t* O; int ldc;
    __device__ __forceinline__ void operator()(const f32x4 (&acc)[2][2][4][2], const Unit& u, int wr, int wc, int fr, int fq) const {
        const int row0 = u.pm * BM + wr * 64 + fr, col0 = u.pn * BM + wc * 32 + 8 * fq;
#pragma unroll
        for (int ai = 0; ai < 2; ++ai)
#pragma unroll
            for (int m = 0; m < 4; ++m) { bf16_t* rowp = O + (size_t)(row0 + ai * HALF + m * 16) * ldc + col0;
#pragma unroll
                for (int bj = 0; bj < 2; ++bj) { const f32x4 v0 = acc[ai][bj][m][0], v1 = acc[ai][bj][m][1];
                    u32x4 w; w.x = cvt_pk_bf16(v0[0], v0[1]); w.y = cvt_pk_bf16(v0[2], v0[3]); w.z = cvt_pk_bf16(v1[0], v1[1]); w.w = cvt_pk_bf16(v1[2], v1[3]);
                    *(u32x4*)(rowp + bj * HALF) = w; } }
    }
};

struct EpiInproj {
    bf16_t* O; const float* rope; GP_LAS const float* gl; GP_LAS float* xch; unsigned char* ikf;
    __device__ __forceinline__ void operator()(const f32x4 (&acc)[2][2][4][2], const Unit& u, int wr, int wc, int fr, int fq) const {
        const int wid = wr * 4 + wc, row0 = u.pm * BM + wr * 64 + fr, col0 = u.pn * BM + wc * 32 + 8 * fq, lc = (wc & 1) * 32 + 8 * fq;
        int mode[2]; int goff[2];
#pragma unroll
        for (int bj = 0; bj < 2; ++bj) { const int gc = u.pn * BM + bj * HALF + (wc >> 1) * 64; goff[bj] = 0;
            if (gc < 512) { mode[bj] = 1; goff[bj] = lc; } else if (gc < 1024) { mode[bj] = 1; goff[bj] = 64 + lc; } else if (gc < 1536) { mode[bj] = 0; }
            else if (gc < 2048) { mode[bj] = 1; goff[bj] = 128 + lc; } else if (gc < 2112) { mode[bj] = 1; goff[bj] = 192 + lc; }
            else if (gc < 2240) { mode[bj] = 3; goff[bj] = 256 + (gc - 2112) + lc; } else { mode[bj] = 2; } }
#pragma unroll
        for (int ai = 0; ai < 2; ++ai)
#pragma unroll
            for (int m = 0; m < 4; ++m)
#pragma unroll
                for (int bj = 0; bj < 2; ++bj) { const f32x4 a = acc[ai][bj][m][0], b = acc[ai][bj][m][1];
                    float s = ((a[0] * a[0] + a[1] * a[1]) + (a[2] * a[2] + a[3] * a[3])) + ((b[0] * b[0] + b[1] * b[1]) + (b[2] * b[2] + b[3] * b[3]));
                    s += __shfl_xor(s, 16); s += __shfl_xor(s, 32);
                    if (fq == 0) xch[(wid * 2 + bj) * 128 + ai * 64 + m * 16 + fr] = s; }
        asm volatile("s_waitcnt lgkmcnt(0)" ::: "memory"); __builtin_amdgcn_s_barrier(); asm volatile("" ::: "memory");
#pragma unroll
        for (int ai = 0; ai < 2; ++ai)
#pragma unroll
            for (int m = 0; m < 4; ++m) { int rl = ai * 64 + m * 16 + fr, row = row0 + ai * HALF + m * 16; asm volatile("" : "+v"(rl), "+v"(row)); const int pos = row % SEQ;
                bf16_t* rowp = O + (size_t)row * NPJ + col0;
#pragma unroll
                for (int bj = 0; bj < 2; ++bj) { f32x4 v0 = acc[ai][bj][m][0], v1 = acc[ai][bj][m][1];
                    if (mode[bj] == 1 || mode[bj] == 3) {
                        float tot = xch[(wid * 2 + bj) * 128 + rl] + xch[((wid ^ 1) * 2 + bj) * 128 + rl];
                        if (mode[bj] == 3) tot += xch[((wr * 4 + (wc ^ 2)) * 2 + (bj ^ 1)) * 128 + rl] + xch[((wr * 4 + (wc ^ 3)) * 2 + (bj ^ 1)) * 128 + rl];
                        const float r = 1.0f / sqrtf(tot * (mode[bj] == 3 ? (1.f / 128.f) : (1.f / 64.f)) + RMS_EPS);
                        const f32x4 g0 = *(GP_LAS const f32x4*)(gl + goff[bj]), g1 = *(GP_LAS const f32x4*)(gl + goff[bj] + 4);
                        v0 = v0 * r * g0; v1 = v1 * r * g1; }
                    if ((mode[bj] == 1 || mode[bj] == 2) && (wc & 1) == 0) {
                        f32x4 o0, o1;
#pragma unroll
                        for (int i = 0; i < 4; ++i) { o0[i] = __shfl_xor(v0[i], 16); o1[i] = __shfl_xor(v1[i], 16); }
                        if (fq < 2) { const float* rp = rope + pos * 16; const float sg = fq == 0 ? -1.0f : 1.0f;
                            const f32x4 t0 = *(const f32x4*)(rp), t1 = *(const f32x4*)(rp + 4), t2 = *(const f32x4*)(rp + 8), t3 = *(const f32x4*)(rp + 12);
                            v0[0] = v0[0] * t0[0] + sg * o0[0] * t0[1]; v0[1] = v0[1] * t0[2] + sg * o0[1] * t0[3];
                            v0[2] = v0[2] * t1[0] + sg * o0[2] * t1[1]; v0[3] = v0[3] * t1[2] + sg * o0[3] * t1[3];
                            v1[0] = v1[0] * t2[0] + sg * o1[0] * t2[1]; v1[1] = v1[1] * t2[2] + sg * o1[1] * t2[3];
                            v1[2] = v1[2] * t3[0] + sg * o1[2] * t3[1]; v1[3] = v1[3] * t3[2] + sg * o1[3] * t3[3]; } }
                    u32x4 w; w.x = cvt_pk_bf16(v0[0], v0[1]); w.y = cvt_pk_bf16(v0[2], v0[3]); w.z = cvt_pk_bf16(v1[0], v1[1]); w.w = cvt_pk_bf16(v1[2], v1[3]);
                    *(u32x4*)(rowp + bj * HALF) = w;
                    if (u.pn == 10 && bj == 1 && wc >= 2) {
                        const int key = row % SEQ, c8 = (wc & 1) * 4 + fq;
                        *(u32x4*)(ikf + ((size_t)((((row / SEQ) * 128 + (key >> 5)) * 4 + (c8 >> 1)) * 64 + (c8 & 1) * 32 + (key & 31)) << 4)) = w; } }
                asm volatile("" ::: "memory"); }
    }
};
struct EpiResid {
    const float* x; float* out; const float* mod;
    __device__ __forceinline__ void operator()(const f32x4 (&acc)[2][2][4][2], const Unit& u, int wr, int wc, int fr, int fq) const {
        const int row0 = u.pm * BM + wr * 64 + fr, col0 = u.pn * BM + wc * 32 + 8 * fq, b = (u.pm * BM) / SEQ;
        f32x4 gv[2][2];
#pragma unroll
        for (int bj = 0; bj < 2; ++bj)
#pragma unroll
            for (int n = 0; n < 2; ++n) gv[bj][n] = *(const f32x4*)(mod + b * 6144 + 2 * 1024 + col0 + bj * HALF + 4 * n);
#pragma unroll
        for (int ai = 0; ai < 2; ++ai)
#pragma unroll
            for (int m = 0; m < 4; ++m) { const size_t off = (size_t)(row0 + ai * HALF + m * 16) * DM + col0;
#pragma unroll
                for (int bj = 0; bj < 2; ++bj)
#pragma unroll
                    for (int n = 0; n < 2; ++n) { const f32x4 xv = *(const f32x4*)(x + off + bj * HALF + 4 * n);
                        *(f32x4*)(out + off + bj * HALF + 4 * n) = xv + gv[bj][n] * acc[ai][bj][m][n]; }
                asm volatile("" ::: "memory"); }
    }
};
struct EpiSwiglu {
    bf16_t* act; const float* bg; const float* bu;
    __device__ __forceinline__ void operator()(const f32x4 (&acc)[2][2][4][2], const Unit& u, int wr, int wc, int fr, int fq) const {
        const int row0 = u.pm * BM + wr * 64 + fr, ff0 = u.pn * HALF + wc * 32 + 8 * fq;
        f32x4 bgv[2], buv[2];
#pragma unroll
        for (int n = 0; n < 2; ++n) { bgv[n] = *(const f32x4*)(bg + u.e * 1024 + ff0 + 4 * n); buv[n] = *(const f32x4*)(bu + u.e * 1024 + ff0 + 4 * n); }
#pragma unroll
        for (int ai = 0; ai < 2; ++ai)
#pragma unroll
            for (int m = 0; m < 4; ++m) {
                float a[8];
#pragma unroll
                for (int n = 0; n < 2; ++n) { const f32x4 g4 = acc[ai][0][m][n] + bgv[n], u4 = acc[ai][1][m][n] + buv[n];
#pragma unroll
                    for (int j = 0; j < 4; ++j) { const float g = fminf(g4[j], 7.0f), uu = fminf(fmaxf(u4[j], -7.0f), 7.0f);
                        const float sg = __builtin_amdgcn_rcpf(1.0f + __builtin_amdgcn_exp2f(-1.702f * 1.4426950408889634f * g));
                        a[4 * n + j] = g * sg * (uu + 1.0f); } }
                u32x4 w; w.x = cvt_pk_bf16(a[0], a[1]); w.y = cvt_pk_bf16(a[2], a[3]); w.z = cvt_pk_bf16(a[4], a[5]); w.w = cvt_pk_bf16(a[6], a[7]);
                *(u32x4*)(act + (size_t)(row0 + ai * HALF + m * 16) * 1024 + ff0) = w; }
    }
};
struct EpiDown {
    float* out; bf16_t* Y; const float* bd; const float* mod; const int2* rowmeta;
    __device__ __forceinline__ void operator()(const f32x4 (&acc)[2][2][4][2], const Unit& u, int wr, int wc, int fr, int fq) const {
        const int row0 = u.pm * BM + wr * 64 + fr, col0 = u.pn * BM + wc * 32 + 8 * fq;
        f32x4 bv[2][2];
#pragma unroll
        for (int bj = 0; bj < 2; ++bj)
#pragma unroll
            for (int n = 0; n < 2; ++n) bv[bj][n] = *(const f32x4*)(bd + u.e * 1024 + col0 + bj * HALF + 4 * n);
        int2 meta[2][4];
#pragma unroll
        for (int ai = 0; ai < 2; ++ai)
#pragma unroll
            for (int m = 0; m < 4; ++m) meta[ai][m] = rowmeta[row0 + ai * HALF + m * 16];
#pragma unroll
        for (int ai = 0; ai < 2; ++ai)
#pragma unroll
            for (int m = 0; m < 4; ++m) {
                const int ent = meta[ai][m].x;
                if (ent >= 0) {
                    const int tok = ent >> 2, kk = ent & 3; const float gt = __int_as_float(meta[ai][m].y);
                    if (kk == 0) { const float* g2 = mod + (tok / SEQ) * 6144 + 5 * 1024 + col0; float* op = out + (size_t)tok * DM + col0;
#pragma unroll
                        for (int bj = 0; bj < 2; ++bj)
#pragma unroll
                            for (int n = 0; n < 2; ++n) { const f32x4 g4 = *(const f32x4*)(g2 + bj * HALF + 4 * n), o4 = *(const f32x4*)(op + bj * HALF + 4 * n);
                                *(f32x4*)(op + bj * HALF + 4 * n) = o4 + g4 * ((acc[ai][bj][m][n] + bv[bj][n]) * gt); }
                    } else { bf16_t* yp = Y + ((size_t)(kk - 1) * NTOK + tok) * DM + col0;
#pragma unroll
                        for (int bj = 0; bj < 2; ++bj) { const f32x4 v0 = (acc[ai][bj][m][0] + bv[bj][0]) * gt, v1 = (acc[ai][bj][m][1] + bv[bj][1]) * gt;
                            u32x4 w; w.x = cvt_pk_bf16(v0[0], v0[1]); w.y = cvt_pk_bf16(v0[2], v0[3]); w.z = cvt_pk_bf16(v1[0], v1[1]); w.w = cvt_pk_bf16(v1[2], v1[3]);
                            *(u32x4*)(yp + bj * HALF) = w; } }
                }
                asm volatile("" ::: "memory"); }
    }
};

template <class Epi, class Sched, bool GATHER>
__device__ __forceinline__ void gemm_phase(GP_LAS unsigned char* lds, const Gemm g, const Sched& S, const Epi& E) {
    const int tid = threadIdx.x, wid = __builtin_amdgcn_readfirstlane(tid >> 6), lane = tid & 63, wr = wid >> 2, wc = wid & 3, fr = lane & 15, fq = lane >> 4;
    const int K = g.K, nt = K / BK;
    unsigned voffB[2];
#pragma unroll
    for (int i = 0; i < 2; ++i) { int R, C; stage_rc(tid * 16 + i * 8192, R, C); const int Rb = (R & ~31) + perm32(R & 31); voffB[i] = (unsigned)(Rb * K + C) * 2u; }
    const size_t kstep = (size_t)(BK * 2);
    const size_t hstep = (size_t)HALF * K * 2;
    const size_t tstep = 2 * hstep;
    const unsigned ldsw = (unsigned)wid * 1024u;
    const int aoff = lds_byte(wr * 64 + fr, fq * 8), boff = lds_byte(wc * 32 + fr, fq * 8);
#define GP_SA(b, h) (((b) * 2 + (h)) * HTB)
#define GP_SB(b, h) ((4 + (b) * 2 + (h)) * HTB)
#define GP_STAGE(bufoff, gbase, voff) do { _Pragma("unroll") for (int _i = 0; _i < 2; ++_i) \
        __builtin_amdgcn_global_load_lds((const unsigned*)((const char*)(gbase) + (voff)[_i]), (GP_LAS unsigned*)(lds + (bufoff) + ldsw + _i * 8192), 16, 0, 0); } while (0)
#define GP_LDA(dst, b, h) do { _Pragma("unroll") for (int m = 0; m < 4; ++m) _Pragma("unroll") for (int k = 0; k < 2; ++k) dst[m][k] = *(const GP_LAS bf16x8*)(lds + GP_SA(b, h) + aoff + m * 2048 + k * 1024); } while (0)
#define GP_LDB(dst, b, h) do { _Pragma("unroll") for (int n = 0; n < 2; ++n) _Pragma("unroll") for (int k = 0; k < 2; ++k) dst[n][k] = *(const GP_LAS bf16x8*)(lds + GP_SB(b, h) + boff + n * 2048 + k * 1024); } while (0)
#define GP_MMA(ai, bj, At, Bt) do { __builtin_amdgcn_s_setprio(1); _Pragma("unroll") for (int m = 0; m < 4; ++m) _Pragma("unroll") for (int n = 0; n < 2; ++n) _Pragma("unroll") for (int k = 0; k < 2; ++k) \
        acc[ai][bj][m][n] = __builtin_amdgcn_mfma_f32_16x16x32_bf16(Bt[n][k], At[m][k], acc[ai][bj][m][n], 0, 0, 0); __builtin_amdgcn_s_setprio(0); } while (0)
#define GP_WAIT_V(n) asm volatile("s_waitcnt vmcnt(" #n ")" ::: "memory")
#define GP_WAIT_L(n) asm volatile("s_waitcnt lgkmcnt(" #n ")" ::: "memory")
#define GP_BAR __builtin_amdgcn_s_barrier()
#define GP_SCHED __builtin_amdgcn_sched_barrier(0)
#define GP_AOFFS(u_, v0_, v1_) do { _Pragma("unroll") for (int _i = 0; _i < 2; ++_i) { int R_, C_; stage_rc(tid * 16 + _i * 8192, R_, C_); int r0_ = (u_).pm * BM + R_, r1_ = r0_ + HALF; \
        if (GATHER) { r0_ = g.rowsrc[r0_]; r1_ = g.rowsrc[r1_]; } \
        v0_[_i] = (unsigned)(r0_ * K + C_) * 2u; v1_[_i] = (unsigned)(r1_ * K + C_) * 2u; } } while (0)
    Unit cur, nxt; int ui = 0;
    if (!S.next(0, cur)) return;
    f32x4 acc[2][2][4][2];
#pragma unroll
    for (int a = 0; a < 2; ++a)
#pragma unroll
        for (int b = 0; b < 2; ++b)
#pragma unroll
            for (int m = 0; m < 4; ++m)
#pragma unroll
                for (int n = 0; n < 2; ++n) acc[a][b][m][n] = (f32x4){0.f, 0.f, 0.f, 0.f};
    bf16x8 At[4][2], B0[2][2], B1[2][2];
    unsigned vA0[2], vA1[2], nA0[2], nA1[2];
    GP_AOFFS(cur, vA0, vA1);
    const char* Ab = (const char*)g.A;
    const char* cB = (const char*)g.Bt + ((size_t)cur.e * g.N + (size_t)cur.pn * BM) * K * 2;
    GP_STAGE(GP_SB(0, 0), cB, voffB); GP_STAGE(GP_SB(0, 1), cB + hstep, voffB); GP_STAGE(GP_SA(0, 0), Ab, vA0); GP_STAGE(GP_SA(0, 1), Ab, vA1);
    if (wr == 1) GP_BAR;
    GP_WAIT_V(2); GP_BAR;
    GP_STAGE(GP_SB(1, 0), cB + kstep, voffB); GP_STAGE(GP_SA(1, 0), Ab + kstep, vA0); GP_STAGE(GP_SB(1, 1), cB + hstep + kstep, voffB);
    GP_WAIT_V(6); GP_BAR;
    for (;;) {
        const bool has_next = S.next(ui + 1, nxt);
        const char* nB = cB;
        if (has_next) { nB = (const char*)g.Bt + ((size_t)nxt.e * g.N + (size_t)nxt.pn * BM) * K * 2; GP_AOFFS(nxt, nA0, nA1); }
        else { nA0[0] = vA0[0]; nA0[1] = vA0[1]; nA1[0] = vA1[0]; nA1[1] = vA1[1]; }
        for (int t = 0; t < nt; t += 2) {
            const bool last = (t == nt - 2);
            const char* a1 = Ab + (size_t)(t + 1) * kstep;
            const char* a2 = last ? Ab : Ab + (size_t)(t + 2) * kstep; const char* b2 = last ? nB : cB + (size_t)(t + 2) * kstep;
            const char* a3 = a2 + kstep; const char* b3 = b2 + kstep;
            GP_LDB(B0, 0, 0); GP_LDB(B1, 0, 1); GP_SCHED; GP_LDA(At, 0, 0); GP_STAGE(GP_SA(1, 1), a1, vA1);
            if (last) { vA0[0] = nA0[0]; vA0[1] = nA0[1]; vA1[0] = nA1[0]; vA1[1] = nA1[1]; }
            GP_WAIT_V(8); GP_WAIT_L(0); GP_BAR; GP_MMA(0, 0, At, B0); GP_MMA(0, 1, At, B1); GP_BAR; GP_SCHED;
            GP_LDA(At, 0, 1); GP_STAGE(GP_SB(0, 0), b2, voffB); GP_STAGE(GP_SB(0, 1), b2 + hstep, voffB); GP_STAGE(GP_SA(0, 0), a2, vA0);
            GP_WAIT_V(8); GP_WAIT_L(0); GP_BAR; GP_MMA(1, 0, At, B0); GP_MMA(1, 1, At, B1); GP_BAR; GP_SCHED;
            GP_LDB(B0, 1, 0); GP_LDB(B1, 1, 1); GP_SCHED; GP_LDA(At, 1, 0); GP_STAGE(GP_SA(0, 1), a2, vA1);
            GP_WAIT_V(8); GP_WAIT_L(0); GP_BAR; GP_MMA(0, 0, At, B0); GP_MMA(0, 1, At, B1); GP_BAR; GP_SCHED;
            GP_LDA(At, 1, 1); GP_STAGE(GP_SB(1, 0), b3, voffB); GP_STAGE(GP_SB(1, 1), b3 + hstep, voffB); GP_STAGE(GP_SA(1, 0), a3, vA0);
            GP_WAIT_V(8); GP_WAIT_L(0); GP_BAR; GP_MMA(1, 0, At, B0); GP_MMA(1, 1, At, B1); GP_BAR; GP_SCHED;
        }
        if (wr == 0) GP_BAR;
        E(acc, cur, wr, wc, fr, fq);
        if (!has_next) break;
#pragma unroll
        for (int a = 0; a < 2; ++a)
#pragma unroll
            for (int b = 0; b < 2; ++b)
#pragma unroll
                for (int m = 0; m < 4; ++m)
#pragma unroll
                    for (int n = 0; n < 2; ++n) acc[a][b][m][n] = (f32x4){0.f, 0.f, 0.f, 0.f};
        cur = nxt; cB = nB; ++ui;
        if (wr == 1) GP_BAR;
    }
    GP_WAIT_V(0);
    GP_BAR;
#undef GP_SA
#undef GP_SB
#undef GP_STAGE
#undef GP_LDA
#undef GP_LDB
#undef GP_MMA
#undef GP_WAIT_V
#undef GP_WAIT_L
#undef GP_BAR
#undef GP_SCHED
#undef GP_AOFFS
}
}
#include <hip/hip_cooperative_groups.h>
namespace cg = cooperative_groups;
#define LAS __attribute__((address_space(3)))
typedef float f32x4 __attribute__((ext_vector_type(4)));
typedef unsigned u32x4 __attribute__((ext_vector_type(4)));
typedef short bf16x8 __attribute__((ext_vector_type(8)));
constexpr int NWAVES = 8, NTHREADS = 512;
constexpr int LDS_RING = 131072;
constexpr int LDS_MISC = 159744;
constexpr int LDS_BYTES = 159744 + 256;

struct Params {
    const float* in[24];
    float* out; unsigned char* ws;
    int ph_lo, ph_hi;
};
__device__ __forceinline__ unsigned pk2(float lo, float hi) { return (unsigned)f2bf(lo) | ((unsigned)f2bf(hi) << 16); }
__device__ __forceinline__ float wave_sum(float v) {
#pragma unroll
    for (int o = 1; o < 64; o <<= 1) v += __shfl_xor(v, o);
    return v;
}

struct P0Item { const float* W; int ld, k0, n0; bf16_t* WT; int row0, Kdst; };
__device__ __forceinline__ void p0_load(const P0Item& it, f32x4 (&v)[8], int lane) {
#pragma unroll
    for (int i = 0; i < 8; ++i) v[i] = __builtin_nontemporal_load((const f32x4*)(it.W + (size_t)(it.k0 + 8 * i + (lane >> 3)) * it.ld + it.n0 + 4 * (lane & 7)));
}
__device__ __forceinline__ void p0_finish(const P0Item& it, const f32x4 (&v)[8], LAS float* scr, int lane) {
#pragma unroll
    for (int i = 0; i < 8; ++i) { LAS float* d = scr + (8 * i + (lane >> 3)) * 33 + 4 * (lane & 7); d[0] = v[i][0]; d[1] = v[i][1]; d[2] = v[i][2]; d[3] = v[i][3]; }
    asm volatile("s_waitcnt lgkmcnt(0)" ::: "memory");
    const int c = lane & 7;
#pragma unroll
    for (int j = 0; j < 4; ++j) { const int n = (lane >> 3) + 8 * j; const LAS float* s = scr + (8 * c) * 33 + n;
        u32x4 o; o.x = pk2(s[0 * 33], s[1 * 33]); o.y = pk2(s[2 * 33], s[3 * 33]); o.z = pk2(s[4 * 33], s[5 * 33]); o.w = pk2(s[6 * 33], s[7 * 33]);
        *(u32x4*)(it.WT + (size_t)(it.row0 + n) * it.Kdst + it.k0 + 8 * c) = o; }
    asm volatile("s_waitcnt lgkmcnt(0)" ::: "memory");
}
__device__ __forceinline__ void phase_prep(const Params& p, LAS unsigned char* lds, int tid, int lane, int wave) {
    unsigned char* ws = p.ws;
    {
        LAS float* sc = (LAS float*)lds;
        LAS float* part = (LAS float*)(lds + 32768);
        const float* c = p.in[1]; const float* w_ada = p.in[4]; const float* b_ada = p.in[5];
        {   f32x4 cv4[4];
#pragma unroll
            for (int j = 0; j < 4; ++j) cv4[j] = *(const f32x4*)(c + 4 * (tid + NTHREADS * j));
#pragma unroll
            for (int j = 0; j < 4; ++j) { f32x4 o4;
#pragma unroll
                for (int q = 0; q < 4; ++q) o4[q] = cv4[j][q] / (1.f + __expf(-cv4[j][q]));
                *(LAS f32x4*)(sc + 4 * (tid + NTHREADS * j)) = o4; }
        }
        __syncthreads();
        for (int cb = blockIdx.x; cb < 256; cb += gridDim.x) {
            const int half = lane >> 5, cl = lane & 31;
            float acc[8];
#pragma unroll
            for (int b = 0; b < 8; ++b) acc[b] = 0.f;
            if (cl < 24) {
#pragma unroll 4
                for (int it = 0; it < 64; ++it) { const int k = 128 * wave + 2 * it + half; const float wv = __builtin_nontemporal_load(w_ada + (size_t)k * 6144 + 24 * cb + cl);
#pragma unroll
                    for (int b = 0; b < 8; ++b) acc[b] += sc[b * 1024 + k] * wv; }
#pragma unroll
                for (int b = 0; b < 8; ++b) part[((wave * 2 + half) * 8 + b) * 24 + cl] = acc[b];
            }
            __syncthreads();
            if (tid < 192) { const int b = tid / 24, cc = tid % 24; float s = 0.f;
                for (int q = 0; q < 16; ++q) s += part[(q * 8 + b) * 24 + cc];
                ((float*)(ws + WS_MOD))[b * 6144 + 24 * cb + cc] = s + b_ada[24 * cb + cc]; }
            __syncthreads();
        }
    }
    {
        float* rope = (float*)(ws + WS_ROPE);
        for (int i = blockIdx.x * NTHREADS + tid; i < SEQ * 8; i += gridDim.x * NTHREADS) {
            const int pos = i >> 3, f = i & 7;
            const float inv = f == 0 ? 1.0f : f == 1 ? 0.1939227432f : f == 2 ? 0.03760603070f : f == 3 ? 0.007292664610f : f == 4 ? 0.001414213562f : f == 5 ? 0.0002742481884f : f == 6 ? 5.318295734e-05f : 1.031338525e-05f;
            const float ang = (float)pos * inv;
            const double TWO_PI = 6.283185307179586476925287;
            const double a = (double)ang, r = a - rint(a / TWO_PI) * TWO_PI, r2 = r * r;
            double s = 0.0, c = 0.0, ts = r, tc = 1.0;
#pragma unroll 1
            for (int n = 0; n < 14; ++n) { s += ts; c += tc; ts *= -r2 / (double)((2 * n + 2) * (2 * n + 3)); tc *= -r2 / (double)((2 * n + 1) * (2 * n + 2)); }
            rope[i * 2 + 0] = (float)c; rope[i * 2 + 1] = (float)s;
        }
        if (blockIdx.x == 0 && tid == 0) { const float* al = p.in[10]; float d01 = 0.f, d23 = 0.f;
            for (int j = 0; j < 64; ++j) { d01 += al[j] * al[64 + j]; d23 += al[128 + j] * al[192 + j]; }
            ((float*)(ws + WS_LAM))[0] = expf(d01) - expf(d23) + LAMBDA_INIT; }
    }
    __syncthreads();
    {
        LAS float* scr = (LAS float*)(lds + wave * 8704);
        const int gw = blockIdx.x * NWAVES + wave, NGW = gridDim.x * NWAVES;
        constexpr int I_IN = 16 * 88, I_OUT = 16 * 32, I_UV = 32, NITEMS = I_IN + I_OUT + I_UV;
        auto decode = [&](int r) -> P0Item {
            if (r < I_IN) return P0Item{p.in[6], NIN, 64 * (r / 88), 32 * (r % 88), (bf16_t*)(ws + WS_WINT), 32 * (r % 88), 1024};
            r -= I_IN;
            if (r < I_OUT) return P0Item{p.in[7], 1024, 64 * (r / 32), 32 * (r % 32), (bf16_t*)(ws + WS_WOUTT), 32 * (r % 32), 1024};
            r -= I_OUT;
            const int h = r >> 2, rr = r & 3; return P0Item{p.in[15] + h * 128 * 64, 64, 64 * (rr >> 1), 32 * (rr & 1), (bf16_t*)(ws + WS_WUVT) + h * 64 * 128, 32 * (rr & 1), 128};
        };
        for (int it = gw; it < NITEMS; it += NGW) { const P0Item a = decode(it); f32x4 va[8]; p0_load(a, va, lane); p0_finish(a, va, scr, lane); }
    }
}
constexpr int N_EXPERT_ITEMS = 32 * 3 * 512;
__device__ __forceinline__ bool conv_expert_issue(const Params& p, int lane, int wave, int& cur, P0Item& a, f32x4 (&va)[8]) {
    unsigned char* ws = p.ws;
    const int gw = blockIdx.x * NWAVES + wave, NGW = gridDim.x * NWAVES, r = gw + NGW * cur;
    if (r >= N_EXPERT_ITEMS) return false;
    ++cur;
    const int e = r / 1536, qq = r % 1536, mat = qq / 512, i2 = qq % 512, kb = i2 / 32, nb = i2 % 32, n0 = 32 * nb;
    a = (mat == 2) ? P0Item{p.in[22] + (size_t)e * 1048576, 1024, 64 * kb, n0, (bf16_t*)(ws + WS_WDT) + (size_t)e * 1048576, n0, 1024}
                   : P0Item{p.in[mat == 0 ? 18 : 20] + (size_t)e * 1048576, 1024, 64 * kb, n0, (bf16_t*)(ws + WS_WGUT) + (size_t)e * 2097152, 256 * (n0 >> 7) + (n0 & 127) + (mat == 1 ? 128 : 0), 1024};
    p0_load(a, va, lane);
    return true;
}
__device__ __forceinline__ void conv_expert_items(const Params& p, LAS unsigned char* lds, int lane, int wave, int& cur, int n) {
    unsigned char* ws = p.ws;
    LAS float* scr = (LAS float*)(lds + wave * 8704);
    const int gw = blockIdx.x * NWAVES + wave, NGW = gridDim.x * NWAVES;
    for (int q = 0; q < n; ++q) {
        const int r = gw + NGW * cur;
        if (r >= N_EXPERT_ITEMS) break;
        ++cur;
        const int e = r / 1536, qq = r % 1536, mat = qq / 512, i2 = qq % 512, kb = i2 / 32, nb = i2 % 32, n0 = 32 * nb;
        const P0Item a = (mat == 2) ? P0Item{p.in[22] + (size_t)e * 1048576, 1024, 64 * kb, n0, (bf16_t*)(ws + WS_WDT) + (size_t)e * 1048576, n0, 1024}
                                    : P0Item{p.in[mat == 0 ? 18 : 20] + (size_t)e * 1048576, 1024, 64 * kb, n0, (bf16_t*)(ws + WS_WGUT) + (size_t)e * 2097152, 256 * (n0 >> 7) + (n0 & 127) + (mat == 1 ? 128 : 0), 1024};
        f32x4 va[8]; p0_load(a, va, lane); p0_finish(a, va, scr, lane);
    }
}

__device__ __forceinline__ void phase_norm1(const Params& p, LAS unsigned char* lds, int tid, int lane, int wave) {
    unsigned char* ws = p.ws;
    const float* x = p.in[0]; const float* g = p.in[2]; const float* w_in = p.in[6]; const float* mod = (const float*)(ws + WS_MOD);
    bf16_t* H = (bf16_t*)(ws + WS_H); float* IW = (float*)(ws + WS_IW);
    LAS float* wiw = (LAS float*)lds;
    {   f32x4 wv4[4];
#pragma unroll
        for (int j = 0; j < 4; ++j) { const int q = tid + NTHREADS * j; wv4[j] = *(const f32x4*)(w_in + (size_t)(q >> 1) * NIN + C_IW + 4 * (q & 1)); }
#pragma unroll
        for (int j = 0; j < 4; ++j) { const int q = tid + NTHREADS * j; *(LAS f32x4*)(wiw + 4 * q) = wv4[j]; }
    }
    __syncthreads();
    const int gw = blockIdx.x * NWAVES + wave, NGW = gridDim.x * NWAVES;
    f32x4 gv[4];
#pragma unroll
    for (int j = 0; j < 4; ++j) gv[j] = *(const f32x4*)(g + 4 * (lane + 64 * j));
    f32x4 vn[4];
#pragma unroll
    for (int j = 0; j < 4; ++j) vn[j] = *(const f32x4*)(x + (size_t)(gw < NTOK ? gw : 0) * DM + 4 * (lane + 64 * j));
    for (int t = gw; t < NTOK; t += NGW) {
        const int b = t / SEQ; const float* sh = mod + b * 6144, * sc = sh + 1024;
        f32x4 v[4]; float ss = 0.f;
#pragma unroll
        for (int j = 0; j < 4; ++j) { v[j] = vn[j]; ss += (v[j].x * v[j].x + v[j].y * v[j].y) + (v[j].z * v[j].z + v[j].w * v[j].w); }
        if (t + NGW < NTOK) {
#pragma unroll
            for (int j = 0; j < 4; ++j) vn[j] = *(const f32x4*)(x + (size_t)(t + NGW) * DM + 4 * (lane + 64 * j)); }
        const float r = 1.0f / sqrtf(wave_sum(ss) * (1.f / DM) + RMS_EPS);
        float iw[8];
#pragma unroll
        for (int q = 0; q < 8; ++q) iw[q] = 0.f;
#pragma unroll
        for (int j = 0; j < 4; ++j) { const int k0 = 4 * (lane + 64 * j);
            const f32x4 s4 = *(const f32x4*)(sc + k0), h4 = *(const f32x4*)(sh + k0);
            f32x4 hv = (v[j] * r * gv[j]) * (s4 + 1.0f) + h4;
            *(uint2*)(H + (size_t)t * DM + k0) = make_uint2(pk2(hv.x, hv.y), pk2(hv.z, hv.w));
#pragma unroll
            for (int i = 0; i < 4; ++i) { const f32x4 w0 = *(const LAS f32x4*)(wiw + (k0 + i) * 8), w1 = *(const LAS f32x4*)(wiw + (k0 + i) * 8 + 4);
                iw[0] += hv[i] * w0.x; iw[1] += hv[i] * w0.y; iw[2] += hv[i] * w0.z; iw[3] += hv[i] * w0.w;
                iw[4] += hv[i] * w1.x; iw[5] += hv[i] * w1.y; iw[6] += hv[i] * w1.z; iw[7] += hv[i] * w1.w; } }
#pragma unroll
        for (int i = 0; i < 4; ++i) { const bool up = (lane & 32) != 0; const float snd = up ? iw[i] : iw[i + 4], kp = up ? iw[i + 4] : iw[i]; iw[i] = kp + __shfl_xor(snd, 32); }
#pragma unroll
        for (int i = 0; i < 2; ++i) { const bool up = (lane & 16) != 0; const float snd = up ? iw[i] : iw[i + 2], kp = up ? iw[i + 2] : iw[i]; iw[i] = kp + __shfl_xor(snd, 16); }
        { const bool up = (lane & 8) != 0; const float snd = up ? iw[0] : iw[1], kp = up ? iw[1] : iw[0]; iw[0] = kp + __shfl_xor(snd, 8); }
        { float r8 = iw[0]; r8 += __shfl_xor(r8, 4); r8 += __shfl_xor(r8, 2); r8 += __shfl_xor(r8, 1);
          if ((lane & 7) == 0) IW[(size_t)t * 8 + (lane >> 3)] = r8 * 0.04419417382415922f; }
    }
}


__device__ __forceinline__ void router_tail(float (&pe)[32], const float* rb, int lane, int t, int* topi, float* topg, LAS int* cnt) {
#pragma unroll
    for (int i = 0; i < 8; ++i) { const bool up = (lane & 16) != 0; const float snd = up ? pe[i] : pe[i + 8], kp = up ? pe[i + 8] : pe[i]; pe[i] = kp + __shfl_xor(snd, 16); }
#pragma unroll
    for (int i = 0; i < 4; ++i) { const bool up = (lane & 8) != 0; const float snd = up ? pe[i] : pe[i + 4], kp = up ? pe[i + 4] : pe[i]; pe[i] = kp + __shfl_xor(snd, 8); }
#pragma unroll
    for (int i = 0; i < 2; ++i) { const bool up = (lane & 4) != 0; const float snd = up ? pe[i] : pe[i + 2], kp = up ? pe[i + 2] : pe[i]; pe[i] = kp + __shfl_xor(snd, 4); }
    { const bool up = (lane & 2) != 0; const float snd = up ? pe[0] : pe[1], kp = up ? pe[1] : pe[0]; pe[0] = kp + __shfl_xor(snd, 2); }
    const int myE = lane >> 1;
    float lv = pe[0] + __shfl_xor(pe[0], 1) + rb[myE];
    int idx[4]; float val[4];
#pragma unroll
    for (int k = 0; k < 4; ++k) { float m = lv;
#pragma unroll
        for (int o = 1; o < 64; o <<= 1) m = fmaxf(m, __shfl_xor(m, o));
        const unsigned long long bm = __ballot(lv == m);
        const int e = __builtin_ctzll(bm) >> 1;
        idx[k] = e; val[k] = m; if (myE == e) lv = -INFINITY; }
    if (lane == 0) {
        float ex[4], sum = 0.f;
#pragma unroll
        for (int k = 0; k < 4; ++k) { ex[k] = __expf(val[k] - val[0]); sum += ex[k]; }
        const float inv = 1.f / sum;
        *(int4*)(topi + t * 4) = make_int4(idx[0], idx[1], idx[2], idx[3]);
        *(f32x4*)(topg + t * 4) = (f32x4){ex[0] * inv, ex[1] * inv, ex[2] * inv, ex[3] * inv};
#pragma unroll
        for (int k = 0; k < 4; ++k) atomicAdd((int*)&cnt[idx[k]], 1);
    }
}
__device__ __forceinline__ void phase_norm2(const Params& p, LAS unsigned char* lds, int tid, int lane, int wave) {
    unsigned char* ws = p.ws;
    const float* x1 = p.out; const float* g = p.in[3]; const float* rw = p.in[16]; const float* rb = p.in[17]; const float* mod = (const float*)(ws + WS_MOD);
    bf16_t* H = (bf16_t*)(ws + WS_H); int* topi = (int*)(ws + WS_TOPI); float* topg = (float*)(ws + WS_TOPG); int* chcnt = (int*)(ws + WS_CHCNT);
    LAS float* rwl = (LAS float*)lds;
    {
        f32x4 rv[16];
#pragma unroll
        for (int j = 0; j < 16; ++j) rv[j] = *(const f32x4*)(rw + 4 * (tid + NTHREADS * j));
#pragma unroll
        for (int j = 0; j < 16; ++j) { const int i = 4 * (tid + NTHREADS * j), k = i >> 5, e = i & 31;
            rwl[e * 1028 + k] = rv[j][0]; rwl[(e + 1) * 1028 + k] = rv[j][1]; rwl[(e + 2) * 1028 + k] = rv[j][2]; rwl[(e + 3) * 1028 + k] = rv[j][3]; }
    }
    LAS int* cnt = (LAS int*)(lds + 32 * 1028 * 4);
    __syncthreads();
    for (int ch = blockIdx.x; ch < NCHUNK; ch += gridDim.x) {
        if (tid < 32) cnt[tid] = 0;
        __syncthreads();
        for (int rr = 0; rr < 16; rr += 2) {
            const int t0r = ch * CHTOK + wave * 16 + rr, b = t0r / SEQ; const float* sh = mod + b * 6144 + 3 * 1024, * sc = sh + 1024;
            f32x4 hv0[4], hv1[4];
#define N2_ROW(HV, T_) do { f32x4 v[4]; float ss = 0.f; \
                _Pragma("unroll") for (int j = 0; j < 4; ++j) { v[j] = *(const f32x4*)(x1 + (size_t)(T_) * DM + 4 * (lane + 64 * j)); ss += (v[j].x * v[j].x + v[j].y * v[j].y) + (v[j].z * v[j].z + v[j].w * v[j].w); } \
                const float r = 1.0f / sqrtf(wave_sum(ss) * (1.f / DM) + RMS_EPS); \
                _Pragma("unroll") for (int j = 0; j < 4; ++j) { const int k0 = 4 * (lane + 64 * j); \
                    const f32x4 s4 = *(const f32x4*)(sc + k0), h4 = *(const f32x4*)(sh + k0); \
                    HV[j] = (v[j] * r * *(const f32x4*)(g + k0)) * (s4 + 1.0f) + h4; \
                    *(uint2*)(H + (size_t)(T_) * DM + k0) = make_uint2(pk2(HV[j].x, HV[j].y), pk2(HV[j].z, HV[j].w)); } } while (0)
            N2_ROW(hv0, t0r); N2_ROW(hv1, t0r + 1);
#undef N2_ROW
            float pe0[32], pe1[32];
#pragma unroll
            for (int i = 0; i < 16; ++i) { float a0 = 0.f, a1 = 0.f, b0 = 0.f, b1 = 0.f;
#pragma unroll
                for (int j = 0; j < 4; ++j) { const f32x4 wa = *(const LAS f32x4*)(rwl + i * 1028 + 4 * (lane + 64 * j)), wb = *(const LAS f32x4*)(rwl + (i + 16) * 1028 + 4 * (lane + 64 * j));
                    a0 += (hv0[j].x * wa.x + hv0[j].y * wa.y) + (hv0[j].z * wa.z + hv0[j].w * wa.w); a1 += (hv1[j].x * wa.x + hv1[j].y * wa.y) + (hv1[j].z * wa.z + hv1[j].w * wa.w);
                    b0 += (hv0[j].x * wb.x + hv0[j].y * wb.y) + (hv0[j].z * wb.z + hv0[j].w * wb.w); b1 += (hv1[j].x * wb.x + hv1[j].y * wb.y) + (hv1[j].z * wb.z + hv1[j].w * wb.w); }
                const bool up = (lane & 32) != 0;
                pe0[i] = (up ? b0 : a0) + __shfl_xor(up ? a0 : b0, 32); pe1[i] = (up ? b1 : a1) + __shfl_xor(up ? a1 : b1, 32);
                asm volatile("" ::: "memory"); }
            router_tail(pe0, rb, lane, t0r, topi, topg, cnt);
            router_tail(pe1, rb, lane, t0r + 1, topi, topg, cnt);
        }
        __syncthreads();
        if (tid < 32) chcnt[ch * 32 + tid] = cnt[tid];
        __syncthreads();
    }
}

__device__ __forceinline__ void phase_scatter(const Params& p, LAS unsigned char* lds, int tid, int lane, int wave) {
    unsigned char* ws = p.ws;
    const int* topi = (const int*)(ws + WS_TOPI); const int* chcnt = (const int*)(ws + WS_CHCNT);
    int* rowtok = (int*)(ws + WS_ROWTOK); int* rowsrc = (int*)(ws + WS_ROWSRC); int* tile_e = (int*)(ws + WS_TILEE); int2* rowmeta = (int2*)(ws + WS_ROWMETA); const float* topg = (const float*)(ws + WS_TOPG);
    LAS int* total = (LAS int*)lds; LAS int* before = total + 32; LAS int* padded = total + 64; LAS int* poff = total + 96; LAS int* ent = total + 160; LAS int* psum = total + 1024; LAS int* wcnt = total + 2048;
    for (int ch = blockIdx.x; ch < NCHUNK; ch += gridDim.x) {
        { const int e = tid & 31, part = tid >> 5; int tt = 0, bb = 0;
#pragma unroll 4
          for (int q = 0; q < 16; ++q) { const int c = part * 16 + q; const int v = chcnt[c * 32 + e]; tt += v; bb += (c < ch) ? v : 0; }
          psum[tid] = tt; psum[512 + tid] = bb; }
        { const int i = tid; ent[i] = topi[ch * CHTOK * 4 + i]; }
        __syncthreads();
        if (tid < 32) { int tt = 0, bb = 0;
#pragma unroll 1
            for (int q = 0; q < 16; ++q) { tt += psum[q * 32 + tid]; bb += psum[512 + q * 32 + tid]; }
            total[tid] = tt; before[tid] = bb; padded[tid] = (tt + 255) / 256 * 256; }
        __syncthreads();
        if (tid == 0) { int a = 0;
#pragma unroll 1
            for (int e = 0; e < 32; ++e) { poff[e] = a; a += padded[e]; } poff[32] = a; }
        __syncthreads();
        {
            const int myE = ent[tid]; int myRank = 0;
            const unsigned long long ltm = (1ull << lane) - 1ull;
#pragma unroll 1
            for (int e = 0; e < 32; ++e) { const unsigned long long mk = __ballot(myE == e);
                if (myE == e) myRank = __popcll(mk & ltm);
                if (lane == 0) wcnt[wave * 32 + e] = __popcll(mk); }
            __syncthreads();
            int pos = poff[myE] + before[myE] + myRank;
            for (int w2 = 0; w2 < wave; ++w2) pos += wcnt[w2 * 32 + myE];
            const int en = ch * CHTOK * 4 + tid; rowtok[pos] = en; rowsrc[pos] = en >> 2; rowmeta[pos] = make_int2(en, __float_as_int(topg[en]));
        }
        if (ch == 0) {
            for (int e = wave; e < 32; e += NWAVES) {
                const int p0 = poff[e], te = p0 + total[e], pe = p0 + padded[e];
                for (int r = te + lane; r < pe; r += 64) { rowtok[r] = -1; rowsrc[r] = 0; rowmeta[r] = make_int2(-1, 0); }
                for (int ti = p0 / 256 + lane; ti < pe / 256; ti += 64) tile_e[ti] = e; }
            if (tid == 0) tile_e[MAXTILES] = poff[32] / 256;
        }
        __syncthreads();
    }
}

__device__ __forceinline__ void phase_combine(const Params& p, int tid) {
    unsigned char* ws = p.ws; float* out = p.out; const bf16_t* Y = (const bf16_t*)(ws + WS_Y); const float* mod = (const float*)(ws + WS_MOD);
    const size_t nvec = (size_t)NTOK * DM / 8;
#pragma unroll 1
    for (size_t i = (size_t)blockIdx.x * NTHREADS + tid; i < nvec; i += (size_t)gridDim.x * NTHREADS) {
        const size_t o = i * 8; const int t = (int)(o / DM), n = (int)(o % DM), b = t / SEQ;
        const u32x4 a = __builtin_nontemporal_load((const u32x4*)(Y + o)), c = __builtin_nontemporal_load((const u32x4*)(Y + (size_t)NTOK * DM + o)), d = __builtin_nontemporal_load((const u32x4*)(Y + (size_t)2 * NTOK * DM + o));
        const float* g2 = mod + b * 6144 + 5 * 1024 + n;
        f32x4 o0 = *(const f32x4*)(out + o), o1 = *(const f32x4*)(out + o + 4);
        const f32x4 g0 = *(const f32x4*)g2, g1 = *(const f32x4*)(g2 + 4);
#define LO(u) __uint_as_float((u) << 16)
#define HI(u) __uint_as_float((u) & 0xffff0000u)
        o0.x += g0.x * (LO(a.x) + LO(c.x) + LO(d.x)); o0.y += g0.y * (HI(a.x) + HI(c.x) + HI(d.x));
        o0.z += g0.z * (LO(a.y) + LO(c.y) + LO(d.y)); o0.w += g0.w * (HI(a.y) + HI(c.y) + HI(d.y));
        o1.x += g1.x * (LO(a.z) + LO(c.z) + LO(d.z)); o1.y += g1.y * (HI(a.z) + HI(c.z) + HI(d.z));
        o1.z += g1.z * (LO(a.w) + LO(c.w) + LO(d.w)); o1.w += g1.w * (HI(a.w) + HI(c.w) + HI(d.w));
#undef LO
#undef HI
        *(f32x4*)(out + o) = o0; *(f32x4*)(out + o + 4) = o1;
    }
}

namespace da {
typedef float f32x16 __attribute__((ext_vector_type(16)));
typedef short s16x4 __attribute__((ext_vector_type(4)));
constexpr int KPL = 1040;
constexpr int KT_BYTES = 8 * KPL;
constexpr int VRS = 320;
constexpr int VT_BYTES = 64 * VRS;
constexpr int BUF_BYTES = 2 * KT_BYTES + VT_BYTES;
constexpr int OB_STRIDE = 132;
constexpr int WSF_OFF = 139264;
constexpr float C2 = 0.125f * 1.4426950408889634f;
__device__ __forceinline__ int crow(int r, int hi) { return (r & 3) + 8 * (r >> 2) + 4 * hi; }
__device__ __forceinline__ s16x4 vtr(const LAS unsigned char* p) { return __builtin_bit_cast(s16x4, __builtin_amdgcn_ds_read_tr16_b64_v4i16((LAS s16x4*)p)); }

__device__ __forceinline__ void phase(const Params& p, LAS unsigned char* lds, int tid, int lane, int wave, int& cvcur) {
    unsigned char* ws = p.ws; const bf16_t* PROJ = (const bf16_t*)(ws + WS_PROJ); bf16_t* H = (bf16_t*)(ws + WS_H);
    const float lam = ((const float*)(ws + WS_LAM))[0]; const float* sub_g = p.in[11];
    const int wsel = wave >> 2, wq = wave & 3, r32 = lane & 31, hi = lane >> 5;
    LAS float* wsf = (LAS float*)(lds + WSF_OFF) + wave * 64;
    const int G = gridDim.x, vcu = (G % 8 == 0) ? ((int)blockIdx.x % 8) * (G / 8) + (int)blockIdx.x / 8 : (int)blockIdx.x;
    for (int id = vcu; id < 1024; id += G) {
        const int bh = (id >> 3) & 31, s = id & 7, ii = id >> 8;
        const int qb = (ii == 0) ? s : (ii == 1) ? 15 - s : (ii == 2) ? 16 + s : 31 - s;
        const int b = bh >> 2, h = bh & 3, q0 = qb * 128, NT = 2 * qb + 2, ntw = 2 * qb + 1 + (wq >> 1);
        const bf16_t* base = PROJ + (size_t)b * SEQ * NPJ;
        bf16x8 qr[4];
        { const bf16_t* Qrow = base + (size_t)(q0 + 32 * wq + r32) * NPJ + (wsel ? C_AQ2 : C_AQ1) + h * 64;
#pragma unroll
          for (int d0 = 0; d0 < 4; ++d0) qr[d0] = *(const bf16x8*)(Qrow + 16 * d0 + 8 * hi); }
        float m = -INFINITY, l = 0.f;
        f32x16 o[4];
#pragma unroll
        for (int d0 = 0; d0 < 4; ++d0)
#pragma unroll
            for (int r = 0; r < 16; ++r) o[d0][r] = 0.f;
        const int skey = tid >> 3, sc = tid & 7, vkey = tid >> 4, vch = tid & 15;
        const bf16_t* srcK1 = base + (size_t)skey * NPJ + C_AK1 + h * 64 + 8 * sc;
        const bf16_t* srcK2 = base + (size_t)skey * NPJ + C_AK2 + h * 64 + 8 * sc;
        const bf16_t* srcV = base + (size_t)vkey * NPJ + C_AV + h * 128 + 8 * vch;
        const int dK = sc * KPL + skey * 16, dV = vkey * VRS + vch * 16;
        u32x4 st0, st1, st2, st3;
#define DA_LOAD(kt) do { const size_t ro = (size_t)(kt) * 64 * NPJ; st0 = *(const u32x4*)(srcK1 + ro); st1 = *(const u32x4*)(srcK2 + ro); \
        st2 = *(const u32x4*)(srcV + ro); st3 = *(const u32x4*)(srcV + ro + (size_t)32 * NPJ); } while (0)
#define DA_WRITE(bufi) do { LAS unsigned char* bb = lds + (bufi) * BUF_BYTES; *(LAS u32x4*)(bb + dK) = st0; *(LAS u32x4*)(bb + KT_BYTES + dK) = st1; \
        *(LAS u32x4*)(bb + 2 * KT_BYTES + dV) = st2; *(LAS u32x4*)(bb + 2 * KT_BYTES + dV + 32 * VRS) = st3; } while (0)
        DA_LOAD(0); DA_WRITE(0);
        __syncthreads();
        for (int kt = 0; kt < NT; ++kt) {
            if (kt + 1 < NT) DA_LOAD(kt + 1);
            if (kt < ntw) {
                const LAS unsigned char* bb = lds + (kt & 1) * BUF_BYTES;
                const LAS unsigned char* Kb = bb + wsel * KT_BYTES;
                const LAS unsigned char* Vb = bb + 2 * KT_BYTES;
                f32x16 p0, p1;
#pragma unroll
                for (int r = 0; r < 16; ++r) { p0[r] = 0.f; p1[r] = 0.f; }
#pragma unroll
                for (int d0 = 0; d0 < 4; ++d0) {
                    const bf16x8 a0 = *(const LAS bf16x8*)(Kb + (2 * d0 + hi) * KPL + r32 * 16);
                    const bf16x8 a1 = *(const LAS bf16x8*)(Kb + (2 * d0 + hi) * KPL + (r32 + 32) * 16);
                    p0 = __builtin_amdgcn_mfma_f32_32x32x16_bf16(a0, qr[d0], p0, 0, 0, 0);
                    p1 = __builtin_amdgcn_mfma_f32_32x32x16_bf16(a1, qr[d0], p1, 0, 0, 0);
                }
                float mxa = fmaxf(p0[0], p1[0]), mxb = fmaxf(p0[1], p1[1]), mxc = fmaxf(p0[2], p1[2]), mxd = fmaxf(p0[3], p1[3]);
#pragma unroll
                for (int r = 4; r < 16; r += 4) { mxa = fmaxf(mxa, fmaxf(p0[r], p1[r])); mxb = fmaxf(mxb, fmaxf(p0[r + 1], p1[r + 1])); mxc = fmaxf(mxc, fmaxf(p0[r + 2], p1[r + 2])); mxd = fmaxf(mxd, fmaxf(p0[r + 3], p1[r + 3])); }
                float mx = fmaxf(fmaxf(mxa, mxb), fmaxf(mxc, mxd));
                mx = fmaxf(mx, __shfl_xor(mx, 32)) * C2;
                const float mnew = fmaxf(m, mx);
                if (__any(mnew > m)) {
                    const float f = __builtin_amdgcn_exp2f(m - mnew);
                    l *= f; m = mnew;
                    if (hi == 0) wsf[r32] = f;
                    asm volatile("s_waitcnt lgkmcnt(0)" ::: "memory");
#pragma unroll
                    for (int r = 0; r < 16; ++r) { const float fr = wsf[crow(r, hi)];
#pragma unroll
                        for (int d0 = 0; d0 < 4; ++d0) o[d0][r] *= fr; }
                }
                float lsa = 0.f, lsb = 0.f, lsc = 0.f, lsd = 0.f;
#pragma unroll
                for (int r = 0; r < 16; r += 4) {
                    p0[r] = __builtin_amdgcn_exp2f(p0[r] * C2 - m); p1[r] = __builtin_amdgcn_exp2f(p1[r] * C2 - m); lsa += p0[r] + p1[r];
                    p0[r + 1] = __builtin_amdgcn_exp2f(p0[r + 1] * C2 - m); p1[r + 1] = __builtin_amdgcn_exp2f(p1[r + 1] * C2 - m); lsb += p0[r + 1] + p1[r + 1];
                    p0[r + 2] = __builtin_amdgcn_exp2f(p0[r + 2] * C2 - m); p1[r + 2] = __builtin_amdgcn_exp2f(p1[r + 2] * C2 - m); lsc += p0[r + 2] + p1[r + 2];
                    p0[r + 3] = __builtin_amdgcn_exp2f(p0[r + 3] * C2 - m); p1[r + 3] = __builtin_amdgcn_exp2f(p1[r + 3] * C2 - m); lsd += p0[r + 3] + p1[r + 3]; }
                l += (lsa + lsb) + (lsc + lsd);
                bf16x8 pa[4];
#pragma unroll
                for (int ks = 0; ks < 2; ++ks) {
                    u32x4 w0, w1;
                    w0.x = gp::cvt_pk_bf16(p0[8 * ks + 0], p0[8 * ks + 1]); w0.y = gp::cvt_pk_bf16(p0[8 * ks + 2], p0[8 * ks + 3]);
                    w0.z = gp::cvt_pk_bf16(p0[8 * ks + 4], p0[8 * ks + 5]); w0.w = gp::cvt_pk_bf16(p0[8 * ks + 6], p0[8 * ks + 7]);
                    w1.x = gp::cvt_pk_bf16(p1[8 * ks + 0], p1[8 * ks + 1]); w1.y = gp::cvt_pk_bf16(p1[8 * ks + 2], p1[8 * ks + 3]);
                    w1.z = gp::cvt_pk_bf16(p1[8 * ks + 4], p1[8 * ks + 5]); w1.w = gp::cvt_pk_bf16(p1[8 * ks + 6], p1[8 * ks + 7]);
                    pa[ks] = __builtin_bit_cast(bf16x8, w0); pa[2 + ks] = __builtin_bit_cast(bf16x8, w1);
                }
                const LAS unsigned char* vp = Vb + (4 * hi + ((lane & 15) >> 2)) * VRS + (16 * ((lane >> 4) & 1) + 4 * (lane & 3)) * 2;
#pragma unroll
                for (int d0 = 0; d0 < 4; ++d0)
#pragma unroll
                    for (int ks = 0; ks < 4; ++ks) {
                        const s16x4 lo = vtr(vp + (16 * ks) * VRS + d0 * 64), hv = vtr(vp + (16 * ks + 8) * VRS + d0 * 64);
                        const bf16x8 vf = (bf16x8){lo[0], lo[1], lo[2], lo[3], hv[0], hv[1], hv[2], hv[3]};
                        o[d0] = __builtin_amdgcn_mfma_f32_32x32x16_bf16(pa[ks], vf, o[d0], 0, 0, 0);
                        if (ks == 3) __builtin_amdgcn_sched_barrier(0);
                    }
            }
            if (kt + 1 < NT) DA_WRITE((kt + 1) & 1);
            __syncthreads();
        }
#undef DA_LOAD
#undef DA_WRITE
        l += __shfl_xor(l, 32);
        { const float fac = (wsel ? lam : 1.0f) / l;
          if (hi == 0) wsf[r32] = fac;
          asm volatile("s_waitcnt lgkmcnt(0)" ::: "memory"); }
        LAS float* Ob = (LAS float*)lds + wsel * (128 * OB_STRIDE);
#pragma unroll
        for (int r = 0; r < 16; ++r) { const float fr = wsf[crow(r, hi)]; const int row = 32 * wq + crow(r, hi);
#pragma unroll
            for (int d0 = 0; d0 < 4; ++d0) Ob[row * OB_STRIDE + 32 * d0 + r32] = o[d0][r] * fr; }
        __syncthreads();
        { const LAS float* O1 = (const LAS float*)lds; const LAS float* O2 = O1 + 128 * OB_STRIDE;
          const float g0 = sub_g[2 * lane], g1 = sub_g[2 * lane + 1];
          for (int rr = 0; rr < 16; ++rr) { const int row = 16 * wave + rr;
              const float d0v = O1[row * OB_STRIDE + 2 * lane] - O2[row * OB_STRIDE + 2 * lane], d1v = O1[row * OB_STRIDE + 2 * lane + 1] - O2[row * OB_STRIDE + 2 * lane + 1];
              const float ss = wave_sum(d0v * d0v + d1v * d1v);
              const float rs = (1.0f - LAMBDA_INIT) / sqrtf(ss * (1.f / 128.f) + RMS_EPS);
              *(unsigned*)(H + (size_t)(b * SEQ + q0 + row) * DM + h * 128 + 2 * lane) = pk2(d0v * rs * g0, d1v * rs * g1); } }
        __syncthreads();

    }
}
}
namespace ds {
typedef float f32x16 __attribute__((ext_vector_type(16)));
typedef short s16x4 __attribute__((ext_vector_type(4)));
typedef int i32x4 __attribute__((ext_vector_type(4)));
typedef unsigned u32x2 __attribute__((ext_vector_type(2)));
constexpr int HIST_OFF = 131072, SEL_OFF = 139264, OALL_OFF = 143360;
constexpr float C2 = 0.125f * 1.4426950408889634f;
__device__ __forceinline__ s16x4 vtr(const LAS unsigned char* p) { return __builtin_bit_cast(s16x4, __builtin_amdgcn_ds_read_tr16_b64_v4i16((LAS s16x4*)p)); }
__device__ __forceinline__ unsigned skey(float f) { unsigned u = __float_as_uint(f); if (u == 0x80000000u) u = 0u; return u ^ ((unsigned)((int)u >> 31) | 0x80000000u); }

template <int STOP> __device__ __forceinline__ void unit(const Params& p, LAS unsigned char* lds, int tid, int lane_in, int wave, int b, int qt, int& cvcur) {
    int lane = lane_in; asm volatile("" : "+v"(lane));
    unsigned char* ws = p.ws; const bf16_t* PROJ = (const bf16_t*)(ws + WS_PROJ); bf16_t* H = (bf16_t*)(ws + WS_H);
    const float* IW = (const float*)(ws + WS_IW);
    const int q0 = qt * 8, N = (q0 / 64 + 1) * 64, t0 = b * SEQ + q0;
    const bf16_t* base = PROJ + (size_t)b * SEQ * NPJ;
    LAS float* S = (LAS float*)lds;
    const int r32 = lane & 31, hi = lane >> 5;
    {
        bf16x8 aq[2][4]; f32x4 wv[2][4];
#pragma unroll
        for (int rb = 0; rb < 2; ++rb) {
            const bf16_t* qrow = base + (size_t)(q0 + 4 * rb + 2 * ((r32 >> 2) & 1) + (r32 >> 4)) * NPJ + C_IQ + (4 * ((r32 >> 3) & 1) + (r32 & 3)) * 64 + 8 * hi;
#pragma unroll
            for (int d0 = 0; d0 < 4; ++d0) aq[rb][d0] = *(const bf16x8*)(qrow + 16 * d0);
#pragma unroll
            for (int qq = 0; qq < 4; ++qq) wv[rb][qq] = *(const f32x4*)(IW + (size_t)(t0 + 4 * rb + 2 * hi + (qq >> 1)) * 8 + 4 * (qq & 1));
        }
        const int ntk = N / 32;
        bf16x8 bk[4], bkn[4];
        const unsigned char* ikf = ws + WS_IKF + (size_t)b * 128 * 4096 + lane * 16;
        { const unsigned char* kp = ikf + (size_t)(wave < ntk ? wave : 0) * 4096;
#pragma unroll
          for (int d0 = 0; d0 < 4; ++d0) bkn[d0] = *(const bf16x8*)(kp + d0 * 1024); }
        for (int kt = wave; kt < ntk; kt += NWAVES) {
#pragma unroll
            for (int d0 = 0; d0 < 4; ++d0) bk[d0] = bkn[d0];
            if (kt + NWAVES < ntk) { const unsigned char* kp = ikf + (size_t)(kt + NWAVES) * 4096;
#pragma unroll
                for (int d0 = 0; d0 < 4; ++d0) bkn[d0] = *(const bf16x8*)(kp + d0 * 1024); }
#pragma unroll
            for (int rb = 0; rb < 2; ++rb) {
                f32x16 acc;
#pragma unroll
                for (int r = 0; r < 16; ++r) acc[r] = 0.f;
#pragma unroll
                for (int d0 = 0; d0 < 4; ++d0) acc = __builtin_amdgcn_mfma_f32_32x32x16_bf16(aq[rb][d0], bk[d0], acc, 0, 0, 0);
                float v0 = 0.f, v1 = 0.f;
#pragma unroll
                for (int i = 0; i < 4; ++i) { v0 += wv[rb][0][i] * fmaxf(acc[i], 0.f) + wv[rb][1][i] * fmaxf(acc[4 + i], 0.f);
                                               v1 += wv[rb][2][i] * fmaxf(acc[8 + i], 0.f) + wv[rb][3][i] * fmaxf(acc[12 + i], 0.f); }
                S[(4 * rb + 2 * hi) * 4096 + 32 * kt + r32] = v0;
                S[(4 * rb + 2 * hi + 1) * 4096 + 32 * kt + r32] = v1;
            }
        }
    }
    __syncthreads();
    if (STOP == 1) return;
    asm volatile("" : "+v"(lane));
    LAS float* Sw = S + wave * 4096;
    LAS unsigned short* sel = (LAS unsigned short*)(lds + SEL_OFF) + wave * 256;
    const int nsel = N < 256 ? N : 256;
    if (N <= 256) {
        for (int i = lane; i < N; i += 64) sel[i] = (unsigned short)i;
    } else {
        LAS unsigned* hist = (LAS unsigned*)(lds + OALL_OFF) + wave * 512;
        LAS float* cv = (LAS float*)(lds + HIST_OFF) + wave * 256; LAS int* ci = (LAS int*)cv + 128;
        const unsigned long long ltmask = (1ull << lane) - 1ull;
        const int nit = (N + 255) / 256;
        float t0 = -INFINITY, t1 = -INFINITY, t2 = -INFINITY, t3 = -INFINITY;
#pragma unroll 4
        for (int it = 0; it < nit; ++it) { if (256 * it + 4 * lane < N) { const f32x4 v4 = *(const LAS f32x4*)(Sw + 256 * it + 4 * lane);
#pragma unroll
            for (int q = 0; q < 4; ++q) { const float v = v4[q];
                const float n3 = fmaxf(t3, fminf(t2, v)), n2 = fmaxf(t2, fminf(t1, v)), n1 = fmaxf(t1, fminf(t0, v)); t0 = fmaxf(t0, v); t1 = n1; t2 = n2; t3 = n3; } } }
        float mn = t3, mx = t0;
#pragma unroll
        for (int o = 1; o < 64; o <<= 1) { mn = fminf(mn, __shfl_xor(mn, o)); mx = fmaxf(mx, __shfl_xor(mx, o)); }
        bool done = false;
        if (mx > mn) {
            const float scale = 1024.0f / (mx - mn);
            *(LAS u32x4*)(hist + 8 * lane) = (u32x4){0u, 0u, 0u, 0u}; *(LAS u32x4*)(hist + 8 * lane + 4) = (u32x4){0u, 0u, 0u, 0u};
            asm volatile("s_waitcnt lgkmcnt(0)" ::: "memory");
#pragma unroll 4
            for (int it = 0; it < nit; ++it) { if (256 * it + 4 * lane < N) { const f32x4 v4 = *(const LAS f32x4*)(Sw + 256 * it + 4 * lane);
#pragma unroll
                for (int q = 0; q < 4; ++q) { if (v4[q] >= mn) { int bn = (int)((v4[q] - mn) * scale); bn = bn > 1023 ? 1023 : bn;
                    __hip_atomic_fetch_add(hist + (bn >> 1), 1u << (16 * (bn & 1)), __ATOMIC_RELAXED, __HIP_MEMORY_SCOPE_WORKGROUP); } } } }
            asm volatile("s_waitcnt lgkmcnt(0)" ::: "memory");
            unsigned wq[8];
            { const u32x4 h0 = *(LAS u32x4*)(hist + 8 * lane), h1 = *(LAS u32x4*)(hist + 8 * lane + 4);
              wq[0] = h0.x; wq[1] = h0.y; wq[2] = h0.z; wq[3] = h0.w; wq[4] = h1.x; wq[5] = h1.y; wq[6] = h1.z; wq[7] = h1.w; }
            int sl = 0;
#pragma unroll
            for (int q = 0; q < 8; ++q) sl += (int)(wq[q] & 0xffffu) + (int)(wq[q] >> 16);
            int v = sl;
#pragma unroll
            for (int o = 1; o < 64; o <<= 1) { const int t = __shfl_down(v, o); v += (lane + o < 64) ? t : 0; }
            int ab = v - sl, myB = -1, myAbove = 0, myCnt = 0;
#pragma unroll
            for (int q = 15; q >= 0; --q) { const int cq = (int)((wq[q >> 1] >> (16 * (q & 1))) & 0xffffu);
                if (myB < 0 && ab < 256 && 256 <= ab + cq) { myB = 16 * lane + q; myAbove = ab; myCnt = cq; }
                ab += cq; }
            const unsigned long long bal = __ballot(myB >= 0);
            const int src = __builtin_ctzll(bal);
            const int B = __shfl(myB, src), C = __shfl(myCnt, src), need = 256 - __shfl(myAbove, src);
            if (C <= 128) {
                int outpos = 0, cp = 0;
#pragma unroll 2
                for (int it = 0; it < nit; ++it) { const bool inr = 256 * it + 4 * lane < N; const f32x4 v4 = *(const LAS f32x4*)(Sw + 256 * it + 4 * (inr ? lane : 0));
#pragma unroll
                    for (int q = 0; q < 4; ++q) { int bn = (int)((v4[q] - mn) * scale); bn = bn > 1023 ? 1023 : bn;
                        const bool inb = inr && v4[q] >= mn, take = inb && bn > B, cd = inb && bn == B; const int idx = 256 * it + 4 * lane + q;
                        const unsigned long long bt = __ballot(take), bc = __ballot(cd);
                        if (take) sel[outpos + __popcll(bt & ltmask)] = (unsigned short)idx;
                        if (cd) { const int pos = cp + __popcll(bc & ltmask); cv[pos] = v4[q]; ci[pos] = idx; }
                        outpos += __popcll(bt); cp += __popcll(bc); } }
                asm volatile("s_waitcnt lgkmcnt(0)" ::: "memory");
                const float v0 = lane < C ? cv[lane] : -INFINITY, v1 = lane + 64 < C ? cv[lane + 64] : -INFINITY;
                const int i0 = lane < C ? ci[lane] : 0x7fffffff, i1 = lane + 64 < C ? ci[lane + 64] : 0x7fffffff;
                int r0 = 0, r1 = 0;
                for (int q = 0; q < C; ++q) { const float ov = cv[q]; const int oi = ci[q];
                    r0 += (ov > v0 || (ov == v0 && oi < i0)) ? 1 : 0; r1 += (ov > v1 || (ov == v1 && oi < i1)) ? 1 : 0; }
                const bool t0 = lane < C && r0 < need, t1 = lane + 64 < C && r1 < need;
                const unsigned long long b0 = __ballot(t0);
                if (t0) sel[outpos + __popcll(b0 & ltmask)] = (unsigned short)i0;
                outpos += __popcll(b0);
                const unsigned long long b1 = __ballot(t1);
                if (t1) sel[outpos + __popcll(b1 & ltmask)] = (unsigned short)i1;
                done = true;
            }
        }
        if (!done) {
            {
                LAS int* h8 = (LAS int*)hist;
                unsigned prefix = 0u; int need8 = 256;
#pragma unroll 1
                for (int pass = 0; pass < 4; ++pass) {
                    const int shift = 24 - 8 * pass;
                    *(LAS i32x4*)(h8 + 4 * lane) = (i32x4){0, 0, 0, 0};
                    asm volatile("s_waitcnt lgkmcnt(0)" ::: "memory");
                    for (int j = 0; j < N / 64; ++j) { const unsigned u = skey(Sw[64 * j + lane]);
                        if (pass == 0 || (u >> (shift + 8)) == prefix) __hip_atomic_fetch_add((int*)(h8 + ((u >> shift) & 255u)), 1, __ATOMIC_RELAXED, __HIP_MEMORY_SCOPE_WORKGROUP); }
                    asm volatile("s_waitcnt lgkmcnt(0)" ::: "memory");
                    const i32x4 c = *(LAS i32x4*)(h8 + 4 * lane);
                    const int s4 = c.x + c.y + c.z + c.w; int vv = s4;
#pragma unroll
                    for (int o = 1; o < 64; o <<= 1) { const int t = __shfl_down(vv, o); vv += (lane + o < 64) ? t : 0; }
                    const int a3 = vv - s4, a2 = a3 + c.w, a1 = a2 + c.z, a0 = a1 + c.y;
                    int mB = -1, mA = 0;
                    if (a3 < need8 && need8 <= a3 + c.w) { mB = 4 * lane + 3; mA = a3; }
                    else if (a2 < need8 && need8 <= a2 + c.z) { mB = 4 * lane + 2; mA = a2; }
                    else if (a1 < need8 && need8 <= a1 + c.y) { mB = 4 * lane + 1; mA = a1; }
                    else if (a0 < need8 && need8 <= a0 + c.x) { mB = 4 * lane; mA = a0; }
                    const int sr = __builtin_ctzll(__ballot(mB >= 0));
                    need8 -= __shfl(mA, sr); prefix = (prefix << 8) | (unsigned)__shfl(mB, sr);
                }
                int outpos = 0, eqtaken = 0;
                for (int j = 0; j < N / 64; ++j) { const unsigned u = skey(Sw[64 * j + lane]);
                    const bool eq = (u == prefix); const unsigned long long beq = __ballot(eq);
                    const bool take = (u > prefix) || (eq && (eqtaken + __popcll(beq & ltmask) < need8));
                    const unsigned long long bt = __ballot(take);
                    if (take) sel[outpos + __popcll(bt & ltmask)] = (unsigned short)(64 * j + lane);
                    outpos += __popcll(bt); eqtaken += __popcll(beq); }
            }
        }
    }
    asm volatile("s_waitcnt lgkmcnt(0)" ::: "memory");
    if (STOP == 2) { __syncthreads(); return; }
    asm volatile("" : "+v"(lane));
    {
        const int n16 = lane & 15, g = lane >> 4, t = t0 + wave;
        bf16x8 bqf[2];
#pragma unroll
        for (int ks = 0; ks < 2; ++ks) { bqf[ks] = (bf16x8){0, 0, 0, 0, 0, 0, 0, 0};
            if (n16 < 8) bqf[ks] = *(const bf16x8*)(PROJ + (size_t)t * NPJ + C_BQ + n16 * 64 + 32 * ks + 8 * g); }
        const int nstep = nsel / 32;
        LAS unsigned char* Lb = (LAS unsigned char*)Sw;
        f32x4 ot[8];
#pragma unroll
        for (int cb = 0; cb < 8; ++cb) ot[cb] = (f32x4){0.f, 0.f, 0.f, 0.f};
        float mrun = -INFINITY, lsum = 0.f;
        bf16x8 kA[4], kB[4]; u32x4 stA[8], stB[8];
#define DS_LOADCH(KF, ST, s_) do { \
            { const bf16_t* kr = base + (size_t)sel[32 * (s_) + n16] * NPJ + C_BK + 8 * g; KF[0] = *(const bf16x8*)kr; KF[1] = *(const bf16x8*)(kr + 32); } \
            { const bf16_t* kr = base + (size_t)sel[32 * (s_) + 16 + n16] * NPJ + C_BK + 8 * g; KF[2] = *(const bf16x8*)kr; KF[3] = *(const bf16x8*)(kr + 32); } \
            _Pragma("unroll") for (int i = 0; i < 8; ++i) ST[i] = *(const u32x4*)(base + (size_t)sel[32 * (s_) + 4 * i + g] * NPJ + C_BLAT + 8 * n16); } while (0)
#define DS_PROC(KF, ST) do { \
            f32x4 a0 = (f32x4){0.f, 0.f, 0.f, 0.f}, a1 = (f32x4){0.f, 0.f, 0.f, 0.f}; \
            a0 = __builtin_amdgcn_mfma_f32_16x16x32_bf16(KF[0], bqf[0], a0, 0, 0, 0); a0 = __builtin_amdgcn_mfma_f32_16x16x32_bf16(KF[1], bqf[1], a0, 0, 0, 0); \
            a1 = __builtin_amdgcn_mfma_f32_16x16x32_bf16(KF[2], bqf[0], a1, 0, 0, 0); a1 = __builtin_amdgcn_mfma_f32_16x16x32_bf16(KF[3], bqf[1], a1, 0, 0, 0); \
            float cm = fmaxf(fmaxf(fmaxf(a0[0], a0[1]), fmaxf(a0[2], a0[3])), fmaxf(fmaxf(a1[0], a1[1]), fmaxf(a1[2], a1[3]))); \
            cm = fmaxf(cm, __shfl_xor(cm, 16)); cm = fmaxf(cm, __shfl_xor(cm, 32)); cm *= C2; \
            const float mnew = fmaxf(mrun, cm); \
            if (__any(mnew > mrun)) { const float f = __builtin_amdgcn_exp2f(mrun - mnew); lsum *= f; mrun = mnew; \
                _Pragma("unroll") for (int cb = 0; cb < 8; ++cb) ot[cb] = ot[cb] * f; } \
            float e[8]; \
            _Pragma("unroll") for (int i = 0; i < 4; ++i) { e[i] = __builtin_amdgcn_exp2f(a0[i] * C2 - mrun); e[4 + i] = __builtin_amdgcn_exp2f(a1[i] * C2 - mrun); } \
            lsum += ((e[0] + e[1]) + (e[2] + e[3])) + ((e[4] + e[5]) + (e[6] + e[7])); \
            u32x4 pw; pw.x = gp::cvt_pk_bf16(e[0], e[1]); pw.y = gp::cvt_pk_bf16(e[2], e[3]); pw.z = gp::cvt_pk_bf16(e[4], e[5]); pw.w = gp::cvt_pk_bf16(e[6], e[7]); \
            const bf16x8 pbv = __builtin_bit_cast(bf16x8, pw); \
            _Pragma("unroll") for (int i = 0; i < 8; ++i) { const int sig = 4 * i + g, ch = n16; \
                *(LAS u32x4*)(Lb + sig * 256 + (((ch >> 1) ^ (sig & 7)) * 32) + (ch & 1) * 16) = ST[i]; } \
            asm volatile("s_waitcnt lgkmcnt(0)" ::: "memory"); \
            const int rq = 4 * g + (n16 >> 2); \
            _Pragma("unroll") for (int cb = 0; cb < 8; ++cb) { \
                const s16x4 lo = vtr(Lb + rq * 256 + ((cb ^ (rq & 7)) * 32) + 8 * (lane & 3)); \
                const s16x4 hv = vtr(Lb + (16 + rq) * 256 + ((cb ^ (rq & 7)) * 32) + 8 * (lane & 3)); \
                const bf16x8 af = (bf16x8){lo[0], lo[1], lo[2], lo[3], hv[0], hv[1], hv[2], hv[3]}; \
                ot[cb] = __builtin_amdgcn_mfma_f32_16x16x32_bf16(af, pbv, ot[cb], 0, 0, 0); } \
            asm volatile("s_waitcnt lgkmcnt(0)" ::: "memory"); } while (0)
        DS_LOADCH(kA, stA, 0);
#pragma unroll 1
        for (int s = 0; s < nstep; s += 2) {
            DS_LOADCH(kB, stB, s + 1);
            DS_PROC(kA, stA);
            if (s + 2 < nstep) DS_LOADCH(kA, stA, s + 2);
            DS_PROC(kB, stB);
        }
#undef DS_LOADCH
#undef DS_PROC
        lsum += __shfl_xor(lsum, 16); lsum += __shfl_xor(lsum, 32);
        const float linv = 1.0f / lsum;
        if (n16 < 8) {
            LAS bf16_t* Oall = (LAS bf16_t*)(lds + OALL_OFF) + (wave * 8 + n16) * 128;
#pragma unroll
            for (int cb = 0; cb < 8; ++cb) *(LAS u32x2*)(Oall + 16 * cb + 4 * g) = (u32x2){pk2(ot[cb][0] * linv, ot[cb][1] * linv), pk2(ot[cb][2] * linv, ot[cb][3] * linv)};
        }
    }
    __syncthreads();
    if (STOP == 3) return;
    asm volatile("" : "+v"(lane));
    P0Item cvi, cvj; f32x4 cva[8], cvb[8];
    const bool cvok = conv_expert_issue(p, lane, wave, cvcur, cvi, cva);
    const bool cvok2 = conv_expert_issue(p, lane, wave, cvcur, cvj, cvb);
    {
        const int n16 = lane & 15, g = lane >> 4, hh = wave;
        const bf16_t* WuvT = (const bf16_t*)(ws + WS_WUVT) + hh * 64 * 128;
        const LAS bf16_t* Oall = (const LAS bf16_t*)(lds + OALL_OFF) + ((n16 & 7) * 8 + hh) * 128;
        bf16x8 af[4];
#pragma unroll
        for (int ks = 0; ks < 4; ++ks) af[ks] = *(const LAS bf16x8*)(Oall + 32 * ks + 8 * g);
#pragma unroll
        for (int nb = 0; nb < 4; ++nb) {
            f32x4 a = (f32x4){0.f, 0.f, 0.f, 0.f};
#pragma unroll
            for (int ks = 0; ks < 4; ++ks) { const bf16x8 bf = *(const bf16x8*)(WuvT + (16 * nb + n16) * 128 + 32 * ks + 8 * g);
                a = __builtin_amdgcn_mfma_f32_16x16x32_bf16(af[ks], bf, a, 0, 0, 0); }
            if (g < 2) {
#pragma unroll
                for (int i = 0; i < 4; ++i) H[(size_t)(t0 + 4 * g + i) * DM + 512 + hh * 64 + 16 * nb + n16] = f2bf(a[i]);
            }
        }
    }
    __syncthreads();
    if (cvok) p0_finish(cvi, cva, (LAS float*)(lds + wave * 8704), lane);
    if (cvok2) p0_finish(cvj, cvb, (LAS float*)(lds + wave * 8704), lane);
    __syncthreads();
}

template <int STOP> __device__ __forceinline__ void phase(const Params& p, LAS unsigned char* lds, int tid, int lane, int wave, int& cvcur) {
    const int G = gridDim.x, k = blockIdx.x;
    const bool nice = (G == 256);
    const int nit = nice ? 16 : (4096 - k + G - 1) / G;
    for (int i = 0; i < nit; ++i) {
        int b, qt;
        if (nice) { const int j = k >> 3; b = k & 7; qt = 511 - (i * 32 + ((i & 1) ? 31 - j : j)); }
        else { const int u = k + i * G; b = u & 7; qt = 511 - (u >> 3); }
        unit<STOP>(p, lds, tid, lane, wave, b, qt, cvcur);
    }
}
}

#define XB_TMO      128
#define XB_XCNT(j)  (256  + 64 * (j))
#define XB_XSUB(j)  (1280 + 64 * (j))
#define XB_XGEN(j)  (2304 + 64 * (j))
#define XB_TOP      3328
#define XB_TOPGEN   3392
#define XCD_BAR_WORDS 3456
#define XB_SPIN_CAP (1u << 22)
__device__ __forceinline__ unsigned xb_ld(unsigned* p)              { return __hip_atomic_load(p, __ATOMIC_RELAXED, __HIP_MEMORY_SCOPE_AGENT); }
__device__ __forceinline__ unsigned xb_add(unsigned* p, unsigned v) { return __hip_atomic_fetch_add(p, v, __ATOMIC_RELAXED, __HIP_MEMORY_SCOPE_AGENT); }
__device__ __forceinline__ unsigned xb_xcc_id() { return (unsigned)__builtin_amdgcn_s_getreg((3 << 11) | 20) & 0xFu; }
#define XB_SPIN(cond, bar) do { unsigned _sp = 0; while (cond) { __builtin_amdgcn_s_sleep(1); \
    if ((++_sp & 255u) == 0u) { if (xb_ld(&(bar)[XB_TMO])) break; if (_sp > XB_SPIN_CAP) { atomicAdd(&(bar)[XB_TMO], 1u); break; } } } } while (0)
struct XcdBarrier { unsigned* bar; unsigned x; volatile LAS unsigned* st; };
__device__ __forceinline__ XcdBarrier xcd_barrier_post(unsigned* bar, volatile LAS unsigned* st) {
    XcdBarrier b; b.bar = bar; b.x = xb_xcc_id(); b.st = st;
    if (threadIdx.x == 0) (void)xb_add(&bar[XB_XCNT(b.x)], 1u);
    return b;
}
__device__ __forceinline__ void xcd_barrier_complete(unsigned* bar, unsigned x, unsigned& nloc, unsigned& nx) {
    const unsigned G = gridDim.x * gridDim.y * gridDim.z;
    unsigned sum, cnt, mine, sp = 0u;
    for (;;) {
        sum = 0u; cnt = 0u; mine = 0u;
#pragma unroll
        for (unsigned j = 0; j < 16; ++j) { const unsigned c = xb_ld(&bar[XB_XCNT(j)]); sum += c; cnt += (c > 0u) ? 1u : 0u; mine = (j == x) ? c : mine; }
        if (sum == G) break;
        __builtin_amdgcn_s_sleep(1);
        if ((++sp & 255u) == 0u) { if (xb_ld(&bar[XB_TMO])) break; if (sp > XB_SPIN_CAP) { atomicAdd(&bar[XB_TMO], 1u); break; } }
    }
    nloc = mine > 0u ? mine : 1u; nx = cnt > 0u ? cnt : 1u;
}
__device__ __forceinline__ void xcd_barrier(const XcdBarrier& b) {
    asm volatile("s_waitcnt vmcnt(0)" ::: "memory");
    __syncthreads();
    if (threadIdx.x == 0) {
        unsigned* bar = b.bar;
        __builtin_amdgcn_s_waitcnt(0);
        unsigned nloc = b.st[0], nx = b.st[1];
        if (nloc == 0u) { xcd_barrier_complete(bar, b.x, nloc, nx); b.st[0] = nloc; b.st[1] = nx; }
        const unsigned old = xb_add(&bar[XB_XSUB(b.x)], 1u);
        const unsigned gen = old / nloc;
        if (old + 1u == (gen + 1u) * nloc) {
            __builtin_amdgcn_fence(__ATOMIC_RELEASE, "agent");
            asm volatile("s_waitcnt vmcnt(0)" ::: "memory");
            const unsigned og = xb_add(&bar[XB_TOP], 1u);
            const unsigned tg = og / nx;
            if (og + 1u == (tg + 1u) * nx) xb_add(&bar[XB_TOPGEN], 1u);
            else XB_SPIN(xb_ld(&bar[XB_TOPGEN]) == tg, bar);
            __builtin_amdgcn_fence(__ATOMIC_ACQUIRE, "agent");
            xb_add(&bar[XB_XGEN(b.x)], 1u);
            asm volatile("s_waitcnt vmcnt(0)" ::: "memory");
        } else {
            XB_SPIN(xb_ld(&bar[XB_XGEN(b.x)]) == gen, bar);
            __builtin_amdgcn_fence(__ATOMIC_ACQUIRE, "agent");
            asm volatile("s_waitcnt vmcnt(0)" ::: "memory");
        }
    }
    __syncthreads();
}
constexpr int N_PHASES = 10;
__global__ void __launch_bounds__(NTHREADS, 2) mega(Params p) {
    extern __shared__ __attribute__((aligned(16))) unsigned char lds_raw[];
    LAS unsigned char* lds = (LAS unsigned char*)lds_raw;
    cg::grid_group grid = cg::this_grid();
    int tid = threadIdx.x, lane = tid & 63; const int wave = __builtin_amdgcn_readfirstlane(tid >> 6);
#define FRESH() do { tid = threadIdx.x; asm volatile("" : "+v"(tid)); lane = tid & 63; } while (0)
    unsigned char* ws = p.ws;
    const int lo = p.ph_lo, hi = p.ph_hi;
    volatile LAS unsigned* MISC = (volatile LAS unsigned*)(lds + LDS_MISC);
    if (tid < 16) MISC[tid] = 0u;
    __syncthreads();
    XcdBarrier bar = xcd_barrier_post((unsigned*)(ws + WS_CTL), MISC);
#define IN(k) (lo <= (k) && (k) < hi)
#define SEAM(k) do { if (IN(k) && IN((k) + 1)) xcd_barrier(bar); } while (0)
    if (lo < 0) grid.sync();
    if (IN(0)) { FRESH(); phase_prep(p, lds, tid, lane, wave); } SEAM(0);
    if (IN(1)) { FRESH(); phase_norm1(p, lds, tid, lane, wave); } SEAM(1);
    if (IN(2)) { FRESH();
        gp::Gemm g{(const bf16_t*)(ws + WS_H), (const bf16_t*)(ws + WS_WINT), NPJ, DM, nullptr};
        gp::StaticOrder S; S.init(NTOK, NPJ, gridDim.x, blockIdx.x);
        LAS float* gl = (LAS float*)(lds + LDS_RING + 8192);
        if (tid < 64) { gl[tid] = p.in[8][tid]; gl[64 + tid] = p.in[9][tid]; gl[128 + tid] = p.in[12][tid]; gl[192 + tid] = p.in[13][tid]; }
        if (tid < 128) gl[256 + tid] = p.in[14][tid];
        __syncthreads();
        gp::EpiInproj E{(bf16_t*)(ws + WS_PROJ), (const float*)(ws + WS_ROPE), gl, (LAS float*)(lds + LDS_RING), ws + WS_IKF};
        gp::gemm_phase<gp::EpiInproj, gp::StaticOrder, false>(lds, g, S, E);
    } SEAM(2);
    if (IN(3)) { int cvcur = 0;
        const bool dsa_first = (((int)blockIdx.x >> 3) & 1) != 0;
        if (!dsa_first) { FRESH(); da::phase(p, lds, tid, lane, wave, cvcur); }
        FRESH(); ds::phase<0>(p, lds, tid, lane, wave, cvcur);
        if (dsa_first) { FRESH(); da::phase(p, lds, tid, lane, wave, cvcur); }
        conv_expert_items(p, lds, lane, wave, cvcur, 1 << 20); } SEAM(3);
    if (IN(4)) { FRESH();
        gp::Gemm g{(const bf16_t*)(ws + WS_H), (const bf16_t*)(ws + WS_WOUTT), DM, DM, nullptr};
        gp::StaticOrder S; S.init(NTOK, DM, gridDim.x, blockIdx.x);
        gp::EpiResid E{p.in[0], p.out, (const float*)(ws + WS_MOD)};
        gp::gemm_phase<gp::EpiResid, gp::StaticOrder, false>(lds, g, S, E);
    } SEAM(4);
    if (IN(5)) { FRESH(); phase_norm2(p, lds, tid, lane, wave); } SEAM(5);
    if (IN(6)) { FRESH(); phase_scatter(p, lds, tid, lane, wave); } SEAM(6);
    if (IN(7)) { FRESH();
        const int* tile_e = (const int*)(ws + WS_TILEE);
        gp::Gemm g{(const bf16_t*)(ws + WS_H), (const bf16_t*)(ws + WS_WGUT), 2048, DM, (const int*)(ws + WS_ROWSRC)};
        gp::MoeOrder S{tile_e, tile_e[MAXTILES], 8, (int)blockIdx.x, (int)gridDim.x};
        gp::EpiSwiglu E{(bf16_t*)(ws + WS_ACT), p.in[19], p.in[21]};
        gp::gemm_phase<gp::EpiSwiglu, gp::MoeOrder, true>(lds, g, S, E);
    } SEAM(7);
    if (IN(8)) { FRESH();
        const int* tile_e = (const int*)(ws + WS_TILEE);
        gp::Gemm g{(const bf16_t*)(ws + WS_ACT), (const bf16_t*)(ws + WS_WDT), DM, DM, nullptr};
        gp::MoeOrder S{tile_e, tile_e[MAXTILES], 4, (int)blockIdx.x, (int)gridDim.x};
        gp::EpiDown E{p.out, (bf16_t*)(ws + WS_Y), p.in[23], (const float*)(ws + WS_MOD), (const int2*)(ws + WS_ROWMETA)};
        gp::gemm_phase<gp::EpiDown, gp::MoeOrder, false>(lds, g, S, E);
    } SEAM(8);
    if (IN(9)) { FRESH(); phase_combine(p, tid); }
#undef IN
#undef SEAM
}

static int g_grid = 0;
static void launch_mega(const Params& base, int lo, int hi, hipStream_t stream) {
    Params p = base; p.ph_lo = lo; p.ph_hi = hi;
    void* args[] = {&p};
    hipError_t e = hipLaunchCooperativeKernel((const void*)mega, dim3(g_grid), dim3(NTHREADS), args, LDS_BYTES, stream);
    if (e != hipSuccess) fprintf(stderr, "kernel_launch: cooperative launch [%d,%d) failed: %s (grid %d)\n", lo, hi, hipGetErrorString(e), g_grid);
}
extern "C" void kernel_launch(void* const* d_in, const int* in_sizes, int n_in, void* d_out, int out_size, void* d_ws, size_t ws_size, hipStream_t stream) {
    if (ws_size < WS_END) { fprintf(stderr, "kernel_launch: workspace too small: %zu < %zu\n", ws_size, (size_t)WS_END); return; }
    if (g_grid == 0) {
        int dev = 0, cus = 0, per_cu = 0;
        hipGetDevice(&dev); hipDeviceGetAttribute(&cus, hipDeviceAttributeMultiprocessorCount, dev);
        if (hipFuncSetAttribute((const void*)mega, hipFuncAttributeMaxDynamicSharedMemorySize, LDS_BYTES) != hipSuccess) fprintf(stderr, "kernel_launch: hipFuncSetAttribute failed\n");
        hipOccupancyMaxActiveBlocksPerMultiprocessor(&per_cu, (const void*)mega, NTHREADS, LDS_BYTES);
        (void)hipGetLastError();
        if (per_cu < 1) { fprintf(stderr, "kernel_launch: occupancy query says %d blocks/CU\n", per_cu); per_cu = 1; }
        g_grid = cus * 1;
        fprintf(stderr, "kernel_launch: cus %d per_cu %d grid %d\n", cus, per_cu, g_grid);
    }
    const float* x = (const float*)d_in[0];
    float* out = (float*)d_out; char* ws = (char*)d_ws;
    float* mod = (float*)(ws + WS_MOD); float* rope = (float*)(ws + WS_ROPE); float* lam = (float*)(ws + WS_LAM);
    float* IW = (float*)(ws + WS_IW);
    bf16_t* H = (bf16_t*)(ws + WS_H); bf16_t* PROJ = (bf16_t*)(ws + WS_PROJ);
    Params P{};
    for (int i = 0; i < 24; ++i) P.in[i] = (const float*)d_in[i];
    P.out = out; P.ws = (unsigned char*)d_ws;

    (void)hipMemsetAsync((char*)d_ws + WS_CTL, 0, 16384, stream);
    launch_mega(P, 0, N_PHASES, stream);
    (void)rope; (void)lam; (void)IW; (void)H; (void)PROJ;
    (void)x; (void)mod;
}
```

```cpp
#include <hip/hip_runtime.h>
#include <stdint.h>
#include <cstdio>

typedef unsigned short bf16_t;
__device__ __forceinline__ float bf2f(bf16_t v) { return __uint_as_float(((unsigned)v) << 16); }
__device__ __forceinline__ bf16_t f2bf(float f) { unsigned u = __float_as_uint(f); return (bf16_t)((u + 0x7fffu + ((u >> 16) & 1u)) >> 16); }

constexpr int NB = 8, SEQ = 4096, DM = 1024, NTOK = NB * SEQ;
constexpr int NIN = 2824, NPJ = 2816;
constexpr int C_AQ1 = 0, C_AQ2 = 256, C_AK1 = 512, C_AK2 = 768, C_AV = 1024, C_BQ = 1536, C_BK = 2048, C_BLAT = 2112, C_IQ = 2240, C_IK = 2752, C_IW = 2816;
constexpr int NEXP = 32, TOPK = 4, NPAIR = NTOK * TOPK;
constexpr int MAXTILES = NPAIR / 256 + NEXP;
constexpr int PPAD = MAXTILES * 256;
constexpr int NCHUNK = 256, CHTOK = NTOK / NCHUNK;
constexpr float RMS_EPS = 1e-6f;
constexpr float LAMBDA_INIT = 0.2f;

constexpr size_t MiB = 1u << 20;
constexpr size_t WS_CTL = 0;
constexpr size_t WS_MOD = 1 * MiB;
constexpr size_t WS_ROPE = WS_MOD + 256 * 1024;
constexpr size_t WS_LAM = WS_ROPE + 256 * 1024;
constexpr size_t WS_CHCNT = WS_LAM + 4096;
constexpr size_t WS_TILEE = WS_CHCNT + 32768;
constexpr size_t WS_TOPI = 2 * MiB;
constexpr size_t WS_TOPG = WS_TOPI + 512 * 1024;
constexpr size_t WS_ROWTOK = 3 * MiB;
constexpr size_t WS_ROWSRC = 3 * MiB + 640 * 1024;
constexpr size_t WS_IW = 5 * MiB;
constexpr size_t WS_ROWMETA = 6 * MiB;
constexpr size_t WS_WINT = 8 * MiB;
constexpr size_t WS_WOUTT = 14 * MiB;
constexpr size_t WS_WUVT = 16 * MiB;
constexpr size_t WS_WDT = 17 * MiB;
constexpr size_t WS_WGUT = 81 * MiB;
constexpr size_t WS_H = 209 * MiB;
constexpr size_t WS_PROJ = 273 * MiB;
constexpr size_t WS_ACT = WS_PROJ;
constexpr size_t WS_Y = WS_WGUT;
constexpr size_t WS_IKF = WS_ACT + (size_t)PPAD * 1024 * 2;
constexpr size_t WS_END = WS_IKF + 4 * MiB;

namespace gp {
#define GP_LAS __attribute__((address_space(3)))
typedef short bf16x8 __attribute__((ext_vector_type(8)));
typedef float f32x4 __attribute__((ext_vector_type(4)));
typedef unsigned u32x4 __attribute__((ext_vector_type(4)));
constexpr int BM = 256, BK = 64, HALF = 128, HTB = HALF * BK * 2  , STAGE_BYTES = 8 * HTB;

__host__ __device__ __forceinline__ int lds_byte(int r, int c) { const int st = (r >> 4) * 2 + (c >> 5), rr = r & 15, cc = c & 31, ob = rr * 64 + cc * 2; return st * 1024 + (ob ^ (((ob >> 9) & 1) << 5)); }
__host__ __device__ __forceinline__ void stage_rc(int b, int& R, int& C) { const int st = b / 1024, sb = b % 1024, swz = sb ^ (((sb >> 9) & 1) << 5); R = (st >> 1) * 16 + swz / 64; C = (st & 1) * 32 + (swz % 64) / 2; }
__host__ __device__ __forceinline__ int perm32(int rho) { const int n = rho >> 4, i = rho & 15; return 8 * (i >> 2) + 4 * n + (i & 3); }

struct Unit { int pm, pn, e; };
struct Gemm { const bf16_t* A; const bf16_t* Bt; int N, K; const int* rowsrc; };

struct StaticOrder {
    int nM, nN, nwg, G, c;
    __device__ void init(int M, int N, int G_, int c_) { nM = M / BM; nN = N / BM; nwg = nM * nN; G = G_; c = c_; }
    __device__ bool next(int i, Unit& u) const {
        const long L = (long)i * G + c; if (L >= nwg) return false;
        int wgid = (int)L; { const int q = nwg / 8, r = nwg % 8, xcd = wgid % 8, off = wgid / 8; wgid = (xcd < r ? xcd * (q + 1) : r * (q + 1) + (xcd - r) * q) + off; }
        const int nig = 8 * nN, gid = wgid / nig, fm = gid * 8, gsz = (nM - fm) < 8 ? (nM - fm) : 8;
        u.pm = fm + ((wgid % nig) % gsz); u.pn = (wgid % nig) / gsz; u.e = 0; return true;
    }
};
struct MoeOrder {
    const int* tile_e; int ntiles, nN, c, G;
    __device__ bool next(int i, Unit& u) const {
        const int j = c >> 3, x = c & 7, tpx = (G >> 3) / nN;
        const int tile = i * (tpx * 8) + x * tpx + j / nN;
        if (tile >= ntiles) return false;
        u.pm = tile; u.pn = j % nN; u.e = tile_e[tile]; return true;
    }
};

__device__ __forceinline__ unsigned cvt_pk_bf16(float lo, float hi) { unsigned r; asm volatile("v_cvt_pk_bf16_f32 %0, %1, %2" : "=v"(r) : "v"(lo), "v"(hi)); return r; }

struct EpiBf16 {
    bf16_t* O; int ldc;
    __device__ __forceinline__ void operator()(const f32x4 (&acc)[2][2][4][2], const Unit& u, int wr, int wc, int fr, int fq) const {
        const int row0 = u.pm * BM + wr * 64 + fr, col0 = u.pn * BM + wc * 32 + 8 * fq;
#pragma unroll
        for (int ai = 0; ai < 2; ++ai)
#pragma unroll
            for (int m = 0; m < 4; ++m) { bf16_t* rowp = O + (size_t)(row0 + ai * HALF + m * 16) * ldc + col0;
#pragma unroll
                for (int bj = 0; bj < 2; ++bj) { const f32x4 v0 = acc[ai][bj][m][0], v1 = acc[ai][bj][m][1];
                    u32x4 w; w.x = cvt_pk_bf16(v0[0], v0[1]); w.y = cvt_pk_bf16(v0[2], v0[3]); w.z = cvt_pk_bf16(v1[0], v1[1]); w.w = cvt_pk_bf16(v1[2], v1[3]);
                    *(u32x4*)(rowp + bj * HALF) = w; } }
    }
};

struct EpiInproj {
    bf16_t* O; const float* rope; GP_LAS const float* gl; GP_LAS float* xch; unsigned char* ikf;
    __device__ __forceinline__ void operator()(const f32x4 (&acc)[2][2][4][2], const Unit& u, int wr, int wc, int fr, int fq) const {
        const int wid = wr * 4 + wc, row0 = u.pm * BM + wr * 64 + fr, col0 = u.pn * BM + wc * 32 + 8 * fq, lc = (wc & 1) * 32 + 8 * fq;
        int mode[2]; int goff[2];
#pragma unroll
        for (int bj = 0; bj < 2; ++bj) { const int gc = u.pn * BM + bj * HALF + (wc >> 1) * 64; goff[bj] = 0;
            if (gc < 512) { mode[bj] = 1; goff[bj] = lc; } else if (gc < 1024) { mode[bj] = 1; goff[bj] = 64 + lc; } else if (gc < 1536) { mode[bj] = 0; }
            else if (gc < 2048) { mode[bj] = 1; goff[bj] = 128 + lc; } else if (gc < 2112) { mode[bj] = 1; goff[bj] = 192 + lc; }
            else if (gc < 2240) { mode[bj] = 3; goff[bj] = 256 + (gc - 2112) + lc; } else { mode[bj] = 2; } }
#pragma unroll
        for (int ai = 0; ai < 2; ++ai)
#pragma unroll
            for (int m = 0; m < 4; ++m)
#pragma unroll
                for (int bj = 0; bj < 2; ++bj) { const f32x4 a = acc[ai][bj][m][0], b = acc[ai][bj][m][1];
                    float s = ((a[0] * a[0] + a[1] * a[1]) + (a[2] * a[2] + a[3] * a[3])) + ((b[0] * b[0] + b[1] * b[1]) + (b[2] * b[2] + b[3] * b[3]));
                    s += __shfl_xor(s, 16); s += __shfl_xor(s, 32);
                    if (fq == 0) xch[(wid * 2 + bj) * 128 + ai * 64 + m * 16 + fr] = s; }
        asm volatile("s_waitcnt lgkmcnt(0)" ::: "memory"); __builtin_amdgcn_s_barrier(); asm volatile("" ::: "memory");
#pragma unroll
        for (int ai = 0; ai < 2; ++ai)
#pragma unroll
            for (int m = 0; m < 4; ++m) { int rl = ai * 64 + m * 16 + fr, row = row0 + ai * HALF + m * 16; asm volatile("" : "+v"(rl), "+v"(row)); const int pos = row % SEQ;
                bf16_t* rowp = O + (size_t)row * NPJ + col0;
#pragma unroll
                for (int bj = 0; bj < 2; ++bj) { f32x4 v0 = acc[ai][bj][m][0], v1 = acc[ai][bj][m][1];
                    if (mode[bj] == 1 || mode[bj] == 3) {
                        float tot = xch[(wid * 2 + bj) * 128 + rl] + xch[((wid ^ 1) * 2 + bj) * 128 + rl];
                        if (mode[bj] == 3) tot += xch[((wr * 4 + (wc ^ 2)) * 2 + (bj ^ 1)) * 128 + rl] + xch[((wr * 4 + (wc ^ 3)) * 2 + (bj ^ 1)) * 128 + rl];
                        const float r = 1.0f / sqrtf(tot * (mode[bj] == 3 ? (1.f / 128.f) : (1.f / 64.f)) + RMS_EPS);
                        const f32x4 g0 = *(GP_LAS const f32x4*)(gl + goff[bj]), g1 = *(GP_LAS const f32x4*)(gl + goff[bj] + 4);
                        v0 = v0 * r * g0; v1 = v1 * r * g1; }
                    if ((mode[bj] == 1 || mode[bj] == 2) && (wc & 1) == 0) {
                        f32x4 o0, o1;
#pragma unroll
                        for (int i = 0; i < 4; ++i) { o0[i] = __shfl_xor(v0[i], 16); o1[i] = __shfl_xor(v1[i], 16); }
                        if (fq < 2) { const float* rp = rope + pos * 16; const float sg = fq == 0 ? -1.0f : 1.0f;
                            const f32x4 t0 = *(const f32x4*)(rp), t1 = *(const f32x4*)(rp + 4), t2 = *(const f32x4*)(rp + 8), t3 = *(const f32x4*)(rp + 12);
                            v0[0] = v0[0] * t0[0] + sg * o0[0] * t0[1]; v0[1] = v0[1] * t0[2] + sg * o0[1] * t0[3];
                            v0[2] = v0[2] * t1[0] + sg * o0[2] * t1[1]; v0[3] = v0[3] * t1[2] + sg * o0[3] * t1[3];
                            v1[0] = v1[0] * t2[0] + sg * o1[0] * t2[1]; v1[1] = v1[1] * t2[2] + sg * o1[1] * t2[3];
                            v1[2] = v1[2] * t3[0] + sg * o1[2] * t3[1]; v1[3] = v1[3] * t3[2] + sg * o1[3] * t3[3]; } }
                    u32x4 w; w.x = cvt_pk_bf16(v0[0], v0[1]); w.y = cvt_pk_bf16(v0[2], v0[3]); w.z = cvt_pk_bf16(v1[0], v1[1]); w.w = cvt_pk_bf16(v1[2], v1[3]);
                    *(u32x4*)(rowp + bj * HALF) = w;
                    if (u.pn == 10 && bj == 1 && wc >= 2) {
                        const int key = row % SEQ, c8 = (wc & 1) * 4 + fq;
                        *(u32x4*)(ikf + ((size_t)((((row / SEQ) * 128 + (key >> 5)) * 4 + (c8 >> 1)) * 64 + (c8 & 1) * 32 + (key & 31)) << 4)) = w; } }
                asm volatile("" ::: "memory"); }
    }
};
struct EpiResid {
    const float* x; float* out; const float* mod;
    __device__ __forceinline__ void operator()(const f32x4 (&acc)[2][2][4][2], const Unit& u, int wr, int wc, int fr, int fq) const {
        const int row0 = u.pm * BM + wr * 64 + fr, col0 = u.pn * BM + wc * 32 + 8 * fq, b = (u.pm * BM) / SEQ;
        f32x4 gv[2][2];
#pragma unroll
        for (int bj = 0; bj < 2; ++bj)
#pragma unroll
            for (int n = 0; n < 2; ++n) gv[bj][n] = *(const f32x4*)(mod + b * 6144 + 2 * 1024 + col0 + bj * HALF + 4 * n);
#pragma unroll
        for (int ai = 0; ai < 2; ++ai)
#pragma unroll
            for (int m = 0; m < 4; ++m) { const size_t off = (size_t)(row0 + ai * HALF + m * 16) * DM + col0;
#pragma unroll
                for (int bj = 0; bj < 2; ++bj)
#pragma unroll
                    for (int n = 0; n < 2; ++n) { const f32x4 xv = *(const f32x4*)(x + off + bj * HALF + 4 * n);
                        *(f32x4*)(out + off + bj * HALF + 4 * n) = xv + gv[bj][n] * acc[ai][bj][m][n]; }
                asm volatile("" ::: "memory"); }
    }
};
struct EpiSwiglu {
    bf16_t* act; const float* bg; const float* bu;
    __device__ __forceinline__ void operator()(const f32x4 (&acc)[2][2][4][2], const Unit& u, int wr, int wc, int fr, int fq) const {
        const int row0 = u.pm * BM + wr * 64 + fr, ff0 = u.pn * HALF + wc * 32 + 8 * fq;
        f32x4 bgv[2], buv[2];
#pragma unroll
        for (int n = 0; n < 2; ++n) { bgv[n] = *(const f32x4*)(bg + u.e * 1024 + ff0 + 4 * n); buv[n] = *(const f32x4*)(bu + u.e * 1024 + ff0 + 4 * n); }
#pragma unroll
        for (int ai = 0; ai < 2; ++ai)
#pragma unroll
            for (int m = 0; m < 4; ++m) {
                float a[8];
#pragma unroll
                for (int n = 0; n < 2; ++n) { const f32x4 g4 = acc[ai][0][m][n] + bgv[n], u4 = acc[ai][1][m][n] + buv[n];
#pragma unroll
                    for (int j = 0; j < 4; ++j) { const float g = fminf(g4[j], 7.0f), uu = fminf(fmaxf(u4[j], -7.0f), 7.0f);
                        const float sg = __builtin_amdgcn_rcpf(1.0f + __builtin_amdgcn_exp2f(-1.702f * 1.4426950408889634f * g));
                        a[4 * n + j] = g * sg * (uu + 1.0f); } }
                u32x4 w; w.x = cvt_pk_bf16(a[0], a[1]); w.y = cvt_pk_bf16(a[2], a[3]); w.z = cvt_pk_bf16(a[4], a[5]); w.w = cvt_pk_bf16(a[6], a[7]);
                *(u32x4*)(act + (size_t)(row0 + ai * HALF + m * 16) * 1024 + ff0) = w; }
    }
};
struct EpiDown {
    float* out; bf16_t* Y; const float* bd; const float* mod; const int2* rowmeta;
    __device__ __forceinline__ void operator()(const f32x4 (&acc)[2][2][4][2], const Unit& u, int wr, int wc, int fr, int fq) const {
        const int row0 = u.pm * BM + wr * 64 + fr, col0 = u.pn * BM + wc * 32 + 8 * fq;
        f32x4 bv[2][2];
#pragma unroll
        for (int bj = 0; bj < 2; ++bj)
#pragma unroll
            for (int n = 0; n < 2; ++n) bv[bj][n] = *(const f32x4*)(bd + u.e * 1024 + col0 + bj * HALF + 4 * n);
        int2 meta[2][4];
#pragma unroll
        for (int ai = 0; ai < 2; ++ai)
#pragma unroll
            for (int m = 0; m < 4; ++m) meta[ai][m] = rowmeta[row0 + ai * HALF + m * 16];
#pragma unroll
        for (int ai = 0; ai < 2; ++ai)
#pragma unroll
            for (int m = 0; m < 4; ++m) {
                const int ent = meta[ai][m].x;
                if (ent >= 0) {
                    const int tok = ent >> 2, kk = ent & 3; const float gt = __int_as_float(meta[ai][m].y);
                    if (kk == 0) { const float* g2 = mod + (tok / SEQ) * 6144 + 5 * 1024 + col0; float* op = out + (size_t)tok * DM + col0;
#pragma unroll
                        for (int bj = 0; bj < 2; ++bj)
#pragma unroll
                            for (int n = 0; n < 2; ++n) { const f32x4 g4 = *(const f32x4*)(g2 + bj * HALF + 4 * n), o4 = *(const f32x4*)(op + bj * HALF + 4 * n);
                                *(f32x4*)(op + bj * HALF + 4 * n) = o4 + g4 * ((acc[ai][bj][m][n] + bv[bj][n]) * gt); }
                    } else { bf16_t* yp = Y + ((size_t)(kk - 1) * NTOK + tok) * DM + col0;
#pragma unroll
                        for (int bj = 0; bj < 2; ++bj) { const f32x4 v0 = (acc[ai][bj][m][0] + bv[bj][0]) * gt, v1 = (acc[ai][bj][m][1] + bv[bj][1]) * gt;
                            u32x4 w; w.x = cvt_pk_bf16(v0[0], v0[1]); w.y = cvt_pk_bf16(v0[2], v0[3]); w.z = cvt_pk_bf16(v1[0], v1[1]); w.w = cvt_pk_bf16(v1[2], v1[3]);
                            *(u32x4*)(yp + bj * HALF) = w; } }
                }
                asm volatile("" ::: "memory"); }
    }
};

template <class Epi, class Sched, bool GATHER>
__device__ __forceinline__ void gemm_phase(GP_LAS unsigned char* lds, const Gemm g, const Sched& S, const Epi& E) {
    const int tid = threadIdx.x, wid = __builtin_amdgcn_readfirstlane(tid >> 6), lane = tid & 63, wr = wid >> 2, wc = wid & 3, fr = lane & 15, fq = lane >> 4;
    const int K = g.K, nt = K / BK;
    unsigned voffB[2];
#pragma unroll
    for (int i = 0; i < 2; ++i) { int R, C; stage_rc(tid * 16 + i * 8192, R, C); const int Rb = (R & ~31) + perm32(R & 31); voffB[i] = (unsigned)(Rb * K + C) * 2u; }
    const size_t kstep = (size_t)(BK * 2);
    const size_t hstep = (size_t)HALF * K * 2;
    const size_t tstep = 2 * hstep;
    const unsigned ldsw = (unsigned)wid * 1024u;
    const int aoff = lds_byte(wr * 64 + fr, fq * 8), boff = lds_byte(wc * 32 + fr, fq * 8);
#define GP_SA(b, h) (((b) * 2 + (h)) * HTB)
#define GP_SB(b, h) ((4 + (b) * 2 + (h)) * HTB)
#define GP_STAGE(bufoff, gbase, voff) do { _Pragma("unroll") for (int _i = 0; _i < 2; ++_i) \
        __builtin_amdgcn_global_load_lds((const unsigned*)((const char*)(gbase) + (voff)[_i]), (GP_LAS unsigned*)(lds + (bufoff) + ldsw + _i * 8192), 16, 0, 0); } while (0)
#define GP_LDA(dst, b, h) do { _Pragma("unroll") for (int m = 0; m < 4; ++m) _Pragma("unroll") for (int k = 0; k < 2; ++k) dst[m][k] = *(const GP_LAS bf16x8*)(lds + GP_SA(b, h) + aoff + m * 2048 + k * 1024); } while (0)
#define GP_LDB(dst, b, h) do { _Pragma("unroll") for (int n = 0; n < 2; ++n) _Pragma("unroll") for (int k = 0; k < 2; ++k) dst[n][k] = *(const GP_LAS bf16x8*)(lds + GP_SB(b, h) + boff + n * 2048 + k * 1024); } while (0)
#define GP_MMA(ai, bj, At, Bt) do { __builtin_amdgcn_s_setprio(1); _Pragma("unroll") for (int m = 0; m < 4; ++m) _Pragma("unroll") for (int n = 0; n < 2; ++n) _Pragma("unroll") for (int k = 0; k < 2; ++k) \
        acc[ai][bj][m][n] = __builtin_amdgcn_mfma_f32_16x16x32_bf16(Bt[n][k], At[m][k], acc[ai][bj][m][n], 0, 0, 0); __builtin_amdgcn_s_setprio(0); } while (0)
#define GP_WAIT_V(n) asm volatile("s_waitcnt vmcnt(" #n ")" ::: "memory")
#define GP_WAIT_L(n) asm volatile("s_waitcnt lgkmcnt(" #n ")" ::: "memory")
#define GP_BAR __builtin_amdgcn_s_barrier()
#define GP_SCHED __builtin_amdgcn_sched_barrier(0)
#define GP_AOFFS(u_, v0_, v1_) do { _Pragma("unroll") for (int _i = 0; _i < 2; ++_i) { int R_, C_; stage_rc(tid * 16 + _i * 8192, R_, C_); int r0_ = (u_).pm * BM + R_, r1_ = r0_ + HALF; \
        if (GATHER) { r0_ = g.rowsrc[r0_]; r1_ = g.rowsrc[r1_]; } \
        v0_[_i] = (unsigned)(r0_ * K + C_) * 2u; v1_[_i] = (unsigned)(r1_ * K + C_) * 2u; } } while (0)
    Unit cur, nxt; int ui = 0;
    if (!S.next(0, cur)) return;
    f32x4 acc[2][2][4][2];
#pragma unroll
    for (int a = 0; a < 2; ++a)
#pragma unroll
        for (int b = 0; b < 2; ++b)
#pragma unroll
            for (int m = 0; m < 4; ++m)
#pragma unroll
                for (int n = 0; n < 2; ++n) acc[a][b][m][n] = (f32x4){0.f, 0.f, 0.f, 0.f};
    bf16x8 At[4][2], B0[2][2], B1[2][2];
    unsigned vA0[2], vA1[2], nA0[2], nA1[2];
    GP_AOFFS(cur, vA0, vA1);
    const char* Ab = (const char*)g.A;
    const char* cB = (const char*)g.Bt + ((size_t)cur.e * g.N + (size_t)cur.pn * BM) * K * 2;
    GP_STAGE(GP_SB(0, 0), cB, voffB); GP_STAGE(GP_SB(0, 1), cB + hstep, voffB); GP_STAGE(GP_SA(0, 0), Ab, vA0); GP_STAGE(GP_SA(0, 1), Ab, vA1);
    if (wr == 1) GP_BAR;
    GP_WAIT_V(2); GP_BAR;
    GP_STAGE(GP_SB(1, 0), cB + kstep, voffB); GP_STAGE(GP_SA(1, 0), Ab + kstep, vA0); GP_STAGE(GP_SB(1, 1), cB + hstep + kstep, voffB);
    GP_WAIT_V(6); GP_BAR;
    for (;;) {
        const bool has_next = S.next(ui + 1, nxt);
        const char* nB = cB;
        if (has_next) { nB = (const char*)g.Bt + ((size_t)nxt.e * g.N + (size_t)nxt.pn * BM) * K * 2; GP_AOFFS(nxt, nA0, nA1); }
        else { nA0[0] = vA0[0]; nA0[1] = vA0[1]; nA1[0] = vA1[0]; nA1[1] = vA1[1]; }
        for (int t = 0; t < nt; t += 2) {
            const bool last = (t == nt - 2);
            const char* a1 = Ab + (size_t)(t + 1) * kstep;
            const char* a2 = last ? Ab : Ab + (size_t)(t + 2) * kstep; const char* b2 = last ? nB : cB + (size_t)(t + 2) * kstep;
            const char* a3 = a2 + kstep; const char* b3 = b2 + kstep;
            GP_LDB(B0, 0, 0); GP_LDB(B1, 0, 1); GP_SCHED; GP_LDA(At, 0, 0); GP_STAGE(GP_SA(1, 1), a1, vA1);
            if (last) { vA0[0] = nA0[0]; vA0[1] = nA0[1]; vA1[0] = nA1[0]; vA1[1] = nA1[1]; }
            GP_WAIT_V(8); GP_WAIT_L(0); GP_BAR; GP_MMA(0, 0, At, B0); GP_MMA(0, 1, At, B1); GP_BAR; GP_SCHED;
            GP_LDA(At, 0, 1); GP_STAGE(GP_SB(0, 0), b2, voffB); GP_STAGE(GP_SB(0, 1), b2 + hstep, voffB); GP_STAGE(GP_SA(0, 0), a2, vA0);
            GP_WAIT_V(8); GP_WAIT_L(0); GP_BAR; GP_MMA(1, 0, At, B0); GP_MMA(1, 1, At, B1); GP_BAR; GP_SCHED;
            GP_LDB(B0, 1, 0); GP_LDB(B1, 1, 1); GP_SCHED; GP_LDA(At, 1, 0); GP_STAGE(GP_SA(0, 1), a2, vA1);
            GP_WAIT_V(8); GP_WAIT_L(0); GP_BAR; GP_MMA(0, 0, At, B0); GP_MMA(0, 1, At, B1); GP_BAR; GP_SCHED;
            GP_LDA(At, 1, 1); GP_STAGE(GP_SB(1, 0), b3, voffB); GP_STAGE(GP_SB(1, 1), b3 + hstep, voffB); GP_STAGE(GP_SA(1, 0), a3, vA0);
            GP_WAIT_V(8); GP_WAIT_L(0); GP_BAR; GP_MMA(1, 0, At, B0); GP_MMA(1, 1, At, B1); GP_BAR; GP_SCHED;
        }
        if (wr == 0) GP_BAR;
        E(acc, cur, wr, wc, fr, fq);
        if (!has_next) break;
#pragma unroll
        for (int a = 0; a < 2; ++a)
#pragma unroll
            for (int b = 0; b < 2; ++b)
#pragma unroll
                for (int m = 0; m < 4; ++m)
#pragma unroll
                    for (int n = 0; n < 2; ++n) acc[a][b][m][n] = (f32x4){0.f, 0.f, 0.f, 0.f};
        cur = nxt; cB = nB; ++ui;
        if (wr == 1) GP_BAR;
    }
    GP_WAIT_V(0);
    GP_BAR;
#undef GP_SA
#undef GP_SB
#undef GP_STAGE
#undef GP_LDA
#undef GP_LDB
#undef GP_MMA
#undef GP_WAIT_V
#undef GP_WAIT_L
#undef GP_BAR
#undef GP_SCHED
#undef GP_AOFFS
}
}
#include <hip/hip_cooperative_groups.h>
namespace cg = cooperative_groups;
#define LAS __attribute__((address_space(3)))
typedef float f32x4 __attribute__((ext_vector_type(4)));
typedef unsigned u32x4 __attribute__((ext_vector_type(4)));
typedef short bf16x8 __attribute__((ext_vector_type(8)));
constexpr int NWAVES = 8, NTHREADS = 512;
constexpr int LDS_RING = 131072;
constexpr int LDS_MISC = 159744;
constexpr int LDS_BYTES = 159744 + 256;

struct Params {
    const float* in[24];
    float* out; unsigned char* ws;
    int ph_lo, ph_hi;
};
__device__ __forceinline__ unsigned pk2(float lo, float hi) { return (unsigned)f2bf(lo) | ((unsigned)f2bf(hi) << 16); }
__device__ __forceinline__ float wave_sum(float v) {
#pragma unroll
    for (int o = 1; o < 64; o <<= 1) v += __shfl_xor(v, o);
    return v;
}

struct P0Item { const float* W; int ld, k0, n0; bf16_t* WT; int row0, Kdst; };
__device__ __forceinline__ void p0_load(const P0Item& it, f32x4 (&v)[8], int lane) {
#pragma unroll
    for (int i = 0; i < 8; ++i) v[i] = __builtin_nontemporal_load((const f32x4*)(it.W + (size_t)(it.k0 + 8 * i + (lane >> 3)) * it.ld + it.n0 + 4 * (lane & 7)));
}
__device__ __forceinline__ void p0_finish(const P0Item& it, const f32x4 (&v)[8], LAS float* scr, int lane) {
#pragma unroll
    for (int i = 0; i < 8; ++i) { LAS float* d = scr + (8 * i + (lane >> 3)) * 33 + 4 * (lane & 7); d[0] = v[i][0]; d[1] = v[i][1]; d[2] = v[i][2]; d[3] = v[i][3]; }
    asm volatile("s_waitcnt lgkmcnt(0)" ::: "memory");
    const int c = lane & 7;
#pragma unroll
    for (int j = 0; j < 4; ++j) { const int n = (lane >> 3) + 8 * j; const LAS float* s = scr + (8 * c) * 33 + n;
        u32x4 o; o.x = pk2(s[0 * 33], s[1 * 33]); o.y = pk2(s[2 * 33], s[3 * 33]); o.z = pk2(s[4 * 33], s[5 * 33]); o.w = pk2(s[6 * 33], s[7 * 33]);
        *(u32x4*)(it.WT + (size_t)(it.row0 + n) * it.Kdst + it.k0 + 8 * c) = o; }
    asm volatile("s_waitcnt lgkmcnt(0)" ::: "memory");
}
__device__ __forceinline__ void phase_prep(const Params& p, LAS unsigned char* lds, int tid, int lane, int wave) {
    unsigned char* ws = p.ws;
    {
        LAS float* sc = (LAS float*)lds;
        LAS float* part = (LAS float*)(lds + 32768);
        const float* c = p.in[1]; const float* w_ada = p.in[4]; const float* b_ada = p.in[5];
        {   f32x4 cv4[4];
#pragma unroll
            for (int j = 0; j < 4; ++j) cv4[j] = *(const f32x4*)(c + 4 * (tid + NTHREADS * j));
#pragma unroll
            for (int j = 0; j < 4; ++j) { f32x4 o4;
#pragma unroll
                for (int q = 0; q < 4; ++q) o4[q] = cv4[j][q] / (1.f + __expf(-cv4[j][q]));
                *(LAS f32x4*)(sc + 4 * (tid + NTHREADS * j)) = o4; }
        }
        __syncthreads();
        for (int cb = blockIdx.x; cb < 256; cb += gridDim.x) {
            const int half = lane >> 5, cl = lane & 31;
            float acc[8];
#pragma unroll
            for (int b = 0; b < 8; ++b) acc[b] = 0.f;
            if (cl < 24) {
#pragma unroll 4
                for (int it = 0; it < 64; ++it) { const int k = 128 * wave + 2 * it + half; const float wv = __builtin_nontemporal_load(w_ada + (size_t)k * 6144 + 24 * cb + cl);
#pragma unroll
                    for (int b = 0; b < 8; ++b) acc[b] += sc[b * 1024 + k] * wv; }
#pragma unroll
                for (int b = 0; b < 8; ++b) part[((wave * 2 + half) * 8 + b) * 24 + cl] = acc[b];
            }
            __syncthreads();
            if (tid < 192) { const int b = tid / 24, cc = tid % 24; float s = 0.f;
                for (int q = 0; q < 16; ++q) s += part[(q * 8 + b) * 24 + cc];
                ((float*)(ws + WS_MOD))[b * 6144 + 24 * cb + cc] = s + b_ada[24 * cb + cc]; }
            __syncthreads();
        }
    }
    {
        float* rope = (float*)(ws + WS_ROPE);
        for (int i = blockIdx.x * NTHREADS + tid; i < SEQ * 8; i += gridDim.x * NTHREADS) {
            const int pos = i >> 3, f = i & 7;
            const float inv = f == 0 ? 1.0f : f == 1 ? 0.1939227432f : f == 2 ? 0.03760603070f : f == 3 ? 0.007292664610f : f == 4 ? 0.001414213562f : f == 5 ? 0.0002742481884f : f == 6 ? 5.318295734e-05f : 1.031338525e-05f;
            const float ang = (float)pos * inv;
            const double TWO_PI = 6.283185307179586476925287;
            const double a = (double)ang, r = a - rint(a / TWO_PI) * TWO_PI, r2 = r * r;
            double s = 0.0, c = 0.0, ts = r, tc = 1.0;
#pragma unroll 1
            for (int n = 0; n < 14; ++n) { s += ts; c += tc; ts *= -r2 / (double)((2 * n + 2) * (2 * n + 3)); tc *= -r2 / (double)((2 * n + 1) * (2 * n + 2)); }
            rope[i * 2 + 0] = (float)c; rope[i * 2 + 1] = (float)s;
        }
        if (blockIdx.x == 0 && tid == 0) { const float* al = p.in[10]; float d01 = 0.f, d23 = 0.f;
            for (int j = 0; j < 64; ++j) { d01 += al[j] * al[64 + j]; d23 += al[128 + j] * al[192 + j]; }
            ((float*)(ws + WS_LAM))[0] = expf(d01) - expf(d23) + LAMBDA_INIT; }
    }
    __syncthreads();
    {
        LAS float* scr = (LAS float*)(lds + wave * 8704);
        const int gw = blockIdx.x * NWAVES + wave, NGW = gridDim.x * NWAVES;
        constexpr int I_IN = 16 * 88, I_OUT = 16 * 32, I_UV = 32, NITEMS = I_IN + I_OUT + I_UV;
        auto decode = [&](int r) -> P0Item {
            if (r < I_IN) return P0Item{p.in[6], NIN, 64 * (r / 88), 32 * (r % 88), (bf16_t*)(ws + WS_WINT), 32 * (r % 88), 1024};
            r -= I_IN;
            if (r < I_OUT) return P0Item{p.in[7], 1024, 64 * (r / 32), 32 * (r % 32), (bf16_t*)(ws + WS_WOUTT), 32 * (r % 32), 1024};
            r -= I_OUT;
            const int h = r >> 2, rr = r & 3; return P0Item{p.in[15] + h * 128 * 64, 64, 64 * (rr >> 1), 32 * (rr & 1), (bf16_t*)(ws + WS_WUVT) + h * 64 * 128, 32 * (rr & 1), 128};
        };
        for (int it = gw; it < NITEMS; it += NGW) { const P0Item a = decode(it); f32x4 va[8]; p0_load(a, va, lane); p0_finish(a, va, scr, lane); }
    }
}
constexpr int N_EXPERT_ITEMS = 32 * 3 * 512;
__device__ __forceinline__ bool conv_expert_issue(const Params& p, int lane, int wave, int& cur, P0Item& a, f32x4 (&va)[8]) {
    unsigned char* ws = p.ws;
    const int gw = blockIdx.x * NWAVES + wave, NGW = gridDim.x * NWAVES, r = gw + NGW * cur;
    if (r >= N_EXPERT_ITEMS) return false;
    ++cur;
    const int e = r / 1536, qq = r % 1536, mat = qq / 512, i2 = qq % 512, kb = i2 / 32, nb = i2 % 32, n0 = 32 * nb;
    a = (mat == 2) ? P0Item{p.in[22] + (size_t)e * 1048576, 1024, 64 * kb, n0, (bf16_t*)(ws + WS_WDT) + (size_t)e * 1048576, n0, 1024}
                   : P0Item{p.in[mat == 0 ? 18 : 20] + (size_t)e * 1048576, 1024, 64 * kb, n0, (bf16_t*)(ws + WS_WGUT) + (size_t)e * 2097152, 256 * (n0 >> 7) + (n0 & 127) + (mat == 1 ? 128 : 0), 1024};
    p0_load(a, va, lane);
    return true;
}
__device__ __forceinline__ void conv_expert_items(const Params& p, LAS unsigned char* lds, int lane, int wave, int& cur, int n) {
    unsigned char* ws = p.ws;
    LAS float* scr = (LAS float*)(lds + wave * 8704);
    const int gw = blockIdx.x * NWAVES + wave, NGW = gridDim.x * NWAVES;
    for (int q = 0; q < n; ++q) {
        const int r = gw + NGW * cur;
        if (r >= N_EXPERT_ITEMS) break;
        ++cur;
        const int e = r / 1536, qq = r % 1536, mat = qq / 512, i2 = qq % 512, kb = i2 / 32, nb = i2 % 32, n0 = 32 * nb;
        const P0Item a = (mat == 2) ? P0Item{p.in[22] + (size_t)e * 1048576, 1024, 64 * kb, n0, (bf16_t*)(ws + WS_WDT) + (size_t)e * 1048576, n0, 1024}
                                    : P0Item{p.in[mat == 0 ? 18 : 20] + (size_t)e * 1048576, 1024, 64 * kb, n0, (bf16_t*)(ws + WS_WGUT) + (size_t)e * 2097152, 256 * (n0 >> 7) + (n0 & 127) + (mat == 1 ? 128 : 0), 1024};
        f32x4 va[8]; p0_load(a, va, lane); p0_finish(a, va, scr, lane);
    }
}

__device__ __forceinline__ void phase_norm1(const Params& p, LAS unsigned char* lds, int tid, int lane, int wave) {
    unsigned char* ws = p.ws;
    const float* x = p.in[0]; const float* g = p.in[2]; const float* w_in = p.in[6]; const float* mod = (const float*)(ws + WS_MOD);
    bf16_t* H = (bf16_t*)(ws + WS_H); float* IW = (float*)(ws + WS_IW);
    LAS float* wiw = (LAS float*)lds;
    {   f32x4 wv4[4];
#pragma unroll
        for (int j = 0; j < 4; ++j) { const int q = tid + NTHREADS * j; wv4[j] = *(const f32x4*)(w_in + (size_t)(q >> 1) * NIN + C_IW + 4 * (q & 1)); }
#pragma unroll
        for (int j = 0; j < 4; ++j) { const int q = tid + NTHREADS * j; *(LAS f32x4*)(wiw + 4 * q) = wv4[j]; }
    }
    __syncthreads();
    const int gw = blockIdx.x * NWAVES + wave, NGW = gridDim.x * NWAVES;
    f32x4 gv[4];
#pragma unroll
    for (int j = 0; j < 4; ++j) gv[j] = *(const f32x4*)(g + 4 * (lane + 64 * j));
    f32x4 vn[4];
#pragma unroll
    for (int j = 0; j < 4; ++j) vn[j] = *(const f32x4*)(x + (size_t)(gw < NTOK ? gw : 0) * DM + 4 * (lane + 64 * j));
    for (int t = gw; t < NTOK; t += NGW) {
        const int b = t / SEQ; const float* sh = mod + b * 6144, * sc = sh + 1024;
        f32x4 v[4]; float ss = 0.f;
#pragma unroll
        for (int j = 0; j < 4; ++j) { v[j] = vn[j]; ss += (v[j].x * v[j].x + v[j].y * v[j].y) + (v[j].z * v[j].z + v[j].w * v[j].w); }
        if (t + NGW < NTOK) {
#pragma unroll
            for (int j = 0; j < 4; ++j) vn[j] = *(const f32x4*)(x + (size_t)(t + NGW) * DM + 4 * (lane + 64 * j)); }
        const float r = 1.0f / sqrtf(wave_sum(ss) * (1.f / DM) + RMS_EPS);
        float iw[8];
#pragma unroll
        for (int q = 0; q < 8; ++q) iw[q] = 0.f;
#pragma unroll
        for (int j = 0; j < 4; ++j) { const int k0 = 4 * (lane + 64 * j);
            const f32x4 s4 = *(const f32x4*)(sc + k0), h4 = *(const f32x4*)(sh + k0);
            f32x4 hv = (v[j] * r * gv[j]) * (s4 + 1.0f) + h4;
            *(uint2*)(H + (size_t)t * DM + k0) = make_uint2(pk2(hv.x, hv.y), pk2(hv.z, hv.w));
#pragma unroll
            for (int i = 0; i < 4; ++i) { const f32x4 w0 = *(const LAS f32x4*)(wiw + (k0 + i) * 8), w1 = *(const LAS f32x4*)(wiw + (k0 + i) * 8 + 4);
                iw[0] += hv[i] * w0.x; iw[1] += hv[i] * w0.y; iw[2] += hv[i] * w0.z; iw[3] += hv[i] * w0.w;
                iw[4] += hv[i] * w1.x; iw[5] += hv[i] * w1.y; iw[6] += hv[i] * w1.z; iw[7] += hv[i] * w1.w; } }
#pragma unroll
        for (int i = 0; i < 4; ++i) { const bool up = (lane & 32) != 0; const float snd = up ? iw[i] : iw[i + 4], kp = up ? iw[i + 4] : iw[i]; iw[i] = kp + __shfl_xor(snd, 32); }
#pragma unroll
        for (int i = 0; i < 2; ++i) { const bool up = (lane & 16) != 0; const float snd = up ? iw[i] : iw[i + 2], kp = up ? iw[i + 2] : iw[i]; iw[i] = kp + __shfl_xor(snd, 16); }
        { const bool up = (lane & 8) != 0; const float snd = up ? iw[0] : iw[1], kp = up ? iw[1] : iw[0]; iw[0] = kp + __shfl_xor(snd, 8); }
        { float r8 = iw[0]; r8 += __shfl_xor(r8, 4); r8 += __shfl_xor(r8, 2); r8 += __shfl_xor(r8, 1);
          if ((lane & 7) == 0) IW[(size_t)t * 8 + (lane >> 3)] = r8 * 0.04419417382415922f; }
    }
}


__device__ __forceinline__ void router_tail(float (&pe)[32], const float* rb, int lane, int t, int* topi, float* topg, LAS int* cnt) {
#pragma unroll
    for (int i = 0; i < 8; ++i) { const bool up = (lane & 16) != 0; const float snd = up ? pe[i] : pe[i + 8], kp = up ? pe[i + 8] : pe[i]; pe[i] = kp + __shfl_xor(snd, 16); }
#pragma unroll
    for (int i = 0; i < 4; ++i) { const bool up = (lane & 8) != 0; const float snd = up ? pe[i] : pe[i + 4], kp = up ? pe[i + 4] : pe[i]; pe[i] = kp + __shfl_xor(snd, 8); }
#pragma unroll
    for (int i = 0; i < 2; ++i) { const bool up = (lane & 4) != 0; const float snd = up ? pe[i] : pe[i + 2], kp = up ? pe[i + 2] : pe[i]; pe[i] = kp + __shfl_xor(snd, 4); }
    { const bool up = (lane & 2) != 0; const float snd = up ? pe[0] : pe[1], kp = up ? pe[1] : pe[0]; pe[0] = kp + __shfl_xor(snd, 2); }
    const int myE = lane >> 1;
    float lv = pe[0] + __shfl_xor(pe[0], 1) + rb[myE];
    int idx[4]; float val[4];
#pragma unroll
    for (int k = 0; k < 4; ++k) { float m = lv;
#pragma unroll
        for (int o = 1; o < 64; o <<= 1) m = fmaxf(m, __shfl_xor(m, o));
        const unsigned long long bm = __ballot(lv == m);
        const int e = __builtin_ctzll(bm) >> 1;
        idx[k] = e; val[k] = m; if (myE == e) lv = -INFINITY; }
    if (lane == 0) {
        float ex[4], sum = 0.f;
#pragma unroll
        for (int k = 0; k < 4; ++k) { ex[k] = __expf(val[k] - val[0]); sum += ex[k]; }
        const float inv = 1.f / sum;
        *(int4*)(topi + t * 4) = make_int4(idx[0], idx[1], idx[2], idx[3]);
        *(f32x4*)(topg + t * 4) = (f32x4){ex[0] * inv, ex[1] * inv, ex[2] * inv, ex[3] * inv};
#pragma unroll
        for (int k = 0; k < 4; ++k) atomicAdd((int*)&cnt[idx[k]], 1);
    }
}
__device__ __forceinline__ void phase_norm2(const Params& p, LAS unsigned char* lds, int tid, int lane, int wave) {
    unsigned char* ws = p.ws;
    const float* x1 = p.out; const float* g = p.in[3]; const float* rw = p.in[16]; const float* rb = p.in[17]; const float* mod = (const float*)(ws + WS_MOD);
    bf16_t* H = (bf16_t*)(ws + WS_H); int* topi = (int*)(ws + WS_TOPI); float* topg = (float*)(ws + WS_TOPG); int* chcnt = (int*)(ws + WS_CHCNT);
    LAS float* rwl = (LAS float*)lds;
    {
        f32x4 rv[16];
#pragma unroll
        for (int j = 0; j < 16; ++j) rv[j] = *(const f32x4*)(rw + 4 * (tid + NTHREADS * j));
#pragma unroll
        for (int j = 0; j < 16; ++j) { const int i = 4 * (tid + NTHREADS * j), k = i >> 5, e = i & 31;
            rwl[e * 1028 + k] = rv[j][0]; rwl[(e + 1) * 1028 + k] = rv[j][1]; rwl[(e + 2) * 1028 + k] = rv[j][2]; rwl[(e + 3) * 1028 + k] = rv[j][3]; }
    }
    LAS int* cnt = (LAS int*)(lds + 32 * 1028 * 4);
    __syncthreads();
    for (int ch = blockIdx.x; ch < NCHUNK; ch += gridDim.x) {
        if (tid < 32) cnt[tid] = 0;
        __syncthreads();
        f32x4 xa[4], xb[4];
#pragma unroll
        for (int j = 0; j < 4; ++j) { xa[j] = *(const f32x4*)(x1 + (size_t)(ch * CHTOK + wave * 16) * DM + 4 * (lane + 64 * j)); xb[j] = *(const f32x4*)(x1 + (size_t)(ch * CHTOK + wave * 16 + 1) * DM + 4 * (lane + 64 * j)); }
        for (int rr = 0; rr < 16; rr += 2) {
            const int t0r = ch * CHTOK + wave * 16 + rr, b = t0r / SEQ; const float* sh = mod + b * 6144 + 3 * 1024, * sc = sh + 1024;
            f32x4 hv0[4], hv1[4];
#define N2_ROW(HV, T_, XS) do { f32x4 v[4]; float ss = 0.f; \
                _Pragma("unroll") for (int j = 0; j < 4; ++j) { v[j] = XS[j]; ss += (v[j].x * v[j].x + v[j].y * v[j].y) + (v[j].z * v[j].z + v[j].w * v[j].w); } \
                const float r = 1.0f / sqrtf(wave_sum(ss) * (1.f / DM) + RMS_EPS); \
                _Pragma("unroll") for (int j = 0; j < 4; ++j) { const int k0 = 4 * (lane + 64 * j); \
                    const f32x4 s4 = *(const f32x4*)(sc + k0), h4 = *(const f32x4*)(sh + k0); \
                    HV[j] = (v[j] * r * *(const f32x4*)(g + k0)) * (s4 + 1.0f) + h4; \
                    *(uint2*)(H + (size_t)(T_) * DM + k0) = make_uint2(pk2(HV[j].x, HV[j].y), pk2(HV[j].z, HV[j].w)); } } while (0)
            N2_ROW(hv0, t0r, xa); N2_ROW(hv1, t0r + 1, xb);
#undef N2_ROW
            if (rr + 2 < 16) {
#pragma unroll
                for (int j = 0; j < 4; ++j) { xa[j] = *(const f32x4*)(x1 + (size_t)(t0r + 2) * DM + 4 * (lane + 64 * j)); xb[j] = *(const f32x4*)(x1 + (size_t)(t0r + 3) * DM + 4 * (lane + 64 * j)); } }
            float pe0[32], pe1[32];
#pragma unroll
            for (int i = 0; i < 16; ++i) { float a0 = 0.f, a1 = 0.f, b0 = 0.f, b1 = 0.f;
#pragma unroll
                for (int j = 0; j < 4; ++j) { const f32x4 wa = *(const LAS f32x4*)(rwl + i * 1028 + 4 * (lane + 64 * j)), wb = *(const LAS f32x4*)(rwl + (i + 16) * 1028 + 4 * (lane + 64 * j));
                    a0 += (hv0[j].x * wa.x + hv0[j].y * wa.y) + (hv0[j].z * wa.z + hv0[j].w * wa.w); a1 += (hv1[j].x * wa.x + hv1[j].y * wa.y) + (hv1[j].z * wa.z + hv1[j].w * wa.w);
                    b0 += (hv0[j].x * wb.x + hv0[j].y * wb.y) + (hv0[j].z * wb.z + hv0[j].w * wb.w); b1 += (hv1[j].x * wb.x + hv1[j].y * wb.y) + (hv1[j].z * wb.z + hv1[j].w * wb.w); }
                const bool up = (lane & 32) != 0;
                pe0[i] = (up ? b0 : a0) + __shfl_xor(up ? a0 : b0, 32); pe1[i] = (up ? b1 : a1) + __shfl_xor(up ? a1 : b1, 32);
                asm volatile("" ::: "memory"); }
            router_tail(pe0, rb, lane, t0r, topi, topg, cnt);
            router_tail(pe1, rb, lane, t0r + 1, topi, topg, cnt);
        }
        __syncthreads();
        if (tid < 32) chcnt[ch * 32 + tid] = cnt[tid];
        __syncthreads();
    }
}

__device__ __forceinline__ void phase_scatter(const Params& p, LAS unsigned char* lds, int tid, int lane, int wave) {
    unsigned char* ws = p.ws;
    const int* topi = (const int*)(ws + WS_TOPI); const int* chcnt = (const int*)(ws + WS_CHCNT);
    int* rowtok = (int*)(ws + WS_ROWTOK); int* rowsrc = (int*)(ws + WS_ROWSRC); int* tile_e = (int*)(ws + WS_TILEE); int2* rowmeta = (int2*)(ws + WS_ROWMETA); const float* topg = (const float*)(ws + WS_TOPG);
    LAS int* total = (LAS int*)lds; LAS int* before = total + 32; LAS int* padded = total + 64; LAS int* poff = total + 96; LAS int* ent = total + 160; LAS int* psum = total + 1024; LAS int* wcnt = total + 2048;
    for (int ch = blockIdx.x; ch < NCHUNK; ch += gridDim.x) {
        { const int e = tid & 31, part = tid >> 5; int tt = 0, bb = 0;
#pragma unroll 4
          for (int q = 0; q < 16; ++q) { const int c = part * 16 + q; const int v = chcnt[c * 32 + e]; tt += v; bb += (c < ch) ? v : 0; }
          psum[tid] = tt; psum[512 + tid] = bb; }
        { const int i = tid; ent[i] = topi[ch * CHTOK * 4 + i]; }
        __syncthreads();
        if (tid < 32) { int tt = 0, bb = 0;
#pragma unroll 1
            for (int q = 0; q < 16; ++q) { tt += psum[q * 32 + tid]; bb += psum[512 + q * 32 + tid]; }
            total[tid] = tt; before[tid] = bb; padded[tid] = (tt + 255) / 256 * 256; }
        __syncthreads();
        if (tid == 0) { int a = 0;
#pragma unroll 1
            for (int e = 0; e < 32; ++e) { poff[e] = a; a += padded[e]; } poff[32] = a; }
        __syncthreads();
        {
            const int myE = ent[tid]; int myRank = 0;
            const unsigned long long ltm = (1ull << lane) - 1ull;
#pragma unroll 1
            for (int e = 0; e < 32; ++e) { const unsigned long long mk = __ballot(myE == e);
                if (myE == e) myRank = __popcll(mk & ltm);
                if (lane == 0) wcnt[wave * 32 + e] = __popcll(mk); }
            __syncthreads();
            int pos = poff[myE] + before[myE] + myRank;
            for (int w2 = 0; w2 < wave; ++w2) pos += wcnt[w2 * 32 + myE];
            const int en = ch * CHTOK * 4 + tid; rowtok[pos] = en; rowsrc[pos] = en >> 2; rowmeta[pos] = make_int2(en, __float_as_int(topg[en]));
        }
        if (ch == 0) {
            for (int e = wave; e < 32; e += NWAVES) {
                const int p0 = poff[e], te = p0 + total[e], pe = p0 + padded[e];
                for (int r = te + lane; r < pe; r += 64) { rowtok[r] = -1; rowsrc[r] = 0; rowmeta[r] = make_int2(-1, 0); }
                for (int ti = p0 / 256 + lane; ti < pe / 256; ti += 64) tile_e[ti] = e; }
            if (tid == 0) tile_e[MAXTILES] = poff[32] / 256;
        }
        __syncthreads();
    }
}

__device__ __forceinline__ void phase_combine(const Params& p, int tid) {
    unsigned char* ws = p.ws; float* out = p.out; const bf16_t* Y = (const bf16_t*)(ws + WS_Y); const float* mod = (const float*)(ws + WS_MOD);
    const size_t nvec = (size_t)NTOK * DM / 8;
#pragma unroll 1
    for (size_t i = (size_t)blockIdx.x * NTHREADS + tid; i < nvec; i += (size_t)gridDim.x * NTHREADS) {
        const size_t o = i * 8; const int t = (int)(o / DM), n = (int)(o % DM), b = t / SEQ;
        const u32x4 a = __builtin_nontemporal_load((const u32x4*)(Y + o)), c = __builtin_nontemporal_load((const u32x4*)(Y + (size_t)NTOK * DM + o)), d = __builtin_nontemporal_load((const u32x4*)(Y + (size_t)2 * NTOK * DM + o));
        const float* g2 = mod + b * 6144 + 5 * 1024 + n;
        f32x4 o0 = *(const f32x4*)(out + o), o1 = *(const f32x4*)(out + o + 4);
        const f32x4 g0 = *(const f32x4*)g2, g1 = *(const f32x4*)(g2 + 4);
#define LO(u) __uint_as_float((u) << 16)
#define HI(u) __uint_as_float((u) & 0xffff0000u)
        o0.x += g0.x * (LO(a.x) + LO(c.x) + LO(d.x)); o0.y += g0.y * (HI(a.x) + HI(c.x) + HI(d.x));
        o0.z += g0.z * (LO(a.y) + LO(c.y) + LO(d.y)); o0.w += g0.w * (HI(a.y) + HI(c.y) + HI(d.y));
        o1.x += g1.x * (LO(a.z) + LO(c.z) + LO(d.z)); o1.y += g1.y * (HI(a.z) + HI(c.z) + HI(d.z));
        o1.z += g1.z * (LO(a.w) + LO(c.w) + LO(d.w)); o1.w += g1.w * (HI(a.w) + HI(c.w) + HI(d.w));
#undef LO
#undef HI
        *(f32x4*)(out + o) = o0; *(f32x4*)(out + o + 4) = o1;
    }
}

namespace da {
typedef float f32x16 __attribute__((ext_vector_type(16)));
typedef short s16x4 __attribute__((ext_vector_type(4)));
constexpr int KPL = 1040;
constexpr int KT_BYTES = 8 * KPL;
constexpr int VRS = 320;
constexpr int VT_BYTES = 64 * VRS;
constexpr int BUF_BYTES = 2 * KT_BYTES + VT_BYTES;
constexpr int OB_STRIDE = 132;
constexpr int WSF_OFF = 139264;
constexpr float C2 = 0.125f * 1.4426950408889634f;
__device__ __forceinline__ int crow(int r, int hi) { return (r & 3) + 8 * (r >> 2) + 4 * hi; }
__device__ __forceinline__ s16x4 vtr(const LAS unsigned char* p) { return __builtin_bit_cast(s16x4, __builtin_amdgcn_ds_read_tr16_b64_v4i16((LAS s16x4*)p)); }

__device__ __forceinline__ void phase(const Params& p, LAS unsigned char* lds, int tid, int lane, int wave, int& cvcur) {
    unsigned char* ws = p.ws; const bf16_t* PROJ = (const bf16_t*)(ws + WS_PROJ); bf16_t* H = (bf16_t*)(ws + WS_H);
    const float lam = ((const float*)(ws + WS_LAM))[0]; const float* sub_g = p.in[11];
    const int wsel = wave >> 2, wq = wave & 3, r32 = lane & 31, hi = lane >> 5;
    LAS float* wsf = (LAS float*)(lds + WSF_OFF) + wave * 64;
    const int G = gridDim.x, vcu = (G % 8 == 0) ? ((int)blockIdx.x % 8) * (G / 8) + (int)blockIdx.x / 8 : (int)blockIdx.x;
    for (int id = vcu; id < 1024; id += G) {
        const int bh = (id >> 3) & 31, s = id & 7, ii = id >> 8;
        const int qb = (ii == 0) ? s : (ii == 1) ? 15 - s : (ii == 2) ? 16 + s : 31 - s;
        const int b = bh >> 2, h = bh & 3, q0 = qb * 128, NT = 2 * qb + 2, ntw = 2 * qb + 1 + (wq >> 1);
        const bf16_t* base = PROJ + (size_t)b * SEQ * NPJ;
        bf16x8 qr[4];
        { const bf16_t* Qrow = base + (size_t)(q0 + 32 * wq + r32) * NPJ + (wsel ? C_AQ2 : C_AQ1) + h * 64;
#pragma unroll
          for (int d0 = 0; d0 < 4; ++d0) qr[d0] = *(const bf16x8*)(Qrow + 16 * d0 + 8 * hi); }
        float m = -INFINITY, l = 0.f;
        f32x16 o[4];
#pragma unroll
        for (int d0 = 0; d0 < 4; ++d0)
#pragma unroll
            for (int r = 0; r < 16; ++r) o[d0][r] = 0.f;
        const int skey = tid >> 3, sc = tid & 7, vkey = tid >> 4, vch = tid & 15;
        const bf16_t* srcK1 = base + (size_t)skey * NPJ + C_AK1 + h * 64 + 8 * sc;
        const bf16_t* srcK2 = base + (size_t)skey * NPJ + C_AK2 + h * 64 + 8 * sc;
        const bf16_t* srcV = base + (size_t)vkey * NPJ + C_AV + h * 128 + 8 * vch;
        const int dK = sc * KPL + skey * 16, dV = vkey * VRS + vch * 16;
        u32x4 st0, st1, st2, st3;
#define DA_LOAD(kt) do { const size_t ro = (size_t)(kt) * 64 * NPJ; st0 = *(const u32x4*)(srcK1 + ro); st1 = *(const u32x4*)(srcK2 + ro); \
        st2 = *(const u32x4*)(srcV + ro); st3 = *(const u32x4*)(srcV + ro + (size_t)32 * NPJ); } while (0)
#define DA_WRITE(bufi) do { LAS unsigned char* bb = lds + (bufi) * BUF_BYTES; *(LAS u32x4*)(bb + dK) = st0; *(LAS u32x4*)(bb + KT_BYTES + dK) = st1; \
        *(LAS u32x4*)(bb + 2 * KT_BYTES + dV) = st2; *(LAS u32x4*)(bb + 2 * KT_BYTES + dV + 32 * VRS) = st3; } while (0)
        DA_LOAD(0); DA_WRITE(0);
        __syncthreads();
        for (int kt = 0; kt < NT; ++kt) {
            if (kt + 1 < NT) DA_LOAD(kt + 1);
            if (kt < ntw) {
                const LAS unsigned char* bb = lds + (kt & 1) * BUF_BYTES;
                const LAS unsigned char* Kb = bb + wsel * KT_BYTES;
                const LAS unsigned char* Vb = bb + 2 * KT_BYTES;
                f32x16 p0, p1;
#pragma unroll
                for (int r = 0; r < 16; ++r) { p0[r] = 0.f; p1[r] = 0.f; }
#pragma unroll
                for (int d0 = 0; d0 < 4; ++d0) {
                    const bf16x8 a0 = *(const LAS bf16x8*)(Kb + (2 * d0 + hi) * KPL + r32 * 16);
                    const bf16x8 a1 = *(const LAS bf16x8*)(Kb + (2 * d0 + hi) * KPL + (r32 + 32) * 16);
                    p0 = __builtin_amdgcn_mfma_f32_32x32x16_bf16(a0, qr[d0], p0, 0, 0, 0);
                    p1 = __builtin_amdgcn_mfma_f32_32x32x16_bf16(a1, qr[d0], p1, 0, 0, 0);
                }
                float mxa = fmaxf(p0[0], p1[0]), mxb = fmaxf(p0[1], p1[1]), mxc = fmaxf(p0[2], p1[2]), mxd = fmaxf(p0[3], p1[3]);
#pragma unroll
                for (int r = 4; r < 16; r += 4) { mxa = fmaxf(mxa, fmaxf(p0[r], p1[r])); mxb = fmaxf(mxb, fmaxf(p0[r + 1], p1[r + 1])); mxc = fmaxf(mxc, fmaxf(p0[r + 2], p1[r + 2])); mxd = fmaxf(mxd, fmaxf(p0[r + 3], p1[r + 3])); }
                float mx = fmaxf(fmaxf(mxa, mxb), fmaxf(mxc, mxd));
                mx = fmaxf(mx, __shfl_xor(mx, 32)) * C2;
                const float mnew = fmaxf(m, mx);
                if (__any(mnew > m)) {
                    const float f = __builtin_amdgcn_exp2f(m - mnew);
                    l *= f; m = mnew;
                    if (hi == 0) wsf[r32] = f;
                    asm volatile("s_waitcnt lgkmcnt(0)" ::: "memory");
#pragma unroll
                    for (int r = 0; r < 16; ++r) { const float fr = wsf[crow(r, hi)];
#pragma unroll
                        for (int d0 = 0; d0 < 4; ++d0) o[d0][r] *= fr; }
                }
                float lsa = 0.f, lsb = 0.f, lsc = 0.f, lsd = 0.f;
#pragma unroll
                for (int r = 0; r < 16; r += 4) {
                    p0[r] = __builtin_amdgcn_exp2f(p0[r] * C2 - m); p1[r] = __builtin_amdgcn_exp2f(p1[r] * C2 - m); lsa += p0[r] + p1[r];
                    p0[r + 1] = __builtin_amdgcn_exp2f(p0[r + 1] * C2 - m); p1[r + 1] = __builtin_amdgcn_exp2f(p1[r + 1] * C2 - m); lsb += p0[r + 1] + p1[r + 1];
                    p0[r + 2] = __builtin_amdgcn_exp2f(p0[r + 2] * C2 - m); p1[r + 2] = __builtin_amdgcn_exp2f(p1[r + 2] * C2 - m); lsc += p0[r + 2] + p1[r + 2];
                    p0[r + 3] = __builtin_amdgcn_exp2f(p0[r + 3] * C2 - m); p1[r + 3] = __builtin_amdgcn_exp2f(p1[r + 3] * C2 - m); lsd += p0[r + 3] + p1[r + 3]; }
                l += (lsa + lsb) + (lsc + lsd);
                bf16x8 pa[4];
#pragma unroll
                for (int ks = 0; ks < 2; ++ks) {
                    u32x4 w0, w1;
                    w0.x = gp::cvt_pk_bf16(p0[8 * ks + 0], p0[8 * ks + 1]); w0.y = gp::cvt_pk_bf16(p0[8 * ks + 2], p0[8 * ks + 3]);
                    w0.z = gp::cvt_pk_bf16(p0[8 * ks + 4], p0[8 * ks + 5]); w0.w = gp::cvt_pk_bf16(p0[8 * ks + 6], p0[8 * ks + 7]);
                    w1.x = gp::cvt_pk_bf16(p1[8 * ks + 0], p1[8 * ks + 1]); w1.y = gp::cvt_pk_bf16(p1[8 * ks + 2], p1[8 * ks + 3]);
                    w1.z = gp::cvt_pk_bf16(p1[8 * ks + 4], p1[8 * ks + 5]); w1.w = gp::cvt_pk_bf16(p1[8 * ks + 6], p1[8 * ks + 7]);
                    pa[ks] = __builtin_bit_cast(bf16x8, w0); pa[2 + ks] = __builtin_bit_cast(bf16x8, w1);
                }
                const LAS unsigned char* vp = Vb + (4 * hi + ((lane & 15) >> 2)) * VRS + (16 * ((lane >> 4) & 1) + 4 * (lane & 3)) * 2;
#pragma unroll
                for (int d0 = 0; d0 < 4; ++d0)
#pragma unroll
                    for (int ks = 0; ks < 4; ++ks) {
                        const s16x4 lo = vtr(vp + (16 * ks) * VRS + d0 * 64), hv = vtr(vp + (16 * ks + 8) * VRS + d0 * 64);
                        const bf16x8 vf = (bf16x8){lo[0], lo[1], lo[2], lo[3], hv[0], hv[1], hv[2], hv[3]};
                        o[d0] = __builtin_amdgcn_mfma_f32_32x32x16_bf16(pa[ks], vf, o[d0], 0, 0, 0);
                        if (ks == 3) __builtin_amdgcn_sched_barrier(0);
                    }
            }
            if (kt + 1 < NT) DA_WRITE((kt + 1) & 1);
            __syncthreads();
        }
#undef DA_LOAD
#undef DA_WRITE
        l += __shfl_xor(l, 32);
        { const float fac = (wsel ? lam : 1.0f) / l;
          if (hi == 0) wsf[r32] = fac;
          asm volatile("s_waitcnt lgkmcnt(0)" ::: "memory"); }
        LAS float* Ob = (LAS float*)lds + wsel * (128 * OB_STRIDE);
#pragma unroll
        for (int r = 0; r < 16; ++r) { const float fr = wsf[crow(r, hi)]; const int row = 32 * wq + crow(r, hi);
#pragma unroll
            for (int d0 = 0; d0 < 4; ++d0) Ob[row * OB_STRIDE + 32 * d0 + r32] = o[d0][r] * fr; }
        __syncthreads();
        { const LAS float* O1 = (const LAS float*)lds; const LAS float* O2 = O1 + 128 * OB_STRIDE;
          const float g0 = sub_g[2 * lane], g1 = sub_g[2 * lane + 1];
          for (int rr = 0; rr < 16; ++rr) { const int row = 16 * wave + rr;
              const float d0v = O1[row * OB_STRIDE + 2 * lane] - O2[row * OB_STRIDE + 2 * lane], d1v = O1[row * OB_STRIDE + 2 * lane + 1] - O2[row * OB_STRIDE + 2 * lane + 1];
              const float ss = wave_sum(d0v * d0v + d1v * d1v);
              const float rs = (1.0f - LAMBDA_INIT) / sqrtf(ss * (1.f / 128.f) + RMS_EPS);
              *(unsigned*)(H + (size_t)(b * SEQ + q0 + row) * DM + h * 128 + 2 * lane) = pk2(d0v * rs * g0, d1v * rs * g1); } }
        __syncthreads();

    }
}
}
namespace ds {
typedef float f32x16 __attribute__((ext_vector_type(16)));
typedef short s16x4 __attribute__((ext_vector_type(4)));
typedef int i32x4 __attribute__((ext_vector_type(4)));
typedef unsigned u32x2 __attribute__((ext_vector_type(2)));
constexpr int HIST_OFF = 131072, SEL_OFF = 139264, OALL_OFF = 143360;
constexpr float C2 = 0.125f * 1.4426950408889634f;
__device__ __forceinline__ s16x4 vtr(const LAS unsigned char* p) { return __builtin_bit_cast(s16x4, __builtin_amdgcn_ds_read_tr16_b64_v4i16((LAS s16x4*)p)); }
__device__ __forceinline__ unsigned skey(float f) { unsigned u = __float_as_uint(f); if (u == 0x80000000u) u = 0u; return u ^ ((unsigned)((int)u >> 31) | 0x80000000u); }

template <int STOP> __device__ __forceinline__ void unit(const Params& p, LAS unsigned char* lds, int tid, int lane_in, int wave, int b, int qt, int& cvcur) {
    int lane = lane_in; asm volatile("" : "+v"(lane));
    unsigned char* ws = p.ws; const bf16_t* PROJ = (const bf16_t*)(ws + WS_PROJ); bf16_t* H = (bf16_t*)(ws + WS_H);
    const float* IW = (const float*)(ws + WS_IW);
    const int q0 = qt * 8, N = (q0 / 64 + 1) * 64, t0 = b * SEQ + q0;
    const bf16_t* base = PROJ + (size_t)b * SEQ * NPJ;
    LAS float* S = (LAS float*)lds;
    const int r32 = lane & 31, hi = lane >> 5;
    {
        bf16x8 aq[2][4]; f32x4 wv[2][4];
#pragma unroll
        for (int rb = 0; rb < 2; ++rb) {
            const bf16_t* qrow = base + (size_t)(q0 + 4 * rb + 2 * ((r32 >> 2) & 1) + (r32 >> 4)) * NPJ + C_IQ + (4 * ((r32 >> 3) & 1) + (r32 & 3)) * 64 + 8 * hi;
#pragma unroll
            for (int d0 = 0; d0 < 4; ++d0) aq[rb][d0] = *(const bf16x8*)(qrow + 16 * d0);
#pragma unroll
            for (int qq = 0; qq < 4; ++qq) wv[rb][qq] = *(const f32x4*)(IW + (size_t)(t0 + 4 * rb + 2 * hi + (qq >> 1)) * 8 + 4 * (qq & 1));
        }
        const int ntk = N / 32;
        bf16x8 bk[4], bkn[4];
        const unsigned char* ikf = ws + WS_IKF + (size_t)b * 128 * 4096 + lane * 16;
        { const unsigned char* kp = ikf + (size_t)(wave < ntk ? wave : 0) * 4096;
#pragma unroll
          for (int d0 = 0; d0 < 4; ++d0) bkn[d0] = *(const bf16x8*)(kp + d0 * 1024); }
        for (int kt = wave; kt < ntk; kt += NWAVES) {
#pragma unroll
            for (int d0 = 0; d0 < 4; ++d0) bk[d0] = bkn[d0];
            if (kt + NWAVES < ntk) { const unsigned char* kp = ikf + (size_t)(kt + NWAVES) * 4096;
#pragma unroll
                for (int d0 = 0; d0 < 4; ++d0) bkn[d0] = *(const bf16x8*)(kp + d0 * 1024); }
#pragma unroll
            for (int rb = 0; rb < 2; ++rb) {
                f32x16 acc;
#pragma unroll
                for (int r = 0; r < 16; ++r) acc[r] = 0.f;
#pragma unroll
                for (int d0 = 0; d0 < 4; ++d0) acc = __builtin_amdgcn_mfma_f32_32x32x16_bf16(aq[rb][d0], bk[d0], acc, 0, 0, 0);
                float v0 = 0.f, v1 = 0.f;
#pragma unroll
                for (int i = 0; i < 4; ++i) { v0 += wv[rb][0][i] * fmaxf(acc[i], 0.f) + wv[rb][1][i] * fmaxf(acc[4 + i], 0.f);
                                               v1 += wv[rb][2][i] * fmaxf(acc[8 + i], 0.f) + wv[rb][3][i] * fmaxf(acc[12 + i], 0.f); }
                S[(4 * rb + 2 * hi) * 4096 + 32 * kt + r32] = v0;
                S[(4 * rb + 2 * hi + 1) * 4096 + 32 * kt + r32] = v1;
            }
        }
    }
    __syncthreads();
    if (STOP == 1) return;
    asm volatile("" : "+v"(lane));
    LAS float* Sw = S + wave * 4096;
    LAS unsigned short* sel = (LAS unsigned short*)(lds + SEL_OFF) + wave * 256;
    const int nsel = N < 256 ? N : 256;
    if (N <= 256) {
        for (int i = lane; i < N; i += 64) sel[i] = (unsigned short)i;
    } else {
        LAS unsigned* hist = (LAS unsigned*)(lds + OALL_OFF) + wave * 512;
        LAS float* cv = (LAS float*)(lds + HIST_OFF) + wave * 256; LAS int* ci = (LAS int*)cv + 128;
        const unsigned long long ltmask = (1ull << lane) - 1ull;
        const int nit = (N + 255) / 256;
        float t0 = -INFINITY, t1 = -INFINITY, t2 = -INFINITY, t3 = -INFINITY;
#pragma unroll 4
        for (int it = 0; it < nit; ++it) { if (256 * it + 4 * lane < N) { const f32x4 v4 = *(const LAS f32x4*)(Sw + 256 * it + 4 * lane);
#pragma unroll
            for (int q = 0; q < 4; ++q) { const float v = v4[q];
                const float n3 = fmaxf(t3, fminf(t2, v)), n2 = fmaxf(t2, fminf(t1, v)), n1 = fmaxf(t1, fminf(t0, v)); t0 = fmaxf(t0, v); t1 = n1; t2 = n2; t3 = n3; } } }
        float mn = t3, mx = t0;
#pragma unroll
        for (int o = 1; o < 64; o <<= 1) { mn = fminf(mn, __shfl_xor(mn, o)); mx = fmaxf(mx, __shfl_xor(mx, o)); }
        bool done = false;
        if (mx > mn) {
            const float scale = 1024.0f / (mx - mn);
            *(LAS u32x4*)(hist + 8 * lane) = (u32x4){0u, 0u, 0u, 0u}; *(LAS u32x4*)(hist + 8 * lane + 4) = (u32x4){0u, 0u, 0u, 0u};
            asm volatile("s_waitcnt lgkmcnt(0)" ::: "memory");
#pragma unroll 4
            for (int it = 0; it < nit; ++it) { if (256 * it + 4 * lane < N) { const f32x4 v4 = *(const LAS f32x4*)(Sw + 256 * it + 4 * lane);
#pragma unroll
                for (int q = 0; q < 4; ++q) { if (v4[q] >= mn) { int bn = (int)((v4[q] - mn) * scale); bn = bn > 1023 ? 1023 : bn;
                    __hip_atomic_fetch_add(hist + (bn >> 1), 1u << (16 * (bn & 1)), __ATOMIC_RELAXED, __HIP_MEMORY_SCOPE_WORKGROUP); } } } }
            asm volatile("s_waitcnt lgkmcnt(0)" ::: "memory");
            unsigned wq[8];
            { const u32x4 h0 = *(LAS u32x4*)(hist + 8 * lane), h1 = *(LAS u32x4*)(hist + 8 * lane + 4);
              wq[0] = h0.x; wq[1] = h0.y; wq[2] = h0.z; wq[3] = h0.w; wq[4] = h1.x; wq[5] = h1.y; wq[6] = h1.z; wq[7] = h1.w; }
            int sl = 0;
#pragma unroll
            for (int q = 0; q < 8; ++q) sl += (int)(wq[q] & 0xffffu) + (int)(wq[q] >> 16);
            int v = sl;
#pragma unroll
            for (int o = 1; o < 64; o <<= 1) { const int t = __shfl_down(v, o); v += (lane + o < 64) ? t : 0; }
            int ab = v - sl, myB = -1, myAbove = 0, myCnt = 0;
#pragma unroll
            for (int q = 15; q >= 0; --q) { const int cq = (int)((wq[q >> 1] >> (16 * (q & 1))) & 0xffffu);
                if (myB < 0 && ab < 256 && 256 <= ab + cq) { myB = 16 * lane + q; myAbove = ab; myCnt = cq; }
                ab += cq; }
            const unsigned long long bal = __ballot(myB >= 0);
            const int src = __builtin_ctzll(bal);
            const int B = __shfl(myB, src), C = __shfl(myCnt, src), need = 256 - __shfl(myAbove, src);
            if (C <= 128) {
                int outpos = 0, cp = 0;
#pragma unroll 2
                for (int it = 0; it < nit; ++it) { const bool inr = 256 * it + 4 * lane < N; const f32x4 v4 = *(const LAS f32x4*)(Sw + 256 * it + 4 * (inr ? lane : 0));
#pragma unroll
                    for (int q = 0; q < 4; ++q) { int bn = (int)((v4[q] - mn) * scale); bn = bn > 1023 ? 1023 : bn;
                        const bool inb = inr && v4[q] >= mn, take = inb && bn > B, cd = inb && bn == B; const int idx = 256 * it + 4 * lane + q;
                        const unsigned long long bt = __ballot(take), bc = __ballot(cd);
                        if (take) sel[outpos + __popcll(bt & ltmask)] = (unsigned short)idx;
                        if (cd) { const int pos = cp + __popcll(bc & ltmask); cv[pos] = v4[q]; ci[pos] = idx; }
                        outpos += __popcll(bt); cp += __popcll(bc); } }
                asm volatile("s_waitcnt lgkmcnt(0)" ::: "memory");
                const float v0 = lane < C ? cv[lane] : -INFINITY, v1 = lane + 64 < C ? cv[lane + 64] : -INFINITY;
                const int i0 = lane < C ? ci[lane] : 0x7fffffff, i1 = lane + 64 < C ? ci[lane + 64] : 0x7fffffff;
                int r0 = 0, r1 = 0;
                for (int q = 0; q < C; ++q) { const float ov = cv[q]; const int oi = ci[q];
                    r0 += (ov > v0 || (ov == v0 && oi < i0)) ? 1 : 0; r1 += (ov > v1 || (ov == v1 && oi < i1)) ? 1 : 0; }
                const bool t0 = lane < C && r0 < need, t1 = lane + 64 < C && r1 < need;
                const unsigned long long b0 = __ballot(t0);
                if (t0) sel[outpos + __popcll(b0 & ltmask)] = (unsigned short)i0;
                outpos += __popcll(b0);
                const unsigned long long b1 = __ballot(t1);
                if (t1) sel[outpos + __popcll(b1 & ltmask)] = (unsigned short)i1;
                done = true;
            }
        }
        if (!done) {
            {
                LAS int* h8 = (LAS int*)hist;
                unsigned prefix = 0u; int need8 = 256;
#pragma unroll 1
                for (int pass = 0; pass < 4; ++pass) {
                    const int shift = 24 - 8 * pass;
                    *(LAS i32x4*)(h8 + 4 * lane) = (i32x4){0, 0, 0, 0};
                    asm volatile("s_waitcnt lgkmcnt(0)" ::: "memory");
                    for (int j = 0; j < N / 64; ++j) { const unsigned u = skey(Sw[64 * j + lane]);
                        if (pass == 0 || (u >> (shift + 8)) == prefix) __hip_atomic_fetch_add((int*)(h8 + ((u >> shift) & 255u)), 1, __ATOMIC_RELAXED, __HIP_MEMORY_SCOPE_WORKGROUP); }
                    asm volatile("s_waitcnt lgkmcnt(0)" ::: "memory");
                    const i32x4 c = *(LAS i32x4*)(h8 + 4 * lane);
                    const int s4 = c.x + c.y + c.z + c.w; int vv = s4;
#pragma unroll
                    for (int o = 1; o < 64; o <<= 1) { const int t = __shfl_down(vv, o); vv += (lane + o < 64) ? t : 0; }
                    const int a3 = vv - s4, a2 = a3 + c.w, a1 = a2 + c.z, a0 = a1 + c.y;
                    int mB = -1, mA = 0;
                    if (a3 < need8 && need8 <= a3 + c.w) { mB = 4 * lane + 3; mA = a3; }
                    else if (a2 < need8 && need8 <= a2 + c.z) { mB = 4 * lane + 2; mA = a2; }
                    else if (a1 < need8 && need8 <= a1 + c.y) { mB = 4 * lane + 1; mA = a1; }
                    else if (a0 < need8 && need8 <= a0 + c.x) { mB = 4 * lane; mA = a0; }
                    const int sr = __builtin_ctzll(__ballot(mB >= 0));
                    need8 -= __shfl(mA, sr); prefix = (prefix << 8) | (unsigned)__shfl(mB, sr);
                }
                int outpos = 0, eqtaken = 0;
                for (int j = 0; j < N / 64; ++j) { const unsigned u = skey(Sw[64 * j + lane]);
                    const bool eq = (u == prefix); const unsigned long long beq = __ballot(eq);
                    const bool take = (u > prefix) || (eq && (eqtaken + __popcll(beq & ltmask) < need8));
                    const unsigned long long bt = __ballot(take);
                    if (take) sel[outpos + __popcll(bt & ltmask)] = (unsigned short)(64 * j + lane);
                    outpos += __popcll(bt); eqtaken += __popcll(beq); }
            }
        }
    }
    asm volatile("s_waitcnt lgkmcnt(0)" ::: "memory");
    if (STOP == 2) { __syncthreads(); return; }
    asm volatile("" : "+v"(lane));
    {
        const int n16 = lane & 15, g = lane >> 4, t = t0 + wave;
        bf16x8 bqf[2];
#pragma unroll
        for (int ks = 0; ks < 2; ++ks) { bqf[ks] = (bf16x8){0, 0, 0, 0, 0, 0, 0, 0};
            if (n16 < 8) bqf[ks] = *(const bf16x8*)(PROJ + (size_t)t * NPJ + C_BQ + n16 * 64 + 32 * ks + 8 * g); }
        const int nstep = nsel / 32;
        LAS unsigned char* Lb = (LAS unsigned char*)Sw;
        f32x4 ot[8];
#pragma unroll
        for (int cb = 0; cb < 8; ++cb) ot[cb] = (f32x4){0.f, 0.f, 0.f, 0.f};
        float mrun = -INFINITY, lsum = 0.f;
        bf16x8 kA[4], kB[4]; u32x4 stA[8], stB[8];
#define DS_LOADCH(KF, ST, s_) do { \
            { const bf16_t* kr = base + (size_t)sel[32 * (s_) + n16] * NPJ + C_BK + 8 * g; KF[0] = *(const bf16x8*)kr; KF[1] = *(const bf16x8*)(kr + 32); } \
            { const bf16_t* kr = base + (size_t)sel[32 * (s_) + 16 + n16] * NPJ + C_BK + 8 * g; KF[2] = *(const bf16x8*)kr; KF[3] = *(const bf16x8*)(kr + 32); } \
            _Pragma("unroll") for (int i = 0; i < 8; ++i) ST[i] = *(const u32x4*)(base + (size_t)sel[32 * (s_) + 4 * i + g] * NPJ + C_BLAT + 8 * n16); } while (0)
#define DS_PROC(KF, ST) do { \
            f32x4 a0 = (f32x4){0.f, 0.f, 0.f, 0.f}, a1 = (f32x4){0.f, 0.f, 0.f, 0.f}; \
            a0 = __builtin_amdgcn_mfma_f32_16x16x32_bf16(KF[0], bqf[0], a0, 0, 0, 0); a0 = __builtin_amdgcn_mfma_f32_16x16x32_bf16(KF[1], bqf[1], a0, 0, 0, 0); \
            a1 = __builtin_amdgcn_mfma_f32_16x16x32_bf16(KF[2], bqf[0], a1, 0, 0, 0); a1 = __builtin_amdgcn_mfma_f32_16x16x32_bf16(KF[3], bqf[1], a1, 0, 0, 0); \
            float cm = fmaxf(fmaxf(fmaxf(a0[0], a0[1]), fmaxf(a0[2], a0[3])), fmaxf(fmaxf(a1[0], a1[1]), fmaxf(a1[2], a1[3]))); \
            cm = fmaxf(cm, __shfl_xor(cm, 16)); cm = fmaxf(cm, __shfl_xor(cm, 32)); cm *= C2; \
            const float mnew = fmaxf(mrun, cm); \
            if (__any(mnew > mrun)) { const float f = __builtin_amdgcn_exp2f(mrun - mnew); lsum *= f; mrun = mnew; \
                _Pragma("unroll") for (int cb = 0; cb < 8; ++cb) ot[cb] = ot[cb] * f; } \
            float e[8]; \
            _Pragma("unroll") for (int i = 0; i < 4; ++i) { e[i] = __builtin_amdgcn_exp2f(a0[i] * C2 - mrun); e[4 + i] = __builtin_amdgcn_exp2f(a1[i] * C2 - mrun); } \
            lsum += ((e[0] + e[1]) + (e[2] + e[3])) + ((e[4] + e[5]) + (e[6] + e[7])); \
            u32x4 pw; pw.x = gp::cvt_pk_bf16(e[0], e[1]); pw.y = gp::cvt_pk_bf16(e[2], e[3]); pw.z = gp::cvt_pk_bf16(e[4], e[5]); pw.w = gp::cvt_pk_bf16(e[6], e[7]); \
            const bf16x8 pbv = __builtin_bit_cast(bf16x8, pw); \
            _Pragma("unroll") for (int i = 0; i < 8; ++i) { const int sig = 4 * i + g, ch = n16; \
                *(LAS u32x4*)(Lb + sig * 256 + (((ch >> 1) ^ (sig & 7)) * 32) + (ch & 1) * 16) = ST[i]; } \
            asm volatile("s_waitcnt lgkmcnt(0)" ::: "memory"); \
            const int rq = 4 * g + (n16 >> 2); \
            _Pragma("unroll") for (int cb = 0; cb < 8; ++cb) { \
                const s16x4 lo = vtr(Lb + rq * 256 + ((cb ^ (rq & 7)) * 32) + 8 * (lane & 3)); \
                const s16x4 hv = vtr(Lb + (16 + rq) * 256 + ((cb ^ (rq & 7)) * 32) + 8 * (lane & 3)); \
                const bf16x8 af = (bf16x8){lo[0], lo[1], lo[2], lo[3], hv[0], hv[1], hv[2], hv[3]}; \
                ot[cb] = __builtin_amdgcn_mfma_f32_16x16x32_bf16(af, pbv, ot[cb], 0, 0, 0); } \
            asm volatile("s_waitcnt lgkmcnt(0)" ::: "memory"); } while (0)
        DS_LOADCH(kA, stA, 0);
#pragma unroll 1
        for (int s = 0; s < nstep; s += 2) {
            DS_LOADCH(kB, stB, s + 1);
            DS_PROC(kA, stA);
            if (s + 2 < nstep) DS_LOADCH(kA, stA, s + 2);
            DS_PROC(kB, stB);
        }
#undef DS_LOADCH
#undef DS_PROC
        lsum += __shfl_xor(lsum, 16); lsum += __shfl_xor(lsum, 32);
        const float linv = 1.0f / lsum;
        if (n16 < 8) {
            LAS bf16_t* Oall = (LAS bf16_t*)(lds + OALL_OFF) + (wave * 8 + n16) * 128;
#pragma unroll
            for (int cb = 0; cb < 8; ++cb) *(LAS u32x2*)(Oall + 16 * cb + 4 * g) = (u32x2){pk2(ot[cb][0] * linv, ot[cb][1] * linv), pk2(ot[cb][2] * linv, ot[cb][3] * linv)};
        }
    }
    __syncthreads();
    if (STOP == 3) return;
    asm volatile("" : "+v"(lane));
    P0Item cvi, cvj; f32x4 cva[8], cvb[8];
    const bool cvok = conv_expert_issue(p, lane, wave, cvcur, cvi, cva);
    const bool cvok2 = conv_expert_issue(p, lane, wave, cvcur, cvj, cvb);
    {
        const int n16 = lane & 15, g = lane >> 4, hh = wave;
        const bf16_t* WuvT = (const bf16_t*)(ws + WS_WUVT) + hh * 64 * 128;
        const LAS bf16_t* Oall = (const LAS bf16_t*)(lds + OALL_OFF) + ((n16 & 7) * 8 + hh) * 128;
        bf16x8 af[4];
#pragma unroll
        for (int ks = 0; ks < 4; ++ks) af[ks] = *(const LAS bf16x8*)(Oall + 32 * ks + 8 * g);
#pragma unroll
        for (int nb = 0; nb < 4; ++nb) {
            f32x4 a = (f32x4){0.f, 0.f, 0.f, 0.f};
#pragma unroll
            for (int ks = 0; ks < 4; ++ks) { const bf16x8 bf = *(const bf16x8*)(WuvT + (16 * nb + n16) * 128 + 32 * ks + 8 * g);
                a = __builtin_amdgcn_mfma_f32_16x16x32_bf16(af[ks], bf, a, 0, 0, 0); }
            if (g < 2) {
#pragma unroll
                for (int i = 0; i < 4; ++i) H[(size_t)(t0 + 4 * g + i) * DM + 512 + hh * 64 + 16 * nb + n16] = f2bf(a[i]);
            }
        }
    }
    __syncthreads();
    if (cvok) p0_finish(cvi, cva, (LAS float*)(lds + wave * 8704), lane);
    if (cvok2) p0_finish(cvj, cvb, (LAS float*)(lds + wave * 8704), lane);
    __syncthreads();
}

template <int STOP> __device__ __forceinline__ void phase(const Params& p, LAS unsigned char* lds, int tid, int lane, int wave, int& cvcur) {
    const int G = gridDim.x, k = blockIdx.x;
    const bool nice = (G == 256);
    const int nit = nice ? 16 : (4096 - k + G - 1) / G;
    for (int i = 0; i < nit; ++i) {
        int b, qt;
        if (nice) { const int j = k >> 3; b = k & 7; qt = 511 - (i * 32 + ((i & 1) ? 31 - j : j)); }
        else { const int u = k + i * G; b = u & 7; qt = 511 - (u >> 3); }
        unit<STOP>(p, lds, tid, lane, wave, b, qt, cvcur);
    }
}
}

#define XB_TMO      128
#define XB_XCNT(j)  (256  + 64 * (j))
#define XB_XSUB(j)  (1280 + 64 * (j))
#define XB_XGEN(j)  (2304 + 64 * (j))
#define XB_TOP      3328
#define XB_TOPGEN   3392
#define XCD_BAR_WORDS 3456
#define XB_SPIN_CAP (1u << 22)
__device__ __forceinline__ unsigned xb_ld(unsigned* p)              { return __hip_atomic_load(p, __ATOMIC_RELAXED, __HIP_MEMORY_SCOPE_AGENT); }
__device__ __forceinline__ unsigned xb_add(unsigned* p, unsigned v) { return __hip_atomic_fetch_add(p, v, __ATOMIC_RELAXED, __HIP_MEMORY_SCOPE_AGENT); }
__device__ __forceinline__ unsigned xb_xcc_id() { return (unsigned)__builtin_amdgcn_s_getreg((3 << 11) | 20) & 0xFu; }
#define XB_SPIN(cond, bar) do { unsigned _sp = 0; while (cond) { __builtin_amdgcn_s_sleep(1); \
    if ((++_sp & 255u) == 0u) { if (xb_ld(&(bar)[XB_TMO])) break; if (_sp > XB_SPIN_CAP) { atomicAdd(&(bar)[XB_TMO], 1u); break; } } } } while (0)
struct XcdBarrier { unsigned* bar; unsigned x; volatile LAS unsigned* st; };
__device__ __forceinline__ XcdBarrier xcd_barrier_post(unsigned* bar, volatile LAS unsigned* st) {
    XcdBarrier b; b.bar = bar; b.x = xb_xcc_id(); b.st = st;
    if (threadIdx.x == 0) (void)xb_add(&bar[XB_XCNT(b.x)], 1u);
    return b;
}
__device__ __forceinline__ void xcd_barrier_complete(unsigned* bar, unsigned x, unsigned& nloc, unsigned& nx) {
    const unsigned G = gridDim.x * gridDim.y * gridDim.z;
    unsigned sum, cnt, mine, sp = 0u;
    for (;;) {
        sum = 0u; cnt = 0u; mine = 0u;
#pragma unroll
        for (unsigned j = 0; j < 16; ++j) { const unsigned c = xb_ld(&bar[XB_XCNT(j)]); sum += c; cnt += (c > 0u) ? 1u : 0u; mine = (j == x) ? c : mine; }
        if (sum == G) break;
        __builtin_amdgcn_s_sleep(1);
        if ((++sp & 255u) == 0u) { if (xb_ld(&bar[XB_TMO])) break; if (sp > XB_SPIN_CAP) { atomicAdd(&bar[XB_TMO], 1u); break; } }
    }
    nloc = mine > 0u ? mine : 1u; nx = cnt > 0u ? cnt : 1u;
}
__device__ __forceinline__ void xcd_barrier(const XcdBarrier& b) {
    asm volatile("s_waitcnt vmcnt(0)" ::: "memory");
    __syncthreads();
    if (threadIdx.x == 0) {
        unsigned* bar = b.bar;
        __builtin_amdgcn_s_waitcnt(0);
        unsigned nloc = b.st[0], nx = b.st[1];
        if (nloc == 0u) { xcd_barrier_complete(bar, b.x, nloc, nx); b.st[0] = nloc; b.st[1] = nx; }
        const unsigned old = xb_add(&bar[XB_XSUB(b.x)], 1u);
        const unsigned gen = old / nloc;
        if (old + 1u == (gen + 1u) * nloc) {
            __builtin_amdgcn_fence(__ATOMIC_RELEASE, "agent");
            asm volatile("s_waitcnt vmcnt(0)" ::: "memory");
            const unsigned og = xb_add(&bar[XB_TOP], 1u);
            const unsigned tg = og / nx;
            if (og + 1u == (tg + 1u) * nx) xb_add(&bar[XB_TOPGEN], 1u);
            else XB_SPIN(xb_ld(&bar[XB_TOPGEN]) == tg, bar);
            __builtin_amdgcn_fence(__ATOMIC_ACQUIRE, "agent");
            xb_add(&bar[XB_XGEN(b.x)], 1u);
            asm volatile("s_waitcnt vmcnt(0)" ::: "memory");
        } else {
            XB_SPIN(xb_ld(&bar[XB_XGEN(b.x)]) == gen, bar);
            __builtin_amdgcn_fence(__ATOMIC_ACQUIRE, "agent");
            asm volatile("s_waitcnt vmcnt(0)" ::: "memory");
        }
    }
    __syncthreads();
}
constexpr int N_PHASES = 10;
__global__ void __launch_bounds__(NTHREADS, 2) mega(Params p) {
    extern __shared__ __attribute__((aligned(16))) unsigned char lds_raw[];
    LAS unsigned char* lds = (LAS unsigned char*)lds_raw;
    cg::grid_group grid = cg::this_grid();
    int tid = threadIdx.x, lane = tid & 63; const int wave = __builtin_amdgcn_readfirstlane(tid >> 6);
#define FRESH() do { tid = threadIdx.x; asm volatile("" : "+v"(tid)); lane = tid & 63; } while (0)
    unsigned char* ws = p.ws;
    const int lo = p.ph_lo, hi = p.ph_hi;
    volatile LAS unsigned* MISC = (volatile LAS unsigned*)(lds + LDS_MISC);
    if (tid < 16) MISC[tid] = 0u;
    __syncthreads();
    XcdBarrier bar = xcd_barrier_post((unsigned*)(ws + WS_CTL), MISC);
#define IN(k) (lo <= (k) && (k) < hi)
#define SEAM(k) do { if (IN(k) && IN((k) + 1)) xcd_barrier(bar); } while (0)
    if (lo < 0) grid.sync();
    if (IN(0)) { FRESH(); phase_prep(p, lds, tid, lane, wave); } SEAM(0);
    if (IN(1)) { FRESH(); phase_norm1(p, lds, tid, lane, wave); } SEAM(1);
    if (IN(2)) { FRESH();
        gp::Gemm g{(const bf16_t*)(ws + WS_H), (const bf16_t*)(ws + WS_WINT), NPJ, DM, nullptr};
        gp::StaticOrder S; S.init(NTOK, NPJ, gridDim.x, blockIdx.x);
        LAS float* gl = (LAS float*)(lds + LDS_RING + 8192);
        if (tid < 64) { gl[tid] = p.in[8][tid]; gl[64 + tid] = p.in[9][tid]; gl[128 + tid] = p.in[12][tid]; gl[192 + tid] = p.in[13][tid]; }
        if (tid < 128) gl[256 + tid] = p.in[14][tid];
        __syncthreads();
        gp::EpiInproj E{(bf16_t*)(ws + WS_PROJ), (const float*)(ws + WS_ROPE), gl, (LAS float*)(lds + LDS_RING), ws + WS_IKF};
        gp::gemm_phase<gp::EpiInproj, gp::StaticOrder, false>(lds, g, S, E);
    } SEAM(2);
    if (IN(3)) { int cvcur = 0;
        const bool dsa_first = (((int)blockIdx.x >> 3) & 1) != 0;
        if (!dsa_first) { FRESH(); da::phase(p, lds, tid, lane, wave, cvcur); }
        FRESH(); ds::phase<0>(p, lds, tid, lane, wave, cvcur);
        if (dsa_first) { FRESH(); da::phase(p, lds, tid, lane, wave, cvcur); }
        conv_expert_items(p, lds, lane, wave, cvcur, 1 << 20); } SEAM(3);
    if (IN(4)) { FRESH();
        gp::Gemm g{(const bf16_t*)(ws + WS_H), (const bf16_t*)(ws + WS_WOUTT), DM, DM, nullptr};
        gp::StaticOrder S; S.init(NTOK, DM, gridDim.x, blockIdx.x);
        gp::EpiResid E{p.in[0], p.out, (const float*)(ws + WS_MOD)};
        gp::gemm_phase<gp::EpiResid, gp::StaticOrder, false>(lds, g, S, E);
    } SEAM(4);
    if (IN(5)) { FRESH(); phase_norm2(p, lds, tid, lane, wave); } SEAM(5);
    if (IN(6)) { FRESH(); phase_scatter(p, lds, tid, lane, wave); } SEAM(6);
    if (IN(7)) { FRESH();
        const int* tile_e = (const int*)(ws + WS_TILEE);
        gp::Gemm g{(const bf16_t*)(ws + WS_H), (const bf16_t*)(ws + WS_WGUT), 2048, DM, (const int*)(ws + WS_ROWSRC)};
        gp::MoeOrder S{tile_e, tile_e[MAXTILES], 8, (int)blockIdx.x, (int)gridDim.x};
        gp::EpiSwiglu E{(bf16_t*)(ws + WS_ACT), p.in[19], p.in[21]};
        gp::gemm_phase<gp::EpiSwiglu, gp::MoeOrder, true>(lds, g, S, E);
    } SEAM(7);
    if (IN(8)) { FRESH();
        const int* tile_e = (const int*)(ws + WS_TILEE);
        gp::Gemm g{(const bf16_t*)(ws + WS_ACT), (const bf16_t*)(ws + WS_WDT), DM, DM, nullptr};
        gp::MoeOrder S{tile_e, tile_e[MAXTILES], 4, (int)blockIdx.x, (int)gridDim.x};
        gp::EpiDown E{p.out, (bf16_t*)(ws + WS_Y), p.in[23], (const float*)(ws + WS_MOD), (const int2*)(ws + WS_ROWMETA)};
        gp::gemm_phase<gp::EpiDown, gp::MoeOrder, false>(lds, g, S, E);
    } SEAM(8);
    if (IN(9)) { FRESH(); phase_combine(p, tid); }
#undef IN
#undef SEAM
}

static int g_grid = 0;
static void launch_mega(const Params& base, int lo, int hi, hipStream_t stream) {
    Params p = base; p.ph_lo = lo; p.ph_hi = hi;
    void* args[] = {&p};
    hipError_t e = hipLaunchCooperativeKernel((const void*)mega, dim3(g_grid), dim3(NTHREADS), args, LDS_BYTES, stream);
    if (e != hipSuccess) fprintf(stderr, "kernel_launch: cooperative launch [%d,%d) failed: %s (grid %d)\n", lo, hi, hipGetErrorString(e), g_grid);
}
extern "C" void kernel_launch(void* const* d_in, const int* in_sizes, int n_in, void* d_out, int out_size, void* d_ws, size_t ws_size, hipStream_t stream) {
    if (ws_size < WS_END) { fprintf(stderr, "kernel_launch: workspace too small: %zu < %zu\n", ws_size, (size_t)WS_END); return; }
    if (g_grid == 0) {
        int dev = 0, cus = 0, per_cu = 0;
        hipGetDevice(&dev); hipDeviceGetAttribute(&cus, hipDeviceAttributeMultiprocessorCount, dev);
        if (hipFuncSetAttribute((const void*)mega, hipFuncAttributeMaxDynamicSharedMemorySize, LDS_BYTES) != hipSuccess) fprintf(stderr, "kernel_launch: hipFuncSetAttribute failed\n");
        hipOccupancyMaxActiveBlocksPerMultiprocessor(&per_cu, (const void*)mega, NTHREADS, LDS_BYTES);
        (void)hipGetLastError();
        if (per_cu < 1) { fprintf(stderr, "kernel_launch: occupancy query says %d blocks/CU\n", per_cu); per_cu = 1; }
        g_grid = cus * 1;
        fprintf(stderr, "kernel_launch: cus %d per_cu %d grid %d\n", cus, per_cu, g_grid);
    }
    const float* x = (const float*)d_in[0];
    float* out = (float*)d_out; char* ws = (char*)d_ws;
    float* mod = (float*)(ws + WS_MOD); float* rope = (float*)(ws + WS_ROPE); float* lam = (float*)(ws + WS_LAM);
    float* IW = (float*)(ws + WS_IW);
    bf16_t* H = (bf16_t*)(ws + WS_H); bf16_t* PROJ = (bf16_t*)(ws + WS_PROJ);
    Params P{};
    for (int i = 0; i < 24; ++i) P.in[i] = (const float*)d_in[i];
    P.out = out; P.ws = (unsigned char*)d_ws;

    (void)hipMemsetAsync((char*)d_ws + WS_CTL, 0, 16384, stream);
    launch_mega(P, 0, N_PHASES, stream);
    (void)rope; (void)lam; (void)IW; (void)H; (void)PROJ;
    (void)x; (void)mod;
}
```

```cpp
#include <hip/hip_runtime.h>
#include <stdint.h>
#include <cstdio>

typedef unsigned short bf16_t;
__device__ __forceinline__ float bf2f(bf16_t v) { return __uint_as_float(((unsigned)v) << 16); }
__device__ __forceinline__ bf16_t f2bf(float f) { unsigned u = __float_as_uint(f); return (bf16_t)((u + 0x7fffu + ((u >> 16) & 1u)) >> 16); }

constexpr int NB = 8, SEQ = 4096, DM = 1024, NTOK = NB * SEQ;
constexpr int NIN = 2824, NPJ = 2816;
constexpr int C_AQ1 = 0, C_AQ2 = 256, C_AK1 = 512, C_AK2 = 768, C_AV = 1024, C_BQ = 1536, C_BK = 2048, C_BLAT = 2112, C_IQ = 2240, C_IK = 2752, C_IW = 2816;
constexpr int NEXP = 32, TOPK = 4, NPAIR = NTOK * TOPK;
constexpr int MAXTILES = NPAIR / 256 + NEXP;
constexpr int PPAD = MAXTILES * 256;
constexpr int NCHUNK = 256, CHTOK = NTOK / NCHUNK;
constexpr float RMS_EPS = 1e-6f;
constexpr float LAMBDA_INIT = 0.2f;

constexpr size_t MiB = 1u << 20;
constexpr size_t WS_CTL = 0;
constexpr size_t WS_MOD = 1 * MiB;
constexpr size_t WS_ROPE = WS_MOD + 256 * 1024;
constexpr size_t WS_LAM = WS_ROPE + 256 * 1024;
constexpr size_t WS_CHCNT = WS_LAM + 4096;
constexpr size_t WS_TILEE = WS_CHCNT + 32768;
constexpr size_t WS_TOPI = 2 * MiB;
constexpr size_t WS_TOPG = WS_TOPI + 512 * 1024;
constexpr size_t WS_ROWTOK = 3 * MiB;
constexpr size_t WS_ROWSRC = 3 * MiB + 640 * 1024;
constexpr size_t WS_IW = 5 * MiB;
constexpr size_t WS_ROWMETA = 6 * MiB;
constexpr size_t WS_WINT = 8 * MiB;
constexpr size_t WS_WOUTT = 14 * MiB;
constexpr size_t WS_WUVT = 16 * MiB;
constexpr size_t WS_WDT = 17 * MiB;
constexpr size_t WS_WGUT = 81 * MiB;
constexpr size_t WS_H = 209 * MiB;
constexpr size_t WS_PROJ = 273 * MiB;
constexpr size_t WS_ACT = WS_PROJ;
constexpr size_t WS_Y = WS_WGUT;
constexpr size_t WS_IKF = WS_ACT + (size_t)PPAD * 1024 * 2;
constexpr size_t WS_END = WS_IKF + 4 * MiB;

namespace gp {
#define GP_LAS __attribute__((address_space(3)))
typedef short bf16x8 __attribute__((ext_vector_type(8)));
typedef float f32x4 __attribute__((ext_vector_type(4)));
typedef unsigned u32x4 __attribute__((ext_vector_type(4)));
constexpr int BM = 256, BK = 64, HALF = 128, HTB = HALF * BK * 2  , STAGE_BYTES = 8 * HTB;

__host__ __device__ __forceinline__ int lds_byte(int r, int c) { const int st = (r >> 4) * 2 + (c >> 5), rr = r & 15, cc = c & 31, ob = rr * 64 + cc * 2; return st * 1024 + (ob ^ (((ob >> 9) & 1) << 5)); }
__host__ __device__ __forceinline__ void stage_rc(int b, int& R, int& C) { const int st = b / 1024, sb = b % 1024, swz = sb ^ (((sb >> 9) & 1) << 5); R = (st >> 1) * 16 + swz / 64; C = (st & 1) * 32 + (swz % 64) / 2; }
__host__ __device__ __forceinline__ int perm32(int rho) { const int n = rho >> 4, i = rho & 15; return 8 * (i >> 2) + 4 * n + (i & 3); }

struct Unit { int pm, pn, e; };
struct Gemm { const bf16_t* A; const bf16_t* Bt; int N, K; const int* rowsrc; };

struct StaticOrder {
    int nM, nN, nwg, G, c;
    __device__ void init(int M, int N, int G_, int c_) { nM = M / BM; nN = N / BM; nwg = nM * nN; G = G_; c = c_; }
    __device__ bool next(int i, Unit& u) const {
        const long L = (long)i * G + c; if (L >= nwg) return false;
        int wgid = (int)L; { const int q = nwg / 8, r = nwg % 8, xcd = wgid % 8, off = wgid / 8; wgid = (xcd < r ? xcd * (q + 1) : r * (q + 1) + (xcd - r) * q) + off; }
        const int nig = 8 * nN, gid = wgid / nig, fm = gid * 8, gsz = (nM - fm) < 8 ? (nM - fm) : 8;
        u.pm = fm + ((wgid % nig) % gsz); u.pn = (wgid % nig) / gsz; u.e = 0; return true;
    }
};
struct MoeOrder {
    const int* tile_e; int ntiles, nN, c, G;
    __device__ bool next(int i, Unit& u) const {
        const int j = c >> 3, x = c & 7, tpx = (G >> 3) / nN;
        const int tile = i * (tpx * 8) + x * tpx + j / nN;
        if (tile >= ntiles) return false;
        u.pm = tile; u.pn = j % nN; u.e = tile_e[tile]; return true;
    }
};

__device__ __forceinline__ unsigned cvt_pk_bf16(float lo, float hi) { unsigned r; asm volatile("v_cvt_pk_bf16_f32 %0, %1, %2" : "=v"(r) : "v"(lo), "v"(hi)); return r; }

struct EpiBf16 {
    bf16_t* O; int ldc;
    __device__ __forceinline__ void operator()(const f32x4 (&acc)[2][2][4][2], const Unit& u, int wr, int wc, int fr, int fq) const {
        const int row0 = u.pm * BM + wr * 64 + fr, col0 = u.pn * BM + wc * 32 + 8 * fq;
#pragma unroll
        for (int ai = 0; ai < 2; ++ai)
#pragma unroll
            for (int m = 0; m < 4; ++m) { bf16_t* rowp = O + (size_t)(row0 + ai * HALF + m * 16) * ldc + col0;
#pragma unroll
                for (int bj = 0; bj < 2; ++bj) { const f32x4 v0 = acc[ai][bj][m][0], v1 = acc[ai][bj][m][1];
                    u32x4 w; w.x = cvt_pk_bf16(v0[0], v0[1]); w.y = cvt_pk_bf16(v0[2], v0[3]); w.z = cvt_pk_bf16(v1[0], v1[1]); w.w = cvt_pk_bf16(v1[2], v1[3]);
                    *(u32x4*)(rowp + bj * HALF) = w; } }
    }
};

struct EpiInproj {
    bf16_t* O; const float* rope; GP_LAS const float* gl; GP_LAS float* xch; unsigned char* ikf;
    __device__ __forceinline__ void operator()(const f32x4 (&acc)[2][2][4][2], const Unit& u, int wr, int wc, int fr, int fq) const {
        const int wid = wr * 4 + wc, row0 = u.pm * BM + wr * 64 + fr, col0 = u.pn * BM + wc * 32 + 8 * fq, lc = (wc & 1) * 32 + 8 * fq;
        int mode[2]; int goff[2];
#pragma unroll
        for (int bj = 0; bj < 2; ++bj) { const int gc = u.pn * BM + bj * HALF + (wc >> 1) * 64; goff[bj] = 0;
            if (gc < 512) { mode[bj] = 1; goff[bj] = lc; } else if (gc < 1024) { mode[bj] = 1; goff[bj] = 64 + lc; } else if (gc < 1536) { mode[bj] = 0; }
            else if (gc < 2048) { mode[bj] = 1; goff[bj] = 128 + lc; } else if (gc < 2112) { mode[bj] = 1; goff[bj] = 192 + lc; }
            else if (gc < 2240) { mode[bj] = 3; goff[bj] = 256 + (gc - 2112) + lc; } else { mode[bj] = 2; } }
#pragma unroll
        for (int ai = 0; ai < 2; ++ai)
#pragma unroll
            for (int m = 0; m < 4; ++m)
#pragma unroll
                for (int bj = 0; bj < 2; ++bj) { const f32x4 a = acc[ai][bj][m][0], b = acc[ai][bj][m][1];
                    float s = ((a[0] * a[0] + a[1] * a[1]) + (a[2] * a[2] + a[3] * a[3])) + ((b[0] * b[0] + b[1] * b[1]) + (b[2] * b[2] + b[3] * b[3]));
                    s += __shfl_xor(s, 16); s += __shfl_xor(s, 32);
                    if (fq == 0) xch[(wid * 2 + bj) * 128 + ai * 64 + m * 16 + fr] = s; }
        asm volatile("s_waitcnt lgkmcnt(0)" ::: "memory"); __builtin_amdgcn_s_barrier(); asm volatile("" ::: "memory");
#pragma unroll
        for (int ai = 0; ai < 2; ++ai)
#pragma unroll
            for (int m = 0; m < 4; ++m) { int rl = ai * 64 + m * 16 + fr, row = row0 + ai * HALF + m * 16; asm volatile("" : "+v"(rl), "+v"(row)); const int pos = row % SEQ;
                bf16_t* rowp = O + (size_t)row * NPJ + col0;
#pragma unroll
                for (int bj = 0; bj < 2; ++bj) { f32x4 v0 = acc[ai][bj][m][0], v1 = acc[ai][bj][m][1];
                    if (mode[bj] == 1 || mode[bj] == 3) {
                        float tot = xch[(wid * 2 + bj) * 128 + rl] + xch[((wid ^ 1) * 2 + bj) * 128 + rl];
                        if (mode[bj] == 3) tot += xch[((wr * 4 + (wc ^ 2)) * 2 + (bj ^ 1)) * 128 + rl] + xch[((wr * 4 + (wc ^ 3)) * 2 + (bj ^ 1)) * 128 + rl];
                        const float r = 1.0f / sqrtf(tot * (mode[bj] == 3 ? (1.f / 128.f) : (1.f / 64.f)) + RMS_EPS);
                        const f32x4 g0 = *(GP_LAS const f32x4*)(gl + goff[bj]), g1 = *(GP_LAS const f32x4*)(gl + goff[bj] + 4);
                        v0 = v0 * r * g0; v1 = v1 * r * g1; }
                    if ((mode[bj] == 1 || mode[bj] == 2) && (wc & 1) == 0) {
                        f32x4 o0, o1;
#pragma unroll
                        for (int i = 0; i < 4; ++i) { o0[i] = __shfl_xor(v0[i], 16); o1[i] = __shfl_xor(v1[i], 16); }
                        if (fq < 2) { const float* rp = rope + pos * 16; const float sg = fq == 0 ? -1.0f : 1.0f;
                            const f32x4 t0 = *(const f32x4*)(rp), t1 = *(const f32x4*)(rp + 4), t2 = *(const f32x4*)(rp + 8), t3 = *(const f32x4*)(rp + 12);
                            v0[0] = v0[0] * t0[0] + sg * o0[0] * t0[1]; v0[1] = v0[1] * t0[2] + sg * o0[1] * t0[3];
                            v0[2] = v0[2] * t1[0] + sg * o0[2] * t1[1]; v0[3] = v0[3] * t1[2] + sg * o0[3] * t1[3];
                            v1[0] = v1[0] * t2[0] + sg * o1[0] * t2[1]; v1[1] = v1[1] * t2[2] + sg * o1[1] * t2[3];
                            v1[2] = v1[2] * t3[0] + sg * o1[2] * t3[1]; v1[3] = v1[3] * t3[2] + sg * o1[3] * t3[3]; } }
                    u32x4 w; w.x = cvt_pk_bf16(v0[0], v0[1]); w.y = cvt_pk_bf16(v0[2], v0[3]); w.z = cvt_pk_bf16(v1[0], v1[1]); w.w = cvt_pk_bf16(v1[2], v1[3]);
                    *(u32x4*)(rowp + bj * HALF) = w;
                    if (u.pn == 10 && bj == 1 && wc >= 2) {
                        const int key = row % SEQ, c8 = (wc & 1) * 4 + fq;
                        *(u32x4*)(ikf + ((size_t)((((row / SEQ) * 128 + (key >> 5)) * 4 + (c8 >> 1)) * 64 + (c8 & 1) * 32 + (key & 31)) << 4)) = w; } }
                asm volatile("" ::: "memory"); }
    }
};
struct EpiResid {
    const float* x; float* out; const float* mod;
    __device__ __forceinline__ void operator()(const f32x4 (&acc)[2][2][4][2], const Unit& u, int wr, int wc, int fr, int fq) const {
        const int row0 = u.pm * BM + wr * 64 + fr, col0 = u.pn * BM + wc * 32 + 8 * fq, b = (u.pm * BM) / SEQ;
        f32x4 gv[2][2];
#pragma unroll
        for (int bj = 0; bj < 2; ++bj)
#pragma unroll
            for (int n = 0; n < 2; ++n) gv[bj][n] = *(const f32x4*)(mod + b * 6144 + 2 * 1024 + col0 + bj * HALF + 4 * n);
#pragma unroll
        for (int ai = 0; ai < 2; ++ai)
#pragma unroll
            for (int m = 0; m < 4; ++m) { const size_t off = (size_t)(row0 + ai * HALF + m * 16) * DM + col0;
#pragma unroll
                for (int bj = 0; bj < 2; ++bj)
#pragma unroll
                    for (int n = 0; n < 2; ++n) { const f32x4 xv = *(const f32x4*)(x + off + bj * HALF + 4 * n);
                        *(f32x4*)(out + off + bj * HALF + 4 * n) = xv + gv[bj][n] * acc[ai][bj][m][n]; }
                asm volatile("" ::: "memory"); }
    }
};
struct EpiSwiglu {
    bf16_t* act; const float* bg; const float* bu;
    __device__ __forceinline__ void operator()(const f32x4 (&acc)[2][2][4][2], const Unit& u, int wr, int wc, int fr, int fq) const {
        const int row0 = u.pm * BM + wr * 64 + fr, ff0 = u.pn * HALF + wc * 32 + 8 * fq;
        f32x4 bgv[2], buv[2];
#pragma unroll
        for (int n = 0; n < 2; ++n) { bgv[n] = *(const f32x4*)(bg + u.e * 1024 + ff0 + 4 * n); buv[n] = *(const f32x4*)(bu + u.e * 1024 + ff0 + 4 * n); }
#pragma unroll
        for (int ai = 0; ai < 2; ++ai)
#pragma unroll
            for (int m = 0; m < 4; ++m) {
                float a[8];
#pragma unroll
                for (int n = 0; n < 2; ++n) { const f32x4 g4 = acc[ai][0][m][n] + bgv[n], u4 = acc[ai][1][m][n] + buv[n];
#pragma unroll
                    for (int j = 0; j < 4; ++j) { const float g = fminf(g4[j], 7.0f), uu = fminf(fmaxf(u4[j], -7.0f), 7.0f);
                        const float sg = __builtin_amdgcn_rcpf(1.0f + __builtin_amdgcn_exp2f(-1.702f * 1.4426950408889634f * g));
                        a[4 * n + j] = g * sg * (uu + 1.0f); } }
                u32x4 w; w.x = cvt_pk_bf16(a[0], a[1]); w.y = cvt_pk_bf16(a[2], a[3]); w.z = cvt_pk_bf16(a[4], a[5]); w.w = cvt_pk_bf16(a[6], a[7]);
                *(u32x4*)(act + (size_t)(row0 + ai * HALF + m * 16) * 1024 + ff0) = w; }
    }
};
struct EpiDown {
    float* out; bf16_t* Y; const float* bd; const float* mod; const int2* rowmeta;
    __device__ __forceinline__ void operator()(const f32x4 (&acc)[2][2][4][2], const Unit& u, int wr, int wc, int fr, int fq) const {
        const int row0 = u.pm * BM + wr * 64 + fr, col0 = u.pn * BM + wc * 32 + 8 * fq;
        f32x4 bv[2][2];
#pragma unroll
        for (int bj = 0; bj < 2; ++bj)
#pragma unroll
            for (int n = 0; n < 2; ++n) bv[bj][n] = *(const f32x4*)(bd + u.e * 1024 + col0 + bj * HALF + 4 * n);
        int2 meta[2][4];
#pragma unroll
        for (int ai = 0; ai < 2; ++ai)
#pragma unroll
            for (int m = 0; m < 4; ++m) meta[ai][m] = rowmeta[row0 + ai * HALF + m * 16];
#pragma unroll
        for (int ai = 0; ai < 2; ++ai)
#pragma unroll
            for (int m = 0; m < 4; ++m) {
                const int ent = meta[ai][m].x;
                if (ent >= 0) {
                    const int tok = ent >> 2, kk = ent & 3; const float gt = __int_as_float(meta[ai][m].y);
                    if (kk == 0) { const float* g2 = mod + (tok / SEQ) * 6144 + 5 * 1024 + col0; float* op = out + (size_t)tok * DM + col0;
#pragma unroll
                        for (int bj = 0; bj < 2; ++bj)
#pragma unroll
                            for (int n = 0; n < 2; ++n) { const f32x4 g4 = *(const f32x4*)(g2 + bj * HALF + 4 * n), o4 = *(const f32x4*)(op + bj * HALF + 4 * n);
                                *(f32x4*)(op + bj * HALF + 4 * n) = o4 + g4 * ((acc[ai][bj][m][n] + bv[bj][n]) * gt); }
                    } else { bf16_t* yp = Y + ((size_t)(kk - 1) * NTOK + tok) * DM + col0;
#pragma unroll
                        for (int bj = 0; bj < 2; ++bj) { const f32x4 v0 = (acc[ai][bj][m][0] + bv[bj][0]) * gt, v1 = (acc[ai][bj][m][1] + bv[bj][1]) * gt;
                            u32x4 w; w.x = cvt_pk_bf16(v0[0], v0[1]); w.y = cvt_pk_bf16(v0[2], v0[3]); w.z = cvt_pk_bf16(v1[0], v1[1]); w.w = cvt_pk_bf16(v1[2], v1[3]);
                            *(u32x4*)(yp + bj * HALF) = w; } }
                }
                asm volatile("" ::: "memory"); }
    }
};

template <class Epi, class Sched, bool GATHER>
__device__ __forceinline__ void gemm_phase(GP_LAS unsigned char* lds, const Gemm g, const Sched& S, const Epi& E) {
    const int tid = threadIdx.x, wid = __builtin_amdgcn_readfirstlane(tid >> 6), lane = tid & 63, wr = wid >> 2, wc = wid & 3, fr = lane & 15, fq = lane >> 4;
    const int K = g.K, nt = K / BK;
    unsigned voffB[2];
#pragma unroll
    for (int i = 0; i < 2; ++i) { int R, C; stage_rc(tid * 16 + i * 8192, R, C); const int Rb = (R & ~31) + perm32(R & 31); voffB[i] = (unsigned)(Rb * K + C) * 2u; }
    const size_t kstep = (size_t)(BK * 2);
    const size_t hstep = (size_t)HALF * K * 2;
    const size_t tstep = 2 * hstep;
    const unsigned ldsw = (unsigned)wid * 1024u;
    const int aoff = lds_byte(wr * 64 + fr, fq * 8), boff = lds_byte(wc * 32 + fr, fq * 8);
#define GP_SA(b, h) (((b) * 2 + (h)) * HTB)
#define GP_SB(b, h) ((4 + (b) * 2 + (h)) * HTB)
#define GP_STAGE(bufoff, gbase, voff) do { _Pragma("unroll") for (int _i = 0; _i < 2; ++_i) \
        __builtin_amdgcn_global_load_lds((const unsigned*)((const char*)(gbase) + (voff)[_i]), (GP_LAS unsigned*)(lds + (bufoff) + ldsw + _i * 8192), 16, 0, 0); } while (0)
#define GP_LDA(dst, b, h) do { _Pragma("unroll") for (int m = 0; m < 4; ++m) _Pragma("unroll") for (int k = 0; k < 2; ++k) dst[m][k] = *(const GP_LAS bf16x8*)(lds + GP_SA(b, h) + aoff + m * 2048 + k * 1024); } while (0)
#define GP_LDB(dst, b, h) do { _Pragma("unroll") for (int n = 0; n < 2; ++n) _Pragma("unroll") for (int k = 0; k < 2; ++k) dst[n][k] = *(const GP_LAS bf16x8*)(lds + GP_SB(b, h) + boff + n * 2048 + k * 1024); } while (0)
#define GP_MMA(ai, bj, At, Bt) do { __builtin_amdgcn_s_setprio(1); _Pragma("unroll") for (int m = 0; m < 4; ++m) _Pragma("unroll") for (int n = 0; n < 2; ++n) _Pragma("unroll") for (int k = 0; k < 2; ++k) \
        acc[ai][bj][m][n] = __builtin_amdgcn_mfma_f32_16x16x32_bf16(Bt[n][k], At[m][k], acc[ai][bj][m][n], 0, 0, 0); __builtin_amdgcn_s_setprio(0); } while (0)
#define GP_WAIT_V(n) asm volatile("s_waitcnt vmcnt(" #n ")" ::: "memory")
#define GP_WAIT_L(n) asm volatile("s_waitcnt lgkmcnt(" #n ")" ::: "memory")
#define GP_BAR __builtin_amdgcn_s_barrier()
#define GP_SCHED __builtin_amdgcn_sched_barrier(0)
#define GP_AOFFS(u_, v0_, v1_) do { _Pragma("unroll") for (int _i = 0; _i < 2; ++_i) { int R_, C_; stage_rc(tid * 16 + _i * 8192, R_, C_); int r0_ = (u_).pm * BM + R_, r1_ = r0_ + HALF; \
        if (GATHER) { r0_ = g.rowsrc[r0_]; r1_ = g.rowsrc[r1_]; } \
        v0_[_i] = (unsigned)(r0_ * K + C_) * 2u; v1_[_i] = (unsigned)(r1_ * K + C_) * 2u; } } while (0)
    Unit cur, nxt; int ui = 0;
    if (!S.next(0, cur)) return;
    f32x4 acc[2][2][4][2];
#pragma unroll
    for (int a = 0; a < 2; ++a)
#pragma unroll
        for (int b = 0; b < 2; ++b)
#pragma unroll
            for (int m = 0; m < 4; ++m)
#pragma unroll
                for (int n = 0; n < 2; ++n) acc[a][b][m][n] = (f32x4){0.f, 0.f, 0.f, 0.f};
    bf16x8 At[4][2], B0[2][2], B1[2][2];
    unsigned vA0[2], vA1[2], nA0[2], nA1[2];
    GP_AOFFS(cur, vA0, vA1);
    const char* Ab = (const char*)g.A;
    const char* cB = (const char*)g.Bt + ((size_t)cur.e * g.N + (size_t)cur.pn * BM) * K * 2;
    GP_STAGE(GP_SB(0, 0), cB, voffB); GP_STAGE(GP_SB(0, 1), cB + hstep, voffB); GP_STAGE(GP_SA(0, 0), Ab, vA0); GP_STAGE(GP_SA(0, 1), Ab, vA1);
    if (wr == 1) GP_BAR;
    GP_WAIT_V(2); GP_BAR;
    GP_STAGE(GP_SB(1, 0), cB + kstep, voffB); GP_STAGE(GP_SA(1, 0), Ab + kstep, vA0); GP_STAGE(GP_SB(1, 1), cB + hstep + kstep, voffB);
    GP_WAIT_V(6); GP_BAR;
    for (;;) {
        const bool has_next = S.next(ui + 1, nxt);
        const char* nB = cB;
        if (has_next) { nB = (const char*)g.Bt + ((size_t)nxt.e * g.N + (size_t)nxt.pn * BM) * K * 2; GP_AOFFS(nxt, nA0, nA1); }
        else { nA0[0] = vA0[0]; nA0[1] = vA0[1]; nA1[0] = vA1[0]; nA1[1] = vA1[1]; }
        for (int t = 0; t < nt; t += 2) {
            const bool last = (t == nt - 2);
            const char* a1 = Ab + (size_t)(t + 1) * kstep;
            const char* a2 = last ? Ab : Ab + (size_t)(t + 2) * kstep; const char* b2 = last ? nB : cB + (size_t)(t + 2) * kstep;
            const char* a3 = a2 + kstep; const char* b3 = b2 + kstep;
            GP_LDB(B0, 0, 0); GP_LDB(B1, 0, 1); GP_SCHED; GP_LDA(At, 0, 0); GP_STAGE(GP_SA(1, 1), a1, vA1);
            if (last) { vA0[0] = nA0[0]; vA0[1] = nA0[1]; vA1[0] = nA1[0]; vA1[1] = nA1[1]; }
            GP_WAIT_V(8); GP_WAIT_L(0); GP_BAR; GP_MMA(0, 0, At, B0); GP_MMA(0, 1, At, B1); GP_BAR; GP_SCHED;
            GP_LDA(At, 0, 1); GP_STAGE(GP_SB(0, 0), b2, voffB); GP_STAGE(GP_SB(0, 1), b2 + hstep, voffB); GP_STAGE(GP_SA(0, 0), a2, vA0);
            GP_WAIT_V(8); GP_WAIT_L(0); GP_BAR; GP_MMA(1, 0, At, B0); GP_MMA(1, 1, At, B1); GP_BAR; GP_SCHED;
            GP_LDB(B0, 1, 0); GP_LDB(B1, 1, 1); GP_SCHED; GP_LDA(At, 1, 0); GP_STAGE(GP_SA(0, 1), a2, vA1);
            GP_WAIT_V(8); GP_WAIT_L(0); GP_BAR; GP_MMA(0, 0, At, B0); GP_MMA(0, 1, At, B1); GP_BAR; GP_SCHED;
            GP_LDA(At, 1, 1); GP_STAGE(GP_SB(1, 0), b3, voffB); GP_STAGE(GP_SB(1, 1), b3 + hstep, voffB); GP_STAGE(GP_SA(1, 0), a3, vA0);
            GP_WAIT_V(8); GP_WAIT_L(0); GP_BAR; GP_MMA(1, 0, At, B0); GP_MMA(1, 1, At, B1); GP_BAR; GP_SCHED;
        }
        if (wr == 0) GP_BAR;
        E(acc, cur, wr, wc, fr, fq);
        if (!has_next) break;
#pragma unroll
        for (int a = 0; a < 2; ++a)
#pragma unroll
            for (int b = 0; b < 2; ++b)
#pragma unroll
                for (int m = 0; m < 4; ++m)
#pragma unroll
                    for (int n = 0; n < 2; ++n) acc[a][b][m][n] = (f32x4){0.f, 0.f, 0.f, 0.f};
        cur = nxt; cB = nB; ++ui;
        if (wr == 1) GP_BAR;
    }
    GP_WAIT_V(0);
    GP_BAR;
#undef GP_SA
#undef GP_SB
#undef GP_STAGE
#undef GP_LDA
#undef GP_LDB
#undef GP_MMA
#undef GP_WAIT_V
#undef GP_WAIT_L
#undef GP_BAR
#undef GP_SCHED
#undef GP_AOFFS
}
}
#include <hip/hip_cooperative_groups.h>
namespace cg = cooperative_groups;
#define LAS __attribute__((address_space(3)))
typedef float f32x4 __attribute__((ext_vector_type(4)));
typedef unsigned u32x4 __attribute__((ext_vector_type(4)));
typedef short bf16x8 __attribute__((ext_vector_type(8)));
constexpr int NWAVES = 8, NTHREADS = 512;
constexpr int LDS_RING = 131072;
constexpr int LDS_MISC = 159744;
constexpr int LDS_BYTES = 159744 + 256;

struct Params {
    const float* in[24];
    float* out; unsigned char* ws;
    int ph_lo, ph_hi;
};
__device__ __forceinline__ unsigned pk2(float lo, float hi) { return (unsigned)f2bf(lo) | ((unsigned)f2bf(hi) << 16); }
__device__ __forceinline__ float wave_sum(float v) {
#pragma unroll
    for (int o = 1; o < 64; o <<= 1) v += __shfl_xor(v, o);
    return v;
}

struct P0Item { const float* W; int ld, k0, n0; bf16_t* WT; int row0, Kdst; };
__device__ __forceinline__ void p0_load(const P0Item& it, f32x4 (&v)[8], int lane) {
#pragma unroll
    for (int i = 0; i < 8; ++i) v[i] = __builtin_nontemporal_load((const f32x4*)(it.W + (size_t)(it.k0 + 8 * i + (lane >> 3)) * it.ld + it.n0 + 4 * (lane & 7)));
}
__device__ __forceinline__ void p0_finish(const P0Item& it, const f32x4 (&v)[8], LAS float* scr, int lane) {
#pragma unroll
    for (int i = 0; i < 8; ++i) { LAS float* d = scr + (8 * i + (lane >> 3)) * 33 + 4 * (lane & 7); d[0] = v[i][0]; d[1] = v[i][1]; d[2] = v[i][2]; d[3] = v[i][3]; }
    asm volatile("s_waitcnt lgkmcnt(0)" ::: "memory");
    const int c = lane & 7;
#pragma unroll
    for (int j = 0; j < 4; ++j) { const int n = (lane >> 3) + 8 * j; const LAS float* s = scr + (8 * c) * 33 + n;
        u32x4 o; o.x = pk2(s[0 * 33], s[1 * 33]); o.y = pk2(s[2 * 33], s[3 * 33]); o.z = pk2(s[4 * 33], s[5 * 33]); o.w = pk2(s[6 * 33], s[7 * 33]);
        *(u32x4*)(it.WT + (size_t)(it.row0 + n) * it.Kdst + it.k0 + 8 * c) = o; }
    asm volatile("s_waitcnt lgkmcnt(0)" ::: "memory");
}
__device__ __forceinline__ void phase_prep(const Params& p, LAS unsigned char* lds, int tid, int lane, int wave) {
    unsigned char* ws = p.ws;
    {
        LAS float* sc = (LAS float*)lds;
        LAS float* part = (LAS float*)(lds + 32768);
        const float* c = p.in[1]; const float* w_ada = p.in[4]; const float* b_ada = p.in[5];
        {   f32x4 cv4[4];
#pragma unroll
            for (int j = 0; j < 4; ++j) cv4[j] = *(const f32x4*)(c + 4 * (tid + NTHREADS * j));
#pragma unroll
            for (int j = 0; j < 4; ++j) { f32x4 o4;
#pragma unroll
                for (int q = 0; q < 4; ++q) o4[q] = cv4[j][q] / (1.f + __expf(-cv4[j][q]));
                *(LAS f32x4*)(sc + 4 * (tid + NTHREADS * j)) = o4; }
        }
        __syncthreads();
        for (int cb = blockIdx.x; cb < 256; cb += gridDim.x) {
            const int half = lane >> 5, cl = lane & 31;
            float acc[8];
#pragma unroll
            for (int b = 0; b < 8; ++b) acc[b] = 0.f;
            if (cl < 24) {
#pragma unroll 4
                for (int it = 0; it < 64; ++it) { const int k = 128 * wave + 2 * it + half; const float wv = __builtin_nontemporal_load(w_ada + (size_t)k * 6144 + 24 * cb + cl);
#pragma unroll
                    for (int b = 0; b < 8; ++b) acc[b] += sc[b * 1024 + k] * wv; }
#pragma unroll
                for (int b = 0; b < 8; ++b) part[((wave * 2 + half) * 8 + b) * 24 + cl] = acc[b];
            }
            __syncthreads();
            if (tid < 192) { const int b = tid / 24, cc = tid % 24; float s = 0.f;
                for (int q = 0; q < 16; ++q) s += part[(q * 8 + b) * 24 + cc];
                ((float*)(ws + WS_MOD))[b * 6144 + 24 * cb + cc] = s + b_ada[24 * cb + cc]; }
            __syncthreads();
        }
    }
    {
        float* rope = (float*)(ws + WS_ROPE);
        for (int i = blockIdx.x * NTHREADS + tid; i < SEQ * 8; i += gridDim.x * NTHREADS) {
            const int pos = i >> 3, f = i & 7;
            const float inv = f == 0 ? 1.0f : f == 1 ? 0.1939227432f : f == 2 ? 0.03760603070f : f == 3 ? 0.007292664610f : f == 4 ? 0.001414213562f : f == 5 ? 0.0002742481884f : f == 6 ? 5.318295734e-05f : 1.031338525e-05f;
            const float ang = (float)pos * inv;
            const double TWO_PI = 6.283185307179586476925287;
            const double a = (double)ang, r = a - rint(a / TWO_PI) * TWO_PI, r2 = r * r;
            double s = 0.0, c = 0.0, ts = r, tc = 1.0;
#pragma unroll 1
            for (int n = 0; n < 14; ++n) { s += ts; c += tc; ts *= -r2 / (double)((2 * n + 2) * (2 * n + 3)); tc *= -r2 / (double)((2 * n + 1) * (2 * n + 2)); }
            rope[i * 2 + 0] = (float)c; rope[i * 2 + 1] = (float)s;
        }
        if (blockIdx.x == 0 && tid == 0) { const float* al = p.in[10]; float d01 = 0.f, d23 = 0.f;
            for (int j = 0; j < 64; ++j) { d01 += al[j] * al[64 + j]; d23 += al[128 + j] * al[192 + j]; }
            ((float*)(ws + WS_LAM))[0] = expf(d01) - expf(d23) + LAMBDA_INIT; }
    }
    __syncthreads();
    {
        LAS float* scr = (LAS float*)(lds + wave * 8704);
        const int gw = blockIdx.x * NWAVES + wave, NGW = gridDim.x * NWAVES;
        constexpr int I_IN = 16 * 88, I_OUT = 16 * 32, I_UV = 32, NITEMS = I_IN + I_OUT + I_UV;
        auto decode = [&](int r) -> P0Item {
            if (r < I_IN) return P0Item{p.in[6], NIN, 64 * (r / 88), 32 * (r % 88), (bf16_t*)(ws + WS_WINT), 32 * (r % 88), 1024};
            r -= I_IN;
            if (r < I_OUT) return P0Item{p.in[7], 1024, 64 * (r / 32), 32 * (r % 32), (bf16_t*)(ws + WS_WOUTT), 32 * (r % 32), 1024};
            r -= I_OUT;
            const int h = r >> 2, rr = r & 3; return P0Item{p.in[15] + h * 128 * 64, 64, 64 * (rr >> 1), 32 * (rr & 1), (bf16_t*)(ws + WS_WUVT) + h * 64 * 128, 32 * (rr & 1), 128};
        };
        for (int it = gw; it < NITEMS; it += NGW) { const P0Item a = decode(it); f32x4 va[8]; p0_load(a, va, lane); p0_finish(a, va, scr, lane); }
    }
}
constexpr int N_EXPERT_ITEMS = 32 * 3 * 512;
__device__ __forceinline__ bool conv_expert_issue(const Params& p, int lane, int wave, int& cur, P0Item& a, f32x4 (&va)[8]) {
    unsigned char* ws = p.ws;
    const int gw = blockIdx.x * NWAVES + wave, NGW = gridDim.x * NWAVES, r = gw + NGW * cur;
    if (r >= N_EXPERT_ITEMS) return false;
    ++cur;
    const int e = r / 1536, qq = r % 1536, mat = qq / 512, i2 = qq % 512, kb = i2 / 32, nb = i2 % 32, n0 = 32 * nb;
    a = (mat == 2) ? P0Item{p.in[22] + (size_t)e * 1048576, 1024, 64 * kb, n0, (bf16_t*)(ws + WS_WDT) + (size_t)e * 1048576, n0, 1024}
                   : P0Item{p.in[mat == 0 ? 18 : 20] + (size_t)e * 1048576, 1024, 64 * kb, n0, (bf16_t*)(ws + WS_WGUT) + (size_t)e * 2097152, 256 * (n0 >> 7) + (n0 & 127) + (mat == 1 ? 128 : 0), 1024};
    p0_load(a, va, lane);
    return true;
}
__device__ __forceinline__ void conv_expert_items(const Params& p, LAS unsigned char* lds, int lane, int wave, int& cur, int n) {
    unsigned char* ws = p.ws;
    LAS float* scr = (LAS float*)(lds + wave * 8704);
    const int gw = blockIdx.x * NWAVES + wave, NGW = gridDim.x * NWAVES;
    for (int q = 0; q < n; ++q) {
        const int r = gw + NGW * cur;
        if (r >= N_EXPERT_ITEMS) break;
        ++cur;
        const int e = r / 1536, qq = r % 1536, mat = qq / 512, i2 = qq % 512, kb = i2 / 32, nb = i2 % 32, n0 = 32 * nb;
        const P0Item a = (mat == 2) ? P0Item{p.in[22] + (size_t)e * 1048576, 1024, 64 * kb, n0, (bf16_t*)(ws + WS_WDT) + (size_t)e * 1048576, n0, 1024}
                                    : P0Item{p.in[mat == 0 ? 18 : 20] + (size_t)e * 1048576, 1024, 64 * kb, n0, (bf16_t*)(ws + WS_WGUT) + (size_t)e * 2097152, 256 * (n0 >> 7) + (n0 & 127) + (mat == 1 ? 128 : 0), 1024};
        f32x4 va[8]; p0_load(a, va, lane); p0_finish(a, va, scr, lane);
    }
}

__device__ __forceinline__ void phase_norm1(const Params& p, LAS unsigned char* lds, int tid, int lane, int wave) {
    unsigned char* ws = p.ws;
    const float* x = p.in[0]; const float* g = p.in[2]; const float* w_in = p.in[6]; const float* mod = (const float*)(ws + WS_MOD);
    bf16_t* H = (bf16_t*)(ws + WS_H); float* IW = (float*)(ws + WS_IW);
    LAS float* wiw = (LAS float*)lds;
    {   f32x4 wv4[4];
#pragma unroll
        for (int j = 0; j < 4; ++j) { const int q = tid + NTHREADS * j; wv4[j] = *(const f32x4*)(w_in + (size_t)(q >> 1) * NIN + C_IW + 4 * (q & 1)); }
#pragma unroll
        for (int j = 0; j < 4; ++j) { const int q = tid + NTHREADS * j; *(LAS f32x4*)(wiw + 4 * q) = wv4[j]; }
    }
    __syncthreads();
    const int gw = blockIdx.x * NWAVES + wave, NGW = gridDim.x * NWAVES;
    f32x4 gv[4];
#pragma unroll
    for (int j = 0; j < 4; ++j) gv[j] = *(const f32x4*)(g + 4 * (lane + 64 * j));
    f32x4 vn[4];
#pragma unroll
    for (int j = 0; j < 4; ++j) vn[j] = *(const f32x4*)(x + (size_t)(gw < NTOK ? gw : 0) * DM + 4 * (lane + 64 * j));
    for (int t = gw; t < NTOK; t += NGW) {
        const int b = t / SEQ; const float* sh = mod + b * 6144, * sc = sh + 1024;
        f32x4 v[4]; float ss = 0.f;
#pragma unroll
        for (int j = 0; j < 4; ++j) { v[j] = vn[j]; ss += (v[j].x * v[j].x + v[j].y * v[j].y) + (v[j].z * v[j].z + v[j].w * v[j].w); }
        if (t + NGW < NTOK) {
#pragma unroll
            for (int j = 0; j < 4; ++j) vn[j] = *(const f32x4*)(x + (size_t)(t + NGW) * DM + 4 * (lane + 64 * j)); }
        const float r = 1.0f / sqrtf(wave_sum(ss) * (1.f / DM) + RMS_EPS);
        float iw[8];
#pragma unroll
        for (int q = 0; q < 8; ++q) iw[q] = 0.f;
#pragma unroll
        for (int j = 0; j < 4; ++j) { const int k0 = 4 * (lane + 64 * j);
            const f32x4 s4 = *(const f32x4*)(sc + k0), h4 = *(const f32x4*)(sh + k0);
            f32x4 hv = (v[j] * r * gv[j]) * (s4 + 1.0f) + h4;
            *(uint2*)(H + (size_t)t * DM + k0) = make_uint2(pk2(hv.x, hv.y), pk2(hv.z, hv.w));
#pragma unroll
            for (int i = 0; i < 4; ++i) { const f32x4 w0 = *(const LAS f32x4*)(wiw + (k0 + i) * 8), w1 = *(const LAS f32x4*)(wiw + (k0 + i) * 8 + 4);
                iw[0] += hv[i] * w0.x; iw[1] += hv[i] * w0.y; iw[2] += hv[i] * w0.z; iw[3] += hv[i] * w0.w;
                iw[4] += hv[i] * w1.x; iw[5] += hv[i] * w1.y; iw[6] += hv[i] * w1.z; iw[7] += hv[i] * w1.w; } }
#pragma unroll
        for (int i = 0; i < 4; ++i) { const bool up = (lane & 32) != 0; const float snd = up ? iw[i] : iw[i + 4], kp = up ? iw[i + 4] : iw[i]; iw[i] = kp + __shfl_xor(snd, 32); }
#pragma unroll
        for (int i = 0; i < 2; ++i) { const bool up = (lane & 16) != 0; const float snd = up ? iw[i] : iw[i + 2], kp = up ? iw[i + 2] : iw[i]; iw[i] = kp + __shfl_xor(snd, 16); }
        { const bool up = (lane & 8) != 0; const float snd = up ? iw[0] : iw[1], kp = up ? iw[1] : iw[0]; iw[0] = kp + __shfl_xor(snd, 8); }
        { float r8 = iw[0]; r8 += __shfl_xor(r8, 4); r8 += __shfl_xor(r8, 2); r8 += __shfl_xor(r8, 1);
          if ((lane & 7) == 0) IW[(size_t)t * 8 + (lane >> 3)] = r8 * 0.04419417382415922f; }
    }
}


__device__ __forceinline__ void router_tail(float (&pe)[32], const float* rb, int lane, int t, int* topi, float* topg, LAS int* cnt) {
#pragma unroll
    for (int i = 0; i < 8; ++i) { const bool up = (lane & 16) != 0; const float snd = up ? pe[i] : pe[i + 8], kp = up ? pe[i + 8] : pe[i]; pe[i] = kp + __shfl_xor(snd, 16); }
#pragma unroll
    for (int i = 0; i < 4; ++i) { const bool up = (lane & 8) != 0; const float snd = up ? pe[i] : pe[i + 4], kp = up ? pe[i + 4] : pe[i]; pe[i] = kp + __shfl_xor(snd, 8); }
#pragma unroll
    for (int i = 0; i < 2; ++i) { const bool up = (lane & 4) != 0; const float snd = up ? pe[i] : pe[i + 2], kp = up ? pe[i + 2] : pe[i]; pe[i] = kp + __shfl_xor(snd, 4); }
    { const bool up = (lane & 2) != 0; const float snd = up ? pe[0] : pe[1], kp = up ? pe[1] : pe[0]; pe[0] = kp + __shfl_xor(snd, 2); }
    const int myE = lane >> 1;
    float lv = pe[0] + __shfl_xor(pe[0], 1) + rb[myE];
    int idx[4]; float val[4];
#pragma unroll
    for (int k = 0; k < 4; ++k) { float m = lv;
#pragma unroll
        for (int o = 1; o < 64; o <<= 1) m = fmaxf(m, __shfl_xor(m, o));
        const unsigned long long bm = __ballot(lv == m);
        const int e = __builtin_ctzll(bm) >> 1;
        idx[k] = e; val[k] = m; if (myE == e) lv = -INFINITY; }
    if (lane == 0) {
        float ex[4], sum = 0.f;
#pragma unroll
        for (int k = 0; k < 4; ++k) { ex[k] = __expf(val[k] - val[0]); sum += ex[k]; }
        const float inv = 1.f / sum;
        *(int4*)(topi + t * 4) = make_int4(idx[0], idx[1], idx[2], idx[3]);
        *(f32x4*)(topg + t * 4) = (f32x4){ex[0] * inv, ex[1] * inv, ex[2] * inv, ex[3] * inv};
#pragma unroll
        for (int k = 0; k < 4; ++k) atomicAdd((int*)&cnt[idx[k]], 1);
    }
}
__device__ __forceinline__ void phase_norm2(const Params& p, LAS unsigned char* lds, int tid, int lane, int wave) {
    unsigned char* ws = p.ws;
    const float* x1 = p.out; const float* g = p.in[3]; const float* rw = p.in[16]; const float* rb = p.in[17]; const float* mod = (const float*)(ws + WS_MOD);
    bf16_t* H = (bf16_t*)(ws + WS_H); int* topi = (int*)(ws + WS_TOPI); float* topg = (float*)(ws + WS_TOPG); int* chcnt = (int*)(ws + WS_CHCNT);
    LAS float* rwl = (LAS float*)lds;
    {
        f32x4 rv[16];
#pragma unroll
        for (int j = 0; j < 16; ++j) rv[j] = *(const f32x4*)(rw + 4 * (tid + NTHREADS * j));
#pragma unroll
        for (int j = 0; j < 16; ++j) { const int i = 4 * (tid + NTHREADS * j), k = i >> 5, e = i & 31;
            rwl[e * 1028 + k] = rv[j][0]; rwl[(e + 1) * 1028 + k] = rv[j][1]; rwl[(e + 2) * 1028 + k] = rv[j][2]; rwl[(e + 3) * 1028 + k] = rv[j][3]; }
    }
    LAS int* cnt = (LAS int*)(lds + 32 * 1028 * 4);
    __syncthreads();
    for (int ch = blockIdx.x; ch < NCHUNK; ch += gridDim.x) {
        if (tid < 32) cnt[tid] = 0;
        __syncthreads();
        f32x4 xa[4], xb[4];
#pragma unroll
        for (int j = 0; j < 4; ++j) { xa[j] = *(const f32x4*)(x1 + (size_t)(ch * CHTOK + wave * 16) * DM + 4 * (lane + 64 * j)); xb[j] = *(const f32x4*)(x1 + (size_t)(ch * CHTOK + wave * 16 + 1) * DM + 4 * (lane + 64 * j)); }
        for (int rr = 0; rr < 16; rr += 2) {
            const int t0r = ch * CHTOK + wave * 16 + rr, b = t0r / SEQ; const float* sh = mod + b * 6144 + 3 * 1024, * sc = sh + 1024;
            f32x4 hv0[4], hv1[4];
#define N2_ROW(HV, T_, XS) do { f32x4 v[4]; float ss = 0.f; \
                _Pragma("unroll") for (int j = 0; j < 4; ++j) { v[j] = XS[j]; ss += (v[j].x * v[j].x + v[j].y * v[j].y) + (v[j].z * v[j].z + v[j].w * v[j].w); } \
                const float r = 1.0f / sqrtf(wave_sum(ss) * (1.f / DM) + RMS_EPS); \
                _Pragma("unroll") for (int j = 0; j < 4; ++j) { const int k0 = 4 * (lane + 64 * j); \
                    const f32x4 s4 = *(const f32x4*)(sc + k0), h4 = *(const f32x4*)(sh + k0); \
                    HV[j] = (v[j] * r * *(const f32x4*)(g + k0)) * (s4 + 1.0f) + h4; \
                    *(uint2*)(H + (size_t)(T_) * DM + k0) = make_uint2(pk2(HV[j].x, HV[j].y), pk2(HV[j].z, HV[j].w)); } } while (0)
            N2_ROW(hv0, t0r, xa); N2_ROW(hv1, t0r + 1, xb);
#undef N2_ROW
            if (rr + 2 < 16) {
#pragma unroll
                for (int j = 0; j < 4; ++j) { xa[j] = *(const f32x4*)(x1 + (size_t)(t0r + 2) * DM + 4 * (lane + 64 * j)); xb[j] = *(const f32x4*)(x1 + (size_t)(t0r + 3) * DM + 4 * (lane + 64 * j)); } }
            float pe0[32], pe1[32];
#pragma unroll
            for (int i = 0; i < 16; ++i) { float a0 = 0.f, a1 = 0.f, b0 = 0.f, b1 = 0.f;
#pragma unroll
                for (int j = 0; j < 4; ++j) { const f32x4 wa = *(const LAS f32x4*)(rwl + i * 1028 + 4 * (lane + 64 * j)), wb = *(const LAS f32x4*)(rwl + (i + 16) * 1028 + 4 * (lane + 64 * j));
                    a0 += (hv0[j].x * wa.x + hv0[j].y * wa.y) + (hv0[j].z * wa.z + hv0[j].w * wa.w); a1 += (hv1[j].x * wa.x + hv1[j].y * wa.y) + (hv1[j].z * wa.z + hv1[j].w * wa.w);
                    b0 += (hv0[j].x * wb.x + hv0[j].y * wb.y) + (hv0[j].z * wb.z + hv0[j].w * wb.w); b1 += (hv1[j].x * wb.x + hv1[j].y * wb.y) + (hv1[j].z * wb.z + hv1[j].w * wb.w); }
                const bool up = (lane & 32) != 0;
                pe0[i] = (up ? b0 : a0) + __shfl_xor(up ? a0 : b0, 32); pe1[i] = (up ? b1 : a1) + __shfl_xor(up ? a1 : b1, 32);
                asm volatile("" ::: "memory"); }
            router_tail(pe0, rb, lane, t0r, topi, topg, cnt);
            router_tail(pe1, rb, lane, t0r + 1, topi, topg, cnt);
        }
        __syncthreads();
        if (tid < 32) chcnt[ch * 32 + tid] = cnt[tid];
        __syncthreads();
    }
}

__device__ __forceinline__ void phase_scatter(const Params& p, LAS unsigned char* lds, int tid, int lane, int wave) {
    unsigned char* ws = p.ws;
    const int* topi = (const int*)(ws + WS_TOPI); const int* chcnt = (const int*)(ws + WS_CHCNT);
    int* rowtok = (int*)(ws + WS_ROWTOK); int* rowsrc = (int*)(ws + WS_ROWSRC); int* tile_e = (int*)(ws + WS_TILEE); int2* rowmeta = (int2*)(ws + WS_ROWMETA); const float* topg = (const float*)(ws + WS_TOPG);
    LAS int* total = (LAS int*)lds; LAS int* before = total + 32; LAS int* padded = total + 64; LAS int* poff = total + 96; LAS int* ent = total + 160; LAS int* psum = total + 1024; LAS int* wcnt = total + 2048;
    for (int ch = blockIdx.x; ch < NCHUNK; ch += gridDim.x) {
        { const int e = tid & 31, part = tid >> 5; int tt = 0, bb = 0;
#pragma unroll 4
          for (int q = 0; q < 16; ++q) { const int c = part * 16 + q; const int v = chcnt[c * 32 + e]; tt += v; bb += (c < ch) ? v : 0; }
          psum[tid] = tt; psum[512 + tid] = bb; }
        { const int i = tid; ent[i] = topi[ch * CHTOK * 4 + i]; }
        __syncthreads();
        if (tid < 32) { int tt = 0, bb = 0;
#pragma unroll 1
            for (int q = 0; q < 16; ++q) { tt += psum[q * 32 + tid]; bb += psum[512 + q * 32 + tid]; }
            total[tid] = tt; before[tid] = bb; padded[tid] = (tt + 255) / 256 * 256; }
        __syncthreads();
        if (tid == 0) { int a = 0;
#pragma unroll 1
            for (int e = 0; e < 32; ++e) { poff[e] = a; a += padded[e]; } poff[32] = a; }
        __syncthreads();
        {
            const int myE = ent[tid]; int myRank = 0;
            const unsigned long long ltm = (1ull << lane) - 1ull;
#pragma unroll 1
            for (int e = 0; e < 32; ++e) { const unsigned long long mk = __ballot(myE == e);
                if (myE == e) myRank = __popcll(mk & ltm);
                if (lane == 0) wcnt[wave * 32 + e] = __popcll(mk); }
            __syncthreads();
            int pos = poff[myE] + before[myE] + myRank;
            for (int w2 = 0; w2 < wave; ++w2) pos += wcnt[w2 * 32 + myE];
            const int en = ch * CHTOK * 4 + tid; rowtok[pos] = en; rowsrc[pos] = en >> 2; rowmeta[pos] = make_int2(en, __float_as_int(topg[en]));
        }
        if (ch == 0) {
            for (int e = wave; e < 32; e += NWAVES) {
                const int p0 = poff[e], te = p0 + total[e], pe = p0 + padded[e];
                for (int r = te + lane; r < pe; r += 64) { rowtok[r] = -1; rowsrc[r] = 0; rowmeta[r] = make_int2(-1, 0); }
                for (int ti = p0 / 256 + lane; ti < pe / 256; ti += 64) tile_e[ti] = e; }
            if (tid == 0) tile_e[MAXTILES] = poff[32] / 256;
        }
        __syncthreads();
    }
}

__device__ __forceinline__ void phase_combine(const Params& p, int tid) {
    unsigned char* ws = p.ws; float* out = p.out; const bf16_t* Y = (const bf16_t*)(ws + WS_Y); const float* mod = (const float*)(ws + WS_MOD);
    const size_t nvec = (size_t)NTOK * DM / 8;
#pragma unroll 1
    for (size_t i = (size_t)blockIdx.x * NTHREADS + tid; i < nvec; i += (size_t)gridDim.x * NTHREADS) {
        const size_t o = i * 8; const int t = (int)(o / DM), n = (int)(o % DM), b = t / SEQ;
        const u32x4 a = __builtin_nontemporal_load((const u32x4*)(Y + o)), c = __builtin_nontemporal_load((const u32x4*)(Y + (size_t)NTOK * DM + o)), d = __builtin_nontemporal_load((const u32x4*)(Y + (size_t)2 * NTOK * DM + o));
        const float* g2 = mod + b * 6144 + 5 * 1024 + n;
        f32x4 o0 = *(const f32x4*)(out + o), o1 = *(const f32x4*)(out + o + 4);
        const f32x4 g0 = *(const f32x4*)g2, g1 = *(const f32x4*)(g2 + 4);
#define LO(u) __uint_as_float((u) << 16)
#define HI(u) __uint_as_float((u) & 0xffff0000u)
        o0.x += g0.x * (LO(a.x) + LO(c.x) + LO(d.x)); o0.y += g0.y * (HI(a.x) + HI(c.x) + HI(d.x));
        o0.z += g0.z * (LO(a.y) + LO(c.y) + LO(d.y)); o0.w += g0.w * (HI(a.y) + HI(c.y) + HI(d.y));
        o1.x += g1.x * (LO(a.z) + LO(c.z) + LO(d.z)); o1.y += g1.y * (HI(a.z) + HI(c.z) + HI(d.z));
        o1.z += g1.z * (LO(a.w) + LO(c.w) + LO(d.w)); o1.w += g1.w * (HI(a.w) + HI(c.w) + HI(d.w));
#undef LO
#undef HI
        *(f32x4*)(out + o) = o0; *(f32x4*)(out + o + 4) = o1;
    }
}

namespace da {
typedef float f32x16 __attribute__((ext_vector_type(16)));
typedef short s16x4 __attribute__((ext_vector_type(4)));
constexpr int KPL = 1040;
constexpr int KT_BYTES = 8 * KPL;
constexpr int VRS = 320;
constexpr int VT_BYTES = 64 * VRS;
constexpr int BUF_BYTES = 2 * KT_BYTES + VT_BYTES;
constexpr int OB_STRIDE = 132;
constexpr int WSF_OFF = 139264;
constexpr float C2 = 0.125f * 1.4426950408889634f;
__device__ __forceinline__ int crow(int r, int hi) { return (r & 3) + 8 * (r >> 2) + 4 * hi; }
__device__ __forceinline__ s16x4 vtr(const LAS unsigned char* p) { return __builtin_bit_cast(s16x4, __builtin_amdgcn_ds_read_tr16_b64_v4i16((LAS s16x4*)p)); }

__device__ __forceinline__ void phase(const Params& p, LAS unsigned char* lds, int tid, int lane, int wave, int& cvcur) {
    unsigned char* ws = p.ws; const bf16_t* PROJ = (const bf16_t*)(ws + WS_PROJ); bf16_t* H = (bf16_t*)(ws + WS_H);
    const float lam = ((const float*)(ws + WS_LAM))[0]; const float* sub_g = p.in[11];
    const int wsel = wave >> 2, wq = wave & 3, r32 = lane & 31, hi = lane >> 5;
    LAS float* wsf = (LAS float*)(lds + WSF_OFF) + wave * 64;
    const int G = gridDim.x, vcu = (G % 8 == 0) ? ((int)blockIdx.x % 8) * (G / 8) + (int)blockIdx.x / 8 : (int)blockIdx.x;
    for (int id = vcu; id < 1024; id += G) {
        const int bh = (id >> 3) & 31, s = id & 7, ii = id >> 8;
        const int qb = (ii == 0) ? s : (ii == 1) ? 15 - s : (ii == 2) ? 16 + s : 31 - s;
        const int b = bh >> 2, h = bh & 3, q0 = qb * 128, NT = 2 * qb + 2, ntw = 2 * qb + 1 + (wq >> 1);
        const bf16_t* base = PROJ + (size_t)b * SEQ * NPJ;
        bf16x8 qr[4];
        { const bf16_t* Qrow = base + (size_t)(q0 + 32 * wq + r32) * NPJ + (wsel ? C_AQ2 : C_AQ1) + h * 64;
#pragma unroll
          for (int d0 = 0; d0 < 4; ++d0) qr[d0] = *(const bf16x8*)(Qrow + 16 * d0 + 8 * hi); }
        float m = -INFINITY, l = 0.f;
        f32x16 o[4];
#pragma unroll
        for (int d0 = 0; d0 < 4; ++d0)
#pragma unroll
            for (int r = 0; r < 16; ++r) o[d0][r] = 0.f;
        const int skey = tid >> 3, sc = tid & 7, vkey = tid >> 4, vch = tid & 15;
        const bf16_t* srcK1 = base + (size_t)skey * NPJ + C_AK1 + h * 64 + 8 * sc;
        const bf16_t* srcK2 = base + (size_t)skey * NPJ + C_AK2 + h * 64 + 8 * sc;
        const bf16_t* srcV = base + (size_t)vkey * NPJ + C_AV + h * 128 + 8 * vch;
        const int dK = sc * KPL + skey * 16, dV = vkey * VRS + vch * 16;
        u32x4 st0, st1, st2, st3;
#define DA_LOAD(kt) do { const size_t ro = (size_t)(kt) * 64 * NPJ; st0 = *(const u32x4*)(srcK1 + ro); st1 = *(const u32x4*)(srcK2 + ro); \
        st2 = *(const u32x4*)(srcV + ro); st3 = *(const u32x4*)(srcV + ro + (size_t)32 * NPJ); } while (0)
#define DA_WRITE(bufi) do { LAS unsigned char* bb = lds + (bufi) * BUF_BYTES; *(LAS u32x4*)(bb + dK) = st0; *(LAS u32x4*)(bb + KT_BYTES + dK) = st1; \
        *(LAS u32x4*)(bb + 2 * KT_BYTES + dV) = st2; *(LAS u32x4*)(bb + 2 * KT_BYTES + dV + 32 * VRS) = st3; } while (0)
        DA_LOAD(0); DA_WRITE(0);
        __syncthreads();
        for (int kt = 0; kt < NT; ++kt) {
            if (kt + 1 < NT) DA_LOAD(kt + 1);
            if (kt < ntw) {
                const LAS unsigned char* bb = lds + (kt & 1) * BUF_BYTES;
                const LAS unsigned char* Kb = bb + wsel * KT_BYTES;
                const LAS unsigned char* Vb = bb + 2 * KT_BYTES;
                f32x16 p0, p1;
#pragma unroll
                for (int r = 0; r < 16; ++r) { p0[r] = 0.f; p1[r] = 0.f; }
#pragma unroll
                for (int d0 = 0; d0 < 4; ++d0) {
                    const bf16x8 a0 = *(const LAS bf16x8*)(Kb + (2 * d0 + hi) * KPL + r32 * 16);
                    const bf16x8 a1 = *(const LAS bf16x8*)(Kb + (2 * d0 + hi) * KPL + (r32 + 32) * 16);
                    p0 = __builtin_amdgcn_mfma_f32_32x32x16_bf16(a0, qr[d0], p0, 0, 0, 0);
                    p1 = __builtin_amdgcn_mfma_f32_32x32x16_bf16(a1, qr[d0], p1, 0, 0, 0);
                }
                float mxa = fmaxf(p0[0], p1[0]), mxb = fmaxf(p0[1], p1[1]), mxc = fmaxf(p0[2], p1[2]), mxd = fmaxf(p0[3], p1[3]);
#pragma unroll
                for (int r = 4; r < 16; r += 4) { mxa = fmaxf(mxa, fmaxf(p0[r], p1[r])); mxb = fmaxf(mxb, fmaxf(p0[r + 1], p1[r + 1])); mxc = fmaxf(mxc, fmaxf(p0[r + 2], p1[r + 2])); mxd = fmaxf(mxd, fmaxf(p0[r + 3], p1[r + 3])); }
                float mx = fmaxf(fmaxf(mxa, mxb), fmaxf(mxc, mxd));
                mx = fmaxf(mx, __shfl_xor(mx, 32)) * C2;
                if (__any(mx - m > 8.0f)) {
                    const float mnew = fmaxf(m, mx);
                    const float f = __builtin_amdgcn_exp2f(m - mnew);
                    l *= f; m = mnew;
                    if (hi == 0) wsf[r32] = f;
                    asm volatile("s_waitcnt lgkmcnt(0)" ::: "memory");
#pragma unroll
                    for (int r = 0; r < 16; ++r) { const float fr = wsf[crow(r, hi)];
#pragma unroll
                        for (int d0 = 0; d0 < 4; ++d0) o[d0][r] *= fr; }
                }
                float lsa = 0.f, lsb = 0.f, lsc = 0.f, lsd = 0.f;
#pragma unroll
                for (int r = 0; r < 16; r += 4) {
                    p0[r] = __builtin_amdgcn_exp2f(p0[r] * C2 - m); p1[r] = __builtin_amdgcn_exp2f(p1[r] * C2 - m); lsa += p0[r] + p1[r];
                    p0[r + 1] = __builtin_amdgcn_exp2f(p0[r + 1] * C2 - m); p1[r + 1] = __builtin_amdgcn_exp2f(p1[r + 1] * C2 - m); lsb += p0[r + 1] + p1[r + 1];
                    p0[r + 2] = __builtin_amdgcn_exp2f(p0[r + 2] * C2 - m); p1[r + 2] = __builtin_amdgcn_exp2f(p1[r + 2] * C2 - m); lsc += p0[r + 2] + p1[r + 2];
                    p0[r + 3] = __builtin_amdgcn_exp2f(p0[r + 3] * C2 - m); p1[r + 3] = __builtin_amdgcn_exp2f(p1[r + 3] * C2 - m); lsd += p0[r + 3] + p1[r + 3]; }
                l += (lsa + lsb) + (lsc + lsd);
                bf16x8 pa[4];
#pragma unroll
                for (int ks = 0; ks < 2; ++ks) {
                    u32x4 w0, w1;
                    w0.x = gp::cvt_pk_bf16(p0[8 * ks + 0], p0[8 * ks + 1]); w0.y = gp::cvt_pk_bf16(p0[8 * ks + 2], p0[8 * ks + 3]);
                    w0.z = gp::cvt_pk_bf16(p0[8 * ks + 4], p0[8 * ks + 5]); w0.w = gp::cvt_pk_bf16(p0[8 * ks + 6], p0[8 * ks + 7]);
                    w1.x = gp::cvt_pk_bf16(p1[8 * ks + 0], p1[8 * ks + 1]); w1.y = gp::cvt_pk_bf16(p1[8 * ks + 2], p1[8 * ks + 3]);
                    w1.z = gp::cvt_pk_bf16(p1[8 * ks + 4], p1[8 * ks + 5]); w1.w = gp::cvt_pk_bf16(p1[8 * ks + 6], p1[8 * ks + 7]);
                    pa[ks] = __builtin_bit_cast(bf16x8, w0); pa[2 + ks] = __builtin_bit_cast(bf16x8, w1);
                }
                const LAS unsigned char* vp = Vb + (4 * hi + ((lane & 15) >> 2)) * VRS + (16 * ((lane >> 4) & 1) + 4 * (lane & 3)) * 2;
#pragma unroll
                for (int d0 = 0; d0 < 4; ++d0)
#pragma unroll
                    for (int ks = 0; ks < 4; ++ks) {
                        const s16x4 lo = vtr(vp + (16 * ks) * VRS + d0 * 64), hv = vtr(vp + (16 * ks + 8) * VRS + d0 * 64);
                        const bf16x8 vf = (bf16x8){lo[0], lo[1], lo[2], lo[3], hv[0], hv[1], hv[2], hv[3]};
                        o[d0] = __builtin_amdgcn_mfma_f32_32x32x16_bf16(pa[ks], vf, o[d0], 0, 0, 0);
                        if (ks == 3) __builtin_amdgcn_sched_barrier(0);
                    }
            }
            if (kt + 1 < NT) DA_WRITE((kt + 1) & 1);
            __syncthreads();
        }
#undef DA_LOAD
#undef DA_WRITE
        l += __shfl_xor(l, 32);
        { const float fac = (wsel ? lam : 1.0f) / l;
          if (hi == 0) wsf[r32] = fac;
          asm volatile("s_waitcnt lgkmcnt(0)" ::: "memory"); }
        LAS float* Ob = (LAS float*)lds + wsel * (128 * OB_STRIDE);
#pragma unroll
        for (int r = 0; r < 16; ++r) { const float fr = wsf[crow(r, hi)]; const int row = 32 * wq + crow(r, hi);
#pragma unroll
            for (int d0 = 0; d0 < 4; ++d0) Ob[row * OB_STRIDE + 32 * d0 + r32] = o[d0][r] * fr; }
        __syncthreads();
        { const LAS float* O1 = (const LAS float*)lds; const LAS float* O2 = O1 + 128 * OB_STRIDE;
          const float g0 = sub_g[2 * lane], g1 = sub_g[2 * lane + 1];
          for (int rr = 0; rr < 16; ++rr) { const int row = 16 * wave + rr;
              const float d0v = O1[row * OB_STRIDE + 2 * lane] - O2[row * OB_STRIDE + 2 * lane], d1v = O1[row * OB_STRIDE + 2 * lane + 1] - O2[row * OB_STRIDE + 2 * lane + 1];
              const float ss = wave_sum(d0v * d0v + d1v * d1v);
              const float rs = (1.0f - LAMBDA_INIT) / sqrtf(ss * (1.f / 128.f) + RMS_EPS);
              *(unsigned*)(H + (size_t)(b * SEQ + q0 + row) * DM + h * 128 + 2 * lane) = pk2(d0v * rs * g0, d1v * rs * g1); } }
        __syncthreads();

    }
}
}
namespace ds {
typedef float f32x16 __attribute__((ext_vector_type(16)));
typedef short s16x4 __attribute__((ext_vector_type(4)));
typedef int i32x4 __attribute__((ext_vector_type(4)));
typedef unsigned u32x2 __attribute__((ext_vector_type(2)));
constexpr int HIST_OFF = 131072, SEL_OFF = 139264, OALL_OFF = 143360;
constexpr float C2 = 0.125f * 1.4426950408889634f;
__device__ __forceinline__ s16x4 vtr(const LAS unsigned char* p) { return __builtin_bit_cast(s16x4, __builtin_amdgcn_ds_read_tr16_b64_v4i16((LAS s16x4*)p)); }
__device__ __forceinline__ unsigned skey(float f) { unsigned u = __float_as_uint(f); if (u == 0x80000000u) u = 0u; return u ^ ((unsigned)((int)u >> 31) | 0x80000000u); }

template <int STOP> __device__ __forceinline__ void unit(const Params& p, LAS unsigned char* lds, int tid, int lane_in, int wave, int b, int qt, int& cvcur) {
    int lane = lane_in; asm volatile("" : "+v"(lane));
    unsigned char* ws = p.ws; const bf16_t* PROJ = (const bf16_t*)(ws + WS_PROJ); bf16_t* H = (bf16_t*)(ws + WS_H);
    const float* IW = (const float*)(ws + WS_IW);
    const int q0 = qt * 8, N = (q0 / 64 + 1) * 64, t0 = b * SEQ + q0;
    const bf16_t* base = PROJ + (size_t)b * SEQ * NPJ;
    LAS float* S = (LAS float*)lds;
    const int r32 = lane & 31, hi = lane >> 5;
    {
        bf16x8 aq[2][4]; f32x4 wv[2][4];
#pragma unroll
        for (int rb = 0; rb < 2; ++rb) {
            const bf16_t* qrow = base + (size_t)(q0 + 4 * rb + 2 * ((r32 >> 2) & 1) + (r32 >> 4)) * NPJ + C_IQ + (4 * ((r32 >> 3) & 1) + (r32 & 3)) * 64 + 8 * hi;
#pragma unroll
            for (int d0 = 0; d0 < 4; ++d0) aq[rb][d0] = *(const bf16x8*)(qrow + 16 * d0);
#pragma unroll
            for (int qq = 0; qq < 4; ++qq) wv[rb][qq] = *(const f32x4*)(IW + (size_t)(t0 + 4 * rb + 2 * hi + (qq >> 1)) * 8 + 4 * (qq & 1));
        }
        const int ntk = N / 32;
        bf16x8 bk[4], bkn[4];
        const unsigned char* ikf = ws + WS_IKF + (size_t)b * 128 * 4096 + lane * 16;
        { const unsigned char* kp = ikf + (size_t)(wave < ntk ? wave : 0) * 4096;
#pragma unroll
          for (int d0 = 0; d0 < 4; ++d0) bkn[d0] = *(const bf16x8*)(kp + d0 * 1024); }
        for (int kt = wave; kt < ntk; kt += NWAVES) {
#pragma unroll
            for (int d0 = 0; d0 < 4; ++d0) bk[d0] = bkn[d0];
            if (kt + NWAVES < ntk) { const unsigned char* kp = ikf + (size_t)(kt + NWAVES) * 4096;
#pragma unroll
                for (int d0 = 0; d0 < 4; ++d0) bkn[d0] = *(const bf16x8*)(kp + d0 * 1024); }
#pragma unroll
            for (int rb = 0; rb < 2; ++rb) {
                f32x16 acc;
#pragma unroll
                for (int r = 0; r < 16; ++r) acc[r] = 0.f;
#pragma unroll
                for (int d0 = 0; d0 < 4; ++d0) acc = __builtin_amdgcn_mfma_f32_32x32x16_bf16(aq[rb][d0], bk[d0], acc, 0, 0, 0);
                float v0 = 0.f, v1 = 0.f;
#pragma unroll
                for (int i = 0; i < 4; ++i) { v0 += wv[rb][0][i] * fmaxf(acc[i], 0.f) + wv[rb][1][i] * fmaxf(acc[4 + i], 0.f);
                                               v1 += wv[rb][2][i] * fmaxf(acc[8 + i], 0.f) + wv[rb][3][i] * fmaxf(acc[12 + i], 0.f); }
                S[(4 * rb + 2 * hi) * 4096 + 32 * kt + r32] = v0;
                S[(4 * rb + 2 * hi + 1) * 4096 + 32 * kt + r32] = v1;
            }
        }
    }
    __syncthreads();
    if (STOP == 1) return;
    asm volatile("" : "+v"(lane));
    LAS float* Sw = S + wave * 4096;
    LAS unsigned short* sel = (LAS unsigned short*)(lds + SEL_OFF) + wave * 256;
    const int nsel = N < 256 ? N : 256;
    if (N <= 256) {
        for (int i = lane; i < N; i += 64) sel[i] = (unsigned short)i;
    } else {
        LAS unsigned* hist = (LAS unsigned*)(lds + OALL_OFF) + wave * 512;
        LAS float* cv = (LAS float*)(lds + HIST_OFF) + wave * 256; LAS int* ci = (LAS int*)cv + 128;
        const unsigned long long ltmask = (1ull << lane) - 1ull;
        const int nit = (N + 255) / 256;
        float t0 = -INFINITY, t1 = -INFINITY, t2 = -INFINITY, t3 = -INFINITY;
#pragma unroll 4
        for (int it = 0; it < nit; ++it) { if (256 * it + 4 * lane < N) { const f32x4 v4 = *(const LAS f32x4*)(Sw + 256 * it + 4 * lane);
#pragma unroll
            for (int q = 0; q < 4; ++q) { const float v = v4[q];
                const float n3 = fmaxf(t3, fminf(t2, v)), n2 = fmaxf(t2, fminf(t1, v)), n1 = fmaxf(t1, fminf(t0, v)); t0 = fmaxf(t0, v); t1 = n1; t2 = n2; t3 = n3; } } }
        float mn = t3, mx = t0;
#pragma unroll
        for (int o = 1; o < 64; o <<= 1) { mn = fminf(mn, __shfl_xor(mn, o)); mx = fmaxf(mx, __shfl_xor(mx, o)); }
        bool done = false;
        if (mx > mn) {
            const float scale = 1024.0f / (mx - mn);
            *(LAS u32x4*)(hist + 8 * lane) = (u32x4){0u, 0u, 0u, 0u}; *(LAS u32x4*)(hist + 8 * lane + 4) = (u32x4){0u, 0u, 0u, 0u};
            asm volatile("s_waitcnt lgkmcnt(0)" ::: "memory");
#pragma unroll 4
            for (int it = 0; it < nit; ++it) { if (256 * it + 4 * lane < N) { const f32x4 v4 = *(const LAS f32x4*)(Sw + 256 * it + 4 * lane);
#pragma unroll
                for (int q = 0; q < 4; ++q) { if (v4[q] >= mn) { int bn = (int)((v4[q] - mn) * scale); bn = bn > 1023 ? 1023 : bn;
                    __hip_atomic_fetch_add(hist + (bn >> 1), 1u << (16 * (bn & 1)), __ATOMIC_RELAXED, __HIP_MEMORY_SCOPE_WORKGROUP); } } } }
            asm volatile("s_waitcnt lgkmcnt(0)" ::: "memory");
            unsigned wq[8];
            { const u32x4 h0 = *(LAS u32x4*)(hist + 8 * lane), h1 = *(LAS u32x4*)(hist + 8 * lane + 4);
              wq[0] = h0.x; wq[1] = h0.y; wq[2] = h0.z; wq[3] = h0.w; wq[4] = h1.x; wq[5] = h1.y; wq[6] = h1.z; wq[7] = h1.w; }
            int sl = 0;
#pragma unroll
            for (int q = 0; q < 8; ++q) sl += (int)(wq[q] & 0xffffu) + (int)(wq[q] >> 16);
            int v = sl;
#pragma unroll
            for (int o = 1; o < 64; o <<= 1) { const int t = __shfl_down(v, o); v += (lane + o < 64) ? t : 0; }
            int ab = v - sl, myB = -1, myAbove = 0, myCnt = 0;
#pragma unroll
            for (int q = 15; q >= 0; --q) { const int cq = (int)((wq[q >> 1] >> (16 * (q & 1))) & 0xffffu);
                if (myB < 0 && ab < 256 && 256 <= ab + cq) { myB = 16 * lane + q; myAbove = ab; myCnt = cq; }
                ab += cq; }
            const unsigned long long bal = __ballot(myB >= 0);
            const int src = __builtin_ctzll(bal);
            const int B = __shfl(myB, src), C = __shfl(myCnt, src), need = 256 - __shfl(myAbove, src);
            if (C <= 128) {
                int outpos = 0, cp = 0;
#pragma unroll 2
                for (int it = 0; it < nit; ++it) { const bool inr = 256 * it + 4 * lane < N; const f32x4 v4 = *(const LAS f32x4*)(Sw + 256 * it + 4 * (inr ? lane : 0));
#pragma unroll
                    for (int q = 0; q < 4; ++q) { int bn = (int)((v4[q] - mn) * scale); bn = bn > 1023 ? 1023 : bn;
                        const bool inb = inr && v4[q] >= mn, take = inb && bn > B, cd = inb && bn == B; const int idx = 256 * it + 4 * lane + q;
                        const unsigned long long bt = __ballot(take), bc = __ballot(cd);
                        if (take) sel[outpos + __popcll(bt & ltmask)] = (unsigned short)idx;
                        if (cd) { const int pos = cp + __popcll(bc & ltmask); cv[pos] = v4[q]; ci[pos] = idx; }
                        outpos += __popcll(bt); cp += __popcll(bc); } }
                asm volatile("s_waitcnt lgkmcnt(0)" ::: "memory");
                const float v0 = lane < C ? cv[lane] : -INFINITY, v1 = lane + 64 < C ? cv[lane + 64] : -INFINITY;
                const int i0 = lane < C ? ci[lane] : 0x7fffffff, i1 = lane + 64 < C ? ci[lane + 64] : 0x7fffffff;
                int r0 = 0, r1 = 0;
                for (int q = 0; q < C; ++q) { const float ov = cv[q]; const int oi = ci[q];
                    r0 += (ov > v0 || (ov == v0 && oi < i0)) ? 1 : 0; r1 += (ov > v1 || (ov == v1 && oi < i1)) ? 1 : 0; }
                const bool t0 = lane < C && r0 < need, t1 = lane + 64 < C && r1 < need;
                const unsigned long long b0 = __ballot(t0);
                if (t0) sel[outpos + __popcll(b0 & ltmask)] = (unsigned short)i0;
                outpos += __popcll(b0);
                const unsigned long long b1 = __ballot(t1);
                if (t1) sel[outpos + __popcll(b1 & ltmask)] = (unsigned short)i1;
                done = true;
            }
        }
        if (!done) {
            {
                LAS int* h8 = (LAS int*)hist;
                unsigned prefix = 0u; int need8 = 256;
#pragma unroll 1
                for (int pass = 0; pass < 4; ++pass) {
                    const int shift = 24 - 8 * pass;
                    *(LAS i32x4*)(h8 + 4 * lane) = (i32x4){0, 0, 0, 0};
                    asm volatile("s_waitcnt lgkmcnt(0)" ::: "memory");
                    for (int j = 0; j < N / 64; ++j) { const unsigned u = skey(Sw[64 * j + lane]);
                        if (pass == 0 || (u >> (shift + 8)) == prefix) __hip_atomic_fetch_add((int*)(h8 + ((u >> shift) & 255u)), 1, __ATOMIC_RELAXED, __HIP_MEMORY_SCOPE_WORKGROUP); }
                    asm volatile("s_waitcnt lgkmcnt(0)" ::: "memory");
                    const i32x4 c = *(LAS i32x4*)(h8 + 4 * lane);
                    const int s4 = c.x + c.y + c.z + c.w; int vv = s4;
#pragma unroll
                    for (int o = 1; o < 64; o <<= 1) { const int t = __shfl_down(vv, o); vv += (lane + o < 64) ? t : 0; }
                    const int a3 = vv - s4, a2 = a3 + c.w, a1 = a2 + c.z, a0 = a1 + c.y;
                    int mB = -1, mA = 0;
                    if (a3 < need8 && need8 <= a3 + c.w) { mB = 4 * lane + 3; mA = a3; }
                    else if (a2 < need8 && need8 <= a2 + c.z) { mB = 4 * lane + 2; mA = a2; }
                    else if (a1 < need8 && need8 <= a1 + c.y) { mB = 4 * lane + 1; mA = a1; }
                    else if (a0 < need8 && need8 <= a0 + c.x) { mB = 4 * lane; mA = a0; }
                    const int sr = __builtin_ctzll(__ballot(mB >= 0));
                    need8 -= __shfl(mA, sr); prefix = (prefix << 8) | (unsigned)__shfl(mB, sr);
                }
                int outpos = 0, eqtaken = 0;
                for (int j = 0; j < N / 64; ++j) { const unsigned u = skey(Sw[64 * j + lane]);
                    const bool eq = (u == prefix); const unsigned long long beq = __ballot(eq);
                    const bool take = (u > prefix) || (eq && (eqtaken + __popcll(beq & ltmask) < need8));
                    const unsigned long long bt = __ballot(take);
                    if (take) sel[outpos + __popcll(bt & ltmask)] = (unsigned short)(64 * j + lane);
                    outpos += __popcll(bt); eqtaken += __popcll(beq); }
            }
        }
    }
    asm volatile("s_waitcnt lgkmcnt(0)" ::: "memory");
    if (STOP == 2) { __syncthreads(); return; }
    asm volatile("" : "+v"(lane));
    {
        const int n16 = lane & 15, g = lane >> 4, t = t0 + wave;
        bf16x8 bqf[2];
#pragma unroll
        for (int ks = 0; ks < 2; ++ks) { bqf[ks] = (bf16x8){0, 0, 0, 0, 0, 0, 0, 0};
            if (n16 < 8) bqf[ks] = *(const bf16x8*)(PROJ + (size_t)t * NPJ + C_BQ + n16 * 64 + 32 * ks + 8 * g); }
        const int nstep = nsel / 32;
        LAS unsigned char* Lb = (LAS unsigned char*)Sw;
        f32x4 ot[8];
#pragma unroll
        for (int cb = 0; cb < 8; ++cb) ot[cb] = (f32x4){0.f, 0.f, 0.f, 0.f};
        float mrun = -INFINITY, lsum = 0.f;
        bf16x8 kA[4], kB[4]; u32x4 stA[8], stB[8];
#define DS_LOADCH(KF, ST, s_) do { \
            { const bf16_t* kr = base + (size_t)sel[32 * (s_) + n16] * NPJ + C_BK + 8 * g; KF[0] = *(const bf16x8*)kr; KF[1] = *(const bf16x8*)(kr + 32); } \
            { const bf16_t* kr = base + (size_t)sel[32 * (s_) + 16 + n16] * NPJ + C_BK + 8 * g; KF[2] = *(const bf16x8*)kr; KF[3] = *(const bf16x8*)(kr + 32); } \
            _Pragma("unroll") for (int i = 0; i < 8; ++i) ST[i] = *(const u32x4*)(base + (size_t)sel[32 * (s_) + 4 * i + g] * NPJ + C_BLAT + 8 * n16); } while (0)
#define DS_PROC(KF, ST) do { \
            f32x4 a0 = (f32x4){0.f, 0.f, 0.f, 0.f}, a1 = (f32x4){0.f, 0.f, 0.f, 0.f}; \
            a0 = __builtin_amdgcn_mfma_f32_16x16x32_bf16(KF[0], bqf[0], a0, 0, 0, 0); a0 = __builtin_amdgcn_mfma_f32_16x16x32_bf16(KF[1], bqf[1], a0, 0, 0, 0); \
            a1 = __builtin_amdgcn_mfma_f32_16x16x32_bf16(KF[2], bqf[0], a1, 0, 0, 0); a1 = __builtin_amdgcn_mfma_f32_16x16x32_bf16(KF[3], bqf[1], a1, 0, 0, 0); \
            float cm = fmaxf(fmaxf(fmaxf(a0[0], a0[1]), fmaxf(a0[2], a0[3])), fmaxf(fmaxf(a1[0], a1[1]), fmaxf(a1[2], a1[3]))); \
            cm = fmaxf(cm, __shfl_xor(cm, 16)); cm = fmaxf(cm, __shfl_xor(cm, 32)); cm *= C2; \
            if (__any(cm - mrun > 8.0f)) { const float mnew = fmaxf(mrun, cm); const float f = __builtin_amdgcn_exp2f(mrun - mnew); lsum *= f; mrun = mnew; \
                _Pragma("unroll") for (int cb = 0; cb < 8; ++cb) ot[cb] = ot[cb] * f; } \
            float e[8]; \
            _Pragma("unroll") for (int i = 0; i < 4; ++i) { e[i] = __builtin_amdgcn_exp2f(a0[i] * C2 - mrun); e[4 + i] = __builtin_amdgcn_exp2f(a1[i] * C2 - mrun); } \
            lsum += ((e[0] + e[1]) + (e[2] + e[3])) + ((e[4] + e[5]) + (e[6] + e[7])); \
            u32x4 pw; pw.x = gp::cvt_pk_bf16(e[0], e[1]); pw.y = gp::cvt_pk_bf16(e[2], e[3]); pw.z = gp::cvt_pk_bf16(e[4], e[5]); pw.w = gp::cvt_pk_bf16(e[6], e[7]); \
            const bf16x8 pbv = __builtin_bit_cast(bf16x8, pw); \
            _Pragma("unroll") for (int i = 0; i < 8; ++i) { const int sig = 4 * i + g, ch = n16; \
                *(LAS u32x4*)(Lb + sig * 256 + (((ch >> 1) ^ (sig & 7)) * 32) + (ch & 1) * 16) = ST[i]; } \
            asm volatile("s_waitcnt lgkmcnt(0)" ::: "memory"); \
            const int rq = 4 * g + (n16 >> 2); \
            _Pragma("unroll") for (int cb = 0; cb < 8; ++cb) { \
                const s16x4 lo = vtr(Lb + rq * 256 + ((cb ^ (rq & 7)) * 32) + 8 * (lane & 3)); \
                const s16x4 hv = vtr(Lb + (16 + rq) * 256 + ((cb ^ (rq & 7)) * 32) + 8 * (lane & 3)); \
                const bf16x8 af = (bf16x8){lo[0], lo[1], lo[2], lo[3], hv[0], hv[1], hv[2], hv[3]}; \
                ot[cb] = __builtin_amdgcn_mfma_f32_16x16x32_bf16(af, pbv, ot[cb], 0, 0, 0); } \
            asm volatile("s_waitcnt lgkmcnt(0)" ::: "memory"); } while (0)
        DS_LOADCH(kA, stA, 0);
#pragma unroll 1
        for (int s = 0; s < nstep; s += 2) {
            DS_LOADCH(kB, stB, s + 1);
            DS_PROC(kA, stA);
            if (s + 2 < nstep) DS_LOADCH(kA, stA, s + 2);
            DS_PROC(kB, stB);
        }
#undef DS_LOADCH
#undef DS_PROC
        lsum += __shfl_xor(lsum, 16); lsum += __shfl_xor(lsum, 32);
        const float linv = 1.0f / lsum;
        if (n16 < 8) {
            LAS bf16_t* Oall = (LAS bf16_t*)(lds + OALL_OFF) + (wave * 8 + n16) * 128;
#pragma unroll
            for (int cb = 0; cb < 8; ++cb) *(LAS u32x2*)(Oall + 16 * cb + 4 * g) = (u32x2){pk2(ot[cb][0] * linv, ot[cb][1] * linv), pk2(ot[cb][2] * linv, ot[cb][3] * linv)};
        }
    }
    __syncthreads();
    if (STOP == 3) return;
    asm volatile("" : "+v"(lane));
    P0Item cvi, cvj; f32x4 cva[8], cvb[8];
    const bool cvok = conv_expert_issue(p, lane, wave, cvcur, cvi, cva);
    const bool cvok2 = conv_expert_issue(p, lane, wave, cvcur, cvj, cvb);
    {
        const int n16 = lane & 15, g = lane >> 4, hh = wave;
        const bf16_t* WuvT = (const bf16_t*)(ws + WS_WUVT) + hh * 64 * 128;
        const LAS bf16_t* Oall = (const LAS bf16_t*)(lds + OALL_OFF) + ((n16 & 7) * 8 + hh) * 128;
        bf16x8 af[4];
#pragma unroll
        for (int ks = 0; ks < 4; ++ks) af[ks] = *(const LAS bf16x8*)(Oall + 32 * ks + 8 * g);
#pragma unroll
        for (int nb = 0; nb < 4; ++nb) {
            f32x4 a = (f32x4){0.f, 0.f, 0.f, 0.f};
#pragma unroll
            for (int ks = 0; ks < 4; ++ks) { const bf16x8 bf = *(const bf16x8*)(WuvT + (16 * nb + n16) * 128 + 32 * ks + 8 * g);
                a = __builtin_amdgcn_mfma_f32_16x16x32_bf16(af[ks], bf, a, 0, 0, 0); }
            if (g < 2) {
#pragma unroll
                for (int i = 0; i < 4; ++i) H[(size_t)(t0 + 4 * g + i) * DM + 512 + hh * 64 + 16 * nb + n16] = f2bf(a[i]);
            }
        }
    }
    __syncthreads();
    if (cvok) p0_finish(cvi, cva, (LAS float*)(lds + wave * 8704), lane);
    if (cvok2) p0_finish(cvj, cvb, (LAS float*)(lds + wave * 8704), lane);
    __syncthreads();
}

template <int STOP> __device__ __forceinline__ void phase(const Params& p, LAS unsigned char* lds, int tid, int lane, int wave, int& cvcur) {
    const int G = gridDim.x, k = blockIdx.x;
    const bool nice = (G == 256);
    const int nit = nice ? 16 : (4096 - k + G - 1) / G;
    for (int i = 0; i < nit; ++i) {
        int b, qt;
        if (nice) { const int j = k >> 3; b = k & 7; qt = 511 - (i * 32 + ((i & 1) ? 31 - j : j)); }
        else { const int u = k + i * G; b = u & 7; qt = 511 - (u >> 3); }
        unit<STOP>(p, lds, tid, lane, wave, b, qt, cvcur);
    }
}
}

#define XB_TMO      128
#define XB_XCNT(j)  (256  + 64 * (j))
#define XB_XSUB(j)  (1280 + 64 * (j))
#define XB_XGEN(j)  (2304 + 64 * (j))
#define XB_TOP      3328
#define XB_TOPGEN   3392
#define XCD_BAR_WORDS 3456
#define XB_SPIN_CAP (1u << 22)
__device__ __forceinline__ unsigned xb_ld(unsigned* p)              { return __hip_atomic_load(p, __ATOMIC_RELAXED, __HIP_MEMORY_SCOPE_AGENT); }
__device__ __forceinline__ unsigned xb_add(unsigned* p, unsigned v) { return __hip_atomic_fetch_add(p, v, __ATOMIC_RELAXED, __HIP_MEMORY_SCOPE_AGENT); }
__device__ __forceinline__ unsigned xb_xcc_id() { return (unsigned)__builtin_amdgcn_s_getreg((3 << 11) | 20) & 0xFu; }
#define XB_SPIN(cond, bar) do { unsigned _sp = 0; while (cond) { __builtin_amdgcn_s_sleep(1); \
    if ((++_sp & 255u) == 0u) { if (xb_ld(&(bar)[XB_TMO])) break; if (_sp > XB_SPIN_CAP) { atomicAdd(&(bar)[XB_TMO], 1u); break; } } } } while (0)
struct XcdBarrier { unsigned* bar; unsigned x; volatile LAS unsigned* st; };
__device__ __forceinline__ XcdBarrier xcd_barrier_post(unsigned* bar, volatile LAS unsigned* st) {
    XcdBarrier b; b.bar = bar; b.x = xb_xcc_id(); b.st = st;
    if (threadIdx.x == 0) (void)xb_add(&bar[XB_XCNT(b.x)], 1u);
    return b;
}
__device__ __forceinline__ void xcd_barrier_complete(unsigned* bar, unsigned x, unsigned& nloc, unsigned& nx) {
    const unsigned G = gridDim.x * gridDim.y * gridDim.z;
    unsigned sum, cnt, mine, sp = 0u;
    for (;;) {
        sum = 0u; cnt = 0u; mine = 0u;
#pragma unroll
        for (unsigned j = 0; j < 16; ++j) { const unsigned c = xb_ld(&bar[XB_XCNT(j)]); sum += c; cnt += (c > 0u) ? 1u : 0u; mine = (j == x) ? c : mine; }
        if (sum == G) break;
        __builtin_amdgcn_s_sleep(1);
        if ((++sp & 255u) == 0u) { if (xb_ld(&bar[XB_TMO])) break; if (sp > XB_SPIN_CAP) { atomicAdd(&bar[XB_TMO], 1u); break; } }
    }
    nloc = mine > 0u ? mine : 1u; nx = cnt > 0u ? cnt : 1u;
}
__device__ __forceinline__ void xcd_barrier(const XcdBarrier& b) {
    asm volatile("s_waitcnt vmcnt(0)" ::: "memory");
    __syncthreads();
    if (threadIdx.x == 0) {
        unsigned* bar = b.bar;
        __builtin_amdgcn_s_waitcnt(0);
        unsigned nloc = b.st[0], nx = b.st[1];
        if (nloc == 0u) { xcd_barrier_complete(bar, b.x, nloc, nx); b.st[0] = nloc; b.st[1] = nx; }
        const unsigned old = xb_add(&bar[XB_XSUB(b.x)], 1u);
        const unsigned gen = old / nloc;
        if (old + 1u == (gen + 1u) * nloc) {
            __builtin_amdgcn_fence(__ATOMIC_RELEASE, "agent");
            asm volatile("s_waitcnt vmcnt(0)" ::: "memory");
            const unsigned og = xb_add(&bar[XB_TOP], 1u);
            const unsigned tg = og / nx;
            if (og + 1u == (tg + 1u) * nx) xb_add(&bar[XB_TOPGEN], 1u);
            else XB_SPIN(xb_ld(&bar[XB_TOPGEN]) == tg, bar);
            __builtin_amdgcn_fence(__ATOMIC_ACQUIRE, "agent");
            xb_add(&bar[XB_XGEN(b.x)], 1u);
            asm volatile("s_waitcnt vmcnt(0)" ::: "memory");
        } else {
            XB_SPIN(xb_ld(&bar[XB_XGEN(b.x)]) == gen, bar);
            __builtin_amdgcn_fence(__ATOMIC_ACQUIRE, "agent");
            asm volatile("s_waitcnt vmcnt(0)" ::: "memory");
        }
    }
    __syncthreads();
}
constexpr int N_PHASES = 10;
__global__ void __launch_bounds__(NTHREADS, 2) mega(Params p) {
    extern __shared__ __attribute__((aligned(16))) unsigned char lds_raw[];
    LAS unsigned char* lds = (LAS unsigned char*)lds_raw;
    cg::grid_group grid = cg::this_grid();
    int tid = threadIdx.x, lane = tid & 63; const int wave = __builtin_amdgcn_readfirstlane(tid >> 6);
#define FRESH() do { tid = threadIdx.x; asm volatile("" : "+v"(tid)); lane = tid & 63; } while (0)
    unsigned char* ws = p.ws;
    const int lo = p.ph_lo, hi = p.ph_hi;
    volatile LAS unsigned* MISC = (volatile LAS unsigned*)(lds + LDS_MISC);
    if (tid < 16) MISC[tid] = 0u;
    __syncthreads();
    XcdBarrier bar = xcd_barrier_post((unsigned*)(ws + WS_CTL), MISC);
#define IN(k) (lo <= (k) && (k) < hi)
#define SEAM(k) do { if (IN(k) && IN((k) + 1)) xcd_barrier(bar); } while (0)
    if (lo < 0) grid.sync();
    if (IN(0)) { FRESH(); phase_prep(p, lds, tid, lane, wave); } SEAM(0);
    if (IN(1)) { FRESH(); phase_norm1(p, lds, tid, lane, wave); } SEAM(1);
    if (IN(2)) { FRESH();
        gp::Gemm g{(const bf16_t*)(ws + WS_H), (const bf16_t*)(ws + WS_WINT), NPJ, DM, nullptr};
        gp::StaticOrder S; S.init(NTOK, NPJ, gridDim.x, blockIdx.x);
        LAS float* gl = (LAS float*)(lds + LDS_RING + 8192);
        if (tid < 64) { gl[tid] = p.in[8][tid]; gl[64 + tid] = p.in[9][tid]; gl[128 + tid] = p.in[12][tid]; gl[192 + tid] = p.in[13][tid]; }
        if (tid < 128) gl[256 + tid] = p.in[14][tid];
        __syncthreads();
        gp::EpiInproj E{(bf16_t*)(ws + WS_PROJ), (const float*)(ws + WS_ROPE), gl, (LAS float*)(lds + LDS_RING), ws + WS_IKF};
        gp::gemm_phase<gp::EpiInproj, gp::StaticOrder, false>(lds, g, S, E);
    } SEAM(2);
    if (IN(3)) { int cvcur = 0;
        const bool dsa_first = (((int)blockIdx.x >> 3) & 1) != 0;
        if (!dsa_first) { FRESH(); da::phase(p, lds, tid, lane, wave, cvcur); }
        FRESH(); ds::phase<0>(p, lds, tid, lane, wave, cvcur);
        if (dsa_first) { FRESH(); da::phase(p, lds, tid, lane, wave, cvcur); }
        conv_expert_items(p, lds, lane, wave, cvcur, 1 << 20); } SEAM(3);
    if (IN(4)) { FRESH();
        gp::Gemm g{(const bf16_t*)(ws + WS_H), (const bf16_t*)(ws + WS_WOUTT), DM, DM, nullptr};
        gp::StaticOrder S; S.init(NTOK, DM, gridDim.x, blockIdx.x);
        gp::EpiResid E{p.in[0], p.out, (const float*)(ws + WS_MOD)};
        gp::gemm_phase<gp::EpiResid, gp::StaticOrder, false>(lds, g, S, E);
    } SEAM(4);
    if (IN(5)) { FRESH(); phase_norm2(p, lds, tid, lane, wave); } SEAM(5);
    if (IN(6)) { FRESH(); phase_scatter(p, lds, tid, lane, wave); } SEAM(6);
    if (IN(7)) { FRESH();
        const int* tile_e = (const int*)(ws + WS_TILEE);
        gp::Gemm g{(const bf16_t*)(ws + WS_H), (const bf16_t*)(ws + WS_WGUT), 2048, DM, (const int*)(ws + WS_ROWSRC)};
        gp::MoeOrder S{tile_e, tile_e[MAXTILES], 8, (int)blockIdx.x, (int)gridDim.x};
        gp::EpiSwiglu E{(bf16_t*)(ws + WS_ACT), p.in[19], p.in[21]};
        gp::gemm_phase<gp::EpiSwiglu, gp::MoeOrder, true>(lds, g, S, E);
    } SEAM(7);
    if (IN(8)) { FRESH();
        const int* tile_e = (const int*)(ws + WS_TILEE);
        gp::Gemm g{(const bf16_t*)(ws + WS_ACT), (const bf16_t*)(ws + WS_WDT), DM, DM, nullptr};
        gp::MoeOrder S{tile_e, tile_e[MAXTILES], 4, (int)blockIdx.x, (int)gridDim.x};
        gp::EpiDown E{p.out, (bf16_t*)(ws + WS_Y), p.in[23], (const float*)(ws + WS_MOD), (const int2*)(ws + WS_ROWMETA)};
        gp::gemm_phase<gp::EpiDown, gp::MoeOrder, false>(lds, g, S, E);
    } SEAM(8);
    if (IN(9)) { FRESH(); phase_combine(p, tid); }
#undef IN
#undef SEAM
}

static int g_grid = 0;
static void launch_mega(const Params& base, int lo, int hi, hipStream_t stream) {
    Params p = base; p.ph_lo = lo; p.ph_hi = hi;
    void* args[] = {&p};
    hipError_t e = hipLaunchCooperativeKernel((const void*)mega, dim3(g_grid), dim3(NTHREADS), args, LDS_BYTES, stream);
    if (e != hipSuccess) fprintf(stderr, "kernel_launch: cooperative launch [%d,%d) failed: %s (grid %d)\n", lo, hi, hipGetErrorString(e), g_grid);
}
extern "C" void kernel_launch(void* const* d_in, const int* in_sizes, int n_in, void* d_out, int out_size, void* d_ws, size_t ws_size, hipStream_t stream) {
    if (ws_size < WS_END) { fprintf(stderr, "kernel_launch: workspace too small: %zu < %zu\n", ws_size, (size_t)WS_END); return; }
    if (g_grid == 0) {
        int dev = 0, cus = 0, per_cu = 0;
        hipGetDevice(&dev); hipDeviceGetAttribute(&cus, hipDeviceAttributeMultiprocessorCount, dev);
        if (hipFuncSetAttribute((const void*)mega, hipFuncAttributeMaxDynamicSharedMemorySize, LDS_BYTES) != hipSuccess) fprintf(stderr, "kernel_launch: hipFuncSetAttribute failed\n");
        hipOccupancyMaxActiveBlocksPerMultiprocessor(&per_cu, (const void*)mega, NTHREADS, LDS_BYTES);
        (void)hipGetLastError();
        if (per_cu < 1) { fprintf(stderr, "kernel_launch: occupancy query says %d blocks/CU\n", per_cu); per_cu = 1; }
        g_grid = cus * 1;
        fprintf(stderr, "kernel_launch: cus %d per_cu %d grid %d\n", cus, per_cu, g_grid);
    }
    const float* x = (const float*)d_in[0];
    float* out = (float*)d_out; char* ws = (char*)d_ws;
    float* mod = (float*)(ws + WS_MOD); float* rope = (float*)(ws + WS_ROPE); float* lam = (float*)(ws + WS_LAM);
    float* IW = (float*)(ws + WS_IW);
    bf16_t* H = (bf16_t*)(ws + WS_H); bf16_t* PROJ = (bf16_t*)(ws + WS_PROJ);
    Params P{};
    for (int i = 0; i < 24; ++i) P.in[i] = (const float*)d_in[i];
    P.out = out; P.ws = (unsigned char*)d_ws;

    (void)hipMemsetAsync((char*)d_ws + WS_CTL, 0, 16384, stream);
    launch_mega(P, 0, N_PHASES, stream);
    (void)rope; (void)lam; (void)IW; (void)H; (void)PROJ;
    (void)x; (void)mod;
}
```

```cpp
#include <hip/hip_runtime.h>
#include <stdint.h>
#include <cstdio>

typedef unsigned short bf16_t;
__device__ __forceinline__ float bf2f(bf16_t v) { return __uint_as_float(((unsigned)v) << 16); }
__device__ __forceinline__ bf16_t f2bf(float f) { unsigned u = __float_as_uint(f); return (bf16_t)((u + 0x7fffu + ((u >> 16) & 1u)) >> 16); }

constexpr int NB = 8, SEQ = 4096, DM = 1024, NTOK = NB * SEQ;
constexpr int NIN = 2824, NPJ = 2816;
constexpr int C_AQ1 = 0, C_AQ2 = 256, C_AK1 = 512, C_AK2 = 768, C_AV = 1024, C_BQ = 1536, C_BK = 2048, C_BLAT = 2112, C_IQ = 2240, C_IK = 2752, C_IW = 2816;
constexpr int NEXP = 32, TOPK = 4, NPAIR = NTOK * TOPK;
constexpr int MAXTILES = NPAIR / 256 + NEXP;
constexpr int PPAD = MAXTILES * 256;
constexpr int NCHUNK = 256, CHTOK = NTOK / NCHUNK;
constexpr float RMS_EPS = 1e-6f;
constexpr float LAMBDA_INIT = 0.2f;

constexpr size_t MiB = 1u << 20;
constexpr size_t WS_CTL = 0;
constexpr size_t WS_MOD = 1 * MiB;
constexpr size_t WS_ROPE = WS_MOD + 256 * 1024;
constexpr size_t WS_LAM = WS_ROPE + 256 * 1024;
constexpr size_t WS_CHCNT = WS_LAM + 4096;
constexpr size_t WS_TILEE = WS_CHCNT + 32768;
constexpr size_t WS_TOPI = 2 * MiB;
constexpr size_t WS_TOPG = WS_TOPI + 512 * 1024;
constexpr size_t WS_ROWTOK = 3 * MiB;
constexpr size_t WS_ROWSRC = 3 * MiB + 640 * 1024;
constexpr size_t WS_IW = 5 * MiB;
constexpr size_t WS_ROWMETA = 6 * MiB;
constexpr size_t WS_WINT = 8 * MiB;
constexpr size_t WS_WOUTT = 14 * MiB;
constexpr size_t WS_WUVT = 16 * MiB;
constexpr size_t WS_WDT = 17 * MiB;
constexpr size_t WS_WGUT = 81 * MiB;
constexpr size_t WS_H = 209 * MiB;
constexpr size_t WS_PROJ = 273 * MiB;
constexpr size_t WS_ACT = WS_PROJ;
constexpr size_t WS_Y = WS_WGUT;
constexpr size_t WS_IKF = WS_ACT + (size_t)PPAD * 1024 * 2;
constexpr size_t WS_END = WS_IKF + 4 * MiB;

namespace gp {
#define GP_LAS __attribute__((address_space(3)))
typedef short bf16x8 __attribute__((ext_vector_type(8)));
typedef float f32x4 __attribute__((ext_vector_type(4)));
typedef unsigned u32x4 __attribute__((ext_vector_type(4)));
constexpr int BM = 256, BK = 64, HALF = 128, HTB = HALF * BK * 2  , STAGE_BYTES = 8 * HTB;

__host__ __device__ __forceinline__ int lds_byte(int r, int c) { const int st = (r >> 4) * 2 + (c >> 5), rr = r & 15, cc = c & 31, ob = rr * 64 + cc * 2; return st * 1024 + (ob ^ (((ob >> 9) & 1) << 5)); }
__host__ __device__ __forceinline__ void stage_rc(int b, int& R, int& C) { const int st = b / 1024, sb = b % 1024, swz = sb ^ (((sb >> 9) & 1) << 5); R = (st >> 1) * 16 + swz / 64; C = (st & 1) * 32 + (swz % 64) / 2; }
__host__ __device__ __forceinline__ int perm32(int rho) { const int n = rho >> 4, i = rho & 15; return 8 * (i >> 2) + 4 * n + (i & 3); }

struct Unit { int pm, pn, e; };
struct Gemm { const bf16_t* A; const bf16_t* Bt; int N, K; const int* rowsrc; };

struct StaticOrder {
    int nM, nN, nwg, G, c;
    __device__ void init(int M, int N, int G_, int c_) { nM = M / BM; nN = N / BM; nwg = nM * nN; G = G_; c = c_; }
    __device__ bool next(int i, Unit& u) const {
        const long L = (long)i * G + c; if (L >= nwg) return false;
        int wgid = (int)L; { const int q = nwg / 8, r = nwg % 8, xcd = wgid % 8, off = wgid / 8; wgid = (xcd < r ? xcd * (q + 1) : r * (q + 1) + (xcd - r) * q) + off; }
        const int nig = 8 * nN, gid = wgid / nig, fm = gid * 8, gsz = (nM - fm) < 8 ? (nM - fm) : 8;
        u.pm = fm + ((wgid % nig) % gsz); u.pn = (wgid % nig) / gsz; u.e = 0; return true;
    }
};
struct MoeOrder {
    const int* tile_e; int ntiles, nN, c, G;
    __device__ bool next(int i, Unit& u) const {
        const int j = c >> 3, x = c & 7, tpx = (G >> 3) / nN;
        const int tile = i * (tpx * 8) + x * tpx + j / nN;
        if (tile >= ntiles) return false;
        u.pm = tile; u.pn = j % nN; u.e = tile_e[tile]; return true;
    }
};

__device__ __forceinline__ unsigned cvt_pk_bf16(float lo, float hi) { unsigned r; asm volatile("v_cvt_pk_bf16_f32 %0, %1, %2" : "=v"(r) : "v"(lo), "v"(hi)); return r; }

struct EpiBf16 {
    bf16_t* O; int ldc;
    __device__ __forceinline__ void operator()(const f32x4 (&acc)[2][2][4][2], const Unit& u, int wr, int wc, int fr, int fq) const {
        const int row0 = u.pm * BM + wr * 64 + fr, col0 = u.pn * BM + wc * 32 + 8 * fq;
#pragma unroll
        for (int ai = 0; ai < 2; ++ai)
#pragma unroll
            for (int m = 0; m < 4; ++m) { bf16_t* rowp = O + (size_t)(row0 + ai * HALF + m * 16) * ldc + col0;
#pragma unroll
                for (int bj = 0; bj < 2; ++bj) { const f32x4 v0 = acc[ai][bj][m][0], v1 = acc[ai][bj][m][1];
                    u32x4 w; w.x = cvt_pk_bf16(v0[0], v0[1]); w.y = cvt_pk_bf16(v0[2], v0[3]); w.z = cvt_pk_bf16(v1[0], v1[1]); w.w = cvt_pk_bf16(v1[2], v1[3]);
                    *(u32x4*)(rowp + bj * HALF) = w; } }
    }
};

struct EpiInproj {
    bf16_t* O; const float* rope; GP_LAS const float* gl; GP_LAS float* xch; unsigned char* ikf;
    __device__ __forceinline__ void operator()(const f32x4 (&acc)[2][2][4][2], const Unit& u, int wr, int wc, int fr, int fq) const {
        const int wid = wr * 4 + wc, row0 = u.pm * BM + wr * 64 + fr, col0 = u.pn * BM + wc * 32 + 8 * fq, lc = (wc & 1) * 32 + 8 * fq;
        int mode[2]; int goff[2];
#pragma unroll
        for (int bj = 0; bj < 2; ++bj) { const int gc = u.pn * BM + bj * HALF + (wc >> 1) * 64; goff[bj] = 0;
            if (gc < 512) { mode[bj] = 1; goff[bj] = lc; } else if (gc < 1024) { mode[bj] = 1; goff[bj] = 64 + lc; } else if (gc < 1536) { mode[bj] = 0; }
            else if (gc < 2048) { mode[bj] = 1; goff[bj] = 128 + lc; } else if (gc < 2112) { mode[bj] = 1; goff[bj] = 192 + lc; }
            else if (gc < 2240) { mode[bj] = 3; goff[bj] = 256 + (gc - 2112) + lc; } else { mode[bj] = 2; } }
#pragma unroll
        for (int ai = 0; ai < 2; ++ai)
#pragma unroll
            for (int m = 0; m < 4; ++m)
#pragma unroll
                for (int bj = 0; bj < 2; ++bj) { const f32x4 a = acc[ai][bj][m][0], b = acc[ai][bj][m][1];
                    float s = ((a[0] * a[0] + a[1] * a[1]) + (a[2] * a[2] + a[3] * a[3])) + ((b[0] * b[0] + b[1] * b[1]) + (b[2] * b[2] + b[3] * b[3]));
                    s += __shfl_xor(s, 16); s += __shfl_xor(s, 32);
                    if (fq == 0) xch[(wid * 2 + bj) * 128 + ai * 64 + m * 16 + fr] = s; }
        asm volatile("s_waitcnt lgkmcnt(0)" ::: "memory"); __builtin_amdgcn_s_barrier(); asm volatile("" ::: "memory");
#pragma unroll
        for (int ai = 0; ai < 2; ++ai)
#pragma unroll
            for (int m = 0; m < 4; ++m) { int rl = ai * 64 + m * 16 + fr, row = row0 + ai * HALF + m * 16; asm volatile("" : "+v"(rl), "+v"(row)); const int pos = row % SEQ;
                bf16_t* rowp = O + (size_t)row * NPJ + col0;
#pragma unroll
                for (int bj = 0; bj < 2; ++bj) { f32x4 v0 = acc[ai][bj][m][0], v1 = acc[ai][bj][m][1];
                    if (mode[bj] == 1 || mode[bj] == 3) {
                        float tot = xch[(wid * 2 + bj) * 128 + rl] + xch[((wid ^ 1) * 2 + bj) * 128 + rl];
                        if (mode[bj] == 3) tot += xch[((wr * 4 + (wc ^ 2)) * 2 + (bj ^ 1)) * 128 + rl] + xch[((wr * 4 + (wc ^ 3)) * 2 + (bj ^ 1)) * 128 + rl];
                        const float r = 1.0f / sqrtf(tot * (mode[bj] == 3 ? (1.f / 128.f) : (1.f / 64.f)) + RMS_EPS);
                        const f32x4 g0 = *(GP_LAS const f32x4*)(gl + goff[bj]), g1 = *(GP_LAS const f32x4*)(gl + goff[bj] + 4);
                        v0 = v0 * r * g0; v1 = v1 * r * g1; }
                    if ((mode[bj] == 1 || mode[bj] == 2) && (wc & 1) == 0) {
                        f32x4 o0, o1;
#pragma unroll
                        for (int i = 0; i < 4; ++i) { o0[i] = __shfl_xor(v0[i], 16); o1[i] = __shfl_xor(v1[i], 16); }
                        if (fq < 2) { const float* rp = rope + pos * 16; const float sg = fq == 0 ? -1.0f : 1.0f;
                            const f32x4 t0 = *(const f32x4*)(rp), t1 = *(const f32x4*)(rp + 4), t2 = *(const f32x4*)(rp + 8), t3 = *(const f32x4*)(rp + 12);
                            v0[0] = v0[0] * t0[0] + sg * o0[0] * t0[1]; v0[1] = v0[1] * t0[2] + sg * o0[1] * t0[3];
                            v0[2] = v0[2] * t1[0] + sg * o0[2] * t1[1]; v0[3] = v0[3] * t1[2] + sg * o0[3] * t1[3];
                            v1[0] = v1[0] * t2[0] + sg * o1[0] * t2[1]; v1[1] = v1[1] * t2[2] + sg * o1[1] * t2[3];
                            v1[2] = v1[2] * t3[0] + sg * o1[2] * t3[1]; v1[3] = v1[3] * t3[2] + sg * o1[3] * t3[3]; } }
                    u32x4 w; w.x = cvt_pk_bf16(v0[0], v0[1]); w.y = cvt_pk_bf16(v0[2], v0[3]); w.z = cvt_pk_bf16(v1[0], v1[1]); w.w = cvt_pk_bf16(v1[2], v1[3]);
                    *(u32x4*)(rowp + bj * HALF) = w;
                    if (u.pn == 10 && bj == 1 && wc >= 2) {
                        const int key = row % SEQ, c8 = (wc & 1) * 4 + fq;
                        *(u32x4*)(ikf + ((size_t)((((row / SEQ) * 128 + (key >> 5)) * 4 + (c8 >> 1)) * 64 + (c8 & 1) * 32 + (key & 31)) << 4)) = w; } }
                asm volatile("" ::: "memory"); }
    }
};
struct EpiResid {
    const float* x; float* out; const float* mod;
    __device__ __forceinline__ void operator()(const f32x4 (&acc)[2][2][4][2], const Unit& u, int wr, int wc, int fr, int fq) const {
        const int row0 = u.pm * BM + wr * 64 + fr, col0 = u.pn * BM + wc * 32 + 8 * fq, b = (u.pm * BM) / SEQ;
        f32x4 gv[2][2];
#pragma unroll
        for (int bj = 0; bj < 2; ++bj)
#pragma unroll
            for (int n = 0; n < 2; ++n) gv[bj][n] = *(const f32x4*)(mod + b * 6144 + 2 * 1024 + col0 + bj * HALF + 4 * n);
#pragma unroll
        for (int ai = 0; ai < 2; ++ai)
#pragma unroll
            for (int m = 0; m < 4; ++m) { const size_t off = (size_t)(row0 + ai * HALF + m * 16) * DM + col0;
#pragma unroll
                for (int bj = 0; bj < 2; ++bj)
#pragma unroll
                    for (int n = 0; n < 2; ++n) { const f32x4 xv = *(const f32x4*)(x + off + bj * HALF + 4 * n);
                        *(f32x4*)(out + off + bj * HALF + 4 * n) = xv + gv[bj][n] * acc[ai][bj][m][n]; }
                asm volatile("" ::: "memory"); }
    }
};
struct EpiSwiglu {
    bf16_t* act; const float* bg; const float* bu;
    __device__ __forceinline__ void operator()(const f32x4 (&acc)[2][2][4][2], const Unit& u, int wr, int wc, int fr, int fq) const {
        const int row0 = u.pm * BM + wr * 64 + fr, ff0 = u.pn * HALF + wc * 32 + 8 * fq;
        f32x4 bgv[2], buv[2];
#pragma unroll
        for (int n = 0; n < 2; ++n) { bgv[n] = *(const f32x4*)(bg + u.e * 1024 + ff0 + 4 * n); buv[n] = *(const f32x4*)(bu + u.e * 1024 + ff0 + 4 * n); }
#pragma unroll
        for (int ai = 0; ai < 2; ++ai)
#pragma unroll
            for (int m = 0; m < 4; ++m) {
                float a[8];
#pragma unroll
                for (int n = 0; n < 2; ++n) { const f32x4 g4 = acc[ai][0][m][n] + bgv[n], u4 = acc[ai][1][m][n] + buv[n];
#pragma unroll
                    for (int j = 0; j < 4; ++j) { const float g = fminf(g4[j], 7.0f), uu = fminf(fmaxf(u4[j], -7.0f), 7.0f);
                        const float sg = __builtin_amdgcn_rcpf(1.0f + __builtin_amdgcn_exp2f(-1.702f * 1.4426950408889634f * g));
                        a[4 * n + j] = g * sg * (uu + 1.0f); } }
                u32x4 w; w.x = cvt_pk_bf16(a[0], a[1]); w.y = cvt_pk_bf16(a[2], a[3]); w.z = cvt_pk_bf16(a[4], a[5]); w.w = cvt_pk_bf16(a[6], a[7]);
                *(u32x4*)(act + (size_t)(row0 + ai * HALF + m * 16) * 1024 + ff0) = w; }
    }
};
struct EpiDown {
    float* out; bf16_t* Y; const float* bd; const float* mod; const int2* rowmeta;
    __device__ __forceinline__ void operator()(const f32x4 (&acc)[2][2][4][2], const Unit& u, int wr, int wc, int fr, int fq) const {
        const int row0 = u.pm * BM + wr * 64 + fr, col0 = u.pn * BM + wc * 32 + 8 * fq;
        f32x4 bv[2][2];
#pragma unroll
        for (int bj = 0; bj < 2; ++bj)
#pragma unroll
            for (int n = 0; n < 2; ++n) bv[bj][n] = *(const f32x4*)(bd + u.e * 1024 + col0 + bj * HALF + 4 * n);
        int2 meta[2][4];
#pragma unroll
        for (int ai = 0; ai < 2; ++ai)
#pragma unroll
            for (int m = 0; m < 4; ++m) meta[ai][m] = rowmeta[row0 + ai * HALF + m * 16];
#pragma unroll
        for (int ai = 0; ai < 2; ++ai)
#pragma unroll
            for (int m = 0; m < 4; ++m) {
                const int ent = meta[ai][m].x;
                if (ent >= 0) {
                    const int tok = ent >> 2, kk = ent & 3; const float gt = __int_as_float(meta[ai][m].y);
                    if (kk == 0) { const float* g2 = mod + (tok / SEQ) * 6144 + 5 * 1024 + col0; float* op = out + (size_t)tok * DM + col0;
#pragma unroll
                        for (int bj = 0; bj < 2; ++bj)
#pragma unroll
                            for (int n = 0; n < 2; ++n) { const f32x4 g4 = *(const f32x4*)(g2 + bj * HALF + 4 * n), o4 = *(const f32x4*)(op + bj * HALF + 4 * n);
                                *(f32x4*)(op + bj * HALF + 4 * n) = o4 + g4 * ((acc[ai][bj][m][n] + bv[bj][n]) * gt); }
                    } else { bf16_t* yp = Y + ((size_t)(kk - 1) * NTOK + tok) * DM + col0;
#pragma unroll
                        for (int bj = 0; bj < 2; ++bj) { const f32x4 v0 = (acc[ai][bj][m][0] + bv[bj][0]) * gt, v1 = (acc[ai][bj][m][1] + bv[bj][1]) * gt;
                            u32x4 w; w.x = cvt_pk_bf16(v0[0], v0[1]); w.y = cvt_pk_bf16(v0[2], v0[3]); w.z = cvt_pk_bf16(v1[0], v1[1]); w.w = cvt_pk_bf16(v1[2], v1[3]);
                            *(u32x4*)(yp + bj * HALF) = w; } }
                }
                asm volatile("" ::: "memory"); }
    }
};

template <class Epi, class Sched, bool GATHER>
__device__ __forceinline__ void gemm_phase(GP_LAS unsigned char* lds, const Gemm g, const Sched& S, const Epi& E) {
    const int tid = threadIdx.x, wid = __builtin_amdgcn_readfirstlane(tid >> 6), lane = tid & 63, wr = wid >> 2, wc = wid & 3, fr = lane & 15, fq = lane >> 4;
    const int K = g.K, nt = K / BK;
    unsigned voffB[2];
#pragma unroll
    for (int i = 0; i < 2; ++i) { int R, C; stage_rc(tid * 16 + i * 8192, R, C); const int Rb = (R & ~31) + perm32(R & 31); voffB[i] = (unsigned)(Rb * K + C) * 2u; }
    const size_t kstep = (size_t)(BK * 2);
    const size_t hstep = (size_t)HALF * K * 2;
    const size_t tstep = 2 * hstep;
    const unsigned ldsw = (unsigned)wid * 1024u;
    const int aoff = lds_byte(wr * 64 + fr, fq * 8), boff = lds_byte(wc * 32 + fr, fq * 8);
#define GP_SA(b, h) (((b) * 2 + (h)) * HTB)
#define GP_SB(b, h) ((4 + (b) * 2 + (h)) * HTB)
#define GP_STAGE(bufoff, gbase, voff) do { _Pragma("unroll") for (int _i = 0; _i < 2; ++_i) \
        __builtin_amdgcn_global_load_lds((const unsigned*)((const char*)(gbase) + (voff)[_i]), (GP_LAS unsigned*)(lds + (bufoff) + ldsw + _i * 8192), 16, 0, 0); } while (0)
#define GP_LDA(dst, b, h) do { _Pragma("unroll") for (int m = 0; m < 4; ++m) _Pragma("unroll") for (int k = 0; k < 2; ++k) dst[m][k] = *(const GP_LAS bf16x8*)(lds + GP_SA(b, h) + aoff + m * 2048 + k * 1024); } while (0)
#define GP_LDB(dst, b, h) do { _Pragma("unroll") for (int n = 0; n < 2; ++n) _Pragma("unroll") for (int k = 0; k < 2; ++k) dst[n][k] = *(const GP_LAS bf16x8*)(lds + GP_SB(b, h) + boff + n * 2048 + k * 1024); } while (0)
#define GP_MMA(ai, bj, At, Bt) do { __builtin_amdgcn_s_setprio(1); _Pragma("unroll") for (int m = 0; m < 4; ++m) _Pragma("unroll") for (int n = 0; n < 2; ++n) _Pragma("unroll") for (int k = 0; k < 2; ++k) \
        acc[ai][bj][m][n] = __builtin_amdgcn_mfma_f32_16x16x32_bf16(Bt[n][k], At[m][k], acc[ai][bj][m][n], 0, 0, 0); __builtin_amdgcn_s_setprio(0); } while (0)
#define GP_WAIT_V(n) asm volatile("s_waitcnt vmcnt(" #n ")" ::: "memory")
#define GP_WAIT_L(n) asm volatile("s_waitcnt lgkmcnt(" #n ")" ::: "memory")
#define GP_BAR __builtin_amdgcn_s_barrier()
#define GP_SCHED __builtin_amdgcn_sched_barrier(0)
#define GP_AOFFS(u_, v0_, v1_) do { _Pragma("unroll") for (int _i = 0; _i < 2; ++_i) { int R_, C_; stage_rc(tid * 16 + _i * 8192, R_, C_); int r0_ = (u_).pm * BM + R_, r1_ = r0_ + HALF; \
        if (GATHER) { r0_ = g.rowsrc[r0_]; r1_ = g.rowsrc[r1_]; } \
        v0_[_i] = (unsigned)(r0_ * K + C_) * 2u; v1_[_i] = (unsigned)(r1_ * K + C_) * 2u; } } while (0)
    Unit cur, nxt; int ui = 0;
    if (!S.next(0, cur)) return;
    f32x4 acc[2][2][4][2];
#pragma unroll
    for (int a = 0; a < 2; ++a)
#pragma unroll
        for (int b = 0; b < 2; ++b)
#pragma unroll
            for (int m = 0; m < 4; ++m)
#pragma unroll
                for (int n = 0; n < 2; ++n) acc[a][b][m][n] = (f32x4){0.f, 0.f, 0.f, 0.f};
    bf16x8 At[4][2], B0[2][2], B1[2][2];
    unsigned vA0[2], vA1[2], nA0[2], nA1[2];
    GP_AOFFS(cur, vA0, vA1);
    const char* Ab = (const char*)g.A;
    const char* cB = (const char*)g.Bt + ((size_t)cur.e * g.N + (size_t)cur.pn * BM) * K * 2;
    GP_STAGE(GP_SB(0, 0), cB, voffB); GP_STAGE(GP_SB(0, 1), cB + hstep, voffB); GP_STAGE(GP_SA(0, 0), Ab, vA0); GP_STAGE(GP_SA(0, 1), Ab, vA1);
    if (wr == 1) GP_BAR;
    GP_WAIT_V(2); GP_BAR;
    GP_STAGE(GP_SB(1, 0), cB + kstep, voffB); GP_STAGE(GP_SA(1, 0), Ab + kstep, vA0); GP_STAGE(GP_SB(1, 1), cB + hstep + kstep, voffB);
    GP_WAIT_V(6); GP_BAR;
    for (;;) {
        const bool has_next = S.next(ui + 1, nxt);
        const char* nB = cB;
        if (has_next) { nB = (const char*)g.Bt + ((size_t)nxt.e * g.N + (size_t)nxt.pn * BM) * K * 2; GP_AOFFS(nxt, nA0, nA1); }
        else { nA0[0] = vA0[0]; nA0[1] = vA0[1]; nA1[0] = vA1[0]; nA1[1] = vA1[1]; }
        for (int t = 0; t < nt; t += 2) {
            const bool last = (t == nt - 2);
            const char* a1 = Ab + (size_t)(t + 1) * kstep;
            const char* a2 = last ? Ab : Ab + (size_t)(t + 2) * kstep; const char* b2 = last ? nB : cB + (size_t)(t + 2) * kstep;
            const char* a3 = a2 + kstep; const char* b3 = b2 + kstep;
            GP_LDB(B0, 0, 0); GP_LDB(B1, 0, 1); GP_SCHED; GP_LDA(At, 0, 0); GP_STAGE(GP_SA(1, 1), a1, vA1);
            if (last) { vA0[0] = nA0[0]; vA0[1] = nA0[1]; vA1[0] = nA1[0]; vA1[1] = nA1[1]; }
            GP_WAIT_V(8); GP_WAIT_L(0); GP_BAR; GP_MMA(0, 0, At, B0); GP_MMA(0, 1, At, B1); GP_BAR; GP_SCHED;
            GP_LDA(At, 0, 1); GP_STAGE(GP_SB(0, 0), b2, voffB); GP_STAGE(GP_SB(0, 1), b2 + hstep, voffB); GP_STAGE(GP_SA(0, 0), a2, vA0);
            GP_WAIT_V(8); GP_WAIT_L(0); GP_BAR; GP_MMA(1, 0, At, B0); GP_MMA(1, 1, At, B1); GP_BAR; GP_SCHED;
            GP_LDB(B0, 1, 0); GP_LDB(B1, 1, 1); GP_SCHED; GP_LDA(At, 1, 0); GP_STAGE(GP_SA(0, 1), a2, vA1);
            GP_WAIT_V(8); GP_WAIT_L(0); GP_BAR; GP_MMA(0, 0, At, B0); GP_MMA(0, 1, At, B1); GP_BAR; GP_SCHED;
            GP_LDA(At, 1, 1); GP_STAGE(GP_SB(1, 0), b3, voffB); GP_STAGE(GP_SB(1, 1), b3 + hstep, voffB); GP_STAGE(GP_SA(1, 0), a3, vA0);
            GP_WAIT_V(8); GP_WAIT_L(0); GP_BAR; GP_MMA(1, 0, At, B0); GP_MMA(1, 1, At, B1); GP_BAR; GP_SCHED;
        }
        if (wr == 0) GP_BAR;
        E(acc, cur, wr, wc, fr, fq);
        if (!has_next) break;
#pragma unroll
        for (int a = 0; a < 2; ++a)
#pragma unroll
            for (int b = 0; b < 2; ++b)
#pragma unroll
                for (int m = 0; m < 4; ++m)
#pragma unroll
                    for (int n = 0; n < 2; ++n) acc[a][b][m][n] = (f32x4){0.f, 0.f, 0.f, 0.f};
        cur = nxt; cB = nB; ++ui;
        if (wr == 1) GP_BAR;
    }
    GP_WAIT_V(0);
    GP_BAR;
#undef GP_SA
#undef GP_SB
#undef GP_STAGE
#undef GP_LDA
#undef GP_LDB
#undef GP_MMA
#undef GP_WAIT_V
#undef GP_WAIT_L
#undef GP_BAR
#undef GP_SCHED
#undef GP_AOFFS
}
}
#include <hip/hip_cooperative_groups.h>
namespace cg = cooperative_groups;
#define LAS __attribute__((address_space(3)))
typedef float f32x4 __attribute__((ext_vector_type(4)));
typedef unsigned u32x4 __attribute__((ext_vector_type(4)));
typedef short bf16x8 __attribute__((ext_vector_type(8)));
constexpr int NWAVES = 8, NTHREADS = 512;
constexpr int LDS_RING = 131072;
constexpr int LDS_MISC = 159744;
constexpr int LDS_BYTES = 159744 + 256;

struct Params {
    const float* in[24];
    float* out; unsigned char* ws;
    int ph_lo, ph_hi;
};
__device__ __forceinline__ unsigned pk2(float lo, float hi) { return (unsigned)f2bf(lo) | ((unsigned)f2bf(hi) << 16); }
__device__ __forceinline__ float wave_sum(float v) {
#pragma unroll
    for (int o = 1; o < 64; o <<= 1) v += __shfl_xor(v, o);
    return v;
}

struct P0Item { const float* W; int ld, k0, n0; bf16_t* WT; int row0, Kdst; };
__device__ __forceinline__ void p0_load(const P0Item& it, f32x4 (&v)[8], int lane) {
#pragma unroll
    for (int i = 0; i < 8; ++i) v[i] = __builtin_nontemporal_load((const f32x4*)(it.W + (size_t)(it.k0 + 8 * i + (lane >> 3)) * it.ld + it.n0 + 4 * (lane & 7)));
}
__device__ __forceinline__ void p0_finish(const P0Item& it, const f32x4 (&v)[8], LAS float* scr, int lane) {
#pragma unroll
    for (int i = 0; i < 8; ++i) { LAS float* d = scr + (8 * i + (lane >> 3)) * 33 + 4 * (lane & 7); d[0] = v[i][0]; d[1] = v[i][1]; d[2] = v[i][2]; d[3] = v[i][3]; }
    asm volatile("s_waitcnt lgkmcnt(0)" ::: "memory");
    const int c = lane & 7;
#pragma unroll
    for (int j = 0; j < 4; ++j) { const int n = (lane >> 3) + 8 * j; const LAS float* s = scr + (8 * c) * 33 + n;
        u32x4 o; o.x = pk2(s[0 * 33], s[1 * 33]); o.y = pk2(s[2 * 33], s[3 * 33]); o.z = pk2(s[4 * 33], s[5 * 33]); o.w = pk2(s[6 * 33], s[7 * 33]);
        *(u32x4*)(it.WT + (size_t)(it.row0 + n) * it.Kdst + it.k0 + 8 * c) = o; }
    asm volatile("s_waitcnt lgkmcnt(0)" ::: "memory");
}
__device__ __forceinline__ void phase_prep(const Params& p, LAS unsigned char* lds, int tid, int lane, int wave) {
    unsigned char* ws = p.ws;
    {
        LAS float* sc = (LAS float*)lds;
        LAS float* part = (LAS float*)(lds + 32768);
        const float* c = p.in[1]; const float* w_ada = p.in[4]; const float* b_ada = p.in[5];
        {   f32x4 cv4[4];
#pragma unroll
            for (int j = 0; j < 4; ++j) cv4[j] = *(const f32x4*)(c + 4 * (tid + NTHREADS * j));
#pragma unroll
            for (int j = 0; j < 4; ++j) { f32x4 o4;
#pragma unroll
                for (int q = 0; q < 4; ++q) o4[q] = cv4[j][q] / (1.f + __expf(-cv4[j][q]));
                *(LAS f32x4*)(sc + 4 * (tid + NTHREADS * j)) = o4; }
        }
        __syncthreads();
        for (int cb = blockIdx.x; cb < 256; cb += gridDim.x) {
            const int half = lane >> 5, cl = lane & 31;
            float acc[8];
#pragma unroll
            for (int b = 0; b < 8; ++b) acc[b] = 0.f;
            if (cl < 24) {
#pragma unroll 4
                for (int it = 0; it < 64; ++it) { const int k = 128 * wave + 2 * it + half; const float wv = __builtin_nontemporal_load(w_ada + (size_t)k * 6144 + 24 * cb + cl);
#pragma unroll
                    for (int b = 0; b < 8; ++b) acc[b] += sc[b * 1024 + k] * wv; }
#pragma unroll
                for (int b = 0; b < 8; ++b) part[((wave * 2 + half) * 8 + b) * 24 + cl] = acc[b];
            }
            __syncthreads();
            if (tid < 192) { const int b = tid / 24, cc = tid % 24; float s = 0.f;
                for (int q = 0; q < 16; ++q) s += part[(q * 8 + b) * 24 + cc];
                ((float*)(ws + WS_MOD))[b * 6144 + 24 * cb + cc] = s + b_ada[24 * cb + cc]; }
            __syncthreads();
        }
    }
    {
        float* rope = (float*)(ws + WS_ROPE);
        for (int i = blockIdx.x * NTHREADS + tid; i < SEQ * 8; i += gridDim.x * NTHREADS) {
            const int pos = i >> 3, f = i & 7;
            const float inv = f == 0 ? 1.0f : f == 1 ? 0.1939227432f : f == 2 ? 0.03760603070f : f == 3 ? 0.007292664610f : f == 4 ? 0.001414213562f : f == 5 ? 0.0002742481884f : f == 6 ? 5.318295734e-05f : 1.031338525e-05f;
            const float ang = (float)pos * inv;
            const double TWO_PI = 6.283185307179586476925287;
            const double a = (double)ang, r = a - rint(a / TWO_PI) * TWO_PI, r2 = r * r;
            double s = 0.0, c = 0.0, ts = r, tc = 1.0;
#pragma unroll 1
            for (int n = 0; n < 14; ++n) { s += ts; c += tc; ts *= -r2 / (double)((2 * n + 2) * (2 * n + 3)); tc *= -r2 / (double)((2 * n + 1) * (2 * n + 2)); }
            rope[i * 2 + 0] = (float)c; rope[i * 2 + 1] = (float)s;
        }
        if (blockIdx.x == 0 && tid == 0) { const float* al = p.in[10]; float d01 = 0.f, d23 = 0.f;
            for (int j = 0; j < 64; ++j) { d01 += al[j] * al[64 + j]; d23 += al[128 + j] * al[192 + j]; }
            ((float*)(ws + WS_LAM))[0] = expf(d01) - expf(d23) + LAMBDA_INIT; }
    }
    __syncthreads();
    {
        LAS float* scr = (LAS float*)(lds + wave * 8704);
        const int gw = blockIdx.x * NWAVES + wave, NGW = gridDim.x * NWAVES;
        constexpr int I_IN = 16 * 88, I_OUT = 16 * 32, I_UV = 32, NITEMS = I_IN + I_OUT + I_UV;
        auto decode = [&](int r) -> P0Item {
            if (r < I_IN) return P0Item{p.in[6], NIN, 64 * (r / 88), 32 * (r % 88), (bf16_t*)(ws + WS_WINT), 32 * (r % 88), 1024};
            r -= I_IN;
            if (r < I_OUT) return P0Item{p.in[7], 1024, 64 * (r / 32), 32 * (r % 32), (bf16_t*)(ws + WS_WOUTT), 32 * (r % 32), 1024};
            r -= I_OUT;
            const int h = r >> 2, rr = r & 3; return P0Item{p.in[15] + h * 128 * 64, 64, 64 * (rr >> 1), 32 * (rr & 1), (bf16_t*)(ws + WS_WUVT) + h * 64 * 128, 32 * (rr & 1), 128};
        };
        for (int it = gw; it < NITEMS; it += NGW) { const P0Item a = decode(it); f32x4 va[8]; p0_load(a, va, lane); p0_finish(a, va, scr, lane); }
    }
}
constexpr int N_EXPERT_ITEMS = 32 * 3 * 512;
__device__ __forceinline__ bool conv_expert_issue(const Params& p, int lane, int wave, int& cur, P0Item& a, f32x4 (&va)[8]) {
    unsigned char* ws = p.ws;
    const int gw = blockIdx.x * NWAVES + wave, NGW = gridDim.x * NWAVES, r = gw + NGW * cur;
    if (r >= N_EXPERT_ITEMS) return false;
    ++cur;
    const int e = r / 1536, qq = r % 1536, mat = qq / 512, i2 = qq % 512, kb = i2 / 32, nb = i2 % 32, n0 = 32 * nb;
    a = (mat == 2) ? P0Item{p.in[22] + (size_t)e * 1048576, 1024, 64 * kb, n0, (bf16_t*)(ws + WS_WDT) + (size_t)e * 1048576, n0, 1024}
                   : P0Item{p.in[mat == 0 ? 18 : 20] + (size_t)e * 1048576, 1024, 64 * kb, n0, (bf16_t*)(ws + WS_WGUT) + (size_t)e * 2097152, 256 * (n0 >> 7) + (n0 & 127) + (mat == 1 ? 128 : 0), 1024};
    p0_load(a, va, lane);
    return true;
}
__device__ __forceinline__ void conv_expert_items(const Params& p, LAS unsigned char* lds, int lane, int wave, int& cur, int n) {
    unsigned char* ws = p.ws;
    LAS float* scr = (LAS float*)(lds + wave * 8704);
    const int gw = blockIdx.x * NWAVES + wave, NGW = gridDim.x * NWAVES;
    for (int q = 0; q < n; ++q) {
        const int r = gw + NGW * cur;
        if (r >= N_EXPERT_ITEMS) break;
        ++cur;
        const int e = r / 1536, qq = r % 1536, mat = qq / 512, i2 = qq % 512, kb = i2 / 32, nb = i2 % 32, n0 = 32 * nb;
        const P0Item a = (mat == 2) ? P0Item{p.in[22] + (size_t)e * 1048576, 1024, 64 * kb, n0, (bf16_t*)(ws + WS_WDT) + (size_t)e * 1048576, n0, 1024}
                                    : P0Item{p.in[mat == 0 ? 18 : 20] + (size_t)e * 1048576, 1024, 64 * kb, n0, (bf16_t*)(ws + WS_WGUT) + (size_t)e * 2097152, 256 * (n0 >> 7) + (n0 & 127) + (mat == 1 ? 128 : 0), 1024};
        f32x4 va[8]; p0_load(a, va, lane); p0_finish(a, va, scr, lane);
    }
}

__device__ __forceinline__ void phase_norm1(const Params& p, LAS unsigned char* lds, int tid, int lane, int wave) {
    unsigned char* ws = p.ws;
    const float* x = p.in[0]; const float* g = p.in[2]; const float* w_in = p.in[6]; const float* mod = (const float*)(ws + WS_MOD);
    bf16_t* H = (bf16_t*)(ws + WS_H); float* IW = (float*)(ws + WS_IW);
    LAS float* wiw = (LAS float*)lds;
    {   f32x4 wv4[4];
#pragma unroll
        for (int j = 0; j < 4; ++j) { const int q = tid + NTHREADS * j; wv4[j] = *(const f32x4*)(w_in + (size_t)(q >> 1) * NIN + C_IW + 4 * (q & 1)); }
#pragma unroll
        for (int j = 0; j < 4; ++j) { const int q = tid + NTHREADS * j; *(LAS f32x4*)(wiw + 4 * q) = wv4[j]; }
    }
    __syncthreads();
    const int gw = blockIdx.x * NWAVES + wave, NGW = gridDim.x * NWAVES;
    f32x4 gv[4];
#pragma unroll
    for (int j = 0; j < 4; ++j) gv[j] = *(const f32x4*)(g + 4 * (lane + 64 * j));
    f32x4 vn[4];
#pragma unroll
    for (int j = 0; j < 4; ++j) vn[j] = *(const f32x4*)(x + (size_t)(gw < NTOK ? gw : 0) * DM + 4 * (lane + 64 * j));
    for (int t = gw; t < NTOK; t += NGW) {
        const int b = t / SEQ; const float* sh = mod + b * 6144, * sc = sh + 1024;
        f32x4 v[4]; float ss = 0.f;
#pragma unroll
        for (int j = 0; j < 4; ++j) { v[j] = vn[j]; ss += (v[j].x * v[j].x + v[j].y * v[j].y) + (v[j].z * v[j].z + v[j].w * v[j].w); }
        if (t + NGW < NTOK) {
#pragma unroll
            for (int j = 0; j < 4; ++j) vn[j] = *(const f32x4*)(x + (size_t)(t + NGW) * DM + 4 * (lane + 64 * j)); }
        const float r = 1.0f / sqrtf(wave_sum(ss) * (1.f / DM) + RMS_EPS);
        float iw[8];
#pragma unroll
        for (int q = 0; q < 8; ++q) iw[q] = 0.f;
#pragma unroll
        for (int j = 0; j < 4; ++j) { const int k0 = 4 * (lane + 64 * j);
            const f32x4 s4 = *(const f32x4*)(sc + k0), h4 = *(const f32x4*)(sh + k0);
            f32x4 hv = (v[j] * r * gv[j]) * (s4 + 1.0f) + h4;
            *(uint2*)(H + (size_t)t * DM + k0) = make_uint2(pk2(hv.x, hv.y), pk2(hv.z, hv.w));
#pragma unroll
            for (int i = 0; i < 4; ++i) { const f32x4 w0 = *(const LAS f32x4*)(wiw + (k0 + i) * 8), w1 = *(const LAS f32x4*)(wiw + (k0 + i) * 8 + 4);
                iw[0] += hv[i] * w0.x; iw[1] += hv[i] * w0.y; iw[2] += hv[i] * w0.z; iw[3] += hv[i] * w0.w;
                iw[4] += hv[i] * w1.x; iw[5] += hv[i] * w1.y; iw[6] += hv[i] * w1.z; iw[7] += hv[i] * w1.w; } }
#pragma unroll
        for (int i = 0; i < 4; ++i) { const bool up = (lane & 32) != 0; const float snd = up ? iw[i] : iw[i + 4], kp = up ? iw[i + 4] : iw[i]; iw[i] = kp + __shfl_xor(snd, 32); }
#pragma unroll
        for (int i = 0; i < 2; ++i) { const bool up = (lane & 16) != 0; const float snd = up ? iw[i] : iw[i + 2], kp = up ? iw[i + 2] : iw[i]; iw[i] = kp + __shfl_xor(snd, 16); }
        { const bool up = (lane & 8) != 0; const float snd = up ? iw[0] : iw[1], kp = up ? iw[1] : iw[0]; iw[0] = kp + __shfl_xor(snd, 8); }
        { float r8 = iw[0]; r8 += __shfl_xor(r8, 4); r8 += __shfl_xor(r8, 2); r8 += __shfl_xor(r8, 1);
          if ((lane & 7) == 0) IW[(size_t)t * 8 + (lane >> 3)] = r8 * 0.04419417382415922f; }
    }
}


__device__ __forceinline__ void router_tail(float (&pe)[32], const float* rb, int lane, int t, int* topi, float* topg, LAS int* cnt) {
#pragma unroll
    for (int i = 0; i < 8; ++i) { const bool up = (lane & 16) != 0; const float snd = up ? pe[i] : pe[i + 8], kp = up ? pe[i + 8] : pe[i]; pe[i] = kp + __shfl_xor(snd, 16); }
#pragma unroll
    for (int i = 0; i < 4; ++i) { const bool up = (lane & 8) != 0; const float snd = up ? pe[i] : pe[i + 4], kp = up ? pe[i + 4] : pe[i]; pe[i] = kp + __shfl_xor(snd, 8); }
#pragma unroll
    for (int i = 0; i < 2; ++i) { const bool up = (lane & 4) != 0; const float snd = up ? pe[i] : pe[i + 2], kp = up ? pe[i + 2] : pe[i]; pe[i] = kp + __shfl_xor(snd, 4); }
    { const bool up = (lane & 2) != 0; const float snd = up ? pe[0] : pe[1], kp = up ? pe[1] : pe[0]; pe[0] = kp + __shfl_xor(snd, 2); }
    const int myE = lane >> 1;
    float lv = pe[0] + __shfl_xor(pe[0], 1) + rb[myE];
    int idx[4]; float val[4];
#pragma unroll
    for (int k = 0; k < 4; ++k) { float m = lv;
#pragma unroll
        for (int o = 1; o < 64; o <<= 1) m = fmaxf(m, __shfl_xor(m, o));
        const unsigned long long bm = __ballot(lv == m);
        const int e = __builtin_ctzll(bm) >> 1;
        idx[k] = e; val[k] = m; if (myE == e) lv = -INFINITY; }
    if (lane == 0) {
        float ex[4], sum = 0.f;
#pragma unroll
        for (int k = 0; k < 4; ++k) { ex[k] = __expf(val[k] - val[0]); sum += ex[k]; }
        const float inv = 1.f / sum;
        *(int4*)(topi + t * 4) = make_int4(idx[0], idx[1], idx[2], idx[3]);
        *(f32x4*)(topg + t * 4) = (f32x4){ex[0] * inv, ex[1] * inv, ex[2] * inv, ex[3] * inv};
#pragma unroll
        for (int k = 0; k < 4; ++k) atomicAdd((int*)&cnt[idx[k]], 1);
    }
}
__device__ __forceinline__ void phase_norm2(const Params& p, LAS unsigned char* lds, int tid, int lane, int wave) {
    unsigned char* ws = p.ws;
    const float* x1 = p.out; const float* g = p.in[3]; const float* rw = p.in[16]; const float* rb = p.in[17]; const float* mod = (const float*)(ws + WS_MOD);
    bf16_t* H = (bf16_t*)(ws + WS_H); int* topi = (int*)(ws + WS_TOPI); float* topg = (float*)(ws + WS_TOPG); int* chcnt = (int*)(ws + WS_CHCNT);
    LAS float* rwl = (LAS float*)lds;
    {
        f32x4 rv[16];
#pragma unroll
        for (int j = 0; j < 16; ++j) rv[j] = *(const f32x4*)(rw + 4 * (tid + NTHREADS * j));
#pragma unroll
        for (int j = 0; j < 16; ++j) { const int i = 4 * (tid + NTHREADS * j), k = i >> 5, e = i & 31;
            rwl[e * 1028 + k] = rv[j][0]; rwl[(e + 1) * 1028 + k] = rv[j][1]; rwl[(e + 2) * 1028 + k] = rv[j][2]; rwl[(e + 3) * 1028 + k] = rv[j][3]; }
    }
    LAS int* cnt = (LAS int*)(lds + 32 * 1028 * 4);
    __syncthreads();
    for (int ch = blockIdx.x; ch < NCHUNK; ch += gridDim.x) {
        if (tid < 32) cnt[tid] = 0;
        __syncthreads();
        f32x4 xa[4], xb[4];
#pragma unroll
        for (int j = 0; j < 4; ++j) { xa[j] = *(const f32x4*)(x1 + (size_t)(ch * CHTOK + wave * 16) * DM + 4 * (lane + 64 * j)); xb[j] = *(const f32x4*)(x1 + (size_t)(ch * CHTOK + wave * 16 + 1) * DM + 4 * (lane + 64 * j)); }
        for (int rr = 0; rr < 16; rr += 2) {
            const int t0r = ch * CHTOK + wave * 16 + rr, b = t0r / SEQ; const float* sh = mod + b * 6144 + 3 * 1024, * sc = sh + 1024;
            f32x4 hv0[4], hv1[4];
#define N2_ROW(HV, T_, XS) do { f32x4 v[4]; float ss = 0.f; \
                _Pragma("unroll") for (int j = 0; j < 4; ++j) { v[j] = XS[j]; ss += (v[j].x * v[j].x + v[j].y * v[j].y) + (v[j].z * v[j].z + v[j].w * v[j].w); } \
                const float r = 1.0f / sqrtf(wave_sum(ss) * (1.f / DM) + RMS_EPS); \
                _Pragma("unroll") for (int j = 0; j < 4; ++j) { const int k0 = 4 * (lane + 64 * j); \
                    const f32x4 s4 = *(const f32x4*)(sc + k0), h4 = *(const f32x4*)(sh + k0); \
                    HV[j] = (v[j] * r * *(const f32x4*)(g + k0)) * (s4 + 1.0f) + h4; \
                    *(uint2*)(H + (size_t)(T_) * DM + k0) = make_uint2(pk2(HV[j].x, HV[j].y), pk2(HV[j].z, HV[j].w)); } } while (0)
            N2_ROW(hv0, t0r, xa); N2_ROW(hv1, t0r + 1, xb);
#undef N2_ROW
            if (rr + 2 < 16) {
#pragma unroll
                for (int j = 0; j < 4; ++j) { xa[j] = *(const f32x4*)(x1 + (size_t)(t0r + 2) * DM + 4 * (lane + 64 * j)); xb[j] = *(const f32x4*)(x1 + (size_t)(t0r + 3) * DM + 4 * (lane + 64 * j)); } }
            float pe0[32], pe1[32];
#pragma unroll
            for (int i = 0; i < 16; ++i) { float a0 = 0.f, a1 = 0.f, b0 = 0.f, b1 = 0.f;
#pragma unroll
                for (int j = 0; j < 4; ++j) { const f32x4 wa = *(const LAS f32x4*)(rwl + i * 1028 + 4 * (lane + 64 * j)), wb = *(const LAS f32x4*)(rwl + (i + 16) * 1028 + 4 * (lane + 64 * j));
                    a0 += (hv0[j].x * wa.x + hv0[j].y * wa.y) + (hv0[j].z * wa.z + hv0[j].w * wa.w); a1 += (hv1[j].x * wa.x + hv1[j].y * wa.y) + (hv1[j].z * wa.z + hv1[j].w * wa.w);
                    b0 += (hv0[j].x * wb.x + hv0[j].y * wb.y) + (hv0[j].z * wb.z + hv0[j].w * wb.w); b1 += (hv1[j].x * wb.x + hv1[j].y * wb.y) + (hv1[j].z * wb.z + hv1[j].w * wb.w); }
                const bool up = (lane & 32) != 0;
                pe0[i] = (up ? b0 : a0) + __shfl_xor(up ? a0 : b0, 32); pe1[i] = (up ? b1 : a1) + __shfl_xor(up ? a1 : b1, 32);
                asm volatile("" ::: "memory"); }
            router_tail(pe0, rb, lane, t0r, topi, topg, cnt);
            router_tail(pe1, rb, lane, t0r + 1, topi, topg, cnt);
        }
        __syncthreads();
        if (tid < 32) chcnt[ch * 32 + tid] = cnt[tid];
        __syncthreads();
    }
}

__device__ __forceinline__ void phase_scatter(const Params& p, LAS unsigned char* lds, int tid, int lane, int wave) {
    unsigned char* ws = p.ws;
    const int* topi = (const int*)(ws + WS_TOPI); const int* chcnt = (const int*)(ws + WS_CHCNT);
    int* rowtok = (int*)(ws + WS_ROWTOK); int* rowsrc = (int*)(ws + WS_ROWSRC); int* tile_e = (int*)(ws + WS_TILEE); int2* rowmeta = (int2*)(ws + WS_ROWMETA); const float* topg = (const float*)(ws + WS_TOPG);
    LAS int* total = (LAS int*)lds; LAS int* before = total + 32; LAS int* padded = total + 64; LAS int* poff = total + 96; LAS int* ent = total + 160; LAS int* psum = total + 1024; LAS int* wcnt = total + 2048;
    for (int ch = blockIdx.x; ch < NCHUNK; ch += gridDim.x) {
        { const int e = tid & 31, part = tid >> 5; int tt = 0, bb = 0;
#pragma unroll 4
          for (int q = 0; q < 16; ++q) { const int c = part * 16 + q; const int v = chcnt[c * 32 + e]; tt += v; bb += (c < ch) ? v : 0; }
          psum[tid] = tt; psum[512 + tid] = bb; }
        { const int i = tid; ent[i] = topi[ch * CHTOK * 4 + i]; }
        __syncthreads();
        if (tid < 32) { int tt = 0, bb = 0;
#pragma unroll 1
            for (int q = 0; q < 16; ++q) { tt += psum[q * 32 + tid]; bb += psum[512 + q * 32 + tid]; }
            total[tid] = tt; before[tid] = bb; padded[tid] = (tt + 255) / 256 * 256; }
        __syncthreads();
        if (tid == 0) { int a = 0;
#pragma unroll 1
            for (int e = 0; e < 32; ++e) { poff[e] = a; a += padded[e]; } poff[32] = a; }
        __syncthreads();
        {
            const int myE = ent[tid]; int myRank = 0;
            const unsigned long long ltm = (1ull << lane) - 1ull;
#pragma unroll 1
            for (int e = 0; e < 32; ++e) { const unsigned long long mk = __ballot(myE == e);
                if (myE == e) myRank = __popcll(mk & ltm);
                if (lane == 0) wcnt[wave * 32 + e] = __popcll(mk); }
            __syncthreads();
            int pos = poff[myE] + before[myE] + myRank;
            for (int w2 = 0; w2 < wave; ++w2) pos += wcnt[w2 * 32 + myE];
            const int en = ch * CHTOK * 4 + tid; rowtok[pos] = en; rowsrc[pos] = en >> 2; rowmeta[pos] = make_int2(en, __float_as_int(topg[en]));
        }
        if (ch == 0) {
            for (int e = wave; e < 32; e += NWAVES) {
                const int p0 = poff[e], te = p0 + total[e], pe = p0 + padded[e];
                for (int r = te + lane; r < pe; r += 64) { rowtok[r] = -1; rowsrc[r] = 0; rowmeta[r] = make_int2(-1, 0); }
                for (int ti = p0 / 256 + lane; ti < pe / 256; ti += 64) tile_e[ti] = e; }
            if (tid == 0) tile_e[MAXTILES] = poff[32] / 256;
        }
        __syncthreads();
    }
}

__device__ __forceinline__ void phase_combine(const Params& p, int tid) {
    unsigned char* ws = p.ws; float* out = p.out; const bf16_t* Y = (const bf16_t*)(ws + WS_Y); const float* mod = (const float*)(ws + WS_MOD);
    const size_t nvec = (size_t)NTOK * DM / 8;
#pragma unroll 1
    for (size_t i = (size_t)blockIdx.x * NTHREADS + tid; i < nvec; i += (size_t)gridDim.x * NTHREADS) {
        const size_t o = i * 8; const int t = (int)(o / DM), n = (int)(o % DM), b = t / SEQ;
        const u32x4 a = __builtin_nontemporal_load((const u32x4*)(Y + o)), c = __builtin_nontemporal_load((const u32x4*)(Y + (size_t)NTOK * DM + o)), d = __builtin_nontemporal_load((const u32x4*)(Y + (size_t)2 * NTOK * DM + o));
        const float* g2 = mod + b * 6144 + 5 * 1024 + n;
        f32x4 o0 = *(const f32x4*)(out + o), o1 = *(const f32x4*)(out + o + 4);
        const f32x4 g0 = *(const f32x4*)g2, g1 = *(const f32x4*)(g2 + 4);
#define LO(u) __uint_as_float((u) << 16)
#define HI(u) __uint_as_float((u) & 0xffff0000u)
        o0.x += g0.x * (LO(a.x) + LO(c.x) + LO(d.x)); o0.y += g0.y * (HI(a.x) + HI(c.x) + HI(d.x));
        o0.z += g0.z * (LO(a.y) + LO(c.y) + LO(d.y)); o0.w += g0.w * (HI(a.y) + HI(c.y) + HI(d.y));
        o1.x += g1.x * (LO(a.z) + LO(c.z) + LO(d.z)); o1.y += g1.y * (HI(a.z) + HI(c.z) + HI(d.z));
        o1.z += g1.z * (LO(a.w) + LO(c.w) + LO(d.w)); o1.w += g1.w * (HI(a.w) + HI(c.w) + HI(d.w));
#undef LO
#undef HI
        *(f32x4*)(out + o) = o0; *(f32x4*)(out + o + 4) = o1;
    }
}

namespace da {
typedef float f32x16 __attribute__((ext_vector_type(16)));
typedef short s16x4 __attribute__((ext_vector_type(4)));
constexpr int KPL = 1040;
constexpr int KT_BYTES = 8 * KPL;
constexpr int VRS = 320;
constexpr int VT_BYTES = 64 * VRS;
constexpr int BUF_BYTES = 2 * KT_BYTES + VT_BYTES;
constexpr int OB_STRIDE = 132;
constexpr int WSF_OFF = 139264;
constexpr float C2 = 0.125f * 1.4426950408889634f;
__device__ __forceinline__ int crow(int r, int hi) { return (r & 3) + 8 * (r >> 2) + 4 * hi; }
__device__ __forceinline__ s16x4 vtr(const LAS unsigned char* p) { return __builtin_bit_cast(s16x4, __builtin_amdgcn_ds_read_tr16_b64_v4i16((LAS s16x4*)p)); }

__device__ __forceinline__ void phase(const Params& p, LAS unsigned char* lds, int tid, int lane, int wave, int& cvcur) {
    unsigned char* ws = p.ws; const bf16_t* PROJ = (const bf16_t*)(ws + WS_PROJ); bf16_t* H = (bf16_t*)(ws + WS_H);
    const float lam = ((const float*)(ws + WS_LAM))[0]; const float* sub_g = p.in[11];
    const int wsel = wave >> 2, wq = wave & 3, r32 = lane & 31, hi = lane >> 5;
    LAS float* wsf = (LAS float*)(lds + WSF_OFF) + wave * 64;
    const int G = gridDim.x, vcu = (G % 8 == 0) ? ((int)blockIdx.x % 8) * (G / 8) + (int)blockIdx.x / 8 : (int)blockIdx.x;
    for (int id = vcu; id < 1024; id += G) {
        const int bh = (id >> 3) & 31, s = id & 7, ii = id >> 8;
        const int qb = (ii == 0) ? s : (ii == 1) ? 15 - s : (ii == 2) ? 16 + s : 31 - s;
        const int b = bh >> 2, h = bh & 3, q0 = qb * 128, NT = 2 * qb + 2, ntw = 2 * qb + 1 + (wq >> 1);
        const bf16_t* base = PROJ + (size_t)b * SEQ * NPJ;
        LAS unsigned char* qlds = lds + 81920 + wave * 4096 + lane * 16;
        { const bf16_t* Qrow = base + (size_t)(q0 + 32 * wq + r32) * NPJ + (wsel ? C_AQ2 : C_AQ1) + h * 64;
#pragma unroll
          for (int d0 = 0; d0 < 4; ++d0) *(LAS bf16x8*)(qlds + d0 * 1024) = *(const bf16x8*)(Qrow + 16 * d0 + 8 * hi); }
        float m = -INFINITY, l = 0.f;
        f32x16 o[4];
#pragma unroll
        for (int d0 = 0; d0 < 4; ++d0)
#pragma unroll
            for (int r = 0; r < 16; ++r) o[d0][r] = 0.f;
        const int skey = tid >> 3, sc = tid & 7, vkey = tid >> 4, vch = tid & 15;
        const bf16_t* srcK1 = base + (size_t)skey * NPJ + C_AK1 + h * 64 + 8 * sc;
        const bf16_t* srcK2 = base + (size_t)skey * NPJ + C_AK2 + h * 64 + 8 * sc;
        const bf16_t* srcV = base + (size_t)vkey * NPJ + C_AV + h * 128 + 8 * vch;
        const int dK = sc * KPL + skey * 16, dV = vkey * VRS + vch * 16;
        u32x4 st0, st1, st2, st3;
#define DA_LOAD(kt) do { const size_t ro = (size_t)(kt) * 64 * NPJ; st0 = *(const u32x4*)(srcK1 + ro); st1 = *(const u32x4*)(srcK2 + ro); \
        st2 = *(const u32x4*)(srcV + ro); st3 = *(const u32x4*)(srcV + ro + (size_t)32 * NPJ); } while (0)
#define DA_WRITE(bufi) do { LAS unsigned char* bb = lds + (bufi) * BUF_BYTES; *(LAS u32x4*)(bb + dK) = st0; *(LAS u32x4*)(bb + KT_BYTES + dK) = st1; \
        *(LAS u32x4*)(bb + 2 * KT_BYTES + dV) = st2; *(LAS u32x4*)(bb + 2 * KT_BYTES + dV + 32 * VRS) = st3; } while (0)
        DA_LOAD(0); DA_WRITE(0);
        __syncthreads();
        for (int kt = 0; kt < NT; ++kt) {
            if (kt + 1 < NT) DA_LOAD(kt + 1);
            if (kt < ntw) {
                const LAS unsigned char* bb = lds + (kt & 1) * BUF_BYTES;
                const LAS unsigned char* Kb = bb + wsel * KT_BYTES;
                const LAS unsigned char* Vb = bb + 2 * KT_BYTES;
                f32x16 p0, p1;
#pragma unroll
                for (int r = 0; r < 16; ++r) { p0[r] = 0.f; p1[r] = 0.f; }
#pragma unroll
                for (int d0 = 0; d0 < 4; ++d0) {
                    const bf16x8 a0 = *(const LAS bf16x8*)(Kb + (2 * d0 + hi) * KPL + r32 * 16);
                    const bf16x8 a1 = *(const LAS bf16x8*)(Kb + (2 * d0 + hi) * KPL + (r32 + 32) * 16);
                    const bf16x8 qf = *(const LAS bf16x8*)(qlds + d0 * 1024);
                    p0 = __builtin_amdgcn_mfma_f32_32x32x16_bf16(a0, qf, p0, 0, 0, 0);
                    p1 = __builtin_amdgcn_mfma_f32_32x32x16_bf16(a1, qf, p1, 0, 0, 0);
                }
                float mxa = fmaxf(p0[0], p1[0]), mxb = fmaxf(p0[1], p1[1]), mxc = fmaxf(p0[2], p1[2]), mxd = fmaxf(p0[3], p1[3]);
#pragma unroll
                for (int r = 4; r < 16; r += 4) { mxa = fmaxf(mxa, fmaxf(p0[r], p1[r])); mxb = fmaxf(mxb, fmaxf(p0[r + 1], p1[r + 1])); mxc = fmaxf(mxc, fmaxf(p0[r + 2], p1[r + 2])); mxd = fmaxf(mxd, fmaxf(p0[r + 3], p1[r + 3])); }
                float mx = fmaxf(fmaxf(mxa, mxb), fmaxf(mxc, mxd));
                mx = fmaxf(mx, __shfl_xor(mx, 32)) * C2;
                if (__any(mx - m > 8.0f)) {
                    const float mnew = fmaxf(m, mx);
                    const float f = __builtin_amdgcn_exp2f(m - mnew);
                    l *= f; m = mnew;
                    if (hi == 0) wsf[r32] = f;
                    asm volatile("s_waitcnt lgkmcnt(0)" ::: "memory");
#pragma unroll
                    for (int r = 0; r < 16; ++r) { const float fr = wsf[crow(r, hi)];
#pragma unroll
                        for (int d0 = 0; d0 < 4; ++d0) o[d0][r] *= fr; }
                }
                float lsa = 0.f, lsb = 0.f, lsc = 0.f, lsd = 0.f;
#pragma unroll
                for (int r = 0; r < 16; r += 4) {
                    p0[r] = __builtin_amdgcn_exp2f(p0[r] * C2 - m); p1[r] = __builtin_amdgcn_exp2f(p1[r] * C2 - m); lsa += p0[r] + p1[r];
                    p0[r + 1] = __builtin_amdgcn_exp2f(p0[r + 1] * C2 - m); p1[r + 1] = __builtin_amdgcn_exp2f(p1[r + 1] * C2 - m); lsb += p0[r + 1] + p1[r + 1];
                    p0[r + 2] = __builtin_amdgcn_exp2f(p0[r + 2] * C2 - m); p1[r + 2] = __builtin_amdgcn_exp2f(p1[r + 2] * C2 - m); lsc += p0[r + 2] + p1[r + 2];
                    p0[r + 3] = __builtin_amdgcn_exp2f(p0[r + 3] * C2 - m); p1[r + 3] = __builtin_amdgcn_exp2f(p1[r + 3] * C2 - m); lsd += p0[r + 3] + p1[r + 3]; }
                l += (lsa + lsb) + (lsc + lsd);
                bf16x8 pa[4];
#pragma unroll
                for (int ks = 0; ks < 2; ++ks) {
                    u32x4 w0, w1;
                    w0.x = gp::cvt_pk_bf16(p0[8 * ks + 0], p0[8 * ks + 1]); w0.y = gp::cvt_pk_bf16(p0[8 * ks + 2], p0[8 * ks + 3]);
                    w0.z = gp::cvt_pk_bf16(p0[8 * ks + 4], p0[8 * ks + 5]); w0.w = gp::cvt_pk_bf16(p0[8 * ks + 6], p0[8 * ks + 7]);
                    w1.x = gp::cvt_pk_bf16(p1[8 * ks + 0], p1[8 * ks + 1]); w1.y = gp::cvt_pk_bf16(p1[8 * ks + 2], p1[8 * ks + 3]);
                    w1.z = gp::cvt_pk_bf16(p1[8 * ks + 4], p1[8 * ks + 5]); w1.w = gp::cvt_pk_bf16(p1[8 * ks + 6], p1[8 * ks + 7]);
                    pa[ks] = __builtin_bit_cast(bf16x8, w0); pa[2 + ks] = __builtin_bit_cast(bf16x8, w1);
                }
                const LAS unsigned char* vp = Vb + (4 * hi + ((lane & 15) >> 2)) * VRS + (16 * ((lane >> 4) & 1) + 4 * (lane & 3)) * 2;
#pragma unroll
                for (int d0 = 0; d0 < 4; ++d0)
#pragma unroll
                    for (int ks = 0; ks < 4; ++ks) {
                        const s16x4 lo = vtr(vp + (16 * ks) * VRS + d0 * 64), hv = vtr(vp + (16 * ks + 8) * VRS + d0 * 64);
                        const bf16x8 vf = (bf16x8){lo[0], lo[1], lo[2], lo[3], hv[0], hv[1], hv[2], hv[3]};
                        o[d0] = __builtin_amdgcn_mfma_f32_32x32x16_bf16(pa[ks], vf, o[d0], 0, 0, 0);
                    }
            }
            if (kt + 1 < NT) DA_WRITE((kt + 1) & 1);
            __syncthreads();
        }
#undef DA_LOAD
#undef DA_WRITE
        l += __shfl_xor(l, 32);
        { const float fac = (wsel ? lam : 1.0f) / l;
          if (hi == 0) wsf[r32] = fac;
          asm volatile("s_waitcnt lgkmcnt(0)" ::: "memory"); }
        LAS float* Ob = (LAS float*)lds + wsel * (128 * OB_STRIDE);
#pragma unroll
        for (int r = 0; r < 16; ++r) { const float fr = wsf[crow(r, hi)]; const int row = 32 * wq + crow(r, hi);
#pragma unroll
            for (int d0 = 0; d0 < 4; ++d0) Ob[row * OB_STRIDE + 32 * d0 + r32] = o[d0][r] * fr; }
        __syncthreads();
        { const LAS float* O1 = (const LAS float*)lds; const LAS float* O2 = O1 + 128 * OB_STRIDE;
          const float g0 = sub_g[2 * lane], g1 = sub_g[2 * lane + 1];
          for (int rr = 0; rr < 16; ++rr) { const int row = 16 * wave + rr;
              const float d0v = O1[row * OB_STRIDE + 2 * lane] - O2[row * OB_STRIDE + 2 * lane], d1v = O1[row * OB_STRIDE + 2 * lane + 1] - O2[row * OB_STRIDE + 2 * lane + 1];
              const float ss = wave_sum(d0v * d0v + d1v * d1v);
              const float rs = (1.0f - LAMBDA_INIT) / sqrtf(ss * (1.f / 128.f) + RMS_EPS);
              *(unsigned*)(H + (size_t)(b * SEQ + q0 + row) * DM + h * 128 + 2 * lane) = pk2(d0v * rs * g0, d1v * rs * g1); } }
        __syncthreads();

    }
}
}
namespace ds {
typedef float f32x16 __attribute__((ext_vector_type(16)));
typedef short s16x4 __attribute__((ext_vector_type(4)));
typedef int i32x4 __attribute__((ext_vector_type(4)));
typedef unsigned u32x2 __attribute__((ext_vector_type(2)));
constexpr int HIST_OFF = 131072, SEL_OFF = 139264, OALL_OFF = 143360;
constexpr float C2 = 0.125f * 1.4426950408889634f;
__device__ __forceinline__ s16x4 vtr(const LAS unsigned char* p) { return __builtin_bit_cast(s16x4, __builtin_amdgcn_ds_read_tr16_b64_v4i16((LAS s16x4*)p)); }
__device__ __forceinline__ unsigned skey(float f) { unsigned u = __float_as_uint(f); if (u == 0x80000000u) u = 0u; return u ^ ((unsigned)((int)u >> 31) | 0x80000000u); }

template <int STOP> __device__ __forceinline__ void unit(const Params& p, LAS unsigned char* lds, int tid, int lane_in, int wave, int b, int qt, int& cvcur) {
    int lane = lane_in; asm volatile("" : "+v"(lane));
    unsigned char* ws = p.ws; const bf16_t* PROJ = (const bf16_t*)(ws + WS_PROJ); bf16_t* H = (bf16_t*)(ws + WS_H);
    const float* IW = (const float*)(ws + WS_IW);
    const int q0 = qt * 8, N = (q0 / 64 + 1) * 64, t0 = b * SEQ + q0;
    const bf16_t* base = PROJ + (size_t)b * SEQ * NPJ;
    LAS float* S = (LAS float*)lds;
    const int r32 = lane & 31, hi = lane >> 5;
    {
        bf16x8 aq[2][4]; f32x4 wv[2][4];
#pragma unroll
        for (int rb = 0; rb < 2; ++rb) {
            const bf16_t* qrow = base + (size_t)(q0 + 4 * rb + 2 * ((r32 >> 2) & 1) + (r32 >> 4)) * NPJ + C_IQ + (4 * ((r32 >> 3) & 1) + (r32 & 3)) * 64 + 8 * hi;
#pragma unroll
            for (int d0 = 0; d0 < 4; ++d0) aq[rb][d0] = *(const bf16x8*)(qrow + 16 * d0);
#pragma unroll
            for (int qq = 0; qq < 4; ++qq) wv[rb][qq] = *(const f32x4*)(IW + (size_t)(t0 + 4 * rb + 2 * hi + (qq >> 1)) * 8 + 4 * (qq & 1));
        }
        const int ntk = N / 32;
        bf16x8 bk[4], bkn[4];
        const unsigned char* ikf = ws + WS_IKF + (size_t)b * 128 * 4096 + lane * 16;
        { const unsigned char* kp = ikf + (size_t)(wave < ntk ? wave : 0) * 4096;
#pragma unroll
          for (int d0 = 0; d0 < 4; ++d0) bkn[d0] = *(const bf16x8*)(kp + d0 * 1024); }
        for (int kt = wave; kt < ntk; kt += NWAVES) {
#pragma unroll
            for (int d0 = 0; d0 < 4; ++d0) bk[d0] = bkn[d0];
            if (kt + NWAVES < ntk) { const unsigned char* kp = ikf + (size_t)(kt + NWAVES) * 4096;
#pragma unroll
                for (int d0 = 0; d0 < 4; ++d0) bkn[d0] = *(const bf16x8*)(kp + d0 * 1024); }
#pragma unroll
            for (int rb = 0; rb < 2; ++rb) {
                f32x16 acc;
#pragma unroll
                for (int r = 0; r < 16; ++r) acc[r] = 0.f;
#pragma unroll
                for (int d0 = 0; d0 < 4; ++d0) acc = __builtin_amdgcn_mfma_f32_32x32x16_bf16(aq[rb][d0], bk[d0], acc, 0, 0, 0);
                float v0 = 0.f, v1 = 0.f;
#pragma unroll
                for (int i = 0; i < 4; ++i) { v0 += wv[rb][0][i] * fmaxf(acc[i], 0.f) + wv[rb][1][i] * fmaxf(acc[4 + i], 0.f);
                                               v1 += wv[rb][2][i] * fmaxf(acc[8 + i], 0.f) + wv[rb][3][i] * fmaxf(acc[12 + i], 0.f); }
                S[(4 * rb + 2 * hi) * 4096 + 32 * kt + r32] = v0;
                S[(4 * rb + 2 * hi + 1) * 4096 + 32 * kt + r32] = v1;
            }
        }
    }
    __syncthreads();
    if (STOP == 1) return;
    asm volatile("" : "+v"(lane));
    LAS float* Sw = S + wave * 4096;
    LAS unsigned short* sel = (LAS unsigned short*)(lds + SEL_OFF) + wave * 256;
    const int nsel = N < 256 ? N : 256;
    if (N <= 256) {
        for (int i = lane; i < N; i += 64) sel[i] = (unsigned short)i;
    } else {
        LAS unsigned* hist = (LAS unsigned*)(lds + OALL_OFF) + wave * 512;
        LAS float* cv = (LAS float*)(lds + HIST_OFF) + wave * 256; LAS int* ci = (LAS int*)cv + 128;
        const unsigned long long ltmask = (1ull << lane) - 1ull;
        const int nit = (N + 255) / 256;
        float t0 = -INFINITY, t1 = -INFINITY, t2 = -INFINITY, t3 = -INFINITY;
#pragma unroll 4
        for (int it = 0; it < nit; ++it) { if (256 * it + 4 * lane < N) { const f32x4 v4 = *(const LAS f32x4*)(Sw + 256 * it + 4 * lane);
#pragma unroll
            for (int q = 0; q < 4; ++q) { const float v = v4[q];
                const float n3 = fmaxf(t3, fminf(t2, v)), n2 = fmaxf(t2, fminf(t1, v)), n1 = fmaxf(t1, fminf(t0, v)); t0 = fmaxf(t0, v); t1 = n1; t2 = n2; t3 = n3; } } }
        float mn = t3, mx = t0;
#pragma unroll
        for (int o = 1; o < 64; o <<= 1) { mn = fminf(mn, __shfl_xor(mn, o)); mx = fmaxf(mx, __shfl_xor(mx, o)); }
        bool done = false;
        if (mx > mn) {
            const float scale = 1024.0f / (mx - mn);
            *(LAS u32x4*)(hist + 8 * lane) = (u32x4){0u, 0u, 0u, 0u}; *(LAS u32x4*)(hist + 8 * lane + 4) = (u32x4){0u, 0u, 0u, 0u};
            asm volatile("s_waitcnt lgkmcnt(0)" ::: "memory");
#pragma unroll 4
            for (int it = 0; it < nit; ++it) { if (256 * it + 4 * lane < N) { const f32x4 v4 = *(const LAS f32x4*)(Sw + 256 * it + 4 * lane);
#pragma unroll
                for (int q = 0; q < 4; ++q) { if (v4[q] >= mn) { int bn = (int)((v4[q] - mn) * scale); bn = bn > 1023 ? 1023 : bn;
                    __hip_atomic_fetch_add(hist + (bn >> 1), 1u << (16 * (bn & 1)), __ATOMIC_RELAXED, __HIP_MEMORY_SCOPE_WORKGROUP); } } } }
            asm volatile("s_waitcnt lgkmcnt(0)" ::: "memory");
            unsigned wq[8];
            { const u32x4 h0 = *(LAS u32x4*)(hist + 8 * lane), h1 = *(LAS u32x4*)(hist + 8 * lane + 4);
              wq[0] = h0.x; wq[1] = h0.y; wq[2] = h0.z; wq[3] = h0.w; wq[4] = h1.x; wq[5] = h1.y; wq[6] = h1.z; wq[7] = h1.w; }
            int sl = 0;
#pragma unroll
            for (int q = 0; q < 8; ++q) sl += (int)(wq[q] & 0xffffu) + (int)(wq[q] >> 16);
            int v = sl;
#pragma unroll
            for (int o = 1; o < 64; o <<= 1) { const int t = __shfl_down(v, o); v += (lane + o < 64) ? t : 0; }
            int ab = v - sl, myB = -1, myAbove = 0, myCnt = 0;
#pragma unroll
            for (int q = 15; q >= 0; --q) { const int cq = (int)((wq[q >> 1] >> (16 * (q & 1))) & 0xffffu);
                if (myB < 0 && ab < 256 && 256 <= ab + cq) { myB = 16 * lane + q; myAbove = ab; myCnt = cq; }
                ab += cq; }
            const unsigned long long bal = __ballot(myB >= 0);
            const int src = __builtin_ctzll(bal);
            const int B = __shfl(myB, src), C = __shfl(myCnt, src), need = 256 - __shfl(myAbove, src);
            if (C <= 128) {
                int outpos = 0, cp = 0;
#pragma unroll 2
                for (int it = 0; it < nit; ++it) { const bool inr = 256 * it + 4 * lane < N; const f32x4 v4 = *(const LAS f32x4*)(Sw + 256 * it + 4 * (inr ? lane : 0));
#pragma unroll
                    for (int q = 0; q < 4; ++q) { int bn = (int)((v4[q] - mn) * scale); bn = bn > 1023 ? 1023 : bn;
                        const bool inb = inr && v4[q] >= mn, take = inb && bn > B, cd = inb && bn == B; const int idx = 256 * it + 4 * lane + q;
                        const unsigned long long bt = __ballot(take), bc = __ballot(cd);
                        if (take) sel[outpos + __popcll(bt & ltmask)] = (unsigned short)idx;
                        if (cd) { const int pos = cp + __popcll(bc & ltmask); cv[pos] = v4[q]; ci[pos] = idx; }
                        outpos += __popcll(bt); cp += __popcll(bc); } }
                asm volatile("s_waitcnt lgkmcnt(0)" ::: "memory");
                const float v0 = lane < C ? cv[lane] : -INFINITY, v1 = lane + 64 < C ? cv[lane + 64] : -INFINITY;
                const int i0 = lane < C ? ci[lane] : 0x7fffffff, i1 = lane + 64 < C ? ci[lane + 64] : 0x7fffffff;
                int r0 = 0, r1 = 0;
                for (int q = 0; q < C; ++q) { const float ov = cv[q]; const int oi = ci[q];
                    r0 += (ov > v0 || (ov == v0 && oi < i0)) ? 1 : 0; r1 += (ov > v1 || (ov == v1 && oi < i1)) ? 1 : 0; }
                const bool t0 = lane < C && r0 < need, t1 = lane + 64 < C && r1 < need;
                const unsigned long long b0 = __ballot(t0);
                if (t0) sel[outpos + __popcll(b0 & ltmask)] = (unsigned short)i0;
                outpos += __popcll(b0);
                const unsigned long long b1 = __ballot(t1);
                if (t1) sel[outpos + __popcll(b1 & ltmask)] = (unsigned short)i1;
                done = true;
            }
        }
        if (!done) {
            {
                LAS int* h8 = (LAS int*)hist;
                unsigned prefix = 0u; int need8 = 256;
#pragma unroll 1
                for (int pass = 0; pass < 4; ++pass) {
                    const int shift = 24 - 8 * pass;
                    *(LAS i32x4*)(h8 + 4 * lane) = (i32x4){0, 0, 0, 0};
                    asm volatile("s_waitcnt lgkmcnt(0)" ::: "memory");
                    for (int j = 0; j < N / 64; ++j) { const unsigned u = skey(Sw[64 * j + lane]);
                        if (pass == 0 || (u >> (shift + 8)) == prefix) __hip_atomic_fetch_add((int*)(h8 + ((u >> shift) & 255u)), 1, __ATOMIC_RELAXED, __HIP_MEMORY_SCOPE_WORKGROUP); }
                    asm volatile("s_waitcnt lgkmcnt(0)" ::: "memory");
                    const i32x4 c = *(LAS i32x4*)(h8 + 4 * lane);
                    const int s4 = c.x + c.y + c.z + c.w; int vv = s4;
#pragma unroll
                    for (int o = 1; o < 64; o <<= 1) { const int t = __shfl_down(vv, o); vv += (lane + o < 64) ? t : 0; }
                    const int a3 = vv - s4, a2 = a3 + c.w, a1 = a2 + c.z, a0 = a1 + c.y;
                    int mB = -1, mA = 0;
                    if (a3 < need8 && need8 <= a3 + c.w) { mB = 4 * lane + 3; mA = a3; }
                    else if (a2 < need8 && need8 <= a2 + c.z) { mB = 4 * lane + 2; mA = a2; }
                    else if (a1 < need8 && need8 <= a1 + c.y) { mB = 4 * lane + 1; mA = a1; }
                    else if (a0 < need8 && need8 <= a0 + c.x) { mB = 4 * lane; mA = a0; }
                    const int sr = __builtin_ctzll(__ballot(mB >= 0));
                    need8 -= __shfl(mA, sr); prefix = (prefix << 8) | (unsigned)__shfl(mB, sr);
                }
                int outpos = 0, eqtaken = 0;
                for (int j = 0; j < N / 64; ++j) { const unsigned u = skey(Sw[64 * j + lane]);
                    const bool eq = (u == prefix); const unsigned long long beq = __ballot(eq);
                    const bool take = (u > prefix) || (eq && (eqtaken + __popcll(beq & ltmask) < need8));
                    const unsigned long long bt = __ballot(take);
                    if (take) sel[outpos + __popcll(bt & ltmask)] = (unsigned short)(64 * j + lane);
                    outpos += __popcll(bt); eqtaken += __popcll(beq); }
            }
        }
    }
    asm volatile("s_waitcnt lgkmcnt(0)" ::: "memory");
    if (STOP == 2) { __syncthreads(); return; }
    asm volatile("" : "+v"(lane));
    {
        const int n16 = lane & 15, g = lane >> 4, t = t0 + wave;
        bf16x8 bqf[2];
#pragma unroll
        for (int ks = 0; ks < 2; ++ks) { bqf[ks] = (bf16x8){0, 0, 0, 0, 0, 0, 0, 0};
            if (n16 < 8) bqf[ks] = *(const bf16x8*)(PROJ + (size_t)t * NPJ + C_BQ + n16 * 64 + 32 * ks + 8 * g); }
        const int nstep = nsel / 32;
        LAS unsigned char* Lb = (LAS unsigned char*)Sw;
        f32x4 ot[8];
#pragma unroll
        for (int cb = 0; cb < 8; ++cb) ot[cb] = (f32x4){0.f, 0.f, 0.f, 0.f};
        float mrun = -INFINITY, lsum = 0.f;
        bf16x8 kA[4], kB[4]; u32x4 stA[8], stB[8];
#define DS_LOADCH(KF, ST, s_) do { \
            { const bf16_t* kr = base + (size_t)sel[32 * (s_) + n16] * NPJ + C_BK + 8 * g; KF[0] = *(const bf16x8*)kr; KF[1] = *(const bf16x8*)(kr + 32); } \
            { const bf16_t* kr = base + (size_t)sel[32 * (s_) + 16 + n16] * NPJ + C_BK + 8 * g; KF[2] = *(const bf16x8*)kr; KF[3] = *(const bf16x8*)(kr + 32); } \
            _Pragma("unroll") for (int i = 0; i < 8; ++i) ST[i] = *(const u32x4*)(base + (size_t)sel[32 * (s_) + 4 * i + g] * NPJ + C_BLAT + 8 * n16); } while (0)
#define DS_PROC(KF, ST) do { \
            f32x4 a0 = (f32x4){0.f, 0.f, 0.f, 0.f}, a1 = (f32x4){0.f, 0.f, 0.f, 0.f}; \
            a0 = __builtin_amdgcn_mfma_f32_16x16x32_bf16(KF[0], bqf[0], a0, 0, 0, 0); a0 = __builtin_amdgcn_mfma_f32_16x16x32_bf16(KF[1], bqf[1], a0, 0, 0, 0); \
            a1 = __builtin_amdgcn_mfma_f32_16x16x32_bf16(KF[2], bqf[0], a1, 0, 0, 0); a1 = __builtin_amdgcn_mfma_f32_16x16x32_bf16(KF[3], bqf[1], a1, 0, 0, 0); \
            float cm = fmaxf(fmaxf(fmaxf(a0[0], a0[1]), fmaxf(a0[2], a0[3])), fmaxf(fmaxf(a1[0], a1[1]), fmaxf(a1[2], a1[3]))); \
            cm = fmaxf(cm, __shfl_xor(cm, 16)); cm = fmaxf(cm, __shfl_xor(cm, 32)); cm *= C2; \
            if (__any(cm - mrun > 8.0f)) { const float mnew = fmaxf(mrun, cm); const float f = __builtin_amdgcn_exp2f(mrun - mnew); lsum *= f; mrun = mnew; \
                _Pragma("unroll") for (int cb = 0; cb < 8; ++cb) ot[cb] = ot[cb] * f; } \
            float e[8]; \
            _Pragma("unroll") for (int i = 0; i < 4; ++i) { e[i] = __builtin_amdgcn_exp2f(a0[i] * C2 - mrun); e[4 + i] = __builtin_amdgcn_exp2f(a1[i] * C2 - mrun); } \
            lsum += ((e[0] + e[1]) + (e[2] + e[3])) + ((e[4] + e[5]) + (e[6] + e[7])); \
            u32x4 pw; pw.x = gp::cvt_pk_bf16(e[0], e[1]); pw.y = gp::cvt_pk_bf16(e[2], e[3]); pw.z = gp::cvt_pk_bf16(e[4], e[5]); pw.w = gp::cvt_pk_bf16(e[6], e[7]); \
            const bf16x8 pbv = __builtin_bit_cast(bf16x8, pw); \
            _Pragma("unroll") for (int i = 0; i < 8; ++i) { const int sig = 4 * i + g, ch = n16; \
                *(LAS u32x4*)(Lb + sig * 256 + (((ch >> 1) ^ (sig & 7)) * 32) + (ch & 1) * 16) = ST[i]; } \
            asm volatile("s_waitcnt lgkmcnt(0)" ::: "memory"); \
            const int rq = 4 * g + (n16 >> 2); \
            _Pragma("unroll") for (int cb = 0; cb < 8; ++cb) { \
                const s16x4 lo = vtr(Lb + rq * 256 + ((cb ^ (rq & 7)) * 32) + 8 * (lane & 3)); \
                const s16x4 hv = vtr(Lb + (16 + rq) * 256 + ((cb ^ (rq & 7)) * 32) + 8 * (lane & 3)); \
                const bf16x8 af = (bf16x8){lo[0], lo[1], lo[2], lo[3], hv[0], hv[1], hv[2], hv[3]}; \
                ot[cb] = __builtin_amdgcn_mfma_f32_16x16x32_bf16(af, pbv, ot[cb], 0, 0, 0); } \
            asm volatile("s_waitcnt lgkmcnt(0)" ::: "memory"); } while (0)
        DS_LOADCH(kA, stA, 0);
#pragma unroll 1
        for (int s = 0; s < nstep; s += 2) {
            DS_LOADCH(kB, stB, s + 1);
            DS_PROC(kA, stA);
            if (s + 2 < nstep) DS_LOADCH(kA, stA, s + 2);
            DS_PROC(kB, stB);
        }
#undef DS_LOADCH
#undef DS_PROC
        lsum += __shfl_xor(lsum, 16); lsum += __shfl_xor(lsum, 32);
        const float linv = 1.0f / lsum;
        if (n16 < 8) {
            LAS bf16_t* Oall = (LAS bf16_t*)(lds + OALL_OFF) + (wave * 8 + n16) * 128;
#pragma unroll
            for (int cb = 0; cb < 8; ++cb) *(LAS u32x2*)(Oall + 16 * cb + 4 * g) = (u32x2){pk2(ot[cb][0] * linv, ot[cb][1] * linv), pk2(ot[cb][2] * linv, ot[cb][3] * linv)};
        }
    }
    __syncthreads();
    if (STOP == 3) return;
    asm volatile("" : "+v"(lane));
    P0Item cvi, cvj; f32x4 cva[8], cvb[8];
    const bool cvok = conv_expert_issue(p, lane, wave, cvcur, cvi, cva);
    const bool cvok2 = conv_expert_issue(p, lane, wave, cvcur, cvj, cvb);
    {
        const int n16 = lane & 15, g = lane >> 4, hh = wave;
        const bf16_t* WuvT = (const bf16_t*)(ws + WS_WUVT) + hh * 64 * 128;
        const LAS bf16_t* Oall = (const LAS bf16_t*)(lds + OALL_OFF) + ((n16 & 7) * 8 + hh) * 128;
        bf16x8 af[4];
#pragma unroll
        for (int ks = 0; ks < 4; ++ks) af[ks] = *(const LAS bf16x8*)(Oall + 32 * ks + 8 * g);
#pragma unroll
        for (int nb = 0; nb < 4; ++nb) {
            f32x4 a = (f32x4){0.f, 0.f, 0.f, 0.f};
#pragma unroll
            for (int ks = 0; ks < 4; ++ks) { const bf16x8 bf = *(const bf16x8*)(WuvT + (16 * nb + n16) * 128 + 32 * ks + 8 * g);
                a = __builtin_amdgcn_mfma_f32_16x16x32_bf16(af[ks], bf, a, 0, 0, 0); }
            if (g < 2) {
#pragma unroll
                for (int i = 0; i < 4; ++i) H[(size_t)(t0 + 4 * g + i) * DM + 512 + hh * 64 + 16 * nb + n16] = f2bf(a[i]);
            }
        }
    }
    __syncthreads();
    if (cvok) p0_finish(cvi, cva, (LAS float*)(lds + wave * 8704), lane);
    if (cvok2) p0_finish(cvj, cvb, (LAS float*)(lds + wave * 8704), lane);
    __syncthreads();
}

template <int STOP> __device__ __forceinline__ void phase(const Params& p, LAS unsigned char* lds, int tid, int lane, int wave, int& cvcur) {
    const int G = gridDim.x, k = blockIdx.x;
    const bool nice = (G == 256);
    const int nit = nice ? 16 : (4096 - k + G - 1) / G;
    for (int i = 0; i < nit; ++i) {
        int b, qt;
        if (nice) { const int j = k >> 3; b = k & 7; qt = 511 - (i * 32 + ((i & 1) ? 31 - j : j)); }
        else { const int u = k + i * G; b = u & 7; qt = 511 - (u >> 3); }
        unit<STOP>(p, lds, tid, lane, wave, b, qt, cvcur);
    }
}
}

#define XB_TMO      128
#define XB_XCNT(j)  (256  + 64 * (j))
#define XB_XSUB(j)  (1280 + 64 * (j))
#define XB_XGEN(j)  (2304 + 64 * (j))
#define XB_TOP      3328
#define XB_TOPGEN   3392
#define XCD_BAR_WORDS 3456
#define XB_SPIN_CAP (1u << 22)
__device__ __forceinline__ unsigned xb_ld(unsigned* p)              { return __hip_atomic_load(p, __ATOMIC_RELAXED, __HIP_MEMORY_SCOPE_AGENT); }
__device__ __forceinline__ unsigned xb_add(unsigned* p, unsigned v) { return __hip_atomic_fetch_add(p, v, __ATOMIC_RELAXED, __HIP_MEMORY_SCOPE_AGENT); }
__device__ __forceinline__ unsigned xb_xcc_id() { return (unsigned)__builtin_amdgcn_s_getreg((3 << 11) | 20) & 0xFu; }
#define XB_SPIN(cond, bar) do { unsigned _sp = 0; while (cond) { __builtin_amdgcn_s_sleep(1); \
    if ((++_sp & 255u) == 0u) { if (xb_ld(&(bar)[XB_TMO])) break; if (_sp > XB_SPIN_CAP) { atomicAdd(&(bar)[XB_TMO], 1u); break; } } } } while (0)
struct XcdBarrier { unsigned* bar; unsigned x; volatile LAS unsigned* st; };
__device__ __forceinline__ XcdBarrier xcd_barrier_post(unsigned* bar, volatile LAS unsigned* st) {
    XcdBarrier b; b.bar = bar; b.x = xb_xcc_id(); b.st = st;
    if (threadIdx.x == 0) (void)xb_add(&bar[XB_XCNT(b.x)], 1u);
    return b;
}
__device__ __forceinline__ void xcd_barrier_complete(unsigned* bar, unsigned x, unsigned& nloc, unsigned& nx) {
    const unsigned G = gridDim.x * gridDim.y * gridDim.z;
    unsigned sum, cnt, mine, sp = 0u;
    for (;;) {
        sum = 0u; cnt = 0u; mine = 0u;
#pragma unroll
        for (unsigned j = 0; j < 16; ++j) { const unsigned c = xb_ld(&bar[XB_XCNT(j)]); sum += c; cnt += (c > 0u) ? 1u : 0u; mine = (j == x) ? c : mine; }
        if (sum == G) break;
        __builtin_amdgcn_s_sleep(1);
        if ((++sp & 255u) == 0u) { if (xb_ld(&bar[XB_TMO])) break; if (sp > XB_SPIN_CAP) { atomicAdd(&bar[XB_TMO], 1u); break; } }
    }
    nloc = mine > 0u ? mine : 1u; nx = cnt > 0u ? cnt : 1u;
}
__device__ __forceinline__ void xcd_barrier(const XcdBarrier& b) {
    asm volatile("s_waitcnt vmcnt(0)" ::: "memory");
    __syncthreads();
    if (threadIdx.x == 0) {
        unsigned* bar = b.bar;
        __builtin_amdgcn_s_waitcnt(0);
        unsigned nloc = b.st[0], nx = b.st[1];
        if (nloc == 0u) { xcd_barrier_complete(bar, b.x, nloc, nx); b.st[0] = nloc; b.st[1] = nx; }
        const unsigned old = xb_add(&bar[XB_XSUB(b.x)], 1u);
        const unsigned gen = old / nloc;
        if (old + 1u == (gen + 1u) * nloc) {
            __builtin_amdgcn_fence(__ATOMIC_RELEASE, "agent");
            asm volatile("s_waitcnt vmcnt(0)" ::: "memory");
            const unsigned og = xb_add(&bar[XB_TOP], 1u);
            const unsigned tg = og / nx;
            if (og + 1u == (tg + 1u) * nx) xb_add(&bar[XB_TOPGEN], 1u);
            else XB_SPIN(xb_ld(&bar[XB_TOPGEN]) == tg, bar);
            __builtin_amdgcn_fence(__ATOMIC_ACQUIRE, "agent");
            xb_add(&bar[XB_XGEN(b.x)], 1u);
            asm volatile("s_waitcnt vmcnt(0)" ::: "memory");
        } else {
            XB_SPIN(xb_ld(&bar[XB_XGEN(b.x)]) == gen, bar);
            __builtin_amdgcn_fence(__ATOMIC_ACQUIRE, "agent");
            asm volatile("s_waitcnt vmcnt(0)" ::: "memory");
        }
    }
    __syncthreads();
}
constexpr int N_PHASES = 10;
__global__ void __launch_bounds__(NTHREADS, 2) mega(Params p) {
    extern __shared__ __attribute__((aligned(16))) unsigned char lds_raw[];
    LAS unsigned char* lds = (LAS unsigned char*)lds_raw;
    cg::grid_group grid = cg::this_grid();
    int tid = threadIdx.x, lane = tid & 63; const int wave = __builtin_amdgcn_readfirstlane(tid >> 6);
#define FRESH() do { tid = threadIdx.x; asm volatile("" : "+v"(tid)); lane = tid & 63; } while (0)
    unsigned char* ws = p.ws;
    const int lo = p.ph_lo, hi = p.ph_hi;
    volatile LAS unsigned* MISC = (volatile LAS unsigned*)(lds + LDS_MISC);
    if (tid < 16) MISC[tid] = 0u;
    __syncthreads();
    XcdBarrier bar = xcd_barrier_post((unsigned*)(ws + WS_CTL), MISC);
#define IN(k) (lo <= (k) && (k) < hi)
#define SEAM(k) do { if (IN(k) && IN((k) + 1)) xcd_barrier(bar); } while (0)
    if (lo < 0) grid.sync();
    if (IN(0)) { FRESH(); phase_prep(p, lds, tid, lane, wave); } SEAM(0);
    if (IN(1)) { FRESH(); phase_norm1(p, lds, tid, lane, wave); } SEAM(1);
    if (IN(2)) { FRESH();
        gp::Gemm g{(const bf16_t*)(ws + WS_H), (const bf16_t*)(ws + WS_WINT), NPJ, DM, nullptr};
        gp::StaticOrder S; S.init(NTOK, NPJ, gridDim.x, blockIdx.x);
        LAS float* gl = (LAS float*)(lds + LDS_RING + 8192);
        if (tid < 64) { gl[tid] = p.in[8][tid]; gl[64 + tid] = p.in[9][tid]; gl[128 + tid] = p.in[12][tid]; gl[192 + tid] = p.in[13][tid]; }
        if (tid < 128) gl[256 + tid] = p.in[14][tid];
        __syncthreads();
        gp::EpiInproj E{(bf16_t*)(ws + WS_PROJ), (const float*)(ws + WS_ROPE), gl, (LAS float*)(lds + LDS_RING), ws + WS_IKF};
        gp::gemm_phase<gp::EpiInproj, gp::StaticOrder, false>(lds, g, S, E);
    } SEAM(2);
    if (IN(3)) { int cvcur = 0;
        const bool dsa_first = (((int)blockIdx.x >> 3) & 1) != 0;
        if (!dsa_first) { FRESH(); da::phase(p, lds, tid, lane, wave, cvcur); }
        FRESH(); ds::phase<0>(p, lds, tid, lane, wave, cvcur);
        if (dsa_first) { FRESH(); da::phase(p, lds, tid, lane, wave, cvcur); }
        conv_expert_items(p, lds, lane, wave, cvcur, 1 << 20); } SEAM(3);
    if (IN(4)) { FRESH();
        gp::Gemm g{(const bf16_t*)(ws + WS_H), (const bf16_t*)(ws + WS_WOUTT), DM, DM, nullptr};
        gp::StaticOrder S; S.init(NTOK, DM, gridDim.x, blockIdx.x);
        gp::EpiResid E{p.in[0], p.out, (const float*)(ws + WS_MOD)};
        gp::gemm_phase<gp::EpiResid, gp::StaticOrder, false>(lds, g, S, E);
    } SEAM(4);
    if (IN(5)) { FRESH(); phase_norm2(p, lds, tid, lane, wave); } SEAM(5);
    if (IN(6)) { FRESH(); phase_scatter(p, lds, tid, lane, wave); } SEAM(6);
    if (IN(7)) { FRESH();
        const int* tile_e = (const int*)(ws + WS_TILEE);
        gp::Gemm g{(const bf16_t*)(ws + WS_H), (const bf16_t*)(ws + WS_WGUT), 2048, DM, (const int*)(ws + WS_ROWSRC)};
        gp::MoeOrder S{tile_e, tile_e[MAXTILES], 8, (int)blockIdx.x, (int)gridDim.x};
        gp::EpiSwiglu E{(bf16_t*)(ws + WS_ACT), p.in[19], p.in[21]};
        gp::gemm_phase<gp::EpiSwiglu, gp::MoeOrder, true>(lds, g, S, E);
    } SEAM(7);
    if (IN(8)) { FRESH();
        const int* tile_e = (const int*)(ws + WS_TILEE);
        gp::Gemm g{(const bf16_t*)(ws + WS_ACT), (const bf16_t*)(ws + WS_WDT), DM, DM, nullptr};
        gp::MoeOrder S{tile_e, tile_e[MAXTILES], 4, (int)blockIdx.x, (int)gridDim.x};
        gp::EpiDown E{p.out, (bf16_t*)(ws + WS_Y), p.in[23], (const float*)(ws + WS_MOD), (const int2*)(ws + WS_ROWMETA)};
        gp::gemm_phase<gp::EpiDown, gp::MoeOrder, false>(lds, g, S, E);
    } SEAM(8);
    if (IN(9)) { FRESH(); phase_combine(p, tid); }
#undef IN
#undef SEAM
}

static int g_grid = 0;
static void launch_mega(const Params& base, int lo, int hi, hipStream_t stream) {
    Params p = base; p.ph_lo = lo; p.ph_hi = hi;
    void* args[] = {&p};
    hipError_t e = hipLaunchCooperativeKernel((const void*)mega, dim3(g_grid), dim3(NTHREADS), args, LDS_BYTES, stream);
    if (e != hipSuccess) fprintf(stderr, "kernel_launch: cooperative launch [%d,%d) failed: %s (grid %d)\n", lo, hi, hipGetErrorString(e), g_grid);
}
extern "C" void kernel_launch(void* const* d_in, const int* in_sizes, int n_in, void* d_out, int out_size, void* d_ws, size_t ws_size, hipStream_t stream) {
    if (ws_size < WS_END) { fprintf(stderr, "kernel_launch: workspace too small: %zu < %zu\n", ws_size, (size_t)WS_END); return; }
    if (g_grid == 0) {
        int dev = 0, cus = 0, per_cu = 0;
        hipGetDevice(&dev); hipDeviceGetAttribute(&cus, hipDeviceAttributeMultiprocessorCount, dev);
        if (hipFuncSetAttribute((const void*)mega, hipFuncAttributeMaxDynamicSharedMemorySize, LDS_BYTES) != hipSuccess) fprintf(stderr, "kernel_launch: hipFuncSetAttribute failed\n");
        hipOccupancyMaxActiveBlocksPerMultiprocessor(&per_cu, (const void*)mega, NTHREADS, LDS_BYTES);
        (void)hipGetLastError();
        if (per_cu < 1) { fprintf(stderr, "kernel_launch: occupancy query says %d blocks/CU\n", per_cu); per_cu = 1; }
        g_grid = cus * 1;
        fprintf(stderr, "kernel_launch: cus %d per_cu %d grid %d\n", cus, per_cu, g_grid);
    }
    const float* x = (const float*)d_in[0];
    float* out = (float*)d_out; char* ws = (char*)d_ws;
    float* mod = (float*)(ws + WS_MOD); float* rope = (float*)(ws + WS_ROPE); float* lam = (float*)(ws + WS_LAM);
    float* IW = (float*)(ws + WS_IW);
    bf16_t* H = (bf16_t*)(ws + WS_H); bf16_t* PROJ = (bf16_t*)(ws + WS_PROJ);
    Params P{};
    for (int i = 0; i < 24; ++i) P.in[i] = (const float*)d_in[i];
    P.out = out; P.ws = (unsigned char*)d_ws;

    (void)hipMemsetAsync((char*)d_ws + WS_CTL, 0, 16384, stream);
    launch_mega(P, 0, N_PHASES, stream);
    (void)rope; (void)lam; (void)IW; (void)H; (void)PROJ;
    (void)x; (void)mod;
}
```

```cpp
#include <hip/hip_runtime.h>
#include <stdint.h>
#include <cstdio>

typedef unsigned short bf16_t;
__device__ __forceinline__ float bf2f(bf16_t v) { return __uint_as_float(((unsigned)v) << 16); }
__device__ __forceinline__ bf16_t f2bf(float f) { unsigned u = __float_as_uint(f); return (bf16_t)((u + 0x7fffu + ((u >> 16) & 1u)) >> 16); }

template <int CTRL> __device__ __forceinline__ float dppf(float x) { return __builtin_bit_cast(float, __builtin_amdgcn_mov_dpp(__builtin_bit_cast(int, x), CTRL, 0xf, 0xf, true)); }
constexpr int DPP_X1 = 0xB1, DPP_X2 = 0x4E, DPP_HM = 0x141, DPP_R8 = 0x128;
struct F2 { float a, b; };
__device__ __forceinline__ F2 swap16(float a, float b) {
    auto s = __builtin_amdgcn_permlane16_swap(__float_as_uint(a), __float_as_uint(b), false, false); return F2{__uint_as_float(s[0]), __uint_as_float(s[1])}; }
__device__ __forceinline__ F2 swap32(float a, float b) {
    auto s = __builtin_amdgcn_permlane32_swap(__float_as_uint(a), __float_as_uint(b), false, false); return F2{__uint_as_float(s[0]), __uint_as_float(s[1])}; }
__device__ __forceinline__ float sum_x16(float x) { const F2 s = swap16(x, x); return s.a + s.b; }
__device__ __forceinline__ float sum_x32(float x) { const F2 s = swap32(x, x); return s.a + s.b; }
__device__ __forceinline__ float max_x16(float x) { const F2 s = swap16(x, x); return fmaxf(s.a, s.b); }
__device__ __forceinline__ float max_x32(float x) { const F2 s = swap32(x, x); return fmaxf(s.a, s.b); }
__device__ __forceinline__ float min_x16(float x) { const F2 s = swap16(x, x); return fminf(s.a, s.b); }
__device__ __forceinline__ float min_x32(float x) { const F2 s = swap32(x, x); return fminf(s.a, s.b); }
__device__ __forceinline__ float get_x16(float x, int lane) { const F2 s = swap16(x, x); return (lane & 16) ? s.a : s.b; }
__device__ __forceinline__ float wave_sum(float v) {
    v += dppf<DPP_X1>(v); v += dppf<DPP_X2>(v); v += dppf<DPP_HM>(v); v += dppf<DPP_R8>(v); v = sum_x16(v); return sum_x32(v); }
__device__ __forceinline__ float wave_max(float v) {
    v = fmaxf(v, dppf<DPP_X1>(v)); v = fmaxf(v, dppf<DPP_X2>(v)); v = fmaxf(v, dppf<DPP_HM>(v)); v = fmaxf(v, dppf<DPP_R8>(v)); v = max_x16(v); return max_x32(v); }
__device__ __forceinline__ float wave_min(float v) {
    v = fminf(v, dppf<DPP_X1>(v)); v = fminf(v, dppf<DPP_X2>(v)); v = fminf(v, dppf<DPP_HM>(v)); v = fminf(v, dppf<DPP_R8>(v)); v = min_x16(v); return min_x32(v); }

constexpr int NB = 8, SEQ = 4096, DM = 1024, NTOK = NB * SEQ;
constexpr int NIN = 2824, NPJ = 2816;
constexpr int C_AQ1 = 0, C_AQ2 = 256, C_AK1 = 512, C_AK2 = 768, C_AV = 1024, C_BQ = 1536, C_BK = 2048, C_BLAT = 2112, C_IQ = 2240, C_IK = 2752, C_IW = 2816;
constexpr int NEXP = 32, TOPK = 4, NPAIR = NTOK * TOPK;
constexpr int MAXTILES = NPAIR / 256 + NEXP;
constexpr int PPAD = MAXTILES * 256;
constexpr int NCHUNK = 256, CHTOK = NTOK / NCHUNK;
constexpr float RMS_EPS = 1e-6f;
constexpr float LAMBDA_INIT = 0.2f;

constexpr size_t MiB = 1u << 20;
constexpr size_t WS_CTL = 0;
constexpr size_t WS_MOD = 1 * MiB;
constexpr size_t WS_ROPE = WS_MOD + 256 * 1024;
constexpr size_t WS_LAM = WS_ROPE + 256 * 1024;
constexpr size_t WS_CHCNT = WS_LAM + 4096;
constexpr size_t WS_TILEE = WS_CHCNT + 32768;
constexpr size_t WS_TOPI = 2 * MiB;
constexpr size_t WS_TOPG = WS_TOPI + 512 * 1024;
constexpr size_t WS_ROWTOK = 3 * MiB;
constexpr size_t WS_ROWSRC = 3 * MiB + 640 * 1024;
constexpr size_t WS_IW = 5 * MiB;
constexpr size_t WS_ROWMETA = 6 * MiB;
constexpr size_t WS_WINT = 8 * MiB;
constexpr size_t WS_WOUTT = 14 * MiB;
constexpr size_t WS_WUVT = 16 * MiB;
constexpr size_t WS_WDT = 17 * MiB;
constexpr size_t WS_WGUT = 81 * MiB;
constexpr size_t WS_H = 209 * MiB;
constexpr size_t WS_PROJ = 273 * MiB;
constexpr size_t WS_ACT = WS_PROJ;
constexpr size_t WS_Y = WS_WGUT;
constexpr size_t WS_IKF = WS_ACT + (size_t)PPAD * 1024 * 2;
constexpr size_t WS_END = WS_IKF + 4 * MiB;

namespace gp {
#define GP_LAS __attribute__((address_space(3)))
typedef short bf16x8 __attribute__((ext_vector_type(8)));
typedef float f32x4 __attribute__((ext_vector_type(4)));
typedef unsigned u32x4 __attribute__((ext_vector_type(4)));
constexpr int BM = 256, BK = 64, HALF = 128, HTB = HALF * BK * 2  , STAGE_BYTES = 8 * HTB;

__host__ __device__ __forceinline__ int lds_byte(int r, int c) { const int st = (r >> 4) * 2 + (c >> 5), rr = r & 15, cc = c & 31, ob = rr * 64 + cc * 2; return st * 1024 + (ob ^ (((ob >> 9) & 1) << 5)); }
__host__ __device__ __forceinline__ void stage_rc(int b, int& R, int& C) { const int st = b / 1024, sb = b % 1024, swz = sb ^ (((sb >> 9) & 1) << 5); R = (st >> 1) * 16 + swz / 64; C = (st & 1) * 32 + (swz % 64) / 2; }
__host__ __device__ __forceinline__ int perm32(int rho) { const int n = rho >> 4, i = rho & 15; return 8 * (i >> 2) + 4 * n + (i & 3); }

struct Unit { int pm, pn, e; };
struct Gemm { const bf16_t* A; const bf16_t* Bt; int N, K; const int* rowsrc; };

struct StaticOrder {
    int nM, nN, nwg, G, c;
    __device__ void init(int M, int N, int G_, int c_) { nM = M / BM; nN = N / BM; nwg = nM * nN; G = G_; c = c_; }
    __device__ bool next(int i, Unit& u) const {
        const long L = (long)i * G + c; if (L >= nwg) return false;
        int wgid = (int)L; { const int q = nwg / 8, r = nwg % 8, xcd = wgid % 8, off = wgid / 8; wgid = (xcd < r ? xcd * (q + 1) : r * (q + 1) + (xcd - r) * q) + off; }
        const int nig = 8 * nN, gid = wgid / nig, fm = gid * 8, gsz = (nM - fm) < 8 ? (nM - fm) : 8;
        u.pm = fm + ((wgid % nig) % gsz); u.pn = (wgid % nig) / gsz; u.e = 0; return true;
    }
};
struct MoeOrder {
    const int* tile_e; int ntiles, nN, c, G;
    __device__ bool next(int i, Unit& u) const {
        const int j = c >> 3, x = c & 7, tpx = (G >> 3) / nN;
        const int tile = i * (tpx * 8) + x * tpx + j / nN;
        if (tile >= ntiles) return false;
        u.pm = tile; u.pn = j % nN; u.e = tile_e[tile]; return true;
    }
};

typedef float f32x2_cv __attribute__((ext_vector_type(2))); typedef __bf16 bf16x2_cv __attribute__((ext_vector_type(2)));
__device__ __forceinline__ unsigned cvt_pk_bf16(float lo, float hi) { const f32x2_cv v = {lo, hi}; return __builtin_bit_cast(unsigned, __builtin_convertvector(v, bf16x2_cv)); }

struct EpiBf16 {
    bf16_t* O; int ldc;
    __device__ __forceinline__ void operator()(const f32x4 (&acc)[2][2][4][2], const Unit& u, int wr, int wc, int fr, int fq) const {
        const int row0 = u.pm * BM + wr * 64 + fr, col0 = u.pn * BM + wc * 32 + 8 * fq;
#pragma unroll
        for (int ai = 0; ai < 2; ++ai)
#pragma unroll
            for (int m = 0; m < 4; ++m) { bf16_t* rowp = O + (size_t)(row0 + ai * HALF + m * 16) * ldc + col0;
#pragma unroll
                for (int bj = 0; bj < 2; ++bj) { const f32x4 v0 = acc[ai][bj][m][0], v1 = acc[ai][bj][m][1];
                    u32x4 w; w.x = cvt_pk_bf16(v0[0], v0[1]); w.y = cvt_pk_bf16(v0[2], v0[3]); w.z = cvt_pk_bf16(v1[0], v1[1]); w.w = cvt_pk_bf16(v1[2], v1[3]);
                    *(u32x4*)(rowp + bj * HALF) = w; } }
    }
};

struct EpiInproj {
    bf16_t* O; const float* rope; GP_LAS const float* gl; GP_LAS float* xch; unsigned char* ikf;
    __device__ __forceinline__ void operator()(const f32x4 (&acc)[2][2][4][2], const Unit& u, int wr, int wc, int fr, int fq) const {
        const int wid = wr * 4 + wc, row0 = u.pm * BM + wr * 64 + fr, col0 = u.pn * BM + wc * 32 + 8 * fq, lc = (wc & 1) * 32 + 8 * fq;
        int mode[2]; int goff[2];
#pragma unroll
        for (int bj = 0; bj < 2; ++bj) { const int gc = u.pn * BM + bj * HALF + (wc >> 1) * 64; goff[bj] = 0;
            if (gc < 512) { mode[bj] = 1; goff[bj] = lc; } else if (gc < 1024) { mode[bj] = 1; goff[bj] = 64 + lc; } else if (gc < 1536) { mode[bj] = 0; }
            else if (gc < 2048) { mode[bj] = 1; goff[bj] = 128 + lc; } else if (gc < 2112) { mode[bj] = 1; goff[bj] = 192 + lc; }
            else if (gc < 2240) { mode[bj] = 3; goff[bj] = 256 + (gc - 2112) + lc; } else { mode[bj] = 2; } }
#pragma unroll
        for (int ai = 0; ai < 2; ++ai)
#pragma unroll
            for (int m = 0; m < 4; ++m)
#pragma unroll
                for (int bj = 0; bj < 2; ++bj) { const f32x4 a = acc[ai][bj][m][0], b = acc[ai][bj][m][1];
                    float s = ((a[0] * a[0] + a[1] * a[1]) + (a[2] * a[2] + a[3] * a[3])) + ((b[0] * b[0] + b[1] * b[1]) + (b[2] * b[2] + b[3] * b[3]));
                    s = sum_x32(sum_x16(s));
                    if (fq == 0) xch[(wid * 2 + bj) * 128 + ai * 64 + m * 16 + fr] = s; }
        asm volatile("s_waitcnt lgkmcnt(0)" ::: "memory"); __builtin_amdgcn_s_barrier(); asm volatile("" ::: "memory");
#pragma unroll
        for (int ai = 0; ai < 2; ++ai)
#pragma unroll
            for (int m = 0; m < 4; ++m) { int rl = ai * 64 + m * 16 + fr, row = row0 + ai * HALF + m * 16; asm volatile("" : "+v"(rl), "+v"(row)); const int pos = row % SEQ;
                bf16_t* rowp = O + (size_t)row * NPJ + col0;
#pragma unroll
                for (int bj = 0; bj < 2; ++bj) { f32x4 v0 = acc[ai][bj][m][0], v1 = acc[ai][bj][m][1];
                    if (mode[bj] == 1 || mode[bj] == 3) {
                        float tot = xch[(wid * 2 + bj) * 128 + rl] + xch[((wid ^ 1) * 2 + bj) * 128 + rl];
                        if (mode[bj] == 3) tot += xch[((wr * 4 + (wc ^ 2)) * 2 + (bj ^ 1)) * 128 + rl] + xch[((wr * 4 + (wc ^ 3)) * 2 + (bj ^ 1)) * 128 + rl];
                        const float r = 1.0f / sqrtf(tot * (mode[bj] == 3 ? (1.f / 128.f) : (1.f / 64.f)) + RMS_EPS);
                        const f32x4 g0 = *(GP_LAS const f32x4*)(gl + goff[bj]), g1 = *(GP_LAS const f32x4*)(gl + goff[bj] + 4);
                        v0 = v0 * r * g0; v1 = v1 * r * g1; }
                    if ((mode[bj] == 1 || mode[bj] == 2) && (wc & 1) == 0) {
                        f32x4 o0, o1;
#pragma unroll
                        for (int i = 0; i < 4; ++i) { o0[i] = get_x16(v0[i], fq << 4); o1[i] = get_x16(v1[i], fq << 4); }
                        if (fq < 2) { const float* rp = rope + pos * 16; const float sg = fq == 0 ? -1.0f : 1.0f;
                            const f32x4 t0 = *(const f32x4*)(rp), t1 = *(const f32x4*)(rp + 4), t2 = *(const f32x4*)(rp + 8), t3 = *(const f32x4*)(rp + 12);
                            v0[0] = v0[0] * t0[0] + sg * o0[0] * t0[1]; v0[1] = v0[1] * t0[2] + sg * o0[1] * t0[3];
                            v0[2] = v0[2] * t1[0] + sg * o0[2] * t1[1]; v0[3] = v0[3] * t1[2] + sg * o0[3] * t1[3];
                            v1[0] = v1[0] * t2[0] + sg * o1[0] * t2[1]; v1[1] = v1[1] * t2[2] + sg * o1[1] * t2[3];
                            v1[2] = v1[2] * t3[0] + sg * o1[2] * t3[1]; v1[3] = v1[3] * t3[2] + sg * o1[3] * t3[3]; } }
                    u32x4 w; w.x = cvt_pk_bf16(v0[0], v0[1]); w.y = cvt_pk_bf16(v0[2], v0[3]); w.z = cvt_pk_bf16(v1[0], v1[1]); w.w = cvt_pk_bf16(v1[2], v1[3]);
                    *(u32x4*)(rowp + bj * HALF) = w;
                    if (u.pn == 10 && bj == 1 && wc >= 2) {
                        const int key = row % SEQ, c8 = (wc & 1) * 4 + fq;
                        *(u32x4*)(ikf + ((size_t)((((row / SEQ) * 128 + (key >> 5)) * 4 + (c8 >> 1)) * 64 + (c8 & 1) * 32 + (key & 31)) << 4)) = w; } }
                asm volatile("" ::: "memory"); }
    }
};
struct EpiResid {
    const float* x; float* out; const float* mod;
    __device__ __forceinline__ void operator()(const f32x4 (&acc)[2][2][4][2], const Unit& u, int wr, int wc, int fr, int fq) const {
        const int row0 = u.pm * BM + wr * 64 + fr, col0 = u.pn * BM + wc * 32 + 8 * fq, b = (u.pm * BM) / SEQ;
        f32x4 gv[2][2];
#pragma unroll
        for (int bj = 0; bj < 2; ++bj)
#pragma unroll
            for (int n = 0; n < 2; ++n) gv[bj][n] = *(const f32x4*)(mod + b * 6144 + 2 * 1024 + col0 + bj * HALF + 4 * n);
#pragma unroll
        for (int ai = 0; ai < 2; ++ai)
#pragma unroll
            for (int m = 0; m < 4; ++m) { const size_t off = (size_t)(row0 + ai * HALF + m * 16) * DM + col0;
#pragma unroll
                for (int bj = 0; bj < 2; ++bj)
#pragma unroll
                    for (int n = 0; n < 2; ++n) { const f32x4 xv = *(const f32x4*)(x + off + bj * HALF + 4 * n);
                        *(f32x4*)(out + off + bj * HALF + 4 * n) = xv + gv[bj][n] * acc[ai][bj][m][n]; }
                asm volatile("" ::: "memory"); }
    }
};
struct EpiSwiglu {
    bf16_t* act; const float* bg; const float* bu;
    __device__ __forceinline__ void operator()(const f32x4 (&acc)[2][2][4][2], const Unit& u, int wr, int wc, int fr, int fq) const {
        const int row0 = u.pm * BM + wr * 64 + fr, ff0 = u.pn * HALF + wc * 32 + 8 * fq;
        f32x4 bgv[2], buv[2];
#pragma unroll
        for (int n = 0; n < 2; ++n) { bgv[n] = *(const f32x4*)(bg + u.e * 1024 + ff0 + 4 * n); buv[n] = *(const f32x4*)(bu + u.e * 1024 + ff0 + 4 * n); }
#pragma unroll
        for (int ai = 0; ai < 2; ++ai)
#pragma unroll
            for (int m = 0; m < 4; ++m) {
                float a[8];
#pragma unroll
                for (int n = 0; n < 2; ++n) { const f32x4 g4 = acc[ai][0][m][n] + bgv[n], u4 = acc[ai][1][m][n] + buv[n];
#pragma unroll
                    for (int j = 0; j < 4; ++j) { const float g = fminf(g4[j], 7.0f), uu = fminf(fmaxf(u4[j], -7.0f), 7.0f);
                        const float sg = __builtin_amdgcn_rcpf(1.0f + __builtin_amdgcn_exp2f(-1.702f * 1.4426950408889634f * g));
                        a[4 * n + j] = g * sg * (uu + 1.0f); } }
                u32x4 w; w.x = cvt_pk_bf16(a[0], a[1]); w.y = cvt_pk_bf16(a[2], a[3]); w.z = cvt_pk_bf16(a[4], a[5]); w.w = cvt_pk_bf16(a[6], a[7]);
                *(u32x4*)(act + (size_t)(row0 + ai * HALF + m * 16) * 1024 + ff0) = w; }
    }
};
struct EpiDown {
    float* out; bf16_t* Y; const float* bd; const float* mod; const int2* rowmeta;
    __device__ __forceinline__ void operator()(const f32x4 (&acc)[2][2][4][2], const Unit& u, int wr, int wc, int fr, int fq) const {
        const int row0 = u.pm * BM + wr * 64 + fr, col0 = u.pn * BM + wc * 32 + 8 * fq;
        f32x4 bv[2][2];
#pragma unroll
        for (int bj = 0; bj < 2; ++bj)
#pragma unroll
            for (int n = 0; n < 2; ++n) bv[bj][n] = *(const f32x4*)(bd + u.e * 1024 + col0 + bj * HALF + 4 * n);
        int2 meta[2][4];
#pragma unroll
        for (int ai = 0; ai < 2; ++ai)
#pragma unroll
            for (int m = 0; m < 4; ++m) meta[ai][m] = rowmeta[row0 + ai * HALF + m * 16];
#pragma unroll
        for (int ai = 0; ai < 2; ++ai)
#pragma unroll
            for (int m = 0; m < 4; ++m) {
                const int ent = meta[ai][m].x;
                if (ent >= 0) {
                    const int tok = ent >> 2, kk = ent & 3; const float gt = __int_as_float(meta[ai][m].y);
                    if (kk == 0) { const float* g2 = mod + (tok / SEQ) * 6144 + 5 * 1024 + col0; float* op = out + (size_t)tok * DM + col0;
#pragma unroll
                        for (int bj = 0; bj < 2; ++bj)
#pragma unroll
                            for (int n = 0; n < 2; ++n) { const f32x4 g4 = *(const f32x4*)(g2 + bj * HALF + 4 * n), o4 = *(const f32x4*)(op + bj * HALF + 4 * n);
                                *(f32x4*)(op + bj * HALF + 4 * n) = o4 + g4 * ((acc[ai][bj][m][n] + bv[bj][n]) * gt); }
                    } else { bf16_t* yp = Y + ((size_t)(kk - 1) * NTOK + tok) * DM + col0;
#pragma unroll
                        for (int bj = 0; bj < 2; ++bj) { const f32x4 v0 = (acc[ai][bj][m][0] + bv[bj][0]) * gt, v1 = (acc[ai][bj][m][1] + bv[bj][1]) * gt;
                            u32x4 w; w.x = cvt_pk_bf16(v0[0], v0[1]); w.y = cvt_pk_bf16(v0[2], v0[3]); w.z = cvt_pk_bf16(v1[0], v1[1]); w.w = cvt_pk_bf16(v1[2], v1[3]);
                            *(u32x4*)(yp + bj * HALF) = w; } }
                }
                asm volatile("" ::: "memory"); }
    }
};

template <class Epi, class Sched, bool GATHER>
__device__ __forceinline__ void gemm_phase(GP_LAS unsigned char* lds, const Gemm g, const Sched& S, const Epi& E) {
    const int tid = threadIdx.x, wid = __builtin_amdgcn_readfirstlane(tid >> 6), lane = tid & 63, wr = wid >> 2, wc = wid & 3, fr = lane & 15, fq = lane >> 4;
    const int K = g.K, nt = K / BK;
    unsigned voffB[2];
#pragma unroll
    for (int i = 0; i < 2; ++i) { int R, C; stage_rc(tid * 16 + i * 8192, R, C); const int Rb = (R & ~31) + perm32(R & 31); voffB[i] = (unsigned)(Rb * K + C) * 2u; }
    const size_t kstep = (size_t)(BK * 2);
    const size_t hstep = (size_t)HALF * K * 2;
    const size_t tstep = 2 * hstep;
    const unsigned ldsw = (unsigned)wid * 1024u;
    const int aoff = lds_byte(wr * 64 + fr, fq * 8), boff = lds_byte(wc * 32 + fr, fq * 8);
#define GP_SA(b, h) (((b) * 2 + (h)) * HTB)
#define GP_SB(b, h) ((4 + (b) * 2 + (h)) * HTB)
#define GP_STAGE(bufoff, gbase, voff) do { _Pragma("unroll") for (int _i = 0; _i < 2; ++_i) \
        __builtin_amdgcn_global_load_lds((const unsigned*)((const char*)(gbase) + (voff)[_i]), (GP_LAS unsigned*)(lds + (bufoff) + ldsw + _i * 8192), 16, 0, 0); } while (0)
#define GP_LDA(dst, b, h) do { _Pragma("unroll") for (int m = 0; m < 4; ++m) _Pragma("unroll") for (int k = 0; k < 2; ++k) dst[m][k] = *(const GP_LAS bf16x8*)(lds + GP_SA(b, h) + aoff + m * 2048 + k * 1024); } while (0)
#define GP_LDB(dst, b, h) do { _Pragma("unroll") for (int n = 0; n < 2; ++n) _Pragma("unroll") for (int k = 0; k < 2; ++k) dst[n][k] = *(const GP_LAS bf16x8*)(lds + GP_SB(b, h) + boff + n * 2048 + k * 1024); } while (0)
#define GP_MMA(ai, bj, At, Bt) do { __builtin_amdgcn_s_setprio(1); _Pragma("unroll") for (int m = 0; m < 4; ++m) _Pragma("unroll") for (int n = 0; n < 2; ++n) _Pragma("unroll") for (int k = 0; k < 2; ++k) \
        acc[ai][bj][m][n] = __builtin_amdgcn_mfma_f32_16x16x32_bf16(Bt[n][k], At[m][k], acc[ai][bj][m][n], 0, 0, 0); __builtin_amdgcn_s_setprio(0); } while (0)
#define GP_WAIT_V(n) asm volatile("s_waitcnt vmcnt(" #n ")" ::: "memory")
#define GP_WAIT_L(n) asm volatile("s_waitcnt lgkmcnt(" #n ")" ::: "memory")
#define GP_BAR __builtin_amdgcn_s_barrier()
#define GP_SCHED __builtin_amdgcn_sched_barrier(0)
#define GP_AOFFS(u_, v0_, v1_) do { _Pragma("unroll") for (int _i = 0; _i < 2; ++_i) { int R_, C_; stage_rc(tid * 16 + _i * 8192, R_, C_); int r0_ = (u_).pm * BM + R_, r1_ = r0_ + HALF; \
        if (GATHER) { r0_ = g.rowsrc[r0_]; r1_ = g.rowsrc[r1_]; } \
        v0_[_i] = (unsigned)(r0_ * K + C_) * 2u; v1_[_i] = (unsigned)(r1_ * K + C_) * 2u; } } while (0)
    Unit cur, nxt; int ui = 0;
    if (!S.next(0, cur)) return;
    f32x4 acc[2][2][4][2];
#pragma unroll
    for (int a = 0; a < 2; ++a)
#pragma unroll
        for (int b = 0; b < 2; ++b)
#pragma unroll
            for (int m = 0; m < 4; ++m)
#pragma unroll
                for (int n = 0; n < 2; ++n) acc[a][b][m][n] = (f32x4){0.f, 0.f, 0.f, 0.f};
    bf16x8 At[4][2], B0[2][2], B1[2][2];
    unsigned vA0[2], vA1[2], nA0[2], nA1[2];
    GP_AOFFS(cur, vA0, vA1);
    const char* Ab = (const char*)g.A;
    const char* cB = (const char*)g.Bt + ((size_t)cur.e * g.N + (size_t)cur.pn * BM) * K * 2;
    GP_STAGE(GP_SB(0, 0), cB, voffB); GP_STAGE(GP_SB(0, 1), cB + hstep, voffB); GP_STAGE(GP_SA(0, 0), Ab, vA0); GP_STAGE(GP_SA(0, 1), Ab, vA1);
    if (wr == 1) GP_BAR;
    GP_WAIT_V(2); GP_BAR;
    GP_STAGE(GP_SB(1, 0), cB + kstep, voffB); GP_STAGE(GP_SA(1, 0), Ab + kstep, vA0); GP_STAGE(GP_SB(1, 1), cB + hstep + kstep, voffB);
    GP_WAIT_V(6); GP_BAR;
    for (;;) {
        const bool has_next = S.next(ui + 1, nxt);
        const char* nB = cB;
        if (has_next) { nB = (const char*)g.Bt + ((size_t)nxt.e * g.N + (size_t)nxt.pn * BM) * K * 2; GP_AOFFS(nxt, nA0, nA1); }
        else { nA0[0] = vA0[0]; nA0[1] = vA0[1]; nA1[0] = vA1[0]; nA1[1] = vA1[1]; }
        for (int t = 0; t < nt; t += 2) {
            const bool last = (t == nt - 2);
            const char* a1 = Ab + (size_t)(t + 1) * kstep;
            const char* a2 = last ? Ab : Ab + (size_t)(t + 2) * kstep; const char* b2 = last ? nB : cB + (size_t)(t + 2) * kstep;
            const char* a3 = a2 + kstep; const char* b3 = b2 + kstep;
            GP_LDB(B0, 0, 0); GP_LDB(B1, 0, 1); GP_SCHED; GP_LDA(At, 0, 0); GP_STAGE(GP_SA(1, 1), a1, vA1);
            if (last) { vA0[0] = nA0[0]; vA0[1] = nA0[1]; vA1[0] = nA1[0]; vA1[1] = nA1[1]; }
            GP_WAIT_V(8); GP_WAIT_L(0); GP_BAR; GP_MMA(0, 0, At, B0); GP_MMA(0, 1, At, B1); GP_BAR; GP_SCHED;
            GP_LDA(At, 0, 1); GP_STAGE(GP_SB(0, 0), b2, voffB); GP_STAGE(GP_SB(0, 1), b2 + hstep, voffB); GP_STAGE(GP_SA(0, 0), a2, vA0);
            GP_WAIT_V(8); GP_WAIT_L(0); GP_BAR; GP_MMA(1, 0, At, B0); GP_MMA(1, 1, At, B1); GP_BAR; GP_SCHED;
            GP_LDB(B0, 1, 0); GP_LDB(B1, 1, 1); GP_SCHED; GP_LDA(At, 1, 0); GP_STAGE(GP_SA(0, 1), a2, vA1);
            GP_WAIT_V(8); GP_WAIT_L(0); GP_BAR; GP_MMA(0, 0, At, B0); GP_MMA(0, 1, At, B1); GP_BAR; GP_SCHED;
            GP_LDA(At, 1, 1); GP_STAGE(GP_SB(1, 0), b3, voffB); GP_STAGE(GP_SB(1, 1), b3 + hstep, voffB); GP_STAGE(GP_SA(1, 0), a3, vA0);
            GP_WAIT_V(8); GP_WAIT_L(0); GP_BAR; GP_MMA(1, 0, At, B0); GP_MMA(1, 1, At, B1); GP_BAR; GP_SCHED;
        }
        if (wr == 0) GP_BAR;
        E(acc, cur, wr, wc, fr, fq);
        if (!has_next) break;
#pragma unroll
        for (int a = 0; a < 2; ++a)
#pragma unroll
            for (int b = 0; b < 2; ++b)
#pragma unroll
                for (int m = 0; m < 4; ++m)
#pragma unroll
                    for (int n = 0; n < 2; ++n) acc[a][b][m][n] = (f32x4){0.f, 0.f, 0.f, 0.f};
        cur = nxt; cB = nB; ++ui;
        if (wr == 1) GP_BAR;
    }
    GP_WAIT_V(0);
    GP_BAR;
#undef GP_SA
#undef GP_SB
#undef GP_STAGE
#undef GP_LDA
#undef GP_LDB
#undef GP_MMA
#undef GP_WAIT_V
#undef GP_WAIT_L
#undef GP_BAR
#undef GP_SCHED
#undef GP_AOFFS
}
}
#include <hip/hip_cooperative_groups.h>
namespace cg = cooperative_groups;
#define LAS __attribute__((address_space(3)))
typedef float f32x4 __attribute__((ext_vector_type(4)));
typedef unsigned u32x4 __attribute__((ext_vector_type(4)));
typedef short bf16x8 __attribute__((ext_vector_type(8)));
constexpr int NWAVES = 8, NTHREADS = 512;
constexpr int LDS_RING = 131072;
constexpr int LDS_MISC = 159744;
constexpr int LDS_BYTES = 159744 + 256;

struct Params {
    const float* in[24];
    float* out; unsigned char* ws;
    int ph_lo, ph_hi;
};
__device__ __forceinline__ unsigned pk2(float lo, float hi) { return (unsigned)f2bf(lo) | ((unsigned)f2bf(hi) << 16); }

struct P0Item { const float* W; int ld, k0, n0; bf16_t* WT; int row0, Kdst; };
__device__ __forceinline__ void p0_load(const P0Item& it, f32x4 (&v)[8], int lane) {
#pragma unroll
    for (int i = 0; i < 8; ++i) v[i] = __builtin_nontemporal_load((const f32x4*)(it.W + (size_t)(it.k0 + 8 * i + (lane >> 3)) * it.ld + it.n0 + 4 * (lane & 7)));
}
__device__ __forceinline__ void p0_finish(const P0Item& it, const f32x4 (&v)[8], LAS float* scr, int lane) {
#pragma unroll
    for (int i = 0; i < 8; ++i) { LAS float* d = scr + (8 * i + (lane >> 3)) * 33 + 4 * (lane & 7); d[0] = v[i][0]; d[1] = v[i][1]; d[2] = v[i][2]; d[3] = v[i][3]; }
    asm volatile("s_waitcnt lgkmcnt(0)" ::: "memory");
    const int c = lane & 7;
#pragma unroll
    for (int j = 0; j < 4; ++j) { const int n = (lane >> 3) + 8 * j; const LAS float* s = scr + (8 * c) * 33 + n;
        u32x4 o; o.x = pk2(s[0 * 33], s[1 * 33]); o.y = pk2(s[2 * 33], s[3 * 33]); o.z = pk2(s[4 * 33], s[5 * 33]); o.w = pk2(s[6 * 33], s[7 * 33]);
        *(u32x4*)(it.WT + (size_t)(it.row0 + n) * it.Kdst + it.k0 + 8 * c) = o; }
    asm volatile("s_waitcnt lgkmcnt(0)" ::: "memory");
}
__device__ __forceinline__ void phase_prep(const Params& p, LAS unsigned char* lds, int tid, int lane, int wave) {
    unsigned char* ws = p.ws;
    {
        LAS float* sc = (LAS float*)lds;
        LAS float* part = (LAS float*)(lds + 32768);
        const float* c = p.in[1]; const float* w_ada = p.in[4]; const float* b_ada = p.in[5];
        {   f32x4 cv4[4];
#pragma unroll
            for (int j = 0; j < 4; ++j) cv4[j] = *(const f32x4*)(c + 4 * (tid + NTHREADS * j));
#pragma unroll
            for (int j = 0; j < 4; ++j) { f32x4 o4;
#pragma unroll
                for (int q = 0; q < 4; ++q) o4[q] = cv4[j][q] / (1.f + __expf(-cv4[j][q]));
                *(LAS f32x4*)(sc + 4 * (tid + NTHREADS * j)) = o4; }
        }
        __syncthreads();
        for (int cb = blockIdx.x; cb < 256; cb += gridDim.x) {
            const int half = lane >> 5, cl = lane & 31;
            float acc[8];
#pragma unroll
            for (int b = 0; b < 8; ++b) acc[b] = 0.f;
            if (cl < 24) {
#pragma unroll 4
                for (int it = 0; it < 64; ++it) { const int k = 128 * wave + 2 * it + half; const float wv = __builtin_nontemporal_load(w_ada + (size_t)k * 6144 + 24 * cb + cl);
#pragma unroll
                    for (int b = 0; b < 8; ++b) acc[b] += sc[b * 1024 + k] * wv; }
#pragma unroll
                for (int b = 0; b < 8; ++b) part[((wave * 2 + half) * 8 + b) * 24 + cl] = acc[b];
            }
            __syncthreads();
            if (tid < 192) { const int b = tid / 24, cc = tid % 24; float s = 0.f;
                for (int q = 0; q < 16; ++q) s += part[(q * 8 + b) * 24 + cc];
                ((float*)(ws + WS_MOD))[b * 6144 + 24 * cb + cc] = s + b_ada[24 * cb + cc]; }
            __syncthreads();
        }
    }
    {
        float* rope = (float*)(ws + WS_ROPE);
        for (int i = blockIdx.x * NTHREADS + tid; i < SEQ * 8; i += gridDim.x * NTHREADS) {
            const int pos = i >> 3, f = i & 7;
            const float inv = f == 0 ? 1.0f : f == 1 ? 0.1939227432f : f == 2 ? 0.03760603070f : f == 3 ? 0.007292664610f : f == 4 ? 0.001414213562f : f == 5 ? 0.0002742481884f : f == 6 ? 5.318295734e-05f : 1.031338525e-05f;
            const float ang = (float)pos * inv;
            const double TWO_PI = 6.283185307179586476925287;
            const double a = (double)ang, r = a - rint(a / TWO_PI) * TWO_PI, r2 = r * r;
            double s = 0.0, c = 0.0, ts = r, tc = 1.0;
#pragma unroll 1
            for (int n = 0; n < 14; ++n) { s += ts; c += tc; ts *= -r2 / (double)((2 * n + 2) * (2 * n + 3)); tc *= -r2 / (double)((2 * n + 1) * (2 * n + 2)); }
            rope[i * 2 + 0] = (float)c; rope[i * 2 + 1] = (float)s;
        }
        if (blockIdx.x == 0 && wave == 0) { const float* al = p.in[10];
            const float d01 = wave_sum(al[lane] * al[64 + lane]), d23 = wave_sum(al[128 + lane] * al[192 + lane]);
            if (lane == 0) ((float*)(ws + WS_LAM))[0] = expf(d01) - expf(d23) + LAMBDA_INIT; }
    }
    __syncthreads();
    {
        LAS float* scr = (LAS float*)(lds + wave * 8704);
        const int gw = blockIdx.x * NWAVES + wave, NGW = gridDim.x * NWAVES;
        constexpr int I_IN = 16 * 88, I_OUT = 16 * 32, I_UV = 32, NITEMS = I_IN + I_OUT + I_UV;
        auto decode = [&](int r) -> P0Item {
            if (r < I_IN) return P0Item{p.in[6], NIN, 64 * (r / 88), 32 * (r % 88), (bf16_t*)(ws + WS_WINT), 32 * (r % 88), 1024};
            r -= I_IN;
            if (r < I_OUT) return P0Item{p.in[7], 1024, 64 * (r / 32), 32 * (r % 32), (bf16_t*)(ws + WS_WOUTT), 32 * (r % 32), 1024};
            r -= I_OUT;
            const int h = r >> 2, rr = r & 3; return P0Item{p.in[15] + h * 128 * 64, 64, 64 * (rr >> 1), 32 * (rr & 1), (bf16_t*)(ws + WS_WUVT) + h * 64 * 128, 32 * (rr & 1), 128};
        };
        for (int it = gw; it < NITEMS; it += NGW) { const P0Item a = decode(it); f32x4 va[8]; p0_load(a, va, lane); p0_finish(a, va, scr, lane); }
    }
}
constexpr int N_EXPERT_ITEMS = 32 * 3 * 512;
__device__ __forceinline__ bool conv_expert_issue(const Params& p, int lane, int wave, int& cur, P0Item& a, f32x4 (&va)[8]) {
    unsigned char* ws = p.ws;
    const int gw = blockIdx.x * NWAVES + wave, NGW = gridDim.x * NWAVES, r = gw + NGW * cur;
    if (r >= N_EXPERT_ITEMS) return false;
    ++cur;
    const int e = r / 1536, qq = r % 1536, mat = qq / 512, i2 = qq % 512, kb = i2 / 32, nb = i2 % 32, n0 = 32 * nb;
    a = (mat == 2) ? P0Item{p.in[22] + (size_t)e * 1048576, 1024, 64 * kb, n0, (bf16_t*)(ws + WS_WDT) + (size_t)e * 1048576, n0, 1024}
                   : P0Item{p.in[mat == 0 ? 18 : 20] + (size_t)e * 1048576, 1024, 64 * kb, n0, (bf16_t*)(ws + WS_WGUT) + (size_t)e * 2097152, 256 * (n0 >> 7) + (n0 & 127) + (mat == 1 ? 128 : 0), 1024};
    p0_load(a, va, lane);
    return true;
}
__device__ __forceinline__ void conv_expert_items(const Params& p, LAS unsigned char* lds, int lane, int wave, int& cur, int n) {
    unsigned char* ws = p.ws;
    LAS float* scr = (LAS float*)(lds + wave * 8704);
    const int gw = blockIdx.x * NWAVES + wave, NGW = gridDim.x * NWAVES;
    for (int q = 0; q < n; ++q) {
        const int r = gw + NGW * cur;
        if (r >= N_EXPERT_ITEMS) break;
        ++cur;
        const int e = r / 1536, qq = r % 1536, mat = qq / 512, i2 = qq % 512, kb = i2 / 32, nb = i2 % 32, n0 = 32 * nb;
        const P0Item a = (mat == 2) ? P0Item{p.in[22] + (size_t)e * 1048576, 1024, 64 * kb, n0, (bf16_t*)(ws + WS_WDT) + (size_t)e * 1048576, n0, 1024}
                                    : P0Item{p.in[mat == 0 ? 18 : 20] + (size_t)e * 1048576, 1024, 64 * kb, n0, (bf16_t*)(ws + WS_WGUT) + (size_t)e * 2097152, 256 * (n0 >> 7) + (n0 & 127) + (mat == 1 ? 128 : 0), 1024};
        f32x4 va[8]; p0_load(a, va, lane); p0_finish(a, va, scr, lane);
    }
}

__device__ __forceinline__ void phase_norm1(const Params& p, LAS unsigned char* lds, int tid, int lane, int wave) {
    unsigned char* ws = p.ws;
    const float* x = p.in[0]; const float* g = p.in[2]; const float* w_in = p.in[6]; const float* mod = (const float*)(ws + WS_MOD);
    bf16_t* H = (bf16_t*)(ws + WS_H); float* IW = (float*)(ws + WS_IW);
    LAS float* wiw = (LAS float*)lds;
    {   f32x4 wv4[4];
#pragma unroll
        for (int j = 0; j < 4; ++j) { const int q = tid + NTHREADS * j; wv4[j] = *(const f32x4*)(w_in + (size_t)(q >> 1) * NIN + C_IW + 4 * (q & 1)); }
#pragma unroll
        for (int j = 0; j < 4; ++j) { const int q = tid + NTHREADS * j; *(LAS f32x4*)(wiw + 4 * q) = wv4[j]; }
    }
    __syncthreads();
    const int gw = blockIdx.x * NWAVES + wave, NGW = gridDim.x * NWAVES;
    f32x4 gv[4];
#pragma unroll
    for (int j = 0; j < 4; ++j) gv[j] = *(const f32x4*)(g + 4 * (lane + 64 * j));
    f32x4 vn[4];
#pragma unroll
    for (int j = 0; j < 4; ++j) vn[j] = *(const f32x4*)(x + (size_t)(gw < NTOK ? gw : 0) * DM + 4 * (lane + 64 * j));
    for (int t = gw; t < NTOK; t += NGW) {
        const int b = t / SEQ; const float* sh = mod + b * 6144, * sc = sh + 1024;
        f32x4 v[4]; float ss = 0.f;
#pragma unroll
        for (int j = 0; j < 4; ++j) { v[j] = vn[j]; ss += (v[j].x * v[j].x + v[j].y * v[j].y) + (v[j].z * v[j].z + v[j].w * v[j].w); }
        if (t + NGW < NTOK) {
#pragma unroll
            for (int j = 0; j < 4; ++j) vn[j] = *(const f32x4*)(x + (size_t)(t + NGW) * DM + 4 * (lane + 64 * j)); }
        const float r = 1.0f / sqrtf(wave_sum(ss) * (1.f / DM) + RMS_EPS);
        float iw[8];
#pragma unroll
        for (int q = 0; q < 8; ++q) iw[q] = 0.f;
#pragma unroll
        for (int j = 0; j < 4; ++j) { const int k0 = 4 * (lane + 64 * j);
            const f32x4 s4 = *(const f32x4*)(sc + k0), h4 = *(const f32x4*)(sh + k0);
            f32x4 hv = (v[j] * r * gv[j]) * (s4 + 1.0f) + h4;
            *(uint2*)(H + (size_t)t * DM + k0) = make_uint2(pk2(hv.x, hv.y), pk2(hv.z, hv.w));
#pragma unroll
            for (int i = 0; i < 4; ++i) { const f32x4 w0 = *(const LAS f32x4*)(wiw + (k0 + i) * 8), w1 = *(const LAS f32x4*)(wiw + (k0 + i) * 8 + 4);
                iw[0] += hv[i] * w0.x; iw[1] += hv[i] * w0.y; iw[2] += hv[i] * w0.z; iw[3] += hv[i] * w0.w;
                iw[4] += hv[i] * w1.x; iw[5] += hv[i] * w1.y; iw[6] += hv[i] * w1.z; iw[7] += hv[i] * w1.w; } }
#pragma unroll
        for (int i = 0; i < 4; ++i) { const F2 s = swap32(iw[i], iw[i + 4]); iw[i] = s.a + s.b; }
#pragma unroll
        for (int i = 0; i < 2; ++i) { const F2 s = swap16(iw[i], iw[i + 2]); iw[i] = s.a + s.b; }
        { const float xs = iw[0] + dppf<DPP_R8>(iw[0]), ys = iw[1] + dppf<DPP_R8>(iw[1]); iw[0] = (lane & 8) ? ys : xs; }
        { float r8 = iw[0]; r8 += dppf<DPP_HM>(r8); r8 += dppf<DPP_X2>(r8); r8 += dppf<DPP_X1>(r8);
          if ((lane & 7) == 0) IW[(size_t)t * 8 + (lane >> 3)] = r8 * 0.04419417382415922f; }
    }
}


__device__ __forceinline__ void router_tail(float (&pe)[32], const float* rb, int lane, int t, int* topi, float* topg, LAS int* cnt) {
#pragma unroll
    for (int i = 0; i < 8; ++i) { const F2 s = swap16(pe[i], pe[i + 8]); pe[i] = s.a + s.b; }
#pragma unroll
    for (int i = 0; i < 4; ++i) { const float xs = pe[i] + dppf<DPP_R8>(pe[i]), ys = pe[i + 4] + dppf<DPP_R8>(pe[i + 4]); pe[i] = (lane & 8) ? ys : xs; }
#pragma unroll
    for (int i = 0; i < 2; ++i) { const float xs = pe[i] + dppf<DPP_HM>(pe[i]), ys = pe[i + 2] + dppf<DPP_HM>(pe[i + 2]); pe[i] = (lane & 4) ? ys : xs; }
    { const float xs = pe[0] + dppf<DPP_X2>(pe[0]), ys = pe[1] + dppf<DPP_X2>(pe[1]); pe[0] = (lane & 2) ? ys : xs; }
    const int myE = lane >> 1;
    float lv = pe[0] + dppf<DPP_X1>(pe[0]) + rb[myE];
    int idx[4]; float val[4];
#pragma unroll
    for (int k = 0; k < 4; ++k) { const float m = wave_max(lv);
        const unsigned long long bm = __ballot(lv == m);
        const int e = __builtin_ctzll(bm) >> 1;
        idx[k] = e; val[k] = m; if (myE == e) lv = -INFINITY; }
    if (lane == 0) {
        float ex[4], sum = 0.f;
#pragma unroll
        for (int k = 0; k < 4; ++k) { ex[k] = __expf(val[k] - val[0]); sum += ex[k]; }
        const float inv = 1.f / sum;
        *(int4*)(topi + t * 4) = make_int4(idx[0], idx[1], idx[2], idx[3]);
        *(f32x4*)(topg + t * 4) = (f32x4){ex[0] * inv, ex[1] * inv, ex[2] * inv, ex[3] * inv};
#pragma unroll
        for (int k = 0; k < 4; ++k) atomicAdd((int*)&cnt[idx[k]], 1);
    }
}
__device__ __forceinline__ void phase_norm2(const Params& p, LAS unsigned char* lds, int tid, int lane, int wave) {
    unsigned char* ws = p.ws;
    const float* x1 = p.out; const float* g = p.in[3]; const float* rw = p.in[16]; const float* rb = p.in[17]; const float* mod = (const float*)(ws + WS_MOD);
    bf16_t* H = (bf16_t*)(ws + WS_H); int* topi = (int*)(ws + WS_TOPI); float* topg = (float*)(ws + WS_TOPG); int* chcnt = (int*)(ws + WS_CHCNT);
    LAS float* rwl = (LAS float*)lds;
    {
        f32x4 rv[16];
#pragma unroll
        for (int j = 0; j < 16; ++j) rv[j] = *(const f32x4*)(rw + 4 * (tid + NTHREADS * j));
#pragma unroll
        for (int j = 0; j < 16; ++j) { const int i = 4 * (tid + NTHREADS * j), k = i >> 5, e = i & 31;
            rwl[e * 1028 + k] = rv[j][0]; rwl[(e + 1) * 1028 + k] = rv[j][1]; rwl[(e + 2) * 1028 + k] = rv[j][2]; rwl[(e + 3) * 1028 + k] = rv[j][3]; }
    }
    LAS int* cnt = (LAS int*)(lds + 32 * 1028 * 4);
    __syncthreads();
    for (int ch = blockIdx.x; ch < NCHUNK; ch += gridDim.x) {
        if (tid < 32) cnt[tid] = 0;
        __syncthreads();
        f32x4 xa[4], xb[4];
#pragma unroll
        for (int j = 0; j < 4; ++j) { xa[j] = *(const f32x4*)(x1 + (size_t)(ch * CHTOK + wave * 16) * DM + 4 * (lane + 64 * j)); xb[j] = *(const f32x4*)(x1 + (size_t)(ch * CHTOK + wave * 16 + 1) * DM + 4 * (lane + 64 * j)); }
        for (int rr = 0; rr < 16; rr += 2) {
            const int t0r = ch * CHTOK + wave * 16 + rr, b = t0r / SEQ; const float* sh = mod + b * 6144 + 3 * 1024, * sc = sh + 1024;
            f32x4 hv0[4], hv1[4];
#define N2_ROW(HV, T_, XS) do { f32x4 v[4]; float ss = 0.f; \
                _Pragma("unroll") for (int j = 0; j < 4; ++j) { v[j] = XS[j]; ss += (v[j].x * v[j].x + v[j].y * v[j].y) + (v[j].z * v[j].z + v[j].w * v[j].w); } \
                const float r = 1.0f / sqrtf(wave_sum(ss) * (1.f / DM) + RMS_EPS); \
                _Pragma("unroll") for (int j = 0; j < 4; ++j) { const int k0 = 4 * (lane + 64 * j); \
                    const f32x4 s4 = *(const f32x4*)(sc + k0), h4 = *(const f32x4*)(sh + k0); \
                    HV[j] = (v[j] * r * *(const f32x4*)(g + k0)) * (s4 + 1.0f) + h4; \
                    *(uint2*)(H + (size_t)(T_) * DM + k0) = make_uint2(pk2(HV[j].x, HV[j].y), pk2(HV[j].z, HV[j].w)); } } while (0)
            N2_ROW(hv0, t0r, xa); N2_ROW(hv1, t0r + 1, xb);
#undef N2_ROW
            if (rr + 2 < 16) {
#pragma unroll
                for (int j = 0; j < 4; ++j) { xa[j] = *(const f32x4*)(x1 + (size_t)(t0r + 2) * DM + 4 * (lane + 64 * j)); xb[j] = *(const f32x4*)(x1 + (size_t)(t0r + 3) * DM + 4 * (lane + 64 * j)); } }
            float pe0[32], pe1[32];
#pragma unroll
            for (int i = 0; i < 16; ++i) { float a0 = 0.f, a1 = 0.f, b0 = 0.f, b1 = 0.f;
#pragma unroll
                for (int j = 0; j < 4; ++j) { const f32x4 wa = *(const LAS f32x4*)(rwl + i * 1028 + 4 * (lane + 64 * j)), wb = *(const LAS f32x4*)(rwl + (i + 16) * 1028 + 4 * (lane + 64 * j));
                    a0 += (hv0[j].x * wa.x + hv0[j].y * wa.y) + (hv0[j].z * wa.z + hv0[j].w * wa.w); a1 += (hv1[j].x * wa.x + hv1[j].y * wa.y) + (hv1[j].z * wa.z + hv1[j].w * wa.w);
                    b0 += (hv0[j].x * wb.x + hv0[j].y * wb.y) + (hv0[j].z * wb.z + hv0[j].w * wb.w); b1 += (hv1[j].x * wb.x + hv1[j].y * wb.y) + (hv1[j].z * wb.z + hv1[j].w * wb.w); }
                { const F2 s0 = swap32(a0, b0), s1 = swap32(a1, b1); pe0[i] = s0.a + s0.b; pe1[i] = s1.a + s1.b; }
                asm volatile("" ::: "memory"); }
            router_tail(pe0, rb, lane, t0r, topi, topg, cnt);
            router_tail(pe1, rb, lane, t0r + 1, topi, topg, cnt);
        }
        __syncthreads();
        if (tid < 32) chcnt[ch * 32 + tid] = cnt[tid];
        __syncthreads();
    }
}

__device__ __forceinline__ void phase_scatter(const Params& p, LAS unsigned char* lds, int tid, int lane, int wave) {
    unsigned char* ws = p.ws;
    const int* topi = (const int*)(ws + WS_TOPI); const int* chcnt = (const int*)(ws + WS_CHCNT);
    int* rowtok = (int*)(ws + WS_ROWTOK); int* rowsrc = (int*)(ws + WS_ROWSRC); int* tile_e = (int*)(ws + WS_TILEE); int2* rowmeta = (int2*)(ws + WS_ROWMETA); const float* topg = (const float*)(ws + WS_TOPG);
    LAS int* total = (LAS int*)lds; LAS int* before = total + 32; LAS int* padded = total + 64; LAS int* poff = total + 96; LAS int* ent = total + 160; LAS int* psum = total + 1024; LAS int* wcnt = total + 2048;
    for (int ch = blockIdx.x; ch < NCHUNK; ch += gridDim.x) {
        { const int e = tid & 31, part = tid >> 5; int tt = 0, bb = 0;
#pragma unroll 4
          for (int q = 0; q < 16; ++q) { const int c = part * 16 + q; const int v = chcnt[c * 32 + e]; tt += v; bb += (c < ch) ? v : 0; }
          psum[tid] = tt; psum[512 + tid] = bb; }
        { const int i = tid; ent[i] = topi[ch * CHTOK * 4 + i]; }
        __syncthreads();
        if (tid < 32) { int tt = 0, bb = 0;
#pragma unroll 1
            for (int q = 0; q < 16; ++q) { tt += psum[q * 32 + tid]; bb += psum[512 + q * 32 + tid]; }
            total[tid] = tt; before[tid] = bb; padded[tid] = (tt + 255) / 256 * 256; }
        __syncthreads();
        if (tid == 0) { int a = 0;
#pragma unroll 1
            for (int e = 0; e < 32; ++e) { poff[e] = a; a += padded[e]; } poff[32] = a; }
        __syncthreads();
        {
            const int myE = ent[tid]; int myRank = 0;
            const unsigned long long ltm = (1ull << lane) - 1ull;
#pragma unroll 1
            for (int e = 0; e < 32; ++e) { const unsigned long long mk = __ballot(myE == e);
                if (myE == e) myRank = __popcll(mk & ltm);
                if (lane == 0) wcnt[wave * 32 + e] = __popcll(mk); }
            __syncthreads();
            int pos = poff[myE] + before[myE] + myRank;
            for (int w2 = 0; w2 < wave; ++w2) pos += wcnt[w2 * 32 + myE];
            const int en = ch * CHTOK * 4 + tid; rowtok[pos] = en; rowsrc[pos] = en >> 2; rowmeta[pos] = make_int2(en, __float_as_int(topg[en]));
        }
        if (ch == 0) {
            for (int e = wave; e < 32; e += NWAVES) {
                const int p0 = poff[e], te = p0 + total[e], pe = p0 + padded[e];
                for (int r = te + lane; r < pe; r += 64) { rowtok[r] = -1; rowsrc[r] = 0; rowmeta[r] = make_int2(-1, 0); }
                for (int ti = p0 / 256 + lane; ti < pe / 256; ti += 64) tile_e[ti] = e; }
            if (tid == 0) tile_e[MAXTILES] = poff[32] / 256;
        }
        __syncthreads();
    }
}

__device__ __forceinline__ void phase_combine(const Params& p, int tid) {
    unsigned char* ws = p.ws; float* out = p.out; const bf16_t* Y = (const bf16_t*)(ws + WS_Y); const float* mod = (const float*)(ws + WS_MOD);
    const size_t nvec = (size_t)NTOK * DM / 8;
#pragma unroll 1
    for (size_t i = (size_t)blockIdx.x * NTHREADS + tid; i < nvec; i += (size_t)gridDim.x * NTHREADS) {
        const size_t o = i * 8; const int t = (int)(o / DM), n = (int)(o % DM), b = t / SEQ;
        const u32x4 a = __builtin_nontemporal_load((const u32x4*)(Y + o)), c = __builtin_nontemporal_load((const u32x4*)(Y + (size_t)NTOK * DM + o)), d = __builtin_nontemporal_load((const u32x4*)(Y + (size_t)2 * NTOK * DM + o));
        const float* g2 = mod + b * 6144 + 5 * 1024 + n;
        f32x4 o0 = *(const f32x4*)(out + o), o1 = *(const f32x4*)(out + o + 4);
        const f32x4 g0 = *(const f32x4*)g2, g1 = *(const f32x4*)(g2 + 4);
#define LO(u) __uint_as_float((u) << 16)
#define HI(u) __uint_as_float((u) & 0xffff0000u)
        o0.x += g0.x * (LO(a.x) + LO(c.x) + LO(d.x)); o0.y += g0.y * (HI(a.x) + HI(c.x) + HI(d.x));
        o0.z += g0.z * (LO(a.y) + LO(c.y) + LO(d.y)); o0.w += g0.w * (HI(a.y) + HI(c.y) + HI(d.y));
        o1.x += g1.x * (LO(a.z) + LO(c.z) + LO(d.z)); o1.y += g1.y * (HI(a.z) + HI(c.z) + HI(d.z));
        o1.z += g1.z * (LO(a.w) + LO(c.w) + LO(d.w)); o1.w += g1.w * (HI(a.w) + HI(c.w) + HI(d.w));
#undef LO
#undef HI
        *(f32x4*)(out + o) = o0; *(f32x4*)(out + o + 4) = o1;
    }
}

namespace da {
typedef float f32x16 __attribute__((ext_vector_type(16)));
typedef short s16x4 __attribute__((ext_vector_type(4)));
constexpr int KPL = 1040;
constexpr int KT_BYTES = 8 * KPL;
constexpr int VRS = 320;
constexpr int VT_BYTES = 64 * VRS;
constexpr int BUF_BYTES = 2 * KT_BYTES + VT_BYTES;
constexpr int OB_STRIDE = 132;
constexpr int WSF_OFF = 139264;
constexpr float C2 = 0.125f * 1.4426950408889634f;
__device__ __forceinline__ int crow(int r, int hi) { return (r & 3) + 8 * (r >> 2) + 4 * hi; }
__device__ __forceinline__ s16x4 vtr(const LAS unsigned char* p) { return __builtin_bit_cast(s16x4, __builtin_amdgcn_ds_read_tr16_b64_v4i16((LAS s16x4*)p)); }

__device__ __forceinline__ void phase(const Params& p, LAS unsigned char* lds, int tid, int lane, int wave, int& cvcur) {
    unsigned char* ws = p.ws; const bf16_t* PROJ = (const bf16_t*)(ws + WS_PROJ); bf16_t* H = (bf16_t*)(ws + WS_H);
    const float lam = ((const float*)(ws + WS_LAM))[0]; const float* sub_g = p.in[11];
    const int wsel = wave >> 2, wq = wave & 3, r32 = lane & 31, hi = lane >> 5;
    LAS float* wsf = (LAS float*)(lds + WSF_OFF) + wave * 64;
    const int G = gridDim.x, vcu = (G % 8 == 0) ? ((int)blockIdx.x % 8) * (G / 8) + (int)blockIdx.x / 8 : (int)blockIdx.x;
    for (int id = vcu; id < 1024; id += G) {
        const int bh = (id >> 3) & 31, s = id & 7, ii = id >> 8;
        const int qb = (ii == 0) ? s : (ii == 1) ? 15 - s : (ii == 2) ? 16 + s : 31 - s;
        const int b = bh >> 2, h = bh & 3, q0 = qb * 128, NT = 2 * qb + 2, ntw = 2 * qb + 1 + (wq >> 1);
        const bf16_t* base = PROJ + (size_t)b * SEQ * NPJ;
        LAS unsigned char* qlds = lds + 81920 + wave * 4096 + lane * 16;
        { const bf16_t* Qrow = base + (size_t)(q0 + 32 * wq + r32) * NPJ + (wsel ? C_AQ2 : C_AQ1) + h * 64;
#pragma unroll
          for (int d0 = 0; d0 < 4; ++d0) *(LAS bf16x8*)(qlds + d0 * 1024) = *(const bf16x8*)(Qrow + 16 * d0 + 8 * hi); }
        float m = -INFINITY, l = 0.f;
        f32x16 o[4];
#pragma unroll
        for (int d0 = 0; d0 < 4; ++d0)
#pragma unroll
            for (int r = 0; r < 16; ++r) o[d0][r] = 0.f;
        const int skey = tid >> 3, sc = tid & 7, vkey = tid >> 4, vch = tid & 15;
        const bf16_t* srcK1 = base + (size_t)skey * NPJ + C_AK1 + h * 64 + 8 * sc;
        const bf16_t* srcK2 = base + (size_t)skey * NPJ + C_AK2 + h * 64 + 8 * sc;
        const bf16_t* srcV = base + (size_t)vkey * NPJ + C_AV + h * 128 + 8 * vch;
        const int dK = sc * KPL + skey * 16, dV = vkey * VRS + vch * 16;
        u32x4 st0, st1, st2, st3;
#define DA_LOAD(kt) do { const size_t ro = (size_t)(kt) * 64 * NPJ; st0 = *(const u32x4*)(srcK1 + ro); st1 = *(const u32x4*)(srcK2 + ro); \
        st2 = *(const u32x4*)(srcV + ro); st3 = *(const u32x4*)(srcV + ro + (size_t)32 * NPJ); } while (0)
#define DA_WRITE(bufi) do { LAS unsigned char* bb = lds + (bufi) * BUF_BYTES; *(LAS u32x4*)(bb + dK) = st0; *(LAS u32x4*)(bb + KT_BYTES + dK) = st1; \
        *(LAS u32x4*)(bb + 2 * KT_BYTES + dV) = st2; *(LAS u32x4*)(bb + 2 * KT_BYTES + dV + 32 * VRS) = st3; } while (0)
        DA_LOAD(0); DA_WRITE(0);
        __syncthreads();
        for (int kt = 0; kt < NT; ++kt) {
            if (kt + 1 < NT) DA_LOAD(kt + 1);
            if (kt < ntw) {
                const LAS unsigned char* bb = lds + (kt & 1) * BUF_BYTES;
                const LAS unsigned char* Kb = bb + wsel * KT_BYTES;
                const LAS unsigned char* Vb = bb + 2 * KT_BYTES;
                f32x16 p0, p1;
#pragma unroll
                for (int r = 0; r < 16; ++r) { p0[r] = 0.f; p1[r] = 0.f; }
#pragma unroll
                for (int d0 = 0; d0 < 4; ++d0) {
                    const bf16x8 a0 = *(const LAS bf16x8*)(Kb + (2 * d0 + hi) * KPL + r32 * 16);
                    const bf16x8 a1 = *(const LAS bf16x8*)(Kb + (2 * d0 + hi) * KPL + (r32 + 32) * 16);
                    const bf16x8 qf = *(const LAS bf16x8*)(qlds + d0 * 1024);
                    p0 = __builtin_amdgcn_mfma_f32_32x32x16_bf16(a0, qf, p0, 0, 0, 0);
                    p1 = __builtin_amdgcn_mfma_f32_32x32x16_bf16(a1, qf, p1, 0, 0, 0);
                }
                float mxa = fmaxf(p0[0], p1[0]), mxb = fmaxf(p0[1], p1[1]), mxc = fmaxf(p0[2], p1[2]), mxd = fmaxf(p0[3], p1[3]);
#pragma unroll
                for (int r = 4; r < 16; r += 4) { mxa = fmaxf(mxa, fmaxf(p0[r], p1[r])); mxb = fmaxf(mxb, fmaxf(p0[r + 1], p1[r + 1])); mxc = fmaxf(mxc, fmaxf(p0[r + 2], p1[r + 2])); mxd = fmaxf(mxd, fmaxf(p0[r + 3], p1[r + 3])); }
                float mx = fmaxf(fmaxf(mxa, mxb), fmaxf(mxc, mxd));
                mx = max_x32(mx) * C2;
                if (__any(mx - m > 8.0f)) {
                    const float mnew = fmaxf(m, mx);
                    const float f = __builtin_amdgcn_exp2f(m - mnew);
                    l *= f; m = mnew;
                    if (hi == 0) wsf[r32] = f;
                    asm volatile("s_waitcnt lgkmcnt(0)" ::: "memory");
#pragma unroll
                    for (int r = 0; r < 16; ++r) { const float fr = wsf[crow(r, hi)];
#pragma unroll
                        for (int d0 = 0; d0 < 4; ++d0) o[d0][r] *= fr; }
                }
                float lsa = 0.f, lsb = 0.f, lsc = 0.f, lsd = 0.f;
#pragma unroll
                for (int r = 0; r < 16; r += 4) {
                    p0[r] = __builtin_amdgcn_exp2f(p0[r] * C2 - m); p1[r] = __builtin_amdgcn_exp2f(p1[r] * C2 - m); lsa += p0[r] + p1[r];
                    p0[r + 1] = __builtin_amdgcn_exp2f(p0[r + 1] * C2 - m); p1[r + 1] = __builtin_amdgcn_exp2f(p1[r + 1] * C2 - m); lsb += p0[r + 1] + p1[r + 1];
                    p0[r + 2] = __builtin_amdgcn_exp2f(p0[r + 2] * C2 - m); p1[r + 2] = __builtin_amdgcn_exp2f(p1[r + 2] * C2 - m); lsc += p0[r + 2] + p1[r + 2];
                    p0[r + 3] = __builtin_amdgcn_exp2f(p0[r + 3] * C2 - m); p1[r + 3] = __builtin_amdgcn_exp2f(p1[r + 3] * C2 - m); lsd += p0[r + 3] + p1[r + 3]; }
                l += (lsa + lsb) + (lsc + lsd);
                bf16x8 pa[4];
#pragma unroll
                for (int ks = 0; ks < 2; ++ks) {
                    u32x4 w0, w1;
                    w0.x = gp::cvt_pk_bf16(p0[8 * ks + 0], p0[8 * ks + 1]); w0.y = gp::cvt_pk_bf16(p0[8 * ks + 2], p0[8 * ks + 3]);
                    w0.z = gp::cvt_pk_bf16(p0[8 * ks + 4], p0[8 * ks + 5]); w0.w = gp::cvt_pk_bf16(p0[8 * ks + 6], p0[8 * ks + 7]);
                    w1.x = gp::cvt_pk_bf16(p1[8 * ks + 0], p1[8 * ks + 1]); w1.y = gp::cvt_pk_bf16(p1[8 * ks + 2], p1[8 * ks + 3]);
                    w1.z = gp::cvt_pk_bf16(p1[8 * ks + 4], p1[8 * ks + 5]); w1.w = gp::cvt_pk_bf16(p1[8 * ks + 6], p1[8 * ks + 7]);
                    pa[ks] = __builtin_bit_cast(bf16x8, w0); pa[2 + ks] = __builtin_bit_cast(bf16x8, w1);
                }
                const LAS unsigned char* vp = Vb + (4 * hi + ((lane & 15) >> 2)) * VRS + (16 * ((lane >> 4) & 1) + 4 * (lane & 3)) * 2;
#pragma unroll
                for (int d0 = 0; d0 < 4; ++d0)
#pragma unroll
                    for (int ks = 0; ks < 4; ++ks) {
                        const s16x4 lo = vtr(vp + (16 * ks) * VRS + d0 * 64), hv = vtr(vp + (16 * ks + 8) * VRS + d0 * 64);
                        const bf16x8 vf = (bf16x8){lo[0], lo[1], lo[2], lo[3], hv[0], hv[1], hv[2], hv[3]};
                        o[d0] = __builtin_amdgcn_mfma_f32_32x32x16_bf16(pa[ks], vf, o[d0], 0, 0, 0);
                    }
            }
            if (kt + 1 < NT) DA_WRITE((kt + 1) & 1);
            __syncthreads();
        }
#undef DA_LOAD
#undef DA_WRITE
        l = sum_x32(l);
        { const float fac = (wsel ? lam : 1.0f) / l;
          if (hi == 0) wsf[r32] = fac;
          asm volatile("s_waitcnt lgkmcnt(0)" ::: "memory"); }
        LAS float* Ob = (LAS float*)lds + wsel * (128 * OB_STRIDE);
#pragma unroll
        for (int r = 0; r < 16; ++r) { const float fr = wsf[crow(r, hi)]; const int row = 32 * wq + crow(r, hi);
#pragma unroll
            for (int d0 = 0; d0 < 4; ++d0) Ob[row * OB_STRIDE + 32 * d0 + r32] = o[d0][r] * fr; }
        __syncthreads();
        { const LAS float* O1 = (const LAS float*)lds; const LAS float* O2 = O1 + 128 * OB_STRIDE;
          const float g0 = sub_g[2 * lane], g1 = sub_g[2 * lane + 1];
          for (int rr = 0; rr < 16; ++rr) { const int row = 16 * wave + rr;
              const float d0v = O1[row * OB_STRIDE + 2 * lane] - O2[row * OB_STRIDE + 2 * lane], d1v = O1[row * OB_STRIDE + 2 * lane + 1] - O2[row * OB_STRIDE + 2 * lane + 1];
              const float ss = wave_sum(d0v * d0v + d1v * d1v);
              const float rs = (1.0f - LAMBDA_INIT) / sqrtf(ss * (1.f / 128.f) + RMS_EPS);
              *(unsigned*)(H + (size_t)(b * SEQ + q0 + row) * DM + h * 128 + 2 * lane) = pk2(d0v * rs * g0, d1v * rs * g1); } }
        __syncthreads();

    }
}
}
namespace ds {
typedef float f32x16 __attribute__((ext_vector_type(16)));
typedef short s16x4 __attribute__((ext_vector_type(4)));
typedef int i32x4 __attribute__((ext_vector_type(4)));
typedef unsigned u32x2 __attribute__((ext_vector_type(2)));
constexpr int HIST_OFF = 131072, SEL_OFF = 139264, OALL_OFF = 143360;
constexpr float C2 = 0.125f * 1.4426950408889634f;
__device__ __forceinline__ s16x4 vtr(const LAS unsigned char* p) { return __builtin_bit_cast(s16x4, __builtin_amdgcn_ds_read_tr16_b64_v4i16((LAS s16x4*)p)); }
__device__ __forceinline__ unsigned skey(float f) { unsigned u = __float_as_uint(f); if (u == 0x80000000u) u = 0u; return u ^ ((unsigned)((int)u >> 31) | 0x80000000u); }

template <int STOP> __device__ __forceinline__ void unit(const Params& p, LAS unsigned char* lds, int tid, int lane_in, int wave, int b, int qt, int& cvcur) {
    int lane = lane_in; asm volatile("" : "+v"(lane));
    unsigned char* ws = p.ws; const bf16_t* PROJ = (const bf16_t*)(ws + WS_PROJ); bf16_t* H = (bf16_t*)(ws + WS_H);
    const float* IW = (const float*)(ws + WS_IW);
    const int q0 = qt * 8, N = (q0 / 64 + 1) * 64, t0 = b * SEQ + q0;
    const bf16_t* base = PROJ + (size_t)b * SEQ * NPJ;
    LAS float* S = (LAS float*)lds;
    const int r32 = lane & 31, hi = lane >> 5;
    {
        bf16x8 aq[2][4]; f32x4 wv[2][4];
#pragma unroll
        for (int rb = 0; rb < 2; ++rb) {
            const bf16_t* qrow = base + (size_t)(q0 + 4 * rb + 2 * ((r32 >> 2) & 1) + (r32 >> 4)) * NPJ + C_IQ + (4 * ((r32 >> 3) & 1) + (r32 & 3)) * 64 + 8 * hi;
#pragma unroll
            for (int d0 = 0; d0 < 4; ++d0) aq[rb][d0] = *(const bf16x8*)(qrow + 16 * d0);
#pragma unroll
            for (int qq = 0; qq < 4; ++qq) wv[rb][qq] = *(const f32x4*)(IW + (size_t)(t0 + 4 * rb + 2 * hi + (qq >> 1)) * 8 + 4 * (qq & 1));
        }
        const int ntk = N / 32;
        bf16x8 bk[4], bkn[4];
        const unsigned char* ikf = ws + WS_IKF + (size_t)b * 128 * 4096 + lane * 16;
        { const unsigned char* kp = ikf + (size_t)(wave < ntk ? wave : 0) * 4096;
#pragma unroll
          for (int d0 = 0; d0 < 4; ++d0) bkn[d0] = *(const bf16x8*)(kp + d0 * 1024); }
        for (int kt = wave; kt < ntk; kt += NWAVES) {
#pragma unroll
            for (int d0 = 0; d0 < 4; ++d0) bk[d0] = bkn[d0];
            if (kt + NWAVES < ntk) { const unsigned char* kp = ikf + (size_t)(kt + NWAVES) * 4096;
#pragma unroll
                for (int d0 = 0; d0 < 4; ++d0) bkn[d0] = *(const bf16x8*)(kp + d0 * 1024); }
#pragma unroll
            for (int rb = 0; rb < 2; ++rb) {
                f32x16 acc;
#pragma unroll
                for (int r = 0; r < 16; ++r) acc[r] = 0.f;
#pragma unroll
                for (int d0 = 0; d0 < 4; ++d0) acc = __builtin_amdgcn_mfma_f32_32x32x16_bf16(aq[rb][d0], bk[d0], acc, 0, 0, 0);
                float v0 = 0.f, v1 = 0.f;
#pragma unroll
                for (int i = 0; i < 4; ++i) { v0 += wv[rb][0][i] * fmaxf(acc[i], 0.f) + wv[rb][1][i] * fmaxf(acc[4 + i], 0.f);
                                               v1 += wv[rb][2][i] * fmaxf(acc[8 + i], 0.f) + wv[rb][3][i] * fmaxf(acc[12 + i], 0.f); }
                S[(4 * rb + 2 * hi) * 4096 + 32 * kt + r32] = v0;
                S[(4 * rb + 2 * hi + 1) * 4096 + 32 * kt + r32] = v1;
            }
        }
    }
    __syncthreads();
    if (STOP == 1) return;
    asm volatile("" : "+v"(lane));
    LAS float* Sw = S + wave * 4096;
    LAS unsigned short* sel = (LAS unsigned short*)(lds + SEL_OFF) + wave * 256;
    const int nsel = N < 256 ? N : 256;
    if (N <= 256) {
        for (int i = lane; i < N; i += 64) sel[i] = (unsigned short)i;
    } else {
        LAS unsigned* hist = (LAS unsigned*)(lds + OALL_OFF) + wave * 512;
        LAS float* cv = (LAS float*)(lds + HIST_OFF) + wave * 256; LAS int* ci = (LAS int*)cv + 128;
        const unsigned long long ltmask = (1ull << lane) - 1ull;
        const int nit = (N + 255) / 256;
        float t0 = -INFINITY, t1 = -INFINITY, t2 = -INFINITY, t3 = -INFINITY;
        for (int it = 0; it < nit; ++it) { if (256 * it + 4 * lane < N) { const f32x4 v4 = *(const LAS f32x4*)(Sw + 256 * it + 4 * lane);
            t0 = fmaxf(t0, v4[0]); t1 = fmaxf(t1, v4[1]); t2 = fmaxf(t2, v4[2]); t3 = fmaxf(t3, v4[3]); } }
        float mn = fminf(fminf(t0, t1), fminf(t2, t3)), mx = fmaxf(fmaxf(t0, t1), fmaxf(t2, t3));
        mn = wave_min(mn); mx = wave_max(mx);
        bool done = false;
        if (mx > mn) {
            const float scale = 1024.0f / (mx - mn);
            *(LAS u32x4*)(hist + 8 * lane) = (u32x4){0u, 0u, 0u, 0u}; *(LAS u32x4*)(hist + 8 * lane + 4) = (u32x4){0u, 0u, 0u, 0u};
#pragma unroll 4
            for (int it = 0; it < nit; ++it) { if (256 * it + 4 * lane < N) { const f32x4 v4 = *(const LAS f32x4*)(Sw + 256 * it + 4 * lane);
#pragma unroll
                for (int q = 0; q < 4; ++q) { if (v4[q] >= mn) { int bn = (int)((v4[q] - mn) * scale); bn = bn > 1023 ? 1023 : bn;
                    __hip_atomic_fetch_add(hist + (bn >> 1), 1u << (16 * (bn & 1)), __ATOMIC_RELAXED, __HIP_MEMORY_SCOPE_WORKGROUP); } } } }
            unsigned wq[8];
            { const u32x4 h0 = *(LAS u32x4*)(hist + 8 * lane), h1 = *(LAS u32x4*)(hist + 8 * lane + 4);
              wq[0] = h0.x; wq[1] = h0.y; wq[2] = h0.z; wq[3] = h0.w; wq[4] = h1.x; wq[5] = h1.y; wq[6] = h1.z; wq[7] = h1.w; }
            int sl = 0;
#pragma unroll
            for (int q = 0; q < 8; ++q) sl += (int)(wq[q] & 0xffffu) + (int)(wq[q] >> 16);
            int v = sl;
#pragma unroll
            for (int o = 1; o < 64; o <<= 1) { const int t = __shfl_down(v, o); v += (lane + o < 64) ? t : 0; }
            int ab = v - sl, myB = -1, myAbove = 0, myCnt = 0;
#pragma unroll
            for (int q = 15; q >= 0; --q) { const int cq = (int)((wq[q >> 1] >> (16 * (q & 1))) & 0xffffu);
                if (myB < 0 && ab < 256 && 256 <= ab + cq) { myB = 16 * lane + q; myAbove = ab; myCnt = cq; }
                ab += cq; }
            const unsigned long long bal = __ballot(myB >= 0);
            const int src = __builtin_ctzll(bal);
            const int B = __shfl(myB, src), C = __shfl(myCnt, src), need = 256 - __shfl(myAbove, src);
            if (C <= 128) {
                int outpos = 0, cp = 0;
#pragma unroll 2
                for (int it = 0; it < nit; ++it) { const bool inr = 256 * it + 4 * lane < N; const f32x4 v4 = *(const LAS f32x4*)(Sw + 256 * it + 4 * (inr ? lane : 0));
#pragma unroll
                    for (int q = 0; q < 4; ++q) { int bn = (int)((v4[q] - mn) * scale); bn = bn > 1023 ? 1023 : bn;
                        const bool inb = inr && v4[q] >= mn, take = inb && bn > B, cd = inb && bn == B; const int idx = 256 * it + 4 * lane + q;
                        const unsigned long long bt = __ballot(take), bc = __ballot(cd);
                        if (take) sel[outpos + __popcll(bt & ltmask)] = (unsigned short)idx;
                        if (cd) { const int pos = cp + __popcll(bc & ltmask); cv[pos] = v4[q]; ci[pos] = idx; }
                        outpos += __popcll(bt); cp += __popcll(bc); } }
                const float v0 = lane < C ? cv[lane] : -INFINITY, v1 = lane + 64 < C ? cv[lane + 64] : -INFINITY;
                const int i0 = lane < C ? ci[lane] : 0x7fffffff, i1 = lane + 64 < C ? ci[lane + 64] : 0x7fffffff;
                int r0 = 0, r1 = 0;
                for (int q = 0; q < C; ++q) { const float ov = cv[q]; const int oi = ci[q];
                    r0 += (ov > v0 || (ov == v0 && oi < i0)) ? 1 : 0; r1 += (ov > v1 || (ov == v1 && oi < i1)) ? 1 : 0; }
                const bool t0 = lane < C && r0 < need, t1 = lane + 64 < C && r1 < need;
                const unsigned long long b0 = __ballot(t0);
                if (t0) sel[outpos + __popcll(b0 & ltmask)] = (unsigned short)i0;
                outpos += __popcll(b0);
                const unsigned long long b1 = __ballot(t1);
                if (t1) sel[outpos + __popcll(b1 & ltmask)] = (unsigned short)i1;
                done = true;
            }
        }
        if (!done) {
            {
                LAS int* h8 = (LAS int*)hist;
                unsigned prefix = 0u; int need8 = 256;
#pragma unroll 1
                for (int pass = 0; pass < 4; ++pass) {
                    const int shift = 24 - 8 * pass;
                    *(LAS i32x4*)(h8 + 4 * lane) = (i32x4){0, 0, 0, 0};
                    asm volatile("s_waitcnt lgkmcnt(0)" ::: "memory");
                    for (int j = 0; j < N / 64; ++j) { const unsigned u = skey(Sw[64 * j + lane]);
                        if (pass == 0 || (u >> (shift + 8)) == prefix) __hip_atomic_fetch_add((int*)(h8 + ((u >> shift) & 255u)), 1, __ATOMIC_RELAXED, __HIP_MEMORY_SCOPE_WORKGROUP); }
                    asm volatile("s_waitcnt lgkmcnt(0)" ::: "memory");
                    const i32x4 c = *(LAS i32x4*)(h8 + 4 * lane);
                    const int s4 = c.x + c.y + c.z + c.w; int vv = s4;
#pragma unroll
                    for (int o = 1; o < 64; o <<= 1) { const int t = __shfl_down(vv, o); vv += (lane + o < 64) ? t : 0; }
                    const int a3 = vv - s4, a2 = a3 + c.w, a1 = a2 + c.z, a0 = a1 + c.y;
                    int mB = -1, mA = 0;
                    if (a3 < need8 && need8 <= a3 + c.w) { mB = 4 * lane + 3; mA = a3; }
                    else if (a2 < need8 && need8 <= a2 + c.z) { mB = 4 * lane + 2; mA = a2; }
                    else if (a1 < need8 && need8 <= a1 + c.y) { mB = 4 * lane + 1; mA = a1; }
                    else if (a0 < need8 && need8 <= a0 + c.x) { mB = 4 * lane; mA = a0; }
                    const int sr = __builtin_ctzll(__ballot(mB >= 0));
                    need8 -= __shfl(mA, sr); prefix = (prefix << 8) | (unsigned)__shfl(mB, sr);
                }
                int outpos = 0, eqtaken = 0;
                for (int j = 0; j < N / 64; ++j) { const unsigned u = skey(Sw[64 * j + lane]);
                    const bool eq = (u == prefix); const unsigned long long beq = __ballot(eq);
                    const bool take = (u > prefix) || (eq && (eqtaken + __popcll(beq & ltmask) < need8));
                    const unsigned long long bt = __ballot(take);
                    if (take) sel[outpos + __popcll(bt & ltmask)] = (unsigned short)(64 * j + lane);
                    outpos += __popcll(bt); eqtaken += __popcll(beq); }
            }
        }
    }
    asm volatile("s_waitcnt lgkmcnt(0)" ::: "memory");
    if (STOP == 2) { __syncthreads(); return; }
    asm volatile("" : "+v"(lane));
    {
        const int n16 = lane & 15, g = lane >> 4, t = t0 + wave;
        bf16x8 bqf[2];
#pragma unroll
        for (int ks = 0; ks < 2; ++ks) { bqf[ks] = (bf16x8){0, 0, 0, 0, 0, 0, 0, 0};
            if (n16 < 8) bqf[ks] = *(const bf16x8*)(PROJ + (size_t)t * NPJ + C_BQ + n16 * 64 + 32 * ks + 8 * g); }
        const int nstep = nsel / 32;
        LAS unsigned char* Lb = (LAS unsigned char*)Sw;
        f32x4 ot[8];
#pragma unroll
        for (int cb = 0; cb < 8; ++cb) ot[cb] = (f32x4){0.f, 0.f, 0.f, 0.f};
        float mrun = -INFINITY, lsum = 0.f;
        bf16x8 kA[4], kB[4]; u32x4 stA[8], stB[8];
#define DS_LOADCH(KF, ST, s_) do { \
            { const bf16_t* kr = base + (size_t)sel[32 * (s_) + n16] * NPJ + C_BK + 8 * g; KF[0] = *(const bf16x8*)kr; KF[1] = *(const bf16x8*)(kr + 32); } \
            { const bf16_t* kr = base + (size_t)sel[32 * (s_) + 16 + n16] * NPJ + C_BK + 8 * g; KF[2] = *(const bf16x8*)kr; KF[3] = *(const bf16x8*)(kr + 32); } \
            _Pragma("unroll") for (int i = 0; i < 8; ++i) ST[i] = *(const u32x4*)(base + (size_t)sel[32 * (s_) + 4 * i + g] * NPJ + C_BLAT + 8 * n16); } while (0)
#define DS_PROC(KF, ST) do { \
            f32x4 a0 = (f32x4){0.f, 0.f, 0.f, 0.f}, a1 = (f32x4){0.f, 0.f, 0.f, 0.f}; \
            a0 = __builtin_amdgcn_mfma_f32_16x16x32_bf16(KF[0], bqf[0], a0, 0, 0, 0); a0 = __builtin_amdgcn_mfma_f32_16x16x32_bf16(KF[1], bqf[1], a0, 0, 0, 0); \
            a1 = __builtin_amdgcn_mfma_f32_16x16x32_bf16(KF[2], bqf[0], a1, 0, 0, 0); a1 = __builtin_amdgcn_mfma_f32_16x16x32_bf16(KF[3], bqf[1], a1, 0, 0, 0); \
            float cm = fmaxf(fmaxf(fmaxf(a0[0], a0[1]), fmaxf(a0[2], a0[3])), fmaxf(fmaxf(a1[0], a1[1]), fmaxf(a1[2], a1[3]))); \
            cm = max_x32(max_x16(cm)) * C2; \
            if (__any(cm - mrun > 8.0f)) { const float mnew = fmaxf(mrun, cm); const float f = __builtin_amdgcn_exp2f(mrun - mnew); lsum *= f; mrun = mnew; \
                _Pragma("unroll") for (int cb = 0; cb < 8; ++cb) ot[cb] = ot[cb] * f; } \
            float e[8]; \
            _Pragma("unroll") for (int i = 0; i < 4; ++i) { e[i] = __builtin_amdgcn_exp2f(a0[i] * C2 - mrun); e[4 + i] = __builtin_amdgcn_exp2f(a1[i] * C2 - mrun); } \
            lsum += ((e[0] + e[1]) + (e[2] + e[3])) + ((e[4] + e[5]) + (e[6] + e[7])); \
            u32x4 pw; pw.x = gp::cvt_pk_bf16(e[0], e[1]); pw.y = gp::cvt_pk_bf16(e[2], e[3]); pw.z = gp::cvt_pk_bf16(e[4], e[5]); pw.w = gp::cvt_pk_bf16(e[6], e[7]); \
            const bf16x8 pbv = __builtin_bit_cast(bf16x8, pw); \
            _Pragma("unroll") for (int i = 0; i < 8; ++i) { const int sig = 4 * i + g, ch = n16; \
                *(LAS u32x4*)(Lb + sig * 256 + (((ch >> 1) ^ (sig & 7)) * 32) + (ch & 1) * 16) = ST[i]; } \
            const int rq = 4 * g + (n16 >> 2); \
            _Pragma("unroll") for (int cb = 0; cb < 8; ++cb) { \
                const s16x4 lo = vtr(Lb + rq * 256 + ((cb ^ (rq & 7)) * 32) + 8 * (lane & 3)); \
                const s16x4 hv = vtr(Lb + (16 + rq) * 256 + ((cb ^ (rq & 7)) * 32) + 8 * (lane & 3)); \
                const bf16x8 af = (bf16x8){lo[0], lo[1], lo[2], lo[3], hv[0], hv[1], hv[2], hv[3]}; \
                ot[cb] = __builtin_amdgcn_mfma_f32_16x16x32_bf16(af, pbv, ot[cb], 0, 0, 0); } } while (0)
        DS_LOADCH(kA, stA, 0);
#pragma unroll 1
        for (int s = 0; s < nstep; s += 2) {
            DS_LOADCH(kB, stB, s + 1);
            DS_PROC(kA, stA);
            if (s + 2 < nstep) DS_LOADCH(kA, stA, s + 2);
            DS_PROC(kB, stB);
        }
#undef DS_LOADCH
#undef DS_PROC
        lsum = sum_x32(sum_x16(lsum));
        const float linv = 1.0f / lsum;
        if (n16 < 8) {
            LAS bf16_t* Oall = (LAS bf16_t*)(lds + OALL_OFF) + (wave * 8 + n16) * 128;
#pragma unroll
            for (int cb = 0; cb < 8; ++cb) *(LAS u32x2*)(Oall + 16 * cb + 4 * g) = (u32x2){pk2(ot[cb][0] * linv, ot[cb][1] * linv), pk2(ot[cb][2] * linv, ot[cb][3] * linv)};
        }
    }
    __syncthreads();
    if (STOP == 3) return;
    asm volatile("" : "+v"(lane));
    P0Item cvi, cvj; f32x4 cva[8], cvb[8];
    const bool cvok = conv_expert_issue(p, lane, wave, cvcur, cvi, cva);
    const bool cvok2 = conv_expert_issue(p, lane, wave, cvcur, cvj, cvb);
    {
        const int n16 = lane & 15, g = lane >> 4, hh = wave;
        const bf16_t* WuvT = (const bf16_t*)(ws + WS_WUVT) + hh * 64 * 128;
        const LAS bf16_t* Oall = (const LAS bf16_t*)(lds + OALL_OFF) + ((n16 & 7) * 8 + hh) * 128;
        bf16x8 af[4];
#pragma unroll
        for (int ks = 0; ks < 4; ++ks) af[ks] = *(const LAS bf16x8*)(Oall + 32 * ks + 8 * g);
#pragma unroll
        for (int nb = 0; nb < 4; ++nb) {
            f32x4 a = (f32x4){0.f, 0.f, 0.f, 0.f};
#pragma unroll
            for (int ks = 0; ks < 4; ++ks) { const bf16x8 bf = *(const bf16x8*)(WuvT + (16 * nb + n16) * 128 + 32 * ks + 8 * g);
                a = __builtin_amdgcn_mfma_f32_16x16x32_bf16(af[ks], bf, a, 0, 0, 0); }
            if (g < 2) {
#pragma unroll
                for (int i = 0; i < 4; ++i) H[(size_t)(t0 + 4 * g + i) * DM + 512 + hh * 64 + 16 * nb + n16] = f2bf(a[i]);
            }
        }
    }
    __syncthreads();
    if (cvok) p0_finish(cvi, cva, (LAS float*)(lds + wave * 8704), lane);
    if (cvok2) p0_finish(cvj, cvb, (LAS float*)(lds + wave * 8704), lane);
    __syncthreads();
}

template <int STOP> __device__ __forceinline__ void phase(const Params& p, LAS unsigned char* lds, int tid, int lane, int wave, int& cvcur) {
    const int G = gridDim.x, k = blockIdx.x;
    const bool nice = (G == 256);
    const int nit = nice ? 16 : (4096 - k + G - 1) / G;
    for (int i = 0; i < nit; ++i) {
        int b, qt;
        if (nice) { const int j = k >> 3; b = k & 7; qt = 511 - (i * 32 + ((i & 1) ? 31 - j : j)); }
        else { const int u = k + i * G; b = u & 7; qt = 511 - (u >> 3); }
        unit<STOP>(p, lds, tid, lane, wave, b, qt, cvcur);
    }
}
}

#define XB_TMO      128
#define XB_XCNT(j)  (256  + 64 * (j))
#define XB_XSUB(j)  (1280 + 64 * (j))
#define XB_XGEN(j)  (2304 + 64 * (j))
#define XB_TOP      3328
#define XB_TOPGEN   3392
#define XCD_BAR_WORDS 3456
#define XB_SPIN_CAP (1u << 22)
__device__ __forceinline__ unsigned xb_ld(unsigned* p)              { return __hip_atomic_load(p, __ATOMIC_RELAXED, __HIP_MEMORY_SCOPE_AGENT); }
__device__ __forceinline__ unsigned xb_add(unsigned* p, unsigned v) { return __hip_atomic_fetch_add(p, v, __ATOMIC_RELAXED, __HIP_MEMORY_SCOPE_AGENT); }
__device__ __forceinline__ unsigned xb_xcc_id() { return (unsigned)__builtin_amdgcn_s_getreg((3 << 11) | 20) & 0xFu; }
#define XB_SPIN(cond, bar) do { unsigned _sp = 0; while (cond) { __builtin_amdgcn_s_sleep(1); \
    if ((++_sp & 255u) == 0u) { if (xb_ld(&(bar)[XB_TMO])) break; if (_sp > XB_SPIN_CAP) { atomicAdd(&(bar)[XB_TMO], 1u); break; } } } } while (0)
struct XcdBarrier { unsigned* bar; unsigned x; volatile LAS unsigned* st; };
__device__ __forceinline__ XcdBarrier xcd_barrier_post(unsigned* bar, volatile LAS unsigned* st) {
    XcdBarrier b; b.bar = bar; b.x = xb_xcc_id(); b.st = st;
    if (threadIdx.x == 0) (void)xb_add(&bar[XB_XCNT(b.x)], 1u);
    return b;
}
__device__ __forceinline__ void xcd_barrier_complete(unsigned* bar, unsigned x, unsigned& nloc, unsigned& nx) {
    const unsigned G = gridDim.x * gridDim.y * gridDim.z;
    unsigned sum, cnt, mine, sp = 0u;
    for (;;) {
        sum = 0u; cnt = 0u; mine = 0u;
#pragma unroll
        for (unsigned j = 0; j < 16; ++j) { const unsigned c = xb_ld(&bar[XB_XCNT(j)]); sum += c; cnt += (c > 0u) ? 1u : 0u; mine = (j == x) ? c : mine; }
        if (sum == G) break;
        __builtin_amdgcn_s_sleep(1);
        if ((++sp & 255u) == 0u) { if (xb_ld(&bar[XB_TMO])) break; if (sp > XB_SPIN_CAP) { atomicAdd(&bar[XB_TMO], 1u); break; } }
    }
    nloc = mine > 0u ? mine : 1u; nx = cnt > 0u ? cnt : 1u;
}
__device__ __forceinline__ void xcd_barrier(const XcdBarrier& b) {
    asm volatile("s_waitcnt vmcnt(0)" ::: "memory");
    __syncthreads();
    if (threadIdx.x == 0) {
        unsigned* bar = b.bar;
        __builtin_amdgcn_s_waitcnt(0);
        unsigned nloc = b.st[0], nx = b.st[1];
        if (nloc == 0u) { xcd_barrier_complete(bar, b.x, nloc, nx); b.st[0] = nloc; b.st[1] = nx; }
        const unsigned old = xb_add(&bar[XB_XSUB(b.x)], 1u);
        const unsigned gen = old / nloc;
        if (old + 1u == (gen + 1u) * nloc) {
            __builtin_amdgcn_fence(__ATOMIC_RELEASE, "agent");
            asm volatile("s_waitcnt vmcnt(0)" ::: "memory");
            const unsigned og = xb_add(&bar[XB_TOP], 1u);
            const unsigned tg = og / nx;
            if (og + 1u == (tg + 1u) * nx) xb_add(&bar[XB_TOPGEN], 1u);
            else XB_SPIN(xb_ld(&bar[XB_TOPGEN]) == tg, bar);
            __builtin_amdgcn_fence(__ATOMIC_ACQUIRE, "agent");
            xb_add(&bar[XB_XGEN(b.x)], 1u);
            asm volatile("s_waitcnt vmcnt(0)" ::: "memory");
        } else {
            XB_SPIN(xb_ld(&bar[XB_XGEN(b.x)]) == gen, bar);
            __builtin_amdgcn_fence(__ATOMIC_ACQUIRE, "agent");
            asm volatile("s_waitcnt vmcnt(0)" ::: "memory");
        }
    }
    __syncthreads();
}
constexpr int N_PHASES = 10;
__global__ void __launch_bounds__(NTHREADS, 2) mega(Params p) {
    extern __shared__ __attribute__((aligned(16))) unsigned char lds_raw[];
    LAS unsigned char* lds = (LAS unsigned char*)lds_raw;
    cg::grid_group grid = cg::this_grid();
    int tid = threadIdx.x, lane = tid & 63; const int wave = __builtin_amdgcn_readfirstlane(tid >> 6);
#define FRESH() do { tid = threadIdx.x; asm volatile("" : "+v"(tid)); lane = tid & 63; } while (0)
    unsigned char* ws = p.ws;
    const int lo = p.ph_lo, hi = p.ph_hi;
    volatile LAS unsigned* MISC = (volatile LAS unsigned*)(lds + LDS_MISC);
    if (tid < 16) MISC[tid] = 0u;
    __syncthreads();
    XcdBarrier bar = xcd_barrier_post((unsigned*)(ws + WS_CTL), MISC);
#define IN(k) (lo <= (k) && (k) < hi)
#define SEAM(k) do { if (IN(k) && IN((k) + 1)) xcd_barrier(bar); } while (0)
    if (lo < 0) grid.sync();
    if (IN(0)) { FRESH(); phase_prep(p, lds, tid, lane, wave); } SEAM(0);
    if (IN(1)) { FRESH(); phase_norm1(p, lds, tid, lane, wave); } SEAM(1);
    if (IN(2)) { FRESH();
        gp::Gemm g{(const bf16_t*)(ws + WS_H), (const bf16_t*)(ws + WS_WINT), NPJ, DM, nullptr};
        gp::StaticOrder S; S.init(NTOK, NPJ, gridDim.x, blockIdx.x);
        LAS float* gl = (LAS float*)(lds + LDS_RING + 8192);
        if (tid < 64) { gl[tid] = p.in[8][tid]; gl[64 + tid] = p.in[9][tid]; gl[128 + tid] = p.in[12][tid]; gl[192 + tid] = p.in[13][tid]; }
        if (tid < 128) gl[256 + tid] = p.in[14][tid];
        __syncthreads();
        gp::EpiInproj E{(bf16_t*)(ws + WS_PROJ), (const float*)(ws + WS_ROPE), gl, (LAS float*)(lds + LDS_RING), ws + WS_IKF};
        gp::gemm_phase<gp::EpiInproj, gp::StaticOrder, false>(lds, g, S, E);
    } SEAM(2);
    if (IN(3)) { int cvcur = 0;
        const bool dsa_first = (((int)blockIdx.x >> 3) & 1) != 0;
        if (!dsa_first) { FRESH(); da::phase(p, lds, tid, lane, wave, cvcur); }
        FRESH(); ds::phase<0>(p, lds, tid, lane, wave, cvcur);
        if (dsa_first) { FRESH(); da::phase(p, lds, tid, lane, wave, cvcur); }
        conv_expert_items(p, lds, lane, wave, cvcur, 1 << 20); } SEAM(3);
    if (IN(4)) { FRESH();
        gp::Gemm g{(const bf16_t*)(ws + WS_H), (const bf16_t*)(ws + WS_WOUTT), DM, DM, nullptr};
        gp::StaticOrder S; S.init(NTOK, DM, gridDim.x, blockIdx.x);
        gp::EpiResid E{p.in[0], p.out, (const float*)(ws + WS_MOD)};
        gp::gemm_phase<gp::EpiResid, gp::StaticOrder, false>(lds, g, S, E);
    } SEAM(4);
    if (IN(5)) { FRESH(); phase_norm2(p, lds, tid, lane, wave); } SEAM(5);
    if (IN(6)) { FRESH(); phase_scatter(p, lds, tid, lane, wave); } SEAM(6);
    if (IN(7)) { FRESH();
        const int* tile_e = (const int*)(ws + WS_TILEE);
        gp::Gemm g{(const bf16_t*)(ws + WS_H), (const bf16_t*)(ws + WS_WGUT), 2048, DM, (const int*)(ws + WS_ROWSRC)};
        gp::MoeOrder S{tile_e, tile_e[MAXTILES], 8, (int)blockIdx.x, (int)gridDim.x};
        gp::EpiSwiglu E{(bf16_t*)(ws + WS_ACT), p.in[19], p.in[21]};
        gp::gemm_phase<gp::EpiSwiglu, gp::MoeOrder, true>(lds, g, S, E);
    } SEAM(7);
    if (IN(8)) { FRESH();
        const int* tile_e = (const int*)(ws + WS_TILEE);
        gp::Gemm g{(const bf16_t*)(ws + WS_ACT), (const bf16_t*)(ws + WS_WDT), DM, DM, nullptr};
        gp::MoeOrder S{tile_e, tile_e[MAXTILES], 4, (int)blockIdx.x, (int)gridDim.x};
        gp::EpiDown E{p.out, (bf16_t*)(ws + WS_Y), p.in[23], (const float*)(ws + WS_MOD), (const int2*)(ws + WS_ROWMETA)};
        gp::gemm_phase<gp::EpiDown, gp::MoeOrder, false>(lds, g, S, E);
    } SEAM(8);
    if (IN(9)) { FRESH(); phase_combine(p, tid); }
#undef IN
#undef SEAM
}

static int g_grid = 0;
static void launch_mega(const Params& base, int lo, int hi, hipStream_t stream) {
    Params p = base; p.ph_lo = lo; p.ph_hi = hi;
    void* args[] = {&p};
    hipError_t e = hipLaunchCooperativeKernel((const void*)mega, dim3(g_grid), dim3(NTHREADS), args, LDS_BYTES, stream);
    if (e != hipSuccess) fprintf(stderr, "kernel_launch: cooperative launch [%d,%d) failed: %s (grid %d)\n", lo, hi, hipGetErrorString(e), g_grid);
}
extern "C" void kernel_launch(void* const* d_in, const int* in_sizes, int n_in, void* d_out, int out_size, void* d_ws, size_t ws_size, hipStream_t stream) {
    if (ws_size < WS_END) { fprintf(stderr, "kernel_launch: workspace too small: %zu < %zu\n", ws_size, (size_t)WS_END); return; }
    if (g_grid == 0) {
        int dev = 0, cus = 0, per_cu = 0;
        hipGetDevice(&dev); hipDeviceGetAttribute(&cus, hipDeviceAttributeMultiprocessorCount, dev);
        if (hipFuncSetAttribute((const void*)mega, hipFuncAttributeMaxDynamicSharedMemorySize, LDS_BYTES) != hipSuccess) fprintf(stderr, "kernel_launch: hipFuncSetAttribute failed\n");
        hipOccupancyMaxActiveBlocksPerMultiprocessor(&per_cu, (const void*)mega, NTHREADS, LDS_BYTES);
        (void)hipGetLastError();
        if (per_cu < 1) { fprintf(stderr, "kernel_launch: occupancy query says %d blocks/CU\n", per_cu); per_cu = 1; }
        g_grid = cus * 1;
        fprintf(stderr, "kernel_launch: cus %d per_cu %d grid %d\n", cus, per_cu, g_grid);
    }
    const float* x = (const float*)d_in[0];
    float* out = (float*)d_out; char* ws = (char*)d_ws;
    float* mod = (float*)(ws + WS_MOD); float* rope = (float*)(ws + WS_ROPE); float* lam = (float*)(ws + WS_LAM);
    float* IW = (float*)(ws + WS_IW);
    bf16_t* H = (bf16_t*)(ws + WS_H); bf16_t* PROJ = (bf16_t*)(ws + WS_PROJ);
    Params P{};
    for (int i = 0; i < 24; ++i) P.in[i] = (const float*)d_in[i];
    P.out = out; P.ws = (unsigned char*)d_ws;

    (void)hipMemsetAsync((char*)d_ws + WS_CTL, 0, 16384, stream);
    launch_mega(P, 0, N_PHASES, stream);
    (void)rope; (void)lam; (void)IW; (void)H; (void)PROJ;
    (void)x; (void)mod;
}
```

```cpp
#include <hip/hip_runtime.h>
#include <stdint.h>
#include <cstdio>

typedef unsigned short bf16_t;
__device__ __forceinline__ float bf2f(bf16_t v) { return __uint_as_float(((unsigned)v) << 16); }
__device__ __forceinline__ bf16_t f2bf(float f) { unsigned u = __float_as_uint(f); return (bf16_t)((u + 0x7fffu + ((u >> 16) & 1u)) >> 16); }

template <int CTRL> __device__ __forceinline__ float dppf(float x) { return __builtin_bit_cast(float, __builtin_amdgcn_mov_dpp(__builtin_bit_cast(int, x), CTRL, 0xf, 0xf, true)); }
constexpr int DPP_X1 = 0xB1, DPP_X2 = 0x4E, DPP_HM = 0x141, DPP_R8 = 0x128;
struct F2 { float a, b; };
__device__ __forceinline__ F2 swap16(float a, float b) {
    auto s = __builtin_amdgcn_permlane16_swap(__float_as_uint(a), __float_as_uint(b), false, false); return F2{__uint_as_float(s[0]), __uint_as_float(s[1])}; }
__device__ __forceinline__ F2 swap32(float a, float b) {
    auto s = __builtin_amdgcn_permlane32_swap(__float_as_uint(a), __float_as_uint(b), false, false); return F2{__uint_as_float(s[0]), __uint_as_float(s[1])}; }
__device__ __forceinline__ float sum_x16(float x) { const F2 s = swap16(x, x); return s.a + s.b; }
__device__ __forceinline__ float sum_x32(float x) { const F2 s = swap32(x, x); return s.a + s.b; }
__device__ __forceinline__ float max_x16(float x) { const F2 s = swap16(x, x); return fmaxf(s.a, s.b); }
__device__ __forceinline__ float max_x32(float x) { const F2 s = swap32(x, x); return fmaxf(s.a, s.b); }
__device__ __forceinline__ float min_x16(float x) { const F2 s = swap16(x, x); return fminf(s.a, s.b); }
__device__ __forceinline__ float min_x32(float x) { const F2 s = swap32(x, x); return fminf(s.a, s.b); }
__device__ __forceinline__ float get_x16(float x, int lane) { const F2 s = swap16(x, x); return (lane & 16) ? s.a : s.b; }
__device__ __forceinline__ float wave_sum(float v) {
    v += dppf<DPP_X1>(v); v += dppf<DPP_X2>(v); v += dppf<DPP_HM>(v); v += dppf<DPP_R8>(v); v = sum_x16(v); return sum_x32(v); }
__device__ __forceinline__ float wave_max(float v) {
    v = fmaxf(v, dppf<DPP_X1>(v)); v = fmaxf(v, dppf<DPP_X2>(v)); v = fmaxf(v, dppf<DPP_HM>(v)); v = fmaxf(v, dppf<DPP_R8>(v)); v = max_x16(v); return max_x32(v); }
__device__ __forceinline__ float wave_min(float v) {
    v = fminf(v, dppf<DPP_X1>(v)); v = fminf(v, dppf<DPP_X2>(v)); v = fminf(v, dppf<DPP_HM>(v)); v = fminf(v, dppf<DPP_R8>(v)); v = min_x16(v); return min_x32(v); }

constexpr int NB = 8, SEQ = 4096, DM = 1024, NTOK = NB * SEQ;
constexpr int NIN = 2824, NPJ = 2816;
constexpr int C_AQ1 = 0, C_AQ2 = 256, C_AK1 = 512, C_AK2 = 768, C_AV = 1024, C_BQ = 1536, C_BK = 2048, C_BLAT = 2112, C_IQ = 2240, C_IK = 2752, C_IW = 2816;
constexpr int NEXP = 32, TOPK = 4, NPAIR = NTOK * TOPK;
constexpr int MAXTILES = NPAIR / 256 + NEXP;
constexpr int PPAD = MAXTILES * 256;
constexpr int NCHUNK = 256, CHTOK = NTOK / NCHUNK;
constexpr float RMS_EPS = 1e-6f;
constexpr float LAMBDA_INIT = 0.2f;

constexpr size_t MiB = 1u << 20;
constexpr size_t WS_CTL = 0;
constexpr size_t WS_MOD = 1 * MiB;
constexpr size_t WS_ROPE = WS_MOD + 256 * 1024;
constexpr size_t WS_LAM = WS_ROPE + 256 * 1024;
constexpr size_t WS_CHCNT = WS_LAM + 4096;
constexpr size_t WS_TILEE = WS_CHCNT + 32768;
constexpr size_t WS_TOPI = 2 * MiB;
constexpr size_t WS_TOPG = WS_TOPI + 512 * 1024;
constexpr size_t WS_ROWTOK = 3 * MiB;
constexpr size_t WS_ROWSRC = 3 * MiB + 640 * 1024;
constexpr size_t WS_IW = 5 * MiB;
constexpr size_t WS_ROWMETA = 6 * MiB;
constexpr size_t WS_WINT = 8 * MiB;
constexpr size_t WS_WOUTT = 14 * MiB;
constexpr size_t WS_WUVT = 16 * MiB;
constexpr size_t WS_WDT = 17 * MiB;
constexpr size_t WS_WGUT = 81 * MiB;
constexpr size_t WS_H = 209 * MiB;
constexpr size_t WS_PROJ = 273 * MiB;
constexpr size_t WS_ACT = WS_PROJ;
constexpr size_t WS_Y = WS_WGUT;
constexpr size_t WS_IKF = WS_ACT + (size_t)PPAD * 1024 * 2;
constexpr size_t WS_KL8 = WS_PROJ + 176 * MiB;
constexpr size_t WS_AV8 = WS_PROJ + 182 * MiB;
constexpr size_t WS_AK8 = WS_PROJ + 198 * MiB;
constexpr size_t WS_X1B = WS_PROJ + 136 * MiB;
constexpr size_t WS_END = WS_IKF + 4 * MiB;

namespace gp {
#define GP_LAS __attribute__((address_space(3)))
typedef short bf16x8 __attribute__((ext_vector_type(8)));
typedef float f32x4 __attribute__((ext_vector_type(4)));
typedef unsigned u32x4 __attribute__((ext_vector_type(4)));
typedef unsigned u32x2 __attribute__((ext_vector_type(2)));
typedef int i32x8 __attribute__((ext_vector_type(8)));
constexpr int BM = 256, BK = 64, HALF = 128, HTB = HALF * BK * 2  , STAGE_BYTES = 8 * HTB;

__host__ __device__ __forceinline__ int lds_byte(int r, int c) { const int st = (r >> 4) * 2 + (c >> 5), rr = r & 15, cc = c & 31, ob = rr * 64 + cc * 2; return st * 1024 + (ob ^ (((ob >> 9) & 1) << 5)); }
__host__ __device__ __forceinline__ void stage_rc(int b, int& R, int& C) { const int st = b / 1024, sb = b % 1024, swz = sb ^ (((sb >> 9) & 1) << 5); R = (st >> 1) * 16 + swz / 64; C = (st & 1) * 32 + (swz % 64) / 2; }
__host__ __device__ __forceinline__ int perm32(int rho) { const int n = rho >> 4, i = rho & 15; return 8 * (i >> 2) + 4 * n + (i & 3); }

struct Unit { int pm, pn, e; };
struct Gemm { const bf16_t* A; const bf16_t* Bt; int N, K; const int* rowsrc; };

struct StaticOrder {
    int nM, nN, nwg, G, c;
    __device__ void init(int M, int N, int G_, int c_) { nM = M / BM; nN = N / BM; nwg = nM * nN; G = G_; c = c_; }
    __device__ bool next(int i, Unit& u) const {
        const long L = (long)i * G + c; if (L >= nwg) return false;
        int wgid = (int)L; { const int q = nwg / 8, r = nwg % 8, xcd = wgid % 8, off = wgid / 8; wgid = (xcd < r ? xcd * (q + 1) : r * (q + 1) + (xcd - r) * q) + off; }
        const int nig = 8 * nN, gid = wgid / nig, fm = gid * 8, gsz = (nM - fm) < 8 ? (nM - fm) : 8;
        u.pm = fm + ((wgid % nig) % gsz); u.pn = (wgid % nig) / gsz; u.e = 0; return true;
    }
};
struct MoeOrder {
    const int* tile_e; int ntiles, nN, c, G;
    __device__ bool next(int i, Unit& u) const {
        const int j = c >> 3, x = c & 7, tpx = (G >> 3) / nN;
        const int tile = i * (tpx * 8) + x * tpx + j / nN;
        if (tile >= ntiles) return false;
        u.pm = tile; u.pn = j % nN; u.e = tile_e[tile]; return true;
    }
};

typedef float f32x2_cv __attribute__((ext_vector_type(2))); typedef __bf16 bf16x2_cv __attribute__((ext_vector_type(2)));
__device__ __forceinline__ unsigned cvt_pk_bf16(float lo, float hi) { const f32x2_cv v = {lo, hi}; return __builtin_bit_cast(unsigned, __builtin_convertvector(v, bf16x2_cv)); }

struct EpiBf16 {
    bf16_t* O; int ldc;
    __device__ __forceinline__ void operator()(const f32x4 (&acc)[2][2][4][2], const Unit& u, int wr, int wc, int fr, int fq) const {
        const int row0 = u.pm * BM + wr * 64 + fr, col0 = u.pn * BM + wc * 32 + 8 * fq;
#pragma unroll
        for (int ai = 0; ai < 2; ++ai)
#pragma unroll
            for (int m = 0; m < 4; ++m) { bf16_t* rowp = O + (size_t)(row0 + ai * HALF + m * 16) * ldc + col0;
#pragma unroll
                for (int bj = 0; bj < 2; ++bj) { const f32x4 v0 = acc[ai][bj][m][0], v1 = acc[ai][bj][m][1];
                    u32x4 w; w.x = cvt_pk_bf16(v0[0], v0[1]); w.y = cvt_pk_bf16(v0[2], v0[3]); w.z = cvt_pk_bf16(v1[0], v1[1]); w.w = cvt_pk_bf16(v1[2], v1[3]);
                    *(u32x4*)(rowp + bj * HALF) = w; } }
    }
};

__device__ __forceinline__ unsigned pack4_fp8(float a, float b, float c, float d) {
    int f = __builtin_amdgcn_cvt_pk_fp8_f32(__builtin_amdgcn_fmed3f(a, -448.0f, 448.0f), __builtin_amdgcn_fmed3f(b, -448.0f, 448.0f), 0, false);
    return (unsigned)__builtin_amdgcn_cvt_pk_fp8_f32(__builtin_amdgcn_fmed3f(c, -448.0f, 448.0f), __builtin_amdgcn_fmed3f(d, -448.0f, 448.0f), f, true);
}
struct EpiInproj {
    bf16_t* O; const float* rope; GP_LAS const float* gl; GP_LAS float* xch; unsigned char* ikf; unsigned char* kl8; GP_LAS float* ropel; float ascale; unsigned char* av8; unsigned char* ak8;
    __device__ __forceinline__ void operator()(const f32x4 (&acc)[2][2][4][2], const Unit& u, int wr, int wc, int fr, int fq) const {
        const int wid = wr * 4 + wc, row0 = u.pm * BM + wr * 64 + fr, col0 = u.pn * BM + wc * 32 + 8 * fq, lc = (wc & 1) * 32 + 8 * fq;
        int mode[2]; int goff[2];
#pragma unroll
        for (int bj = 0; bj < 2; ++bj) { const int gc = u.pn * BM + bj * HALF + (wc >> 1) * 64; goff[bj] = 0;
            if (gc < 512) { mode[bj] = 1; goff[bj] = lc; } else if (gc < 1024) { mode[bj] = 1; goff[bj] = 64 + lc; } else if (gc < 1536) { mode[bj] = 0; }
            else if (gc < 2048) { mode[bj] = 1; goff[bj] = 128 + lc; } else if (gc < 2112) { mode[bj] = 1; goff[bj] = 192 + lc; }
            else if (gc < 2240) { mode[bj] = 3; goff[bj] = 256 + (gc - 2112) + lc; } else { mode[bj] = 2; } }
        f32x4 rr0_, rr1_; int rt_;
        { const int t_ = wid * 64 + fq * 16 + fr; const float* rsrc = rope + (size_t)((u.pm * BM) % SEQ) * 16 + 8 * t_;
          rr0_ = *(const f32x4*)rsrc; rr1_ = *(const f32x4*)(rsrc + 4); rt_ = t_; }
#pragma unroll
        for (int ai = 0; ai < 2; ++ai)
#pragma unroll
            for (int m = 0; m < 4; ++m)
#pragma unroll
                for (int bj = 0; bj < 2; ++bj) { const f32x4 a = acc[ai][bj][m][0] * ascale, b = acc[ai][bj][m][1] * ascale;
                    float s = ((a[0] * a[0] + a[1] * a[1]) + (a[2] * a[2] + a[3] * a[3])) + ((b[0] * b[0] + b[1] * b[1]) + (b[2] * b[2] + b[3] * b[3]));
                    s = sum_x32(sum_x16(s));
                    if (fq == 0) xch[(wid * 2 + bj) * 128 + ai * 64 + m * 16 + fr] = s; }
        *(GP_LAS f32x4*)(ropel + 8 * rt_) = rr0_; *(GP_LAS f32x4*)(ropel + 8 * rt_ + 4) = rr1_;
        asm volatile("s_waitcnt lgkmcnt(0)" ::: "memory"); __builtin_amdgcn_s_barrier(); asm volatile("" ::: "memory");
#pragma unroll
        for (int ai = 0; ai < 2; ++ai)
#pragma unroll
            for (int m = 0; m < 4; ++m) { int rl = ai * 64 + m * 16 + fr, row = row0 + ai * HALF + m * 16; asm volatile("" : "+v"(rl), "+v"(row)); const int pos = row % SEQ;
                bf16_t* rowp = O + (size_t)row * NPJ + col0;
#pragma unroll
                for (int bj = 0; bj < 2; ++bj) { f32x4 v0 = acc[ai][bj][m][0] * ascale, v1 = acc[ai][bj][m][1] * ascale;
                    if (mode[bj] == 1 || mode[bj] == 3) {
                        float tot = xch[(wid * 2 + bj) * 128 + rl] + xch[((wid ^ 1) * 2 + bj) * 128 + rl];
                        if (mode[bj] == 3) tot += xch[((wr * 4 + (wc ^ 2)) * 2 + (bj ^ 1)) * 128 + rl] + xch[((wr * 4 + (wc ^ 3)) * 2 + (bj ^ 1)) * 128 + rl];
                        const float r = 1.0f / sqrtf(tot * (mode[bj] == 3 ? (1.f / 128.f) : (1.f / 64.f)) + RMS_EPS);
                        const f32x4 g0 = *(GP_LAS const f32x4*)(gl + goff[bj]), g1 = *(GP_LAS const f32x4*)(gl + goff[bj] + 4);
                        v0 = v0 * r * g0; v1 = v1 * r * g1; }
                    if ((mode[bj] == 1 || mode[bj] == 2) && (wc & 1) == 0) {
                        f32x4 o0, o1;
#pragma unroll
                        for (int i = 0; i < 4; ++i) { o0[i] = get_x16(v0[i], fq << 4); o1[i] = get_x16(v1[i], fq << 4); }
                        if (fq < 2) { const GP_LAS float* rp = ropel + (row - u.pm * BM) * 16; const float sg = fq == 0 ? -1.0f : 1.0f;
                            const f32x4 t0 = *(const GP_LAS f32x4*)(rp), t1 = *(const GP_LAS f32x4*)(rp + 4), t2 = *(const GP_LAS f32x4*)(rp + 8), t3 = *(const GP_LAS f32x4*)(rp + 12);
                            v0[0] = v0[0] * t0[0] + sg * o0[0] * t0[1]; v0[1] = v0[1] * t0[2] + sg * o0[1] * t0[3];
                            v0[2] = v0[2] * t1[0] + sg * o0[2] * t1[1]; v0[3] = v0[3] * t1[2] + sg * o0[3] * t1[3];
                            v1[0] = v1[0] * t2[0] + sg * o1[0] * t2[1]; v1[1] = v1[1] * t2[2] + sg * o1[1] * t2[3];
                            v1[2] = v1[2] * t3[0] + sg * o1[2] * t3[1]; v1[3] = v1[3] * t3[2] + sg * o1[3] * t3[3]; } }
                    u32x4 w; w.x = cvt_pk_bf16(v0[0], v0[1]); w.y = cvt_pk_bf16(v0[2], v0[3]); w.z = cvt_pk_bf16(v1[0], v1[1]); w.w = cvt_pk_bf16(v1[2], v1[3]);
                    if (!((u.pn >= 2 && u.pn <= 5) || (u.pn == 8 && (bj == 0 || wc < 2)) || (u.pn == 10 && bj == 1 && wc >= 2))) *(u32x4*)(rowp + bj * HALF) = w;
                    if (u.pn == 2 || u.pn == 3) {
                        *(u32x2*)(ak8 + (size_t)row * 512 + (col0 + bj * HALF - 512)) = (u32x2){pack4_fp8(v0[0], v0[1], v0[2], v0[3]), pack4_fp8(v1[0], v1[1], v1[2], v1[3])}; }
                    if (u.pn == 4 || u.pn == 5) {
                        *(u32x2*)(av8 + (size_t)row * 512 + (col0 + bj * HALF - 1024)) = (u32x2){pack4_fp8(v0[0], v0[1], v0[2], v0[3]), pack4_fp8(v1[0], v1[1], v1[2], v1[3])}; }
                    if (u.pn == 8 && (bj == 0 || wc < 2)) {
#define GP_SAT8(X) __builtin_amdgcn_fmed3f((X), -448.0f, 448.0f)
                        int f0 = __builtin_amdgcn_cvt_pk_fp8_f32(GP_SAT8(v0[0]), GP_SAT8(v0[1]), 0, false); f0 = __builtin_amdgcn_cvt_pk_fp8_f32(GP_SAT8(v0[2]), GP_SAT8(v0[3]), f0, true);
                        int f1 = __builtin_amdgcn_cvt_pk_fp8_f32(GP_SAT8(v1[0]), GP_SAT8(v1[1]), 0, false); f1 = __builtin_amdgcn_cvt_pk_fp8_f32(GP_SAT8(v1[2]), GP_SAT8(v1[3]), f1, true);
#undef GP_SAT8
                        *(u32x2*)(kl8 + (size_t)row * 192 + (col0 + bj * HALF - 2048)) = (u32x2){(unsigned)f0, (unsigned)f1}; }
                    if (u.pn == 10 && bj == 1 && wc >= 2) {
                        const int key = row % SEQ, c8 = (wc & 1) * 4 + fq;
                        *(u32x4*)(ikf + ((size_t)((((row / SEQ) * 128 + (key >> 5)) * 4 + (c8 >> 1)) * 64 + (c8 & 1) * 32 + (key & 31)) << 4)) = w; } }
                asm volatile("" ::: "memory"); }
    }
};
struct EpiResid {
    const float* x; bf16_t* x1b; const float* mod;
    __device__ __forceinline__ void operator()(const f32x4 (&acc)[2][2][4][2], const Unit& u, int wr, int wc, int fr, int fq) const {
        const int row0 = u.pm * BM + wr * 64 + fr, col0 = u.pn * BM + wc * 32 + 8 * fq, b = (u.pm * BM) / SEQ;
        f32x4 gv[2][2];
#pragma unroll
        for (int bj = 0; bj < 2; ++bj)
#pragma unroll
            for (int n = 0; n < 2; ++n) gv[bj][n] = *(const f32x4*)(mod + b * 6144 + 2 * 1024 + col0 + bj * HALF + 4 * n);
#pragma unroll
        for (int ai = 0; ai < 2; ++ai)
#pragma unroll
            for (int m = 0; m < 4; ++m) { const size_t off = (size_t)(row0 + ai * HALF + m * 16) * DM + col0;
#pragma unroll
                for (int bj = 0; bj < 2; ++bj) { const f32x4 x0 = *(const f32x4*)(x + off + bj * HALF), x1 = *(const f32x4*)(x + off + bj * HALF + 4);
                    const f32x4 r0 = x0 + gv[bj][0] * acc[ai][bj][m][0], r1 = x1 + gv[bj][1] * acc[ai][bj][m][1];
                    u32x4 w; w.x = cvt_pk_bf16(r0[0], r0[1]); w.y = cvt_pk_bf16(r0[2], r0[3]); w.z = cvt_pk_bf16(r1[0], r1[1]); w.w = cvt_pk_bf16(r1[2], r1[3]);
                    *(u32x4*)(x1b + off + bj * HALF) = w; }
                asm volatile("" ::: "memory"); }
    }
};
constexpr float W8_SCALE = 32.0f, W8_INV = 1.0f / 32.0f;
struct EpiSwiglu {
    unsigned char* act; const float* bg; const float* bu;
    __device__ __forceinline__ void operator()(const f32x4 (&acc)[2][2][4][2], const Unit& u, int wr, int wc, int fr, int fq) const {
        const int row0 = u.pm * BM + wr * 64 + fr, ff0 = u.pn * HALF + wc * 32 + 8 * fq;
        f32x4 bgv[2], buv[2];
#pragma unroll
        for (int n = 0; n < 2; ++n) { bgv[n] = *(const f32x4*)(bg + u.e * 1024 + ff0 + 4 * n); buv[n] = *(const f32x4*)(bu + u.e * 1024 + ff0 + 4 * n); }
#pragma unroll
        for (int ai = 0; ai < 2; ++ai)
#pragma unroll
            for (int m = 0; m < 4; ++m) {
                float a[8];
#pragma unroll
                for (int n = 0; n < 2; ++n) { const f32x4 g4 = acc[ai][0][m][n] * W8_INV + bgv[n], u4 = acc[ai][1][m][n] * W8_INV + buv[n];
#pragma unroll
                    for (int j = 0; j < 4; ++j) { const float g = fminf(g4[j], 7.0f), uu = fminf(fmaxf(u4[j], -7.0f), 7.0f);
                        const float sg = __builtin_amdgcn_rcpf(1.0f + __builtin_amdgcn_exp2f(-1.702f * 1.4426950408889634f * g));
                        a[4 * n + j] = g * sg * (uu + 1.0f); } }
                *(u32x2*)(act + (size_t)(row0 + ai * HALF + m * 16) * 1024 + ff0) = (u32x2){pack4_fp8(a[0], a[1], a[2], a[3]), pack4_fp8(a[4], a[5], a[6], a[7])}; }
    }
};
constexpr float Y8_SCALE = 16.0f, Y8_INV = 1.0f / 16.0f;
struct EpiDown {
    unsigned char* Y; const float* bd; const int2* rowmeta;
    __device__ __forceinline__ void operator()(const f32x4 (&acc)[2][2][4][2], const Unit& u, int wr, int wc, int fr, int fq) const {
        const int row0 = u.pm * BM + wr * 64 + fr, col0 = u.pn * BM + wc * 32 + 8 * fq;
        int2 meta[2][4];
#pragma unroll
        for (int ai = 0; ai < 2; ++ai)
#pragma unroll
            for (int m = 0; m < 4; ++m) meta[ai][m] = rowmeta[row0 + ai * HALF + m * 16];
        f32x4 bv[2][2];
#pragma unroll
        for (int bj = 0; bj < 2; ++bj)
#pragma unroll
            for (int n = 0; n < 2; ++n) bv[bj][n] = *(const f32x4*)(bd + u.e * 1024 + col0 + bj * HALF + 4 * n);
#pragma unroll
        for (int ai = 0; ai < 2; ++ai)
#pragma unroll
            for (int m = 0; m < 4; ++m) {
                const int ent = meta[ai][m].x;
                if (ent >= 0) {
                    const int tok = ent >> 2, kk = ent & 3; const float gt = __int_as_float(meta[ai][m].y) * Y8_SCALE;
                    unsigned char* yp = Y + ((size_t)kk * NTOK + tok) * DM + col0;
#pragma unroll
                    for (int bj = 0; bj < 2; ++bj) { const f32x4 v0 = (acc[ai][bj][m][0] * W8_INV + bv[bj][0]) * gt, v1 = (acc[ai][bj][m][1] * W8_INV + bv[bj][1]) * gt;
                        *(u32x2*)(yp + bj * HALF) = (u32x2){pack4_fp8(v0[0], v0[1], v0[2], v0[3]), pack4_fp8(v1[0], v1[1], v1[2], v1[3])}; }
                } }
    }
};

template <class Epi, class Sched, bool GATHER, bool F8 = false>
__device__ __forceinline__ void gemm_phase(GP_LAS unsigned char* lds, const Gemm g, const Sched& S, const Epi& E) {
    const int tid = threadIdx.x, wid = __builtin_amdgcn_readfirstlane(tid >> 6), lane = tid & 63, wr = wid >> 2, wc = wid & 3, fr = lane & 15, fq = lane >> 4;
    const int K = g.K, nt = K / BK;
    unsigned voffB[2];
#pragma unroll
    for (int i = 0; i < 2; ++i) { int R, C; stage_rc(tid * 16 + i * 8192, R, C); const int Rb = (R & ~31) + perm32(R & 31); voffB[i] = (unsigned)(Rb * K + C) * 2u; }
    const size_t kstep = (size_t)(BK * 2);
    const size_t hstep = (size_t)HALF * K * 2;
    const size_t tstep = 2 * hstep;
    const unsigned ldsw = (unsigned)wid * 1024u;
    const int aoff = lds_byte(wr * 64 + fr, fq * 8), boff = lds_byte(wc * 32 + fr, fq * 8);
#define GP_SA(b, h) (((b) * 2 + (h)) * HTB)
#define GP_SB(b, h) ((4 + (b) * 2 + (h)) * HTB)
#define GP_STAGE(bufoff, gbase, voff) do { _Pragma("unroll") for (int _i = 0; _i < 2; ++_i) \
        __builtin_amdgcn_global_load_lds((const unsigned*)((const char*)(gbase) + (voff)[_i]), (GP_LAS unsigned*)(lds + (bufoff) + ldsw + _i * 8192), 16, 0, 0); } while (0)
#define GP_LDA8(m_, slot_) do { const u32x4 lo_ = *(const GP_LAS u32x4*)(lds + abuf_ + aoff + (m_) * 2048), hi_ = *(const GP_LAS u32x4*)(lds + abuf_ + aoff + (m_) * 2048 + 1024); \
        At8[slot_] = (i32x8){(int)lo_.x, (int)lo_.y, (int)lo_.z, (int)lo_.w, (int)hi_.x, (int)hi_.y, (int)hi_.z, (int)hi_.w}; } while (0)
#define GP_LDA(dst, b, h) do { \
        if (F8) { abuf_ = GP_SA(b, h); GP_LDA8(0, 0); GP_LDA8(1, 1); GP_LDA8(2, 2); GP_LDA8(3, 3); }  \
        else { _Pragma("unroll") for (int m = 0; m < 4; ++m) _Pragma("unroll") for (int k = 0; k < 2; ++k) dst[m][k] = *(const GP_LAS bf16x8*)(lds + GP_SA(b, h) + aoff + m * 2048 + k * 1024); } } while (0)
#define GP_LDB(dst, b, h) do { _Pragma("unroll") for (int n = 0; n < 2; ++n) { \
        if (F8) { const u32x4 lo_ = *(const GP_LAS u32x4*)(lds + GP_SB(b, h) + boff + n * 2048), hi_ = *(const GP_LAS u32x4*)(lds + GP_SB(b, h) + boff + n * 2048 + 1024); \
            dst##8[n] = (i32x8){(int)lo_.x, (int)lo_.y, (int)lo_.z, (int)lo_.w, (int)hi_.x, (int)hi_.y, (int)hi_.z, (int)hi_.w}; } \
        else { _Pragma("unroll") for (int k = 0; k < 2; ++k) dst[n][k] = *(const GP_LAS bf16x8*)(lds + GP_SB(b, h) + boff + n * 2048 + k * 1024); } } } while (0)
#define GP_MM8(ai, m_, slot_) do { _Pragma("unroll") for (int n = 0; n < 2; ++n) { \
        acc[ai][0][m_][n] = __builtin_amdgcn_mfma_scale_f32_16x16x128_f8f6f4(B08[n], At8[slot_], acc[ai][0][m_][n], 0, 0, 0, 0, 0, 0); \
        acc[ai][1][m_][n] = __builtin_amdgcn_mfma_scale_f32_16x16x128_f8f6f4(B18[n], At8[slot_], acc[ai][1][m_][n], 0, 0, 0, 0, 0, 0); } } while (0)
#define GP_MMA(ai, bj, At, Bt) do { \
        if (F8) { if ((bj) == 0) { __builtin_amdgcn_s_setprio(1); GP_MM8(ai, 0, 0); GP_MM8(ai, 1, 1); GP_MM8(ai, 2, 2); GP_MM8(ai, 3, 3); __builtin_amdgcn_s_setprio(0); } } \
        else { __builtin_amdgcn_s_setprio(1); _Pragma("unroll") for (int m = 0; m < 4; ++m) _Pragma("unroll") for (int n = 0; n < 2; ++n) _Pragma("unroll") for (int k = 0; k < 2; ++k) \
            acc[ai][bj][m][n] = __builtin_amdgcn_mfma_f32_16x16x32_bf16(Bt[n][k], At[m][k], acc[ai][bj][m][n], 0, 0, 0); __builtin_amdgcn_s_setprio(0); } } while (0)
#define GP_WAIT_V(n) asm volatile("s_waitcnt vmcnt(" #n ")" ::: "memory")
#define GP_WAIT_L(n) asm volatile("s_waitcnt lgkmcnt(" #n ")" ::: "memory")
#define GP_BAR __builtin_amdgcn_s_barrier()
#define GP_SCHED __builtin_amdgcn_sched_barrier(0)
#define GP_AOFFS(u_, v0_, v1_) do { _Pragma("unroll") for (int _i = 0; _i < 2; ++_i) { int R_, C_; stage_rc(tid * 16 + _i * 8192, R_, C_); int r0_ = (u_).pm * BM + R_, r1_ = r0_ + HALF; \
        if (GATHER) { r0_ = g.rowsrc[r0_]; r1_ = g.rowsrc[r1_]; } \
        v0_[_i] = (unsigned)(r0_ * K + C_) * 2u; v1_[_i] = (unsigned)(r1_ * K + C_) * 2u; } } while (0)
    Unit cur, nxt; int ui = 0;
    if (!S.next(0, cur)) return;
    f32x4 acc[2][2][4][2];
#pragma unroll
    for (int a = 0; a < 2; ++a)
#pragma unroll
        for (int b = 0; b < 2; ++b)
#pragma unroll
            for (int m = 0; m < 4; ++m)
#pragma unroll
                for (int n = 0; n < 2; ++n) acc[a][b][m][n] = (f32x4){0.f, 0.f, 0.f, 0.f};
    bf16x8 At[4][2], B0[2][2], B1[2][2];
    i32x8 At8[4], B08[2], B18[2]; int abuf_ = 0;
    unsigned vA0[2], vA1[2], nA0[2], nA1[2];
    GP_AOFFS(cur, vA0, vA1);
    const char* Ab = (const char*)g.A;
    const char* cB = (const char*)g.Bt + ((size_t)cur.e * g.N + (size_t)cur.pn * BM) * K * 2;
    GP_STAGE(GP_SB(0, 0), cB, voffB); GP_STAGE(GP_SB(0, 1), cB + hstep, voffB); GP_STAGE(GP_SA(0, 0), Ab, vA0); GP_STAGE(GP_SA(0, 1), Ab, vA1);
    if (wr == 1) GP_BAR;
    GP_WAIT_V(2); GP_BAR;
    GP_STAGE(GP_SB(1, 0), cB + kstep, voffB); GP_STAGE(GP_SA(1, 0), Ab + kstep, vA0); GP_STAGE(GP_SB(1, 1), cB + hstep + kstep, voffB);
    GP_WAIT_V(6); GP_BAR;
    for (;;) {
        const bool has_next = S.next(ui + 1, nxt);
        const char* nB = cB;
        if (has_next) { nB = (const char*)g.Bt + ((size_t)nxt.e * g.N + (size_t)nxt.pn * BM) * K * 2; GP_AOFFS(nxt, nA0, nA1); }
        else { nA0[0] = vA0[0]; nA0[1] = vA0[1]; nA1[0] = vA1[0]; nA1[1] = vA1[1]; }
        for (int t = 0; t < nt; t += 2) {
            const bool last = (t == nt - 2);
            const char* a1 = Ab + (size_t)(t + 1) * kstep;
            const char* a2 = last ? Ab : Ab + (size_t)(t + 2) * kstep; const char* b2 = last ? nB : cB + (size_t)(t + 2) * kstep;
            const char* a3 = a2 + kstep; const char* b3 = b2 + kstep;
            GP_LDB(B0, 0, 0); GP_LDB(B1, 0, 1); GP_SCHED; GP_LDA(At, 0, 0); GP_STAGE(GP_SA(1, 1), a1, vA1);
            if (last) { vA0[0] = nA0[0]; vA0[1] = nA0[1]; vA1[0] = nA1[0]; vA1[1] = nA1[1]; }
            GP_WAIT_V(8); GP_WAIT_L(0); GP_BAR; GP_MMA(0, 0, At, B0); GP_MMA(0, 1, At, B1); GP_BAR; GP_SCHED;
            GP_LDA(At, 0, 1); GP_STAGE(GP_SB(0, 0), b2, voffB); GP_STAGE(GP_SB(0, 1), b2 + hstep, voffB); GP_STAGE(GP_SA(0, 0), a2, vA0);
            GP_WAIT_V(8); GP_WAIT_L(0); GP_BAR; GP_MMA(1, 0, At, B0); GP_MMA(1, 1, At, B1); GP_BAR; GP_SCHED;
            GP_LDB(B0, 1, 0); GP_LDB(B1, 1, 1); GP_SCHED; GP_LDA(At, 1, 0); GP_STAGE(GP_SA(0, 1), a2, vA1);
            GP_WAIT_V(8); GP_WAIT_L(0); GP_BAR; GP_MMA(0, 0, At, B0); GP_MMA(0, 1, At, B1); GP_BAR; GP_SCHED;
            GP_LDA(At, 1, 1); GP_STAGE(GP_SB(1, 0), b3, voffB); GP_STAGE(GP_SB(1, 1), b3 + hstep, voffB); GP_STAGE(GP_SA(1, 0), a3, vA0);
            GP_WAIT_V(8); GP_WAIT_L(0); GP_BAR; GP_MMA(1, 0, At, B0); GP_MMA(1, 1, At, B1); GP_BAR; GP_SCHED;
        }
        if (wr == 0) GP_BAR;
        E(acc, cur, wr, wc, fr, fq);
        if (!has_next) break;
#pragma unroll
        for (int a = 0; a < 2; ++a)
#pragma unroll
            for (int b = 0; b < 2; ++b)
#pragma unroll
                for (int m = 0; m < 4; ++m)
#pragma unroll
                    for (int n = 0; n < 2; ++n) acc[a][b][m][n] = (f32x4){0.f, 0.f, 0.f, 0.f};
        cur = nxt; cB = nB; ++ui;
        if (wr == 1) GP_BAR;
    }
    GP_WAIT_V(0);
    GP_BAR;
#undef GP_SA
#undef GP_SB
#undef GP_STAGE
#undef GP_LDA
#undef GP_LDA8
#undef GP_MM8
#undef GP_LDB
#undef GP_MMA
#undef GP_WAIT_V
#undef GP_WAIT_L
#undef GP_BAR
#undef GP_SCHED
#undef GP_AOFFS
}
}
#include <hip/hip_cooperative_groups.h>
namespace cg = cooperative_groups;
#define LAS __attribute__((address_space(3)))
typedef float f32x4 __attribute__((ext_vector_type(4)));
typedef unsigned u32x4 __attribute__((ext_vector_type(4)));
typedef unsigned u32x2 __attribute__((ext_vector_type(2)));
typedef short bf16x8 __attribute__((ext_vector_type(8)));
constexpr int NWAVES = 8, NTHREADS = 512;
constexpr int LDS_RING = 131072;
constexpr int LDS_MISC = 159744;
constexpr int LDS_BYTES = 159744 + 512;

struct Params {
    const float* in[24];
    float* out; unsigned char* ws;
    int ph_lo, ph_hi;
};
__device__ __forceinline__ unsigned pk2(float lo, float hi) { return gp::cvt_pk_bf16(lo, hi); }

struct P0Item { const float* W; int ld, k0, n0; unsigned char* WT; int row0, Kdst, f8; };
__device__ __forceinline__ void p0_load(const P0Item& it, f32x4 (&v)[8], int lane) {
#pragma unroll
    for (int i = 0; i < 8; ++i) v[i] = __builtin_nontemporal_load((const f32x4*)(it.W + (size_t)(it.k0 + 8 * i + (lane >> 3)) * it.ld + it.n0 + 4 * (lane & 7)));
}
__device__ __forceinline__ void p0_finish(const P0Item& it, const f32x4 (&v)[8], LAS float* scr, int lane) {
#pragma unroll
    for (int i = 0; i < 8; ++i) { LAS float* d = scr + (8 * i + (lane >> 3)) * 33 + 4 * (lane & 7); d[0] = v[i][0]; d[1] = v[i][1]; d[2] = v[i][2]; d[3] = v[i][3]; }
    asm volatile("s_waitcnt lgkmcnt(0)" ::: "memory");
    const int c = lane & 7;
#pragma unroll
    for (int j = 0; j < 4; ++j) { const int n = (lane >> 3) + 8 * j; const LAS float* s = scr + (8 * c) * 33 + n;
        const size_t eo = (size_t)(it.row0 + n) * it.Kdst + it.k0 + 8 * c;
        if (it.f8) { const float ws_ = gp::W8_SCALE;
            *(u32x2*)(it.WT + eo) = (u32x2){gp::pack4_fp8(ws_ * s[0 * 33], ws_ * s[1 * 33], ws_ * s[2 * 33], ws_ * s[3 * 33]), gp::pack4_fp8(ws_ * s[4 * 33], ws_ * s[5 * 33], ws_ * s[6 * 33], ws_ * s[7 * 33])}; }
        else { u32x4 o; o.x = pk2(s[0 * 33], s[1 * 33]); o.y = pk2(s[2 * 33], s[3 * 33]); o.z = pk2(s[4 * 33], s[5 * 33]); o.w = pk2(s[6 * 33], s[7 * 33]);
            *(u32x4*)(it.WT + 2 * eo) = o; } }
    asm volatile("s_waitcnt lgkmcnt(0)" ::: "memory");
}
__device__ __forceinline__ void phase_prep(const Params& p, LAS unsigned char* lds, int tid, int lane, int wave) {
    unsigned char* ws = p.ws;
    {
        LAS float* sc = (LAS float*)lds;
        LAS float* part = (LAS float*)(lds + 32768);
        const float* c = p.in[1]; const float* w_ada = p.in[4]; const float* b_ada = p.in[5];
        {   f32x4 cv4[4];
#pragma unroll
            for (int j = 0; j < 4; ++j) cv4[j] = *(const f32x4*)(c + 4 * (tid + NTHREADS * j));
#pragma unroll
            for (int j = 0; j < 4; ++j) { f32x4 o4;
#pragma unroll
                for (int q = 0; q < 4; ++q) o4[q] = cv4[j][q] / (1.f + __expf(-cv4[j][q]));
                *(LAS f32x4*)(sc + 4 * (tid + NTHREADS * j)) = o4; }
        }
        __syncthreads();
        for (int cb = blockIdx.x; cb < 256; cb += gridDim.x) {
            const int half = lane >> 5, cl = lane & 31;
            float acc[8];
#pragma unroll
            for (int b = 0; b < 8; ++b) acc[b] = 0.f;
            if (cl < 24) {
                float wv[64];
#pragma unroll
                for (int it = 0; it < 64; ++it) wv[it] = __builtin_nontemporal_load(w_ada + (size_t)(128 * wave + 2 * it + half) * 6144 + 24 * cb + cl);
#pragma unroll
                for (int it = 0; it < 64; ++it) { const int k = 128 * wave + 2 * it + half;
#pragma unroll
                    for (int b = 0; b < 8; ++b) acc[b] += sc[b * 1024 + k] * wv[it]; }
#pragma unroll
                for (int b = 0; b < 8; ++b) part[((wave * 2 + half) * 8 + b) * 24 + cl] = acc[b];
            }
            __syncthreads();
            if (tid < 192) { const int b = tid / 24, cc = tid % 24; float s = 0.f;
                for (int q = 0; q < 16; ++q) s += part[(q * 8 + b) * 24 + cc];
                ((float*)(ws + WS_MOD))[b * 6144 + 24 * cb + cc] = s + b_ada[24 * cb + cc]; }
            __syncthreads();
        }
    }
    {
        float* rope = (float*)(ws + WS_ROPE);
        for (int i = blockIdx.x * NTHREADS + tid; i < SEQ * 8; i += gridDim.x * NTHREADS) {
            const int pos = i >> 3, f = i & 7;
            const float inv = f == 0 ? 1.0f : f == 1 ? 0.1939227432f : f == 2 ? 0.03760603070f : f == 3 ? 0.007292664610f : f == 4 ? 0.001414213562f : f == 5 ? 0.0002742481884f : f == 6 ? 5.318295734e-05f : 1.031338525e-05f;
            const float ang = (float)pos * inv;
            const double TWO_PI = 6.283185307179586476925287;
            const double a = (double)ang, r = a - rint(a / TWO_PI) * TWO_PI, r2 = r * r;
            double s = 0.0, c = 0.0, ts = r, tc = 1.0;
#pragma unroll
            for (int n = 0; n < 14; ++n) { s += ts; c += tc; ts *= r2 * (-1.0 / (double)((2 * n + 2) * (2 * n + 3))); tc *= r2 * (-1.0 / (double)((2 * n + 1) * (2 * n + 2))); }
            rope[i * 2 + 0] = (float)c; rope[i * 2 + 1] = (float)s;
        }
        if (blockIdx.x == 0 && wave == 0) { const float* al = p.in[10];
            const float d01 = wave_sum(al[lane] * al[64 + lane]), d23 = wave_sum(al[128 + lane] * al[192 + lane]);
            if (lane == 0) ((float*)(ws + WS_LAM))[0] = expf(d01) - expf(d23) + LAMBDA_INIT; }
    }
    __syncthreads();
    {
        LAS float* scr = (LAS float*)(lds + wave * 8704);
        const int gw = blockIdx.x * NWAVES + wave, NGW = gridDim.x * NWAVES;
        constexpr int I_IN = 16 * 88, I_OUT = 16 * 32, I_UV = 32, NITEMS = I_IN + I_OUT + I_UV;
        auto decode = [&](int r) -> P0Item {
            if (r < I_IN) return P0Item{p.in[6], NIN, 64 * (r / 88), 32 * (r % 88), ws + WS_WINT, 32 * (r % 88), 1024, 1};
            r -= I_IN;
            if (r < I_OUT) return P0Item{p.in[7], 1024, 64 * (r / 32), 32 * (r % 32), ws + WS_WOUTT, 32 * (r % 32), 1024, 0};
            r -= I_OUT;
            const int h = r >> 2, rr = r & 3; return P0Item{p.in[15] + h * 128 * 64, 64, 64 * (rr >> 1), 32 * (rr & 1), ws + WS_WUVT + (size_t)h * 64 * 128 * 2, 32 * (rr & 1), 128, 0};
        };
        for (int it = gw; it < NITEMS; it += NGW) { const P0Item a = decode(it); f32x4 va[8]; p0_load(a, va, lane); p0_finish(a, va, scr, lane); }
    }
}
constexpr int N_EXPERT_ITEMS = 32 * 3 * 512;
__device__ __forceinline__ bool conv_expert_issue(const Params& p, int lane, int wave, int& cur, P0Item& a, f32x4 (&va)[8]) {
    unsigned char* ws = p.ws;
    const int gw = blockIdx.x * NWAVES + wave, NGW = gridDim.x * NWAVES, r = gw + NGW * cur;
    if (r >= N_EXPERT_ITEMS) return false;
    ++cur;
    const int e = r / 1536, qq = r % 1536, mat = qq / 512, i2 = qq % 512, kb = i2 / 32, nb = i2 % 32, n0 = 32 * nb;
    a = (mat == 2) ? P0Item{p.in[22] + (size_t)e * 1048576, 1024, 64 * kb, n0, ws + WS_WDT + (size_t)e * 1048576, n0, 1024, 1}
                   : P0Item{p.in[mat == 0 ? 18 : 20] + (size_t)e * 1048576, 1024, 64 * kb, n0, ws + WS_WGUT + (size_t)e * 2097152, 256 * (n0 >> 7) + (n0 & 127) + (mat == 1 ? 128 : 0), 1024, 1};
    p0_load(a, va, lane);
    return true;
}
__device__ __forceinline__ void conv_expert_items(const Params& p, LAS unsigned char* lds, int lane, int wave, int& cur, int n) {
    unsigned char* ws = p.ws;
    LAS float* scr = (LAS float*)(lds + wave * 8704);
    const int gw = blockIdx.x * NWAVES + wave, NGW = gridDim.x * NWAVES;
    for (int q = 0; q < n; ++q) {
        const int r = gw + NGW * cur;
        if (r >= N_EXPERT_ITEMS) break;
        ++cur;
        const int e = r / 1536, qq = r % 1536, mat = qq / 512, i2 = qq % 512, kb = i2 / 32, nb = i2 % 32, n0 = 32 * nb;
        const P0Item a = (mat == 2) ? P0Item{p.in[22] + (size_t)e * 1048576, 1024, 64 * kb, n0, ws + WS_WDT + (size_t)e * 1048576, n0, 1024, 1}
                                    : P0Item{p.in[mat == 0 ? 18 : 20] + (size_t)e * 1048576, 1024, 64 * kb, n0, ws + WS_WGUT + (size_t)e * 2097152, 256 * (n0 >> 7) + (n0 & 127) + (mat == 1 ? 128 : 0), 1024, 1};
        f32x4 va[8]; p0_load(a, va, lane); p0_finish(a, va, scr, lane);
    }
}

constexpr int N2_STRIDE = 2080;
constexpr int N2_LO = 16 * N2_STRIDE, N2_PART = 2 * N2_LO, N2_PSTR = 20, N2_CNT = N2_PART + 8 * 32 * N2_PSTR * 4;
__device__ __forceinline__ void phase_norm1(const Params& p, LAS unsigned char* lds, int tid, int lane, int wave) {
    unsigned char* ws = p.ws;
    const float* x = p.in[0]; const float* g = p.in[2]; const float* w_in = p.in[6]; const float* mod = (const float*)(ws + WS_MOD);
    bf16_t* H = (bf16_t*)(ws + WS_H); float* IW = (float*)(ws + WS_IW);
    const int n16 = lane & 15, g4 = lane >> 4;
    bf16x8 bhi[4], blo[4];
#pragma unroll
    for (int s = 0; s < 4; ++s) { float wv[8];
#pragma unroll
        for (int c = 0; c < 8; ++c) wv[c] = n16 < 8 ? w_in[(size_t)(128 * wave + 32 * s + 8 * g4 + c) * NIN + C_IW + n16] : 0.f;
        u32x4 hw, lw;
#pragma unroll
        for (int c = 0; c < 4; ++c) { const unsigned hp = gp::cvt_pk_bf16(wv[2 * c], wv[2 * c + 1]);
            hw[c] = hp; lw[c] = gp::cvt_pk_bf16(wv[2 * c] - __uint_as_float(hp << 16), wv[2 * c + 1] - __uint_as_float(hp & 0xffff0000u)); }
        bhi[s] = __builtin_bit_cast(bf16x8, hw); blo[s] = __builtin_bit_cast(bf16x8, lw); }
    LAS float* part = (LAS float*)(lds + N2_PART);
    for (int ch = blockIdx.x; ch < NCHUNK; ch += gridDim.x) {
        f32x4 xa[4], xb[4];
#pragma unroll
        for (int j = 0; j < 4; ++j) { xa[j] = *(const f32x4*)(x + (size_t)(ch * CHTOK + wave * 16) * DM + 4 * (lane + 64 * j)); xb[j] = *(const f32x4*)(x + (size_t)(ch * CHTOK + wave * 16 + 1) * DM + 4 * (lane + 64 * j)); }
        f32x4 gs4[4], sh4[4];
        { const int b = (ch * CHTOK) / SEQ; const float* sh = mod + b * 6144, * sc = sh + 1024;
#pragma unroll
          for (int j = 0; j < 4; ++j) { const int k0 = 4 * (lane + 64 * j); gs4[j] = *(const f32x4*)(g + k0) * (*(const f32x4*)(sc + k0) + 1.0f); sh4[j] = *(const f32x4*)(sh + k0); } }
        for (int rr = 0; rr < 16; rr += 2) {
            const int t0r = ch * CHTOK + wave * 16 + rr;
#define N1_ROW(Q_, T_, XS) do { f32x4 v[4]; float ss = 0.f; \
                _Pragma("unroll") for (int j = 0; j < 4; ++j) { v[j] = XS[j]; ss += (v[j].x * v[j].x + v[j].y * v[j].y) + (v[j].z * v[j].z + v[j].w * v[j].w); } \
                const float r = 1.0f / sqrtf(wave_sum(ss) * (1.f / DM) + RMS_EPS); \
                _Pragma("unroll") for (int j = 0; j < 4; ++j) { const int k0 = 4 * (lane + 64 * j); \
                    const f32x4 hv = (v[j] * r) * gs4[j] + sh4[j]; \
                    const unsigned h01 = gp::cvt_pk_bf16(hv.x, hv.y), h23 = gp::cvt_pk_bf16(hv.z, hv.w); \
                    *(unsigned*)((unsigned char*)H + (size_t)(T_) * DM + k0) = gp::pack4_fp8(hv.x, hv.y, hv.z, hv.w);        \
                    LAS unsigned char* sp = lds + (2 * wave + (Q_)) * N2_STRIDE + 2 * k0; \
                    *(LAS u32x2*)sp = (u32x2){h01, h23}; \
                    *(LAS u32x2*)(sp + N2_LO) = (u32x2){gp::cvt_pk_bf16(hv.x - __uint_as_float(h01 << 16), hv.y - __uint_as_float(h01 & 0xffff0000u)), \
                                                        gp::cvt_pk_bf16(hv.z - __uint_as_float(h23 << 16), hv.w - __uint_as_float(h23 & 0xffff0000u))}; } } while (0)
            f32x4 va[4], vb[4];
#pragma unroll
            for (int j = 0; j < 4; ++j) { va[j] = xa[j]; vb[j] = xb[j]; }
            if (rr + 2 < 16) {
#pragma unroll
                for (int j = 0; j < 4; ++j) { xa[j] = *(const f32x4*)(x + (size_t)(t0r + 2) * DM + 4 * (lane + 64 * j)); xb[j] = *(const f32x4*)(x + (size_t)(t0r + 3) * DM + 4 * (lane + 64 * j)); } }
            N1_ROW(0, t0r, va); N1_ROW(1, t0r + 1, vb);
#undef N1_ROW
            __syncthreads();
            {   f32x4 acc0 = (f32x4){0.f, 0.f, 0.f, 0.f};
                const LAS unsigned char* ap = lds + n16 * N2_STRIDE + 2 * (128 * wave + 8 * g4);
#pragma unroll
                for (int s = 0; s < 4; ++s) { const bf16x8 ah = *(const LAS bf16x8*)(ap + 64 * s), al = *(const LAS bf16x8*)(ap + N2_LO + 64 * s);
                    __builtin_amdgcn_s_setprio(1);
                    acc0 = __builtin_amdgcn_mfma_f32_16x16x32_bf16(ah, bhi[s], acc0, 0, 0, 0);
                    acc0 = __builtin_amdgcn_mfma_f32_16x16x32_bf16(ah, blo[s], acc0, 0, 0, 0);
                    acc0 = __builtin_amdgcn_mfma_f32_16x16x32_bf16(al, bhi[s], acc0, 0, 0, 0); __builtin_amdgcn_s_setprio(0); }
                *(LAS f32x4*)(part + (wave * 16 + n16) * N2_PSTR + 4 * g4) = acc0; }
            __syncthreads();
            if (lane < 16) { const int q = lane >> 3, col = lane & 7; float sum = 0.f;
#pragma unroll
                for (int w = 0; w < 8; ++w) sum += part[(w * 16 + col) * N2_PSTR + 2 * wave + q];
                IW[(size_t)(t0r + q) * 8 + col] = sum * 0.04419417382415922f; }
        }
    }
}

__device__ __forceinline__ f32x4 n2_ld4(const bf16_t* p4) { const u32x2 w = *(const u32x2*)p4; return (f32x4){__uint_as_float(w.x << 16), __uint_as_float(w.x & 0xffff0000u), __uint_as_float(w.y << 16), __uint_as_float(w.y & 0xffff0000u)}; }
__device__ __forceinline__ void phase_norm2(const Params& p, LAS unsigned char* lds, int tid, int lane, int wave) {
    unsigned char* ws = p.ws;
    const bf16_t* x1 = (const bf16_t*)(ws + WS_X1B); const float* g = p.in[3]; const float* rw = p.in[16]; const float* rb = p.in[17]; const float* mod = (const float*)(ws + WS_MOD);
    bf16_t* H = (bf16_t*)(ws + WS_H); int* topi = (int*)(ws + WS_TOPI); float* topg = (float*)(ws + WS_TOPG); int* chcnt = (int*)(ws + WS_CHCNT);
    const int n16 = lane & 15, g4 = lane >> 4;
    bf16x8 bhi[4][2], blo[4][2];
#pragma unroll
    for (int s = 0; s < 4; ++s)
#pragma unroll
        for (int eh = 0; eh < 2; ++eh) { float wv[8];
#pragma unroll
            for (int c = 0; c < 8; ++c) wv[c] = rw[(size_t)(128 * wave + 32 * s + 8 * g4 + c) * 32 + 16 * eh + n16];
            u32x4 hw, lw;
#pragma unroll
            for (int c = 0; c < 4; ++c) { const unsigned hp = gp::cvt_pk_bf16(wv[2 * c], wv[2 * c + 1]);
                hw[c] = hp; lw[c] = gp::cvt_pk_bf16(wv[2 * c] - __uint_as_float(hp << 16), wv[2 * c + 1] - __uint_as_float(hp & 0xffff0000u)); }
            bhi[s][eh] = __builtin_bit_cast(bf16x8, hw); blo[s][eh] = __builtin_bit_cast(bf16x8, lw); }
    LAS int* cnt = (LAS int*)(lds + N2_CNT);
    LAS float* part = (LAS float*)(lds + N2_PART);
    for (int ch = blockIdx.x; ch < NCHUNK; ch += gridDim.x) {
        if (tid < 32) cnt[tid] = 0;
        f32x4 xa[4], xb[4];
#pragma unroll
        for (int j = 0; j < 4; ++j) { xa[j] = n2_ld4(x1 + (size_t)(ch * CHTOK + wave * 16) * DM + 4 * (lane + 64 * j)); xb[j] = n2_ld4(x1 + (size_t)(ch * CHTOK + wave * 16 + 1) * DM + 4 * (lane + 64 * j)); }
        f32x4 gs4[4], sh4[4];
        { const int b = (ch * CHTOK) / SEQ; const float* sh = mod + b * 6144 + 3 * 1024, * sc = sh + 1024;
#pragma unroll
          for (int j = 0; j < 4; ++j) { const int k0 = 4 * (lane + 64 * j); gs4[j] = *(const f32x4*)(g + k0) * (*(const f32x4*)(sc + k0) + 1.0f); sh4[j] = *(const f32x4*)(sh + k0); } }
        for (int rr = 0; rr < 16; rr += 2) {
            const int t0r = ch * CHTOK + wave * 16 + rr;
#define N2_ROW(Q_, T_, XS) do { f32x4 v[4]; float ss = 0.f; \
                _Pragma("unroll") for (int j = 0; j < 4; ++j) { v[j] = XS[j]; ss += (v[j].x * v[j].x + v[j].y * v[j].y) + (v[j].z * v[j].z + v[j].w * v[j].w); } \
                const float r = 1.0f / sqrtf(wave_sum(ss) * (1.f / DM) + RMS_EPS); \
                _Pragma("unroll") for (int j = 0; j < 4; ++j) { const int k0 = 4 * (lane + 64 * j); \
                    const f32x4 hv = (v[j] * r) * gs4[j] + sh4[j]; \
                    const unsigned h01 = gp::cvt_pk_bf16(hv.x, hv.y), h23 = gp::cvt_pk_bf16(hv.z, hv.w); \
                    *(unsigned*)((unsigned char*)H + (size_t)(T_) * DM + k0) = gp::pack4_fp8(hv.x, hv.y, hv.z, hv.w);        \
                    LAS unsigned char* sp = lds + (2 * wave + (Q_)) * N2_STRIDE + 2 * k0; \
                    *(LAS u32x2*)sp = (u32x2){h01, h23}; \
                    *(LAS u32x2*)(sp + N2_LO) = (u32x2){gp::cvt_pk_bf16(hv.x - __uint_as_float(h01 << 16), hv.y - __uint_as_float(h01 & 0xffff0000u)), \
                                                        gp::cvt_pk_bf16(hv.z - __uint_as_float(h23 << 16), hv.w - __uint_as_float(h23 & 0xffff0000u))}; } } while (0)
            f32x4 va[4], vb[4];
#pragma unroll
            for (int j = 0; j < 4; ++j) { va[j] = xa[j]; vb[j] = xb[j]; }
            if (rr + 2 < 16) {
#pragma unroll
                for (int j = 0; j < 4; ++j) { xa[j] = n2_ld4(x1 + (size_t)(t0r + 2) * DM + 4 * (lane + 64 * j)); xb[j] = n2_ld4(x1 + (size_t)(t0r + 3) * DM + 4 * (lane + 64 * j)); } }
            N2_ROW(0, t0r, va); N2_ROW(1, t0r + 1, vb);
#undef N2_ROW
            __syncthreads();
            {   f32x4 acc0 = (f32x4){0.f, 0.f, 0.f, 0.f}, acc1 = (f32x4){0.f, 0.f, 0.f, 0.f};
                const LAS unsigned char* ap = lds + n16 * N2_STRIDE + 2 * (128 * wave + 8 * g4);
#pragma unroll
                for (int s = 0; s < 4; ++s) { const bf16x8 ah = *(const LAS bf16x8*)(ap + 64 * s), al = *(const LAS bf16x8*)(ap + N2_LO + 64 * s);
                    __builtin_amdgcn_s_setprio(1);
                    acc0 = __builtin_amdgcn_mfma_f32_16x16x32_bf16(ah, bhi[s][0], acc0, 0, 0, 0); acc1 = __builtin_amdgcn_mfma_f32_16x16x32_bf16(ah, bhi[s][1], acc1, 0, 0, 0);
                    acc0 = __builtin_amdgcn_mfma_f32_16x16x32_bf16(ah, blo[s][0], acc0, 0, 0, 0); acc1 = __builtin_amdgcn_mfma_f32_16x16x32_bf16(ah, blo[s][1], acc1, 0, 0, 0);
                    acc0 = __builtin_amdgcn_mfma_f32_16x16x32_bf16(al, bhi[s][0], acc0, 0, 0, 0); acc1 = __builtin_amdgcn_mfma_f32_16x16x32_bf16(al, bhi[s][1], acc1, 0, 0, 0); __builtin_amdgcn_s_setprio(0); }
                *(LAS f32x4*)(part + (wave * 32 + n16) * N2_PSTR + 4 * g4) = acc0; *(LAS f32x4*)(part + (wave * 32 + 16 + n16) * N2_PSTR + 4 * g4) = acc1; }
            __syncthreads();
            {   const int q = lane >> 5, e = lane & 31, t = t0r + q;
                float lv = rb[e];
#pragma unroll
                for (int w = 0; w < 8; ++w) lv += part[(w * 32 + e) * N2_PSTR + 2 * wave + q];
                int idx[4]; float val[4];
#pragma unroll
                for (int k = 0; k < 4; ++k) { float mv = lv;
                    mv = fmaxf(mv, dppf<DPP_X1>(mv)); mv = fmaxf(mv, dppf<DPP_X2>(mv)); mv = fmaxf(mv, dppf<DPP_HM>(mv)); mv = fmaxf(mv, dppf<DPP_R8>(mv)); mv = max_x16(mv);
                    const unsigned long long bm = __ballot(lv == mv);
                    const int ee = __builtin_ctz(q ? (unsigned)(bm >> 32) : (unsigned)bm);
                    idx[k] = ee; val[k] = mv; if (e == ee) lv = -INFINITY; }
                if (e == 0) {
                    float ex[4], sum = 0.f;
#pragma unroll
                    for (int k = 0; k < 4; ++k) { ex[k] = __expf(val[k] - val[0]); sum += ex[k]; }
                    const float inv = 1.f / sum;
                    *(int4*)(topi + t * 4) = make_int4(idx[0], idx[1], idx[2], idx[3]);
                    *(f32x4*)(topg + t * 4) = (f32x4){ex[0] * inv, ex[1] * inv, ex[2] * inv, ex[3] * inv};
#pragma unroll
                    for (int k = 0; k < 4; ++k) atomicAdd((int*)&cnt[idx[k]], 1);
                }
            }
        }
        __syncthreads();
        if (tid < 32) chcnt[ch * 32 + tid] = cnt[tid];
        __syncthreads();
    }
}

__device__ __forceinline__ void phase_scatter(const Params& p, LAS unsigned char* lds, int tid, int lane, int wave) {
    unsigned char* ws = p.ws;
    const int* topi = (const int*)(ws + WS_TOPI); const int* chcnt = (const int*)(ws + WS_CHCNT);
    int* rowtok = (int*)(ws + WS_ROWTOK); int* rowsrc = (int*)(ws + WS_ROWSRC); int* tile_e = (int*)(ws + WS_TILEE); int2* rowmeta = (int2*)(ws + WS_ROWMETA); const float* topg = (const float*)(ws + WS_TOPG);
    LAS int* total = (LAS int*)lds; LAS int* before = total + 32; LAS int* padded = total + 64; LAS int* poff = total + 96; LAS int* ent = total + 160; LAS int* psum = total + 1024; LAS int* wcnt = total + 2048;
    for (int ch = blockIdx.x; ch < NCHUNK; ch += gridDim.x) {
        { const int e = tid & 31, part = tid >> 5; int tt = 0, bb = 0;
#pragma unroll 4
          for (int q = 0; q < 16; ++q) { const int c = part * 16 + q; const int v = chcnt[c * 32 + e]; tt += v; bb += (c < ch) ? v : 0; }
          psum[tid] = tt; psum[512 + tid] = bb; }
        { const int i = tid; ent[i] = topi[ch * CHTOK * 4 + i]; }
        __syncthreads();
        if (tid < 32) { int tt = 0, bb = 0;
#pragma unroll 1
            for (int q = 0; q < 16; ++q) { tt += psum[q * 32 + tid]; bb += psum[512 + q * 32 + tid]; }
            total[tid] = tt; before[tid] = bb; padded[tid] = (tt + 255) / 256 * 256; }
        __syncthreads();
        if (tid == 0) { int a = 0;
#pragma unroll 1
            for (int e = 0; e < 32; ++e) { poff[e] = a; a += padded[e]; } poff[32] = a; }
        __syncthreads();
        {
            const int myE = ent[tid]; int myRank = 0;
            const unsigned long long ltm = (1ull << lane) - 1ull;
#pragma unroll 1
            for (int e = 0; e < 32; ++e) { const unsigned long long mk = __ballot(myE == e);
                if (myE == e) myRank = __popcll(mk & ltm);
                if (lane == 0) wcnt[wave * 32 + e] = __popcll(mk); }
            __syncthreads();
            int pos = poff[myE] + before[myE] + myRank;
            for (int w2 = 0; w2 < wave; ++w2) pos += wcnt[w2 * 32 + myE];
            const int en = ch * CHTOK * 4 + tid; rowtok[pos] = en; rowsrc[pos] = en >> 2; rowmeta[pos] = make_int2(en, __float_as_int(topg[en]));
        }
        if (ch == 0) {
            for (int e = wave; e < 32; e += NWAVES) {
                const int p0 = poff[e], te = p0 + total[e], pe = p0 + padded[e];
                for (int r = te + lane; r < pe; r += 64) { rowtok[r] = -1; rowsrc[r] = 0; rowmeta[r] = make_int2(-1, 0); }
                for (int ti = p0 / 256 + lane; ti < pe / 256; ti += 64) tile_e[ti] = e; }
            if (tid == 0) tile_e[MAXTILES] = poff[32] / 256;
        }
        __syncthreads();
    }
}

__device__ __forceinline__ void phase_combine(const Params& p, int tid) {
    unsigned char* ws = p.ws; float* out = p.out; const unsigned char* Y = ws + WS_Y; const float* mod = (const float*)(ws + WS_MOD);
    const size_t nvec = (size_t)NTOK * DM / 16, SL = (size_t)NTOK * DM;
#pragma unroll 1
    for (size_t i = (size_t)blockIdx.x * NTHREADS + tid; i < nvec; i += (size_t)gridDim.x * NTHREADS) {
        const size_t o = i * 16; const int t = (int)(o / DM), n = (int)(o % DM), b = t / SEQ;
        const u32x4 a = __builtin_nontemporal_load((const u32x4*)(Y + o)), c = __builtin_nontemporal_load((const u32x4*)(Y + SL + o)),
                    d = __builtin_nontemporal_load((const u32x4*)(Y + 2 * SL + o)), e = __builtin_nontemporal_load((const u32x4*)(Y + 3 * SL + o));
        const float* g2 = mod + b * 6144 + 5 * 1024 + n;
        f32x4 ov[4], gv[4];
        { const bf16_t* x1b = (const bf16_t*)(ws + WS_X1B) + o; const u32x4 xa_ = *(const u32x4*)x1b, xb_ = *(const u32x4*)(x1b + 8);
          ov[0] = (f32x4){__uint_as_float(xa_.x << 16), __uint_as_float(xa_.x & 0xffff0000u), __uint_as_float(xa_.y << 16), __uint_as_float(xa_.y & 0xffff0000u)};
          ov[1] = (f32x4){__uint_as_float(xa_.z << 16), __uint_as_float(xa_.z & 0xffff0000u), __uint_as_float(xa_.w << 16), __uint_as_float(xa_.w & 0xffff0000u)};
          ov[2] = (f32x4){__uint_as_float(xb_.x << 16), __uint_as_float(xb_.x & 0xffff0000u), __uint_as_float(xb_.y << 16), __uint_as_float(xb_.y & 0xffff0000u)};
          ov[3] = (f32x4){__uint_as_float(xb_.z << 16), __uint_as_float(xb_.z & 0xffff0000u), __uint_as_float(xb_.w << 16), __uint_as_float(xb_.w & 0xffff0000u)}; }
#pragma unroll
        for (int q = 0; q < 4; ++q) gv[q] = *(const f32x4*)(g2 + 4 * q) * gp::Y8_INV;
#pragma unroll
        for (int q = 0; q < 4; ++q) {
            const auto a0 = __builtin_amdgcn_cvt_pk_f32_fp8((int)a[q], false), a1 = __builtin_amdgcn_cvt_pk_f32_fp8((int)a[q], true);
            const auto c0 = __builtin_amdgcn_cvt_pk_f32_fp8((int)c[q], false), c1 = __builtin_amdgcn_cvt_pk_f32_fp8((int)c[q], true);
            const auto d0 = __builtin_amdgcn_cvt_pk_f32_fp8((int)d[q], false), d1 = __builtin_amdgcn_cvt_pk_f32_fp8((int)d[q], true);
            const auto e0 = __builtin_amdgcn_cvt_pk_f32_fp8((int)e[q], false), e1 = __builtin_amdgcn_cvt_pk_f32_fp8((int)e[q], true);
            ov[q].x += gv[q].x * ((a0[0] + c0[0]) + (d0[0] + e0[0])); ov[q].y += gv[q].y * ((a0[1] + c0[1]) + (d0[1] + e0[1]));
            ov[q].z += gv[q].z * ((a1[0] + c1[0]) + (d1[0] + e1[0])); ov[q].w += gv[q].w * ((a1[1] + c1[1]) + (d1[1] + e1[1])); }
#pragma unroll
        for (int q = 0; q < 4; ++q) *(f32x4*)(out + o + 4 * q) = ov[q];
    }
}

namespace da {
typedef float f32x16 __attribute__((ext_vector_type(16)));
typedef short s16x4 __attribute__((ext_vector_type(4)));
typedef int i32x8 __attribute__((ext_vector_type(8)));
typedef int i32x2 __attribute__((ext_vector_type(2)));
constexpr int KRS = 80;
constexpr int KT_BYTES = 64 * KRS;
constexpr int VRS = 160;
constexpr int VT_BYTES = 64 * VRS;
constexpr int BUF_BYTES = 2 * KT_BYTES + VT_BYTES;
constexpr int OB_STRIDE = 132;
constexpr int WSF_OFF = 139264;
constexpr float C2 = 0.125f * 1.4426950408889634f;
__device__ __forceinline__ int crow(int r, int hi) { return (r & 3) + 8 * (r >> 2) + 4 * hi; }
__device__ __forceinline__ s16x4 vtr(const LAS unsigned char* p) { return __builtin_bit_cast(s16x4, __builtin_amdgcn_ds_read_tr16_b64_v4i16((LAS s16x4*)p)); }

__device__ __forceinline__ void phase(const Params& p, LAS unsigned char* lds, int tid, int lane, int wave, int& cvcur) {
    unsigned char* ws = p.ws; const bf16_t* PROJ = (const bf16_t*)(ws + WS_PROJ); bf16_t* H = (bf16_t*)(ws + WS_H);
    const float lam = ((const float*)(ws + WS_LAM))[0]; const float* sub_g = p.in[11];
    const int wsel = wave >> 2, wq = wave & 3, r32 = lane & 31, hi = lane >> 5;
    LAS float* wsf = (LAS float*)(lds + WSF_OFF) + wave * 64;
    const int G = gridDim.x, vcu = (G % 8 == 0) ? ((int)blockIdx.x % 8) * (G / 8) + (int)blockIdx.x / 8 : (int)blockIdx.x;
    for (int id = vcu; id < 1024; id += G) {
        const int bh = (id >> 3) & 31, s = id & 7, ii = id >> 8;
        const int qb = (ii == 0) ? s : (ii == 1) ? 15 - s : (ii == 2) ? 16 + s : 31 - s;
        const int b = bh >> 2, h = bh & 3, q0 = qb * 128, NT = 2 * qb + 2, ntw = 2 * qb + 1 + (wq >> 1);
        const bf16_t* base = PROJ + (size_t)b * SEQ * NPJ;
        LAS unsigned char* qlds = lds + 81920 + wave * 4096 + lane * 32;
        { const bf16_t* Qrow = base + (size_t)(q0 + 32 * wq + r32) * NPJ + (wsel ? C_AQ2 : C_AQ1) + h * 64 + 32 * hi;
#define DA_P8(LO, HI) ((unsigned)__builtin_amdgcn_cvt_pk_fp8_f32(__uint_as_float((HI) << 16), __uint_as_float((HI) & 0xffff0000u), \
                       __builtin_amdgcn_cvt_pk_fp8_f32(__uint_as_float((LO) << 16), __uint_as_float((LO) & 0xffff0000u), 0, false), true))
#pragma unroll
          for (int d0 = 0; d0 < 2; ++d0) { const u32x4 wa = *(const u32x4*)(Qrow + 16 * d0), wb = *(const u32x4*)(Qrow + 16 * d0 + 8);
              *(LAS u32x4*)(qlds + 16 * d0) = (u32x4){DA_P8(wa.x, wa.y), DA_P8(wa.z, wa.w), DA_P8(wb.x, wb.y), DA_P8(wb.z, wb.w)}; }
#undef DA_P8
        }
        float m = -INFINITY, l = 0.f;
        f32x16 o[4];
#pragma unroll
        for (int d0 = 0; d0 < 4; ++d0)
#pragma unroll
            for (int r = 0; r < 16; ++r) o[d0][r] = 0.f;
        const int skey = tid >> 3, sc = tid & 7;
        const int kkey = (tid & 255) >> 2, kpc = tid & 3, ksel = tid >> 8;
        const unsigned char* srcK = ws + WS_AK8 + ((size_t)b * SEQ + kkey) * 512 + ksel * 256 + h * 64 + 16 * kpc;
        const int dK = ksel * KT_BYTES + kkey * KRS + 16 * kpc;
        const unsigned char* srcV = ws + WS_AV8 + ((size_t)b * SEQ + skey) * 512 + h * 128 + 16 * sc;
        const int vslot = 32 * ((skey >> 2) & 1) + (skey & 3) + 4 * ((skey & 31) >> 3) + 16 * (skey >> 5);
        const int dV = vslot * VRS + sc * 16;
        u32x4 sa0, sa1, sb0, sb1;
#define DA_LOAD(S, kt) do { S##0 = *(const u32x4*)(srcK + (size_t)(kt) * 64 * 512); S##1 = *(const u32x4*)(srcV + (size_t)(kt) * 64 * 512); } while (0)
#define DA_WRITE(S, bufi) do { LAS unsigned char* bb = lds + (bufi) * BUF_BYTES; *(LAS u32x4*)(bb + dK) = S##0; *(LAS u32x4*)(bb + 2 * KT_BYTES + dV) = S##1; } while (0)
        DA_LOAD(sa, 0); DA_WRITE(sa, 0); DA_LOAD(sb, 1); if (2 < NT) DA_LOAD(sa, 2);
        __syncthreads();
#pragma unroll 1
        for (int kt0 = 0; kt0 < NT; kt0 += 2) {
#pragma unroll
          for (int hh2 = 0; hh2 < 2; ++hh2) { const int kt = kt0 + hh2;
            if (kt < ntw) {
                const LAS unsigned char* bb = lds + (kt & 1) * BUF_BYTES;
                const LAS unsigned char* Kb = bb + wsel * KT_BYTES;
                const LAS unsigned char* Vb = bb + 2 * KT_BYTES;
                f32x16 p0, p1;
#pragma unroll
                for (int r = 0; r < 16; ++r) { p0[r] = 0.f; p1[r] = 0.f; }
                {   const u32x4 q0_ = *(const LAS u32x4*)qlds, q1_ = *(const LAS u32x4*)(qlds + 16);
                    const LAS unsigned char* kp = Kb + r32 * KRS + 32 * hi;
                    const u32x4 k0_ = *(const LAS u32x4*)kp, k1_ = *(const LAS u32x4*)(kp + 16), k2_ = *(const LAS u32x4*)(kp + 32 * KRS), k3_ = *(const LAS u32x4*)(kp + 32 * KRS + 16);
                    const i32x8 q8 = {(int)q0_.x, (int)q0_.y, (int)q0_.z, (int)q0_.w, (int)q1_.x, (int)q1_.y, (int)q1_.z, (int)q1_.w};
                    const i32x8 ka = {(int)k0_.x, (int)k0_.y, (int)k0_.z, (int)k0_.w, (int)k1_.x, (int)k1_.y, (int)k1_.z, (int)k1_.w};
                    const i32x8 kb = {(int)k2_.x, (int)k2_.y, (int)k2_.z, (int)k2_.w, (int)k3_.x, (int)k3_.y, (int)k3_.z, (int)k3_.w};
                    __builtin_amdgcn_s_setprio(1);
                    p0 = __builtin_amdgcn_mfma_scale_f32_32x32x64_f8f6f4(ka, q8, p0, 0, 0, 0, 0, 0, 0);
                    p1 = __builtin_amdgcn_mfma_scale_f32_32x32x64_f8f6f4(kb, q8, p1, 0, 0, 0, 0, 0, 0);
                    __builtin_amdgcn_s_setprio(0); }
                p0 = p0 * C2; p1 = p1 * C2;
                float mxa = fmaxf(p0[0], p1[0]), mxb = fmaxf(p0[1], p1[1]), mxc = fmaxf(p0[2], p1[2]), mxd = fmaxf(p0[3], p1[3]);
#pragma unroll
                for (int r = 4; r < 16; r += 4) { mxa = fmaxf(mxa, fmaxf(p0[r], p1[r])); mxb = fmaxf(mxb, fmaxf(p0[r + 1], p1[r + 1])); mxc = fmaxf(mxc, fmaxf(p0[r + 2], p1[r + 2])); mxd = fmaxf(mxd, fmaxf(p0[r + 3], p1[r + 3])); }
                float mx = fmaxf(fmaxf(mxa, mxb), fmaxf(mxc, mxd));
                mx = max_x32(mx);
                if (__any(mx - m > 8.0f)) {
                    const float mnew = fmaxf(m, mx);
                    const float f = __builtin_amdgcn_exp2f(m - mnew);
                    l *= f; m = mnew;
                    if (hi == 0) wsf[r32] = f;
                    asm volatile("s_waitcnt lgkmcnt(0)" ::: "memory");
#pragma unroll
                    for (int r = 0; r < 16; ++r) { const float fr = wsf[crow(r, hi)];
#pragma unroll
                        for (int d0 = 0; d0 < 4; ++d0) o[d0][r] *= fr; }
                }
                p0 = p0 - m; p1 = p1 - m;
                float lsa = 0.f, lsb = 0.f, lsc = 0.f, lsd = 0.f;
#pragma unroll
                for (int r = 0; r < 16; r += 4) {
                    p0[r] = __builtin_amdgcn_exp2f(p0[r]); p1[r] = __builtin_amdgcn_exp2f(p1[r]); lsa += p0[r] + p1[r];
                    p0[r + 1] = __builtin_amdgcn_exp2f(p0[r + 1]); p1[r + 1] = __builtin_amdgcn_exp2f(p1[r + 1]); lsb += p0[r + 1] + p1[r + 1];
                    p0[r + 2] = __builtin_amdgcn_exp2f(p0[r + 2]); p1[r + 2] = __builtin_amdgcn_exp2f(p1[r + 2]); lsc += p0[r + 2] + p1[r + 2];
                    p0[r + 3] = __builtin_amdgcn_exp2f(p0[r + 3]); p1[r + 3] = __builtin_amdgcn_exp2f(p1[r + 3]); lsd += p0[r + 3] + p1[r + 3]; }
                l += (lsa + lsb) + (lsc + lsd);
                i32x8 pa8;
#pragma unroll
                for (int q = 0; q < 4; ++q) {
                    int f0 = __builtin_amdgcn_cvt_pk_fp8_f32(p0[4 * q], p0[4 * q + 1], 0, false); f0 = __builtin_amdgcn_cvt_pk_fp8_f32(p0[4 * q + 2], p0[4 * q + 3], f0, true);
                    int f1 = __builtin_amdgcn_cvt_pk_fp8_f32(p1[4 * q], p1[4 * q + 1], 0, false); f1 = __builtin_amdgcn_cvt_pk_fp8_f32(p1[4 * q + 2], p1[4 * q + 3], f1, true);
                    pa8[q] = f0; pa8[4 + q] = f1; }
                const LAS unsigned char* vp = Vb + (32 * hi + ((lane & 15) >> 1)) * VRS + 16 * ((lane >> 4) & 1) + 8 * (lane & 1);
#pragma unroll
                for (int d0 = 0; d0 < 4; ++d0) {
                    i32x8 vb8;
#pragma unroll
                    for (int j = 0; j < 4; ++j) { const i32x2 tv = __builtin_amdgcn_ds_read_tr8_b64_v2i32((LAS i32x2*)(vp + 8 * j * VRS + 32 * d0)); vb8[2 * j] = tv.x; vb8[2 * j + 1] = tv.y; }
                    __builtin_amdgcn_s_setprio(1);
                    o[d0] = __builtin_amdgcn_mfma_scale_f32_32x32x64_f8f6f4(pa8, vb8, o[d0], 0, 0, 0, 0, 0, 0);
                    __builtin_amdgcn_s_setprio(0);
                }
            }
            if (hh2 == 0) { DA_WRITE(sb, 1); if (kt + 3 < NT) DA_LOAD(sb, kt + 3); }
            else { if (kt + 1 < NT) DA_WRITE(sa, 0); if (kt + 3 < NT) DA_LOAD(sa, kt + 3); }
            __syncthreads();
          }
        }
#undef DA_LOAD
#undef DA_WRITE
        l = sum_x32(l);
        { const float fac = (wsel ? lam : 1.0f) / l;
          if (hi == 0) wsf[r32] = fac;
          asm volatile("s_waitcnt lgkmcnt(0)" ::: "memory"); }
        LAS float* Ob = (LAS float*)lds + wsel * (128 * OB_STRIDE);
#pragma unroll
        for (int r = 0; r < 16; ++r) { const float fr = wsf[crow(r, hi)]; const int row = 32 * wq + crow(r, hi);
#pragma unroll
            for (int d0 = 0; d0 < 4; ++d0) Ob[row * OB_STRIDE + 32 * d0 + r32] = o[d0][r] * fr; }
        __syncthreads();
        { const LAS float* O1 = (const LAS float*)lds; const LAS float* O2 = O1 + 128 * OB_STRIDE;
          const float g0 = sub_g[2 * lane], g1 = sub_g[2 * lane + 1];
          for (int rr = 0; rr < 16; ++rr) { const int row = 16 * wave + rr;
              const float d0v = O1[row * OB_STRIDE + 2 * lane] - O2[row * OB_STRIDE + 2 * lane], d1v = O1[row * OB_STRIDE + 2 * lane + 1] - O2[row * OB_STRIDE + 2 * lane + 1];
              const float ss = wave_sum(d0v * d0v + d1v * d1v);
              const float rs = (1.0f - LAMBDA_INIT) / sqrtf(ss * (1.f / 128.f) + RMS_EPS);
              *(unsigned*)(H + (size_t)(b * SEQ + q0 + row) * DM + h * 128 + 2 * lane) = pk2(d0v * rs * g0, d1v * rs * g1); } }
        __syncthreads();

    }
}
}
namespace ds {
typedef float f32x16 __attribute__((ext_vector_type(16)));
typedef short s16x4 __attribute__((ext_vector_type(4)));
typedef int i32x2 __attribute__((ext_vector_type(2)));
typedef int i32x4 __attribute__((ext_vector_type(4)));

constexpr int HIST_OFF = 131072, SEL_OFF = 139264, OALL_OFF = 143360;
constexpr float C2 = 0.125f * 1.4426950408889634f;
__device__ __forceinline__ s16x4 vtr(const LAS unsigned char* p) { return __builtin_bit_cast(s16x4, __builtin_amdgcn_ds_read_tr16_b64_v4i16((LAS s16x4*)p)); }
__device__ __forceinline__ unsigned skey(float f) { unsigned u = __float_as_uint(f); if (u == 0x80000000u) u = 0u; return u ^ ((unsigned)((int)u >> 31) | 0x80000000u); }

constexpr int AQ_OFF = HIST_OFF, WV_OFF = 160000;
struct UnitPre { u32x4 q; f32x4 w; };
__device__ __forceinline__ void unit_pre_load(const Params& p, UnitPre& U, int tid, int b, int qt) {
    const bf16_t* PROJ = (const bf16_t*)(p.ws + WS_PROJ); const float* IW = (const float*)(p.ws + WS_IW);
    const int q0 = qt * 8, l = tid & 63, r32 = l & 31, hi = l >> 5, rb = tid >> 8, d0 = (tid >> 6) & 3;
    U.q = *(const u32x4*)(PROJ + ((size_t)b * SEQ + q0 + 4 * rb + 2 * ((r32 >> 2) & 1) + (r32 >> 4)) * NPJ + C_IQ + (4 * ((r32 >> 3) & 1) + (r32 & 3)) * 64 + 8 * hi + 16 * d0);
    if (tid < 16) U.w = *(const f32x4*)(IW + ((size_t)b * SEQ + q0) * 8 + 4 * tid);
}
__device__ __forceinline__ void unit_pre_store(const UnitPre& U, LAS unsigned char* lds, int tid) {
    *(LAS u32x4*)(lds + AQ_OFF + tid * 16) = U.q;
    if (tid < 16) *(LAS f32x4*)(lds + WV_OFF + tid * 16) = U.w;
}
__device__ __forceinline__ void first_tile(const Params& p, bf16x8 (&bk0)[4], int lane, int wave, int b, int qt) {
    const int ntk = ((qt * 8) / 64 + 1) * 2;
    const unsigned char* kp = p.ws + WS_IKF + (size_t)b * 128 * 4096 + lane * 16 + (size_t)(wave < ntk ? wave : 0) * 4096;
#pragma unroll
    for (int d0 = 0; d0 < 4; ++d0) bk0[d0] = *(const bf16x8*)(kp + d0 * 1024);
}
template <int STOP> __device__ __forceinline__ void unit(const Params& p, LAS unsigned char* lds, int tid, int lane_in, int wave, int b, int qt, int& cvcur, int nb, int nqt, bf16x8 (&bk0)[4]) {
    int lane = lane_in; asm volatile("" : "+v"(lane));
    unsigned char* ws = p.ws; const bf16_t* PROJ = (const bf16_t*)(ws + WS_PROJ); bf16_t* H = (bf16_t*)(ws + WS_H);
    const float* IW = (const float*)(ws + WS_IW);
    const int q0 = qt * 8, N = (q0 / 64 + 1) * 64, t0 = b * SEQ + q0;
    const bf16_t* base = PROJ + (size_t)b * SEQ * NPJ;
    LAS float* S = (LAS float*)lds;
    const int r32 = lane & 31, hi = lane >> 5;
    {
        if (STOP != 0) { UnitPre U; unit_pre_load(p, U, tid, b, qt); unit_pre_store(U, lds, tid); first_tile(p, bk0, lane, wave, b, qt); __syncthreads(); }
        bf16x8 aq[2][4]; f32x4 wv[2][4];
#pragma unroll
        for (int rb = 0; rb < 2; ++rb) {
#pragma unroll
            for (int d0 = 0; d0 < 4; ++d0) aq[rb][d0] = *(const LAS bf16x8*)(lds + AQ_OFF + ((rb * 4 + d0) * 64 + lane) * 16);
#pragma unroll
            for (int qq = 0; qq < 4; ++qq) wv[rb][qq] = 0.5f * *(const LAS f32x4*)(lds + WV_OFF + ((4 * rb + 2 * hi + (qq >> 1)) * 8 + 4 * (qq & 1)) * 4);
        }
        const int ntk = N / 32;
        bf16x8 bk[4], bkn[4];
        const unsigned char* ikf = ws + WS_IKF + (size_t)b * 128 * 4096 + lane * 16;
#pragma unroll
        for (int d0 = 0; d0 < 4; ++d0) bkn[d0] = bk0[d0];
        for (int kt = wave; kt < ntk; kt += NWAVES) {
#pragma unroll
            for (int d0 = 0; d0 < 4; ++d0) bk[d0] = bkn[d0];
            if (kt + NWAVES < ntk) { const unsigned char* kp = ikf + (size_t)(kt + NWAVES) * 4096;
#pragma unroll
                for (int d0 = 0; d0 < 4; ++d0) bkn[d0] = *(const bf16x8*)(kp + d0 * 1024); }
#pragma unroll
            for (int rb = 0; rb < 2; ++rb) {
                f32x16 acc;
#pragma unroll
                for (int r = 0; r < 16; ++r) acc[r] = 0.f;
                __builtin_amdgcn_s_setprio(1);
#pragma unroll
                for (int d0 = 0; d0 < 4; ++d0) acc = __builtin_amdgcn_mfma_f32_32x32x16_bf16(aq[rb][d0], bk[d0], acc, 0, 0, 0);
                __builtin_amdgcn_s_setprio(0);
                float v0 = 0.f, v1 = 0.f;
#pragma unroll
                for (int i = 0; i < 4; ++i) { v0 = __builtin_fmaf(wv[rb][0][i], acc[i], v0); v0 = __builtin_fmaf(wv[rb][0][i], __builtin_fabsf(acc[i]), v0);
                                               v0 = __builtin_fmaf(wv[rb][1][i], acc[4 + i], v0); v0 = __builtin_fmaf(wv[rb][1][i], __builtin_fabsf(acc[4 + i]), v0);
                                               v1 = __builtin_fmaf(wv[rb][2][i], acc[8 + i], v1); v1 = __builtin_fmaf(wv[rb][2][i], __builtin_fabsf(acc[8 + i]), v1);
                                               v1 = __builtin_fmaf(wv[rb][3][i], acc[12 + i], v1); v1 = __builtin_fmaf(wv[rb][3][i], __builtin_fabsf(acc[12 + i]), v1); }
                S[(4 * rb + 2 * hi) * 4096 + 32 * kt + r32] = v0;
                S[(4 * rb + 2 * hi + 1) * 4096 + 32 * kt + r32] = v1;
            }
        }
    }
    __syncthreads();
    if (STOP == 1) return;
    asm volatile("" : "+v"(lane));
    LAS float* Sw = S + wave * 4096;
    LAS unsigned short* sel = (LAS unsigned short*)(lds + SEL_OFF) + wave * 256;
    const int nsel = N < 256 ? N : 256;
    long bq8[2] = {0l, 0l};
    if ((lane & 15) < 8) { const bf16_t* qp = PROJ + (size_t)(t0 + wave) * NPJ + C_BQ + (lane & 15) * 64 + 16 * (lane >> 4);
#pragma unroll
        for (int ks = 0; ks < 2; ++ks) { const u32x4 w = *(const u32x4*)(qp + 8 * ks);
#define DS_SAT8(X) __builtin_amdgcn_fmed3f(__uint_as_float(X), -448.0f, 448.0f)
            int f0 = __builtin_amdgcn_cvt_pk_fp8_f32(DS_SAT8(w.x << 16), DS_SAT8(w.x & 0xffff0000u), 0, false); f0 = __builtin_amdgcn_cvt_pk_fp8_f32(DS_SAT8(w.y << 16), DS_SAT8(w.y & 0xffff0000u), f0, true);
            int f1 = __builtin_amdgcn_cvt_pk_fp8_f32(DS_SAT8(w.z << 16), DS_SAT8(w.z & 0xffff0000u), 0, false); f1 = __builtin_amdgcn_cvt_pk_fp8_f32(DS_SAT8(w.w << 16), DS_SAT8(w.w & 0xffff0000u), f1, true);
#undef DS_SAT8
            bq8[ks] = (long)(((unsigned long)(unsigned)f1 << 32) | (unsigned long)(unsigned)f0); } }
    const unsigned char* kl8b = ws + WS_KL8 + (size_t)b * SEQ * 192;
    u32x4 kA[2], stA[4]; bool preA = false;
#define DS_LOADCH(KF, ST, s_) do { \
            KF[0] = *(const u32x4*)(kl8b + (unsigned)sel[32 * (s_) + (lane & 15)] * 192u + 16u * (unsigned)(lane >> 4)); \
            KF[1] = *(const u32x4*)(kl8b + (unsigned)sel[32 * (s_) + 16 + (lane & 15)] * 192u + 16u * (unsigned)(lane >> 4)); \
            _Pragma("unroll") for (int i = 0; i < 4; ++i) ST[i] = *(const u32x4*)(kl8b + (unsigned)sel[32 * (s_) + 8 * i + (lane >> 3)] * 192u + 64u + 16u * (unsigned)(lane & 7)); } while (0)
    if (N <= 256) {
        for (int i = lane; i < N; i += 64) sel[i] = (unsigned short)i;
        DS_LOADCH(kA, stA, 0); preA = true;
    } else {
        LAS unsigned* hist = (LAS unsigned*)(lds + OALL_OFF) + wave * 512;
        LAS float* cv = (LAS float*)(lds + HIST_OFF) + wave * 256; LAS int* ci = (LAS int*)cv + 128;
        const unsigned long long ltmask = (1ull << lane) - 1ull;
        const int nit = (N + 255) / 256;
        for (int i = N + lane; i < 256 * nit; i += 64) Sw[i] = -INFINITY;
        float t0 = -INFINITY, t1 = -INFINITY, t2 = -INFINITY, t3 = -INFINITY;
        for (int it = 0; it < nit; ++it) { const f32x4 v4 = *(const LAS f32x4*)(Sw + 256 * it + 4 * lane);
            t0 = fmaxf(t0, v4[0]); t1 = fmaxf(t1, v4[1]); t2 = fmaxf(t2, v4[2]); t3 = fmaxf(t3, v4[3]); }
        float mn = fminf(fminf(t0, t1), fminf(t2, t3)), mx = fmaxf(fmaxf(t0, t1), fmaxf(t2, t3));
        mn = wave_min(mn); mx = wave_max(mx);
        bool done = false;
        if (mx > mn && (fabsf(mn) + fabsf(mx)) * (508.0f / (mx - mn)) < 4.0e6f) {
            const float scale = 508.0f / (mx - mn), off = 8388610.0f - mn * scale, Y0 = 8388608.0f;
#define DS_Y(V) fmaxf(__builtin_fmaf((V), scale, off), Y0)
            *(LAS u32x4*)(hist + 8 * lane) = (u32x4){0u, 0u, 0u, 0u}; *(LAS u32x4*)(hist + 8 * lane + 4) = (u32x4){0u, 0u, 0u, 0u};
#pragma unroll 4
            for (int it = 0; it < nit; ++it) { const f32x4 v4 = *(const LAS f32x4*)(Sw + 256 * it + 4 * lane);
#pragma unroll
                for (int q = 0; q < 4; ++q) { const float y = DS_Y(v4[q]);
                    if (y > Y0) __hip_atomic_fetch_add(hist + (__float_as_uint(y) & 511u), 1u, __ATOMIC_RELAXED, __HIP_MEMORY_SCOPE_WORKGROUP); } }
            unsigned wq[8];
            { const u32x4 h0 = *(LAS u32x4*)(hist + 8 * lane), h1 = *(LAS u32x4*)(hist + 8 * lane + 4);
              wq[0] = h0.x; wq[1] = h0.y; wq[2] = h0.z; wq[3] = h0.w; wq[4] = h1.x; wq[5] = h1.y; wq[6] = h1.z; wq[7] = h1.w; }
            int sl = 0;
#pragma unroll
            for (int q = 0; q < 8; ++q) sl += (int)wq[q];
            int v = sl;
#pragma unroll
            for (int o = 1; o < 64; o <<= 1) { const int t = __shfl_down(v, o); v += (lane + o < 64) ? t : 0; }
            int ab = v - sl, myB = -1, myAbove = 0, myCnt = 0;
#pragma unroll
            for (int q = 7; q >= 0; --q) { const int cq = (int)wq[q];
                if (myB < 0 && ab < 256 && 256 <= ab + cq) { myB = 8 * lane + q; myAbove = ab; myCnt = cq; }
                ab += cq; }
            const unsigned long long bal = __ballot(myB >= 0);
            const int src = __builtin_ctzll(bal);
            const int B = __shfl(myB, src), C = __shfl(myCnt, src), need = 256 - __shfl(myAbove, src);
            if (C <= 128) {
                int outpos = 0, cp = 0;
                const int nq = (nit + 3) >> 2;
                const float yB = Y0 + (float)B, yB1 = Y0 + (float)(B + 1);
#pragma unroll 1
                for (int half = 0; half < 2; ++half) {
                if (half == 1 && outpos >= 32) { DS_LOADCH(kA, stA, 0); preA = true; }
#pragma unroll 2
                for (int it = half ? nq : 0; it < (half ? nit : nq); ++it) { const f32x4 v4 = *(const LAS f32x4*)(Sw + 256 * it + 4 * lane);
#pragma unroll
                    for (int q = 0; q < 4; ++q) {
                        const float y = DS_Y(v4[q]); const int idx = 256 * it + 4 * lane + q;
                        const bool take = y >= yB1;
                        const unsigned long long bt = __ballot(take), bc = __ballot(y == yB);
                        if (take) sel[outpos + (int)__builtin_amdgcn_mbcnt_hi((unsigned)(bt >> 32), __builtin_amdgcn_mbcnt_lo((unsigned)bt, 0u))] = (unsigned short)idx;
                        outpos += __popcll(bt);
                        if (bc != 0ull) {
                            if ((bc >> lane) & 1ull) { const int pos = cp + (int)__builtin_amdgcn_mbcnt_hi((unsigned)(bc >> 32), __builtin_amdgcn_mbcnt_lo((unsigned)bc, 0u)); cv[pos] = v4[q]; ci[pos] = idx; }
                            cp += __popcll(bc); } } }
                }
#undef DS_Y
                const float v0 = lane < C ? cv[lane] : -INFINITY, v1 = lane + 64 < C ? cv[lane + 64] : -INFINITY;
                const int i0 = lane < C ? ci[lane] : 0x7fffffff, i1 = lane + 64 < C ? ci[lane + 64] : 0x7fffffff;
                int r0 = 0, r1 = 0;
                for (int q = 0; q < C; ++q) { const float ov = cv[q]; const int oi = ci[q];
                    r0 += (ov > v0 || (ov == v0 && oi < i0)) ? 1 : 0; r1 += (ov > v1 || (ov == v1 && oi < i1)) ? 1 : 0; }
                const bool t0 = lane < C && r0 < need, t1 = lane + 64 < C && r1 < need;
                const unsigned long long b0 = __ballot(t0);
                if (t0) sel[outpos + __popcll(b0 & ltmask)] = (unsigned short)i0;
                outpos += __popcll(b0);
                const unsigned long long b1 = __ballot(t1);
                if (t1) sel[outpos + __popcll(b1 & ltmask)] = (unsigned short)i1;
                done = true;
            }
        }
        if (!done) {
            {
                LAS int* h8 = (LAS int*)hist;
                unsigned prefix = 0u; int need8 = 256;
#pragma unroll 1
                for (int pass = 0; pass < 4; ++pass) {
                    const int shift = 24 - 8 * pass;
                    *(LAS i32x4*)(h8 + 4 * lane) = (i32x4){0, 0, 0, 0};
                    asm volatile("s_waitcnt lgkmcnt(0)" ::: "memory");
                    for (int j = 0; j < N / 64; ++j) { const unsigned u = skey(Sw[64 * j + lane]);
                        if (pass == 0 || (u >> (shift + 8)) == prefix) __hip_atomic_fetch_add((int*)(h8 + ((u >> shift) & 255u)), 1, __ATOMIC_RELAXED, __HIP_MEMORY_SCOPE_WORKGROUP); }
                    asm volatile("s_waitcnt lgkmcnt(0)" ::: "memory");
                    const i32x4 c = *(LAS i32x4*)(h8 + 4 * lane);
                    const int s4 = c.x + c.y + c.z + c.w; int vv = s4;
#pragma unroll
                    for (int o = 1; o < 64; o <<= 1) { const int t = __shfl_down(vv, o); vv += (lane + o < 64) ? t : 0; }
                    const int a3 = vv - s4, a2 = a3 + c.w, a1 = a2 + c.z, a0 = a1 + c.y;
                    int mB = -1, mA = 0;
                    if (a3 < need8 && need8 <= a3 + c.w) { mB = 4 * lane + 3; mA = a3; }
                    else if (a2 < need8 && need8 <= a2 + c.z) { mB = 4 * lane + 2; mA = a2; }
                    else if (a1 < need8 && need8 <= a1 + c.y) { mB = 4 * lane + 1; mA = a1; }
                    else if (a0 < need8 && need8 <= a0 + c.x) { mB = 4 * lane; mA = a0; }
                    const int sr = __builtin_ctzll(__ballot(mB >= 0));
                    need8 -= __shfl(mA, sr); prefix = (prefix << 8) | (unsigned)__shfl(mB, sr);
                }
                int outpos = 0, eqtaken = 0;
                for (int j = 0; j < N / 64; ++j) { const unsigned u = skey(Sw[64 * j + lane]);
                    const bool eq = (u == prefix); const unsigned long long beq = __ballot(eq);
                    const bool take = (u > prefix) || (eq && (eqtaken + __popcll(beq & ltmask) < need8));
                    const unsigned long long bt = __ballot(take);
                    if (take) sel[outpos + __popcll(bt & ltmask)] = (unsigned short)(64 * j + lane);
                    outpos += __popcll(bt); eqtaken += __popcll(beq); }
            }
        }
    }
    asm volatile("s_waitcnt lgkmcnt(0)" ::: "memory");
    if (STOP == 2) { __syncthreads(); return; }
    asm volatile("" : "+v"(lane));
    bf16x8 wf[4][4];
    UnitPre UN; P0Item cvi, cvj; f32x4 cva[8], cvb[8]; bool cvok = false, cvok2 = false;
    {
        const int n16 = lane & 15, g = lane >> 4, t = t0 + wave;
        const int nstep = nsel / 32;
        LAS unsigned char* Lb = (LAS unsigned char*)Sw;
        f32x4 ot[8];
#pragma unroll
        for (int cb = 0; cb < 8; ++cb) ot[cb] = (f32x4){0.f, 0.f, 0.f, 0.f};
        float mrun = -INFINITY, lsum = 0.f;
        u32x4 kB[2], stB[4], kC[2], stC[4];
#define DS_PROC(KF, ST) do { \
            f32x4 a0 = (f32x4){0.f, 0.f, 0.f, 0.f}, a1 = (f32x4){0.f, 0.f, 0.f, 0.f}; \
            a0 = __builtin_amdgcn_mfma_f32_16x16x32_fp8_fp8((long)(((unsigned long)KF[0].y << 32) | KF[0].x), bq8[0], a0, 0, 0, 0); a0 = __builtin_amdgcn_mfma_f32_16x16x32_fp8_fp8((long)(((unsigned long)KF[0].w << 32) | KF[0].z), bq8[1], a0, 0, 0, 0); \
            a1 = __builtin_amdgcn_mfma_f32_16x16x32_fp8_fp8((long)(((unsigned long)KF[1].y << 32) | KF[1].x), bq8[0], a1, 0, 0, 0); a1 = __builtin_amdgcn_mfma_f32_16x16x32_fp8_fp8((long)(((unsigned long)KF[1].w << 32) | KF[1].z), bq8[1], a1, 0, 0, 0); \
            a0 = a0 * C2; a1 = a1 * C2; \
            float cm = fmaxf(fmaxf(fmaxf(a0[0], a0[1]), fmaxf(a0[2], a0[3])), fmaxf(fmaxf(a1[0], a1[1]), fmaxf(a1[2], a1[3]))); \
            cm = max_x32(max_x16(cm)); \
            if (__any(cm - mrun > 8.0f)) { const float mnew = fmaxf(mrun, cm); const float f = __builtin_amdgcn_exp2f(mrun - mnew); lsum *= f; mrun = mnew; \
                _Pragma("unroll") for (int cb = 0; cb < 8; ++cb) ot[cb] = ot[cb] * f; } \
            float e[8]; \
            _Pragma("unroll") for (int i = 0; i < 4; ++i) { e[i] = __builtin_amdgcn_exp2f(a0[i] - mrun); e[4 + i] = __builtin_amdgcn_exp2f(a1[i] - mrun); } \
            lsum += ((e[0] + e[1]) + (e[2] + e[3])) + ((e[4] + e[5]) + (e[6] + e[7])); \
            int p0 = __builtin_amdgcn_cvt_pk_fp8_f32(e[0], e[1], 0, false); p0 = __builtin_amdgcn_cvt_pk_fp8_f32(e[2], e[3], p0, true); \
            int p1 = __builtin_amdgcn_cvt_pk_fp8_f32(e[4], e[5], 0, false); p1 = __builtin_amdgcn_cvt_pk_fp8_f32(e[6], e[7], p1, true); \
            const long pbv = (long)(((unsigned long)(unsigned)p1 << 32) | (unsigned long)(unsigned)p0); \
            _Pragma("unroll") for (int i = 0; i < 4; ++i) { const int r = lane >> 3, slot = 16 * (i & 1) + 8 * (r >> 2) + (r & 3) + 4 * (i >> 1); \
                *(LAS u32x4*)(Lb + slot * 144 + 16 * (lane & 7)) = ST[i]; } \
            _Pragma("unroll") for (int cb = 0; cb < 8; ++cb) { \
                const i32x2 tv = __builtin_amdgcn_ds_read_tr8_b64_v2i32((LAS i32x2*)(Lb + (8 * g + (n16 >> 1)) * 144 + 16 * cb + 8 * (n16 & 1))); \
                ot[cb] = __builtin_amdgcn_mfma_f32_16x16x32_fp8_fp8((long)(((unsigned long)(unsigned)tv.y << 32) | (unsigned long)(unsigned)tv.x), pbv, ot[cb], 0, 0, 0); } } while (0)
        if (!preA) DS_LOADCH(kA, stA, 0);
        if (nstep > 1) DS_LOADCH(kB, stB, 1);
#pragma unroll 1
        for (int s = 0; s < nstep; s += 3) {
            if (s + 2 < nstep) DS_LOADCH(kC, stC, s + 2);
            DS_PROC(kA, stA);
            if (s + 1 >= nstep) break;
            if (s + 3 < nstep) DS_LOADCH(kA, stA, s + 3);
            DS_PROC(kB, stB);
            if (s + 2 >= nstep) break;
            if (s + 4 < nstep) DS_LOADCH(kB, stB, s + 4);
            DS_PROC(kC, stC);
        }
#undef DS_LOADCH
#undef DS_PROC
        if (STOP == 0) {
            if (nqt >= 0) { unit_pre_load(p, UN, tid, nb, nqt); first_tile(p, bk0, lane, wave, nb, nqt); }
            cvok = conv_expert_issue(p, lane, wave, cvcur, cvi, cva);
            cvok2 = conv_expert_issue(p, lane, wave, cvcur, cvj, cvb);
            const bf16_t* WuvT = (const bf16_t*)(ws + WS_WUVT) + wave * 64 * 128;
#pragma unroll
            for (int nb4 = 0; nb4 < 4; ++nb4)
#pragma unroll
                for (int ks = 0; ks < 4; ++ks) wf[nb4][ks] = *(const bf16x8*)(WuvT + (16 * nb4 + n16) * 128 + 32 * ks + 8 * g); }
        lsum = sum_x32(sum_x16(lsum));
        const float linv = 1.0f / lsum;
        if (n16 < 8) {
            LAS bf16_t* Oall = (LAS bf16_t*)(lds + OALL_OFF) + (wave * 8 + n16) * 128;
#pragma unroll
            for (int cb = 0; cb < 8; ++cb) *(LAS u32x2*)(Oall + 16 * cb + 4 * g) = (u32x2){pk2(ot[cb][0] * linv, ot[cb][1] * linv), pk2(ot[cb][2] * linv, ot[cb][3] * linv)};
        }
    }
    __syncthreads();
    if (STOP == 3) return;
    asm volatile("" : "+v"(lane));
    {
        const int n16 = lane & 15, g = lane >> 4, hh = wave;
        const LAS bf16_t* Oall = (const LAS bf16_t*)(lds + OALL_OFF) + ((n16 & 7) * 8 + hh) * 128;
        bf16x8 af[4];
#pragma unroll
        for (int ks = 0; ks < 4; ++ks) af[ks] = *(const LAS bf16x8*)(Oall + 32 * ks + 8 * g);
#pragma unroll
        for (int nb = 0; nb < 4; ++nb) {
            f32x4 a = (f32x4){0.f, 0.f, 0.f, 0.f};
#pragma unroll
            for (int ks = 0; ks < 4; ++ks) a = __builtin_amdgcn_mfma_f32_16x16x32_bf16(af[ks], wf[nb][ks], a, 0, 0, 0);
            if (g < 2) {
#pragma unroll
                for (int i = 0; i < 4; ++i) H[(size_t)(t0 + 4 * g + i) * DM + 512 + hh * 64 + 16 * nb + n16] = (bf16_t)(gp::cvt_pk_bf16(a[i], 0.f) & 0xffffu);
            }
        }
    }
    if (nqt >= 0) unit_pre_store(UN, lds, tid);
    __syncthreads();
    if (cvok) p0_finish(cvi, cva, (LAS float*)(lds + wave * 8704), lane);
    if (cvok2) p0_finish(cvj, cvb, (LAS float*)(lds + wave * 8704), lane);
    __syncthreads();
}

template <int STOP> __device__ __forceinline__ void phase(const Params& p, LAS unsigned char* lds, int tid, int lane, int wave, int& cvcur) {
    const int G = gridDim.x, k = blockIdx.x;
    const bool nice = (G == 256);
    const int nit = nice ? 16 : (4096 - k + G - 1) / G;
    auto unit_of = [&](int i, int& b, int& qt) {
        if (nice) { const int j = k >> 3; b = k & 7; qt = 511 - (i * 32 + ((i & 1) ? 31 - j : j)); }
        else { const int u = k + i * G; b = u & 7; qt = 511 - (u >> 3); } };
    bf16x8 bk0[4];
    if (STOP == 0 && nit > 0) { int b0, q0; unit_of(0, b0, q0); UnitPre U; unit_pre_load(p, U, tid, b0, q0); first_tile(p, bk0, lane, wave, b0, q0); unit_pre_store(U, lds, tid); __syncthreads(); }
    for (int i = 0; i < nit; ++i) {
        int b, qt, nb = 0, nqt = -1;
        unit_of(i, b, qt);
        if (i + 1 < nit) unit_of(i + 1, nb, nqt);
        unit<STOP>(p, lds, tid, lane, wave, b, qt, cvcur, nb, nqt, bk0);
    }
}
}

#define XB_TMO      128
#define XB_XCNT(j)  (256  + 64 * (j))
#define XB_XSUB(j)  (1280 + 64 * (j))
#define XB_XGEN(j)  (2304 + 64 * (j))
#define XB_TOP      3328
#define XB_TOPGEN   3392
#define XCD_BAR_WORDS 3456
#define XB_SPIN_CAP (1u << 22)
__device__ __forceinline__ unsigned xb_ld(unsigned* p)              { return __hip_atomic_load(p, __ATOMIC_RELAXED, __HIP_MEMORY_SCOPE_AGENT); }
__device__ __forceinline__ unsigned xb_add(unsigned* p, unsigned v) { return __hip_atomic_fetch_add(p, v, __ATOMIC_RELAXED, __HIP_MEMORY_SCOPE_AGENT); }
__device__ __forceinline__ unsigned xb_xcc_id() { return (unsigned)__builtin_amdgcn_s_getreg((3 << 11) | 20) & 0xFu; }
#define XB_SPIN(cond, bar) do { unsigned _sp = 0; while (cond) { __builtin_amdgcn_s_sleep(1); \
    if ((++_sp & 255u) == 0u) { if (xb_ld(&(bar)[XB_TMO])) break; if (_sp > XB_SPIN_CAP) { atomicAdd(&(bar)[XB_TMO], 1u); break; } } } } while (0)
struct XcdBarrier { unsigned* bar; unsigned x; volatile LAS unsigned* st; };
__device__ __forceinline__ XcdBarrier xcd_barrier_post(unsigned* bar, volatile LAS unsigned* st) {
    XcdBarrier b; b.bar = bar; b.x = xb_xcc_id(); b.st = st;
    if (threadIdx.x == 0) (void)xb_add(&bar[XB_XCNT(b.x)], 1u);
    return b;
}
__device__ __forceinline__ void xcd_barrier_complete(unsigned* bar, unsigned x, unsigned& nloc, unsigned& nx) {
    const unsigned G = gridDim.x * gridDim.y * gridDim.z;
    unsigned sum, cnt, mine, sp = 0u;
    for (;;) {
        sum = 0u; cnt = 0u; mine = 0u;
#pragma unroll
        for (unsigned j = 0; j < 16; ++j) { const unsigned c = xb_ld(&bar[XB_XCNT(j)]); sum += c; cnt += (c > 0u) ? 1u : 0u; mine = (j == x) ? c : mine; }
        if (sum == G) break;
        __builtin_amdgcn_s_sleep(1);
        if ((++sp & 255u) == 0u) { if (xb_ld(&bar[XB_TMO])) break; if (sp > XB_SPIN_CAP) { atomicAdd(&bar[XB_TMO], 1u); break; } }
    }
    nloc = mine > 0u ? mine : 1u; nx = cnt > 0u ? cnt : 1u;
}
__device__ __forceinline__ void xcd_barrier(const XcdBarrier& b) {
    asm volatile("s_waitcnt vmcnt(0)" ::: "memory");
    __syncthreads();
    if (threadIdx.x == 0) {
        unsigned* bar = b.bar;
        __builtin_amdgcn_s_waitcnt(0);
        unsigned nloc = b.st[0], nx = b.st[1];
        if (nloc == 0u) { xcd_barrier_complete(bar, b.x, nloc, nx); b.st[0] = nloc; b.st[1] = nx; }
        const unsigned old = xb_add(&bar[XB_XSUB(b.x)], 1u);
        const unsigned gen = old / nloc;
        if (old + 1u == (gen + 1u) * nloc) {
            __builtin_amdgcn_fence(__ATOMIC_RELEASE, "agent");
            asm volatile("s_waitcnt vmcnt(0)" ::: "memory");
            const unsigned og = xb_add(&bar[XB_TOP], 1u);
            const unsigned tg = og / nx;
            if (og + 1u == (tg + 1u) * nx) xb_add(&bar[XB_TOPGEN], 1u);
            else XB_SPIN(xb_ld(&bar[XB_TOPGEN]) == tg, bar);
            __builtin_amdgcn_fence(__ATOMIC_ACQUIRE, "agent");
            xb_add(&bar[XB_XGEN(b.x)], 1u);
            asm volatile("s_waitcnt vmcnt(0)" ::: "memory");
        } else {
            XB_SPIN(xb_ld(&bar[XB_XGEN(b.x)]) == gen, bar);
            __builtin_amdgcn_fence(__ATOMIC_ACQUIRE, "agent");
            asm volatile("s_waitcnt vmcnt(0)" ::: "memory");
        }
    }
    __syncthreads();
}
constexpr int N_PHASES = 10;
__global__ void __launch_bounds__(NTHREADS, 2) mega(Params p) {
    extern __shared__ __attribute__((aligned(16))) unsigned char lds_raw[];
    LAS unsigned char* lds = (LAS unsigned char*)lds_raw;
    cg::grid_group grid = cg::this_grid();
    int tid = threadIdx.x, lane = tid & 63; const int wave = __builtin_amdgcn_readfirstlane(tid >> 6);
#define FRESH() do { tid = threadIdx.x; asm volatile("" : "+v"(tid)); lane = tid & 63; } while (0)
    unsigned char* ws = p.ws;
    const int lo = p.ph_lo, hi = p.ph_hi;
    volatile LAS unsigned* MISC = (volatile LAS unsigned*)(lds + LDS_MISC);
    if (tid < 16) MISC[tid] = 0u;
    __syncthreads();
    XcdBarrier bar = xcd_barrier_post((unsigned*)(ws + WS_CTL), MISC);
#define IN(k) (lo <= (k) && (k) < hi)
#define SEAM(k) do { if (IN(k) && IN((k) + 1)) xcd_barrier(bar); } while (0)
    if (lo < 0) grid.sync();
    if (IN(0)) { FRESH(); phase_prep(p, lds, tid, lane, wave); } SEAM(0);
    if (IN(1)) { FRESH(); phase_norm1(p, lds, tid, lane, wave); } SEAM(1);
    if (IN(2)) { FRESH();
        gp::Gemm g{(const bf16_t*)(ws + WS_H), (const bf16_t*)(ws + WS_WINT), NPJ, DM / 2, nullptr};
        gp::StaticOrder S; S.init(NTOK, NPJ, gridDim.x, blockIdx.x);
        LAS float* gl = (LAS float*)(lds + LDS_RING + 8192);
        if (tid < 64) { gl[tid] = p.in[8][tid]; gl[64 + tid] = p.in[9][tid]; gl[128 + tid] = p.in[12][tid]; gl[192 + tid] = p.in[13][tid]; }
        if (tid < 128) gl[256 + tid] = p.in[14][tid];
        __syncthreads();
        gp::EpiInproj E{(bf16_t*)(ws + WS_PROJ), (const float*)(ws + WS_ROPE), gl, (LAS float*)(lds + LDS_RING), ws + WS_IKF, ws + WS_KL8, (LAS float*)(lds + LDS_RING + 10240), gp::W8_INV, ws + WS_AV8, ws + WS_AK8};
        gp::gemm_phase<gp::EpiInproj, gp::StaticOrder, false, true>(lds, g, S, E);
    } SEAM(2);
    if (IN(3)) { int cvcur = 0;
        const bool dsa_first = (((int)blockIdx.x >> 3) & 1) != 0;
        if (!dsa_first) { FRESH(); da::phase(p, lds, tid, lane, wave, cvcur); }
        FRESH(); ds::phase<0>(p, lds, tid, lane, wave, cvcur);
        if (dsa_first) { FRESH(); da::phase(p, lds, tid, lane, wave, cvcur); }
        conv_expert_items(p, lds, lane, wave, cvcur, 1 << 20); } SEAM(3);
    if (IN(4)) { FRESH();
        gp::Gemm g{(const bf16_t*)(ws + WS_H), (const bf16_t*)(ws + WS_WOUTT), DM, DM, nullptr};
        gp::StaticOrder S; S.init(NTOK, DM, gridDim.x, blockIdx.x);
        gp::EpiResid E{p.in[0], (bf16_t*)(ws + WS_X1B), (const float*)(ws + WS_MOD)};
        gp::gemm_phase<gp::EpiResid, gp::StaticOrder, false>(lds, g, S, E);
    } SEAM(4);
    if (IN(5)) { FRESH(); phase_norm2(p, lds, tid, lane, wave); } SEAM(5);
    if (IN(6)) { FRESH(); phase_scatter(p, lds, tid, lane, wave); } SEAM(6);
    if (IN(7)) { FRESH();
        const int* tile_e = (const int*)(ws + WS_TILEE);
        gp::Gemm g{(const bf16_t*)(ws + WS_H), (const bf16_t*)(ws + WS_WGUT), 2048, DM / 2, (const int*)(ws + WS_ROWSRC)};
        gp::MoeOrder S{tile_e, tile_e[MAXTILES], 8, (int)blockIdx.x, (int)gridDim.x};
        gp::EpiSwiglu E{ws + WS_ACT, p.in[19], p.in[21]};
        gp::gemm_phase<gp::EpiSwiglu, gp::MoeOrder, true, true>(lds, g, S, E);
    } SEAM(7);
    if (IN(8)) { FRESH();
        const int* tile_e = (const int*)(ws + WS_TILEE);
        gp::Gemm g{(const bf16_t*)(ws + WS_ACT), (const bf16_t*)(ws + WS_WDT), DM, DM / 2, nullptr};
        gp::MoeOrder S{tile_e, tile_e[MAXTILES], 4, (int)blockIdx.x, (int)gridDim.x};
        gp::EpiDown E{ws + WS_Y, p.in[23], (const int2*)(ws + WS_ROWMETA)};
        gp::gemm_phase<gp::EpiDown, gp::MoeOrder, false, true>(lds, g, S, E);
    } SEAM(8);
    if (IN(9)) { FRESH(); phase_combine(p, tid); }
#undef IN
#undef SEAM
}

static int g_grid = 0;
static void launch_mega(const Params& base, int lo, int hi, hipStream_t stream) {
    Params p = base; p.ph_lo = lo; p.ph_hi = hi;
    void* args[] = {&p};
    hipError_t e = hipLaunchCooperativeKernel((const void*)mega, dim3(g_grid), dim3(NTHREADS), args, LDS_BYTES, stream);
    if (e != hipSuccess) fprintf(stderr, "kernel_launch: cooperative launch [%d,%d) failed: %s (grid %d)\n", lo, hi, hipGetErrorString(e), g_grid);
}
extern "C" void kernel_launch(void* const* d_in, const int* in_sizes, int n_in, void* d_out, int out_size, void* d_ws, size_t ws_size, hipStream_t stream) {
    if (ws_size < WS_END) { fprintf(stderr, "kernel_launch: workspace too small: %zu < %zu\n", ws_size, (size_t)WS_END); return; }
    if (g_grid == 0) {
        int dev = 0, cus = 0, per_cu = 0;
        hipGetDevice(&dev); hipDeviceGetAttribute(&cus, hipDeviceAttributeMultiprocessorCount, dev);
        if (hipFuncSetAttribute((const void*)mega, hipFuncAttributeMaxDynamicSharedMemorySize, LDS_BYTES) != hipSuccess) fprintf(stderr, "kernel_launch: hipFuncSetAttribute failed\n");
        hipOccupancyMaxActiveBlocksPerMultiprocessor(&per_cu, (const void*)mega, NTHREADS, LDS_BYTES);
        (void)hipGetLastError();
        if (per_cu < 1) { fprintf(stderr, "kernel_launch: occupancy query says %d blocks/CU\n", per_cu); per_cu = 1; }
        g_grid = cus * 1;
        fprintf(stderr, "kernel_launch: cus %d per_cu %d grid %d\n", cus, per_cu, g_grid);
    }
    const float* x = (const float*)d_in[0];
    float* out = (float*)d_out; char* ws = (char*)d_ws;
    float* mod = (float*)(ws + WS_MOD); float* rope = (float*)(ws + WS_ROPE); float* lam = (float*)(ws + WS_LAM);
    float* IW = (float*)(ws + WS_IW);
    bf16_t* H = (bf16_t*)(ws + WS_H); bf16_t* PROJ = (bf16_t*)(ws + WS_PROJ);
    Params P{};
    for (int i = 0; i < 24; ++i) P.in[i] = (const float*)d_in[i];
    P.out = out; P.ws = (unsigned char*)d_ws;

    (void)hipMemsetAsync((char*)d_ws + WS_CTL, 0, 16384, stream);
    launch_mega(P, 0, N_PHASES, stream);
    (void)rope; (void)lam; (void)IW; (void)H; (void)PROJ;
    (void)x; (void)mod;
}
```
